# Optimizing an MI355X kernel written in HIP

```python
import jax, jax.numpy as jnp
from jax import lax
import numpy as np

D_MODEL = 2048
BATCH = 4
SEQ = 4096
DEPTH = 2

HEAD_DIM = 64
A_HEADS = D_MODEL // 128
A_KV_HEADS = A_HEADS // 8
A_WINDOW = 128
ROPE_THETA = 150000.0
B_HEADS = D_MODEL // 128
B_KV_HEADS = B_HEADS // 8
CMP_LEN = 32
CMP_STRIDE = 16
CMP_HIDDEN = 256
SEL_BLOCK = 64
SEL_TOPK = 16
SEL_LOCAL = 2
B_WINDOW = 512
Q_BLOCK = 128
NSA_CHUNK = 64
A_Q_W = A_HEADS * HEAD_DIM
A_KV_W = A_KV_HEADS * HEAD_DIM
B_Q_W = B_HEADS * HEAD_DIM
B_KV_W = B_KV_HEADS * HEAD_DIM
B_GATE_W = 3 * B_HEADS
IN_COLS = A_Q_W + 2 * A_KV_W + B_Q_W + 6 * B_KV_W + B_GATE_W
MIX_W = A_Q_W + B_Q_W
RWKV_N = 64
RWKV_H = D_MODEL // RWKV_N
DECAY_LORA = 96
ICLR_LORA = 96
GATE_LORA = 256
D_FF = 11 * D_MODEL // 4
N_EXPERTS = 8
TOP_K = 2
D_FF_EXPERT = 7 * D_MODEL // 2
N_EVEN = (DEPTH + 1) // 2
N_ODD = DEPTH // 2
RMS_EPS = 1e-5
GN_EPS = 64e-5
NEG_INF = -1e30
FORCE = 1e9

kernel_name = 'hybrid_swa_nsa_rwkv7_moe_trunk'


def rmsnorm(x, g):
    xf = x.astype(jnp.float32)
    y = xf * lax.rsqrt(jnp.mean(xf * xf, axis=-1, keepdims=True) + RMS_EPS)
    return (y * g.astype(jnp.float32)).astype(x.dtype)


def swiglu(x, w13, w2):
    gate, up = jnp.split(x @ w13, 2, axis=-1)
    return (jax.nn.silu(gate) * up) @ w2


def rope(x, positions):
    half = HEAD_DIM // 2
    inv = ROPE_THETA ** (-jnp.arange(half, dtype=jnp.float32) / half)
    ang = positions.astype(jnp.float32)[..., None] * inv
    cos, sin = jnp.cos(ang)[:, :, None, :], jnp.sin(ang)[:, :, None, :]
    xf = x.astype(jnp.float32)
    x1, x2 = xf[..., :half], xf[..., half:]
    return jnp.concatenate([x1 * cos - x2 * sin, x2 * cos + x1 * sin], axis=-1).astype(x.dtype)


def masked_softmax(s, mask, axis):
    s = jnp.where(mask, s, NEG_INF)
    m = jnp.max(s, axis=axis, keepdims=True)
    p = jnp.where(mask, jnp.exp(s - m), 0.0)
    return p / jnp.maximum(jnp.sum(p, axis=axis, keepdims=True), 1e-30)


def banded_attention(q, k, v, window, sink_logits=None):
    B, T, Hkv, G, D = q.shape
    span = window + Q_BLOCK
    k_pad = jnp.pad(k, ((0, 0), (window, 0), (0, 0), (0, 0)))
    v_pad = jnp.pad(v, ((0, 0), (window, 0), (0, 0), (0, 0)))
    i = jnp.arange(Q_BLOCK)[:, None]
    j = jnp.arange(span)[None, :]
    band = (j > i) & (j <= i + window)
    scale = D ** -0.5

    def one_block(start):
        qb = lax.dynamic_slice_in_dim(q, start, Q_BLOCK, axis=1)
        kb = lax.dynamic_slice_in_dim(k_pad, start, span, axis=1)
        vb = lax.dynamic_slice_in_dim(v_pad, start, span, axis=1)
        s = jnp.einsum('bqhgd,bkhd->bhgqk', qb, kb, preferred_element_type=jnp.float32) * scale
        valid = band & (start - window + j >= 0)
        s = jnp.where(valid, s, NEG_INF)
        m = jnp.max(s, axis=-1, keepdims=True)
        if sink_logits is not None:
            sink = sink_logits.astype(jnp.float32)[None, :, :, None, None]
            m = jnp.maximum(m, sink)
            p = jnp.exp(s - m)
            p = p / (jnp.sum(p, axis=-1, keepdims=True) + jnp.exp(sink - m))
        else:
            p = jnp.exp(s - m)
            p = p / jnp.sum(p, axis=-1, keepdims=True)
        return jnp.einsum('bhgqk,bkhd->bqhgd', p.astype(vb.dtype), vb)

    out = lax.map(one_block, jnp.arange(T // Q_BLOCK) * Q_BLOCK)
    return jnp.moveaxis(out, 0, 1).reshape(B, T, Hkv, G, D)


def nsa_compress(kv, pe, w1, b1, w2):
    B, T, Hkv, D = kv.shape
    sub = kv.reshape(B, T // CMP_STRIDE, CMP_STRIDE, Hkv, D)
    blocks = jnp.concatenate([sub[:, :-1], sub[:, 1:]], axis=2)
    blocks = blocks + pe[None, None, :, None, :]
    Nc = blocks.shape[1]
    flat = jnp.moveaxis(blocks, 3, 2).reshape(B, Nc, Hkv, CMP_LEN * D)
    hid = jax.nn.silu(jnp.einsum('bchi,ij->bchj', flat, w1) + b1)
    return jnp.einsum('bchj,jd->bchd', hid, w2)


def nsa_compressed_and_selected(q, kc, vc, k_sel, v_sel):
    B, T, Hkv, G, D = q.shape
    Nc = kc.shape[1]
    n_blocks = T // SEL_BLOCK
    n_sel = min(SEL_TOPK, n_blocks)
    scale = D ** -0.5
    c_start = jnp.arange(Nc) * CMP_STRIDE
    c_end = c_start + CMP_LEN - 1
    s_start = jnp.arange(n_blocks) * SEL_BLOCK
    overlap = ((c_start[:, None] <= s_start[None, :] + SEL_BLOCK - 1)
               & (c_end[:, None] >= s_start[None, :])).astype(jnp.float32)
    kb = k_sel.reshape(B, n_blocks, SEL_BLOCK, Hkv, D).transpose(0, 3, 1, 2, 4)
    vb = v_sel.reshape(B, n_blocks, SEL_BLOCK, Hkv, D).transpose(0, 3, 1, 2, 4)
    gather = jax.vmap(jax.vmap(lambda blocks, idx: blocks[idx]))
    blk = jnp.arange(n_blocks)[None, :]

    def one_chunk(start):
        qc = lax.dynamic_slice_in_dim(q, start, NSA_CHUNK, axis=1)
        t = start + jnp.arange(NSA_CHUNK)
        s = jnp.einsum('bqhgd,bchd->bhgqc', qc, kc, preferred_element_type=jnp.float32) * scale
        p_cmp = masked_softmax(s, c_end[None, :] <= t[:, None], axis=-1)
        o_cmp = jnp.einsum('bhgqc,bchd->bqhgd', p_cmp.astype(vc.dtype), vc)
        imp = jnp.einsum('bhgqc,cn->bhqn', p_cmp, overlap)
        cur = (t // SEL_BLOCK)[:, None]
        forced = (blk == 0) | ((blk <= cur) & (blk > cur - SEL_LOCAL))
        imp = jnp.where(blk > cur, -FORCE, jnp.where(forced, FORCE, imp))
        _, idx = lax.top_k(imp, n_sel)
        kg = gather(kb, idx)
        vg = gather(vb, idx)
        kpos = idx[..., None] * SEL_BLOCK + jnp.arange(SEL_BLOCK)
        smask = (kpos <= t[None, None, :, None, None])[:, :, None]
        s2 = jnp.einsum('bqhgd,bhqnkd->bhgqnk', qc, kg, preferred_element_type=jnp.float32) * scale
        p_sel = masked_softmax(s2, smask, axis=(-2, -1))
        o_sel = jnp.einsum('bhgqnk,bhqnkd->bqhgd', p_sel.astype(vg.dtype), vg)
        return o_cmp, o_sel

    o_cmp, o_sel = lax.map(one_chunk, jnp.arange(T // NSA_CHUNK) * NSA_CHUNK)
    fix = lambda o: jnp.moveaxis(o, 0, 1).reshape(B, T, Hkv, G, D)
    return fix(o_cmp), fix(o_sel)


def attention_mix(h, positions, w_in, w_out, sinks, cmp_pe, cmp_w1, cmp_b1, cmp_w2):
    B, T, _ = h.shape
    ga, gb = A_HEADS // A_KV_HEADS, B_HEADS // B_KV_HEADS
    sizes = (A_Q_W, A_KV_W, A_KV_W, B_Q_W) + (B_KV_W,) * 6 + (B_GATE_W,)
    offsets = np.cumsum(sizes)[:-1].tolist()
    (qa, ka, va, qb, kcmp, vcmp, ksel, vsel, kwin, vwin, gates) = jnp.split(h @ w_in, offsets, axis=-1)
    qa = rope(qa.reshape(B, T, A_HEADS, HEAD_DIM), positions).reshape(B, T, A_KV_HEADS, ga, HEAD_DIM)
    ka = rope(ka.reshape(B, T, A_KV_HEADS, HEAD_DIM), positions)
    va = va.reshape(B, T, A_KV_HEADS, HEAD_DIM)
    o_a = banded_attention(qa, ka, va, A_WINDOW, sinks.reshape(A_KV_HEADS, ga))
    kvh = lambda z: z.reshape(B, T, B_KV_HEADS, HEAD_DIM)
    qb = qb.reshape(B, T, B_KV_HEADS, gb, HEAD_DIM)
    kc = nsa_compress(kvh(kcmp), cmp_pe[0], cmp_w1[0], cmp_b1[0], cmp_w2[0])
    vc = nsa_compress(kvh(vcmp), cmp_pe[1], cmp_w1[1], cmp_b1[1], cmp_w2[1])
    o_cmp, o_sel = nsa_compressed_and_selected(qb, kc, vc, kvh(ksel), kvh(vsel))
    o_win = banded_attention(qb, kvh(kwin), kvh(vwin), B_WINDOW)
    g = jax.nn.sigmoid(gates.astype(jnp.float32)).reshape(B, T, B_KV_HEADS, gb, 3, 1)
    o_b = g[..., 0, :] * o_cmp + g[..., 1, :] * o_sel + g[..., 2, :] * o_win
    o = jnp.concatenate([o_a.reshape(B, T, A_Q_W), o_b.reshape(B, T, B_Q_W).astype(h.dtype)], axis=-1)
    return o @ w_out


def rwkv7_time_mix(h, mu, w_rkv, w0, w1, w2, a0, a1, a2, g1, g2, k_k, k_a, r_k, ln_w, ln_b, w_o):
    B, T, C = h.shape
    f32 = jnp.float32
    xx = jnp.pad(h, ((0, 0), (1, 0), (0, 0)))[:, :-1] - h
    xs = h[None] + xx[None] * mu[:, None, None, :]
    r, k, v = jnp.einsum('ibtc,icd->ibtd', xs[:3], w_rkv)
    xw, xa, xg = xs[3], xs[4], xs[5]
    w_log = -jax.nn.softplus(-(w0 + jnp.tanh(xw @ w1) @ w2).astype(f32)) - 0.5
    decay = jnp.exp(-jnp.exp(w_log))
    a = jax.nn.sigmoid((a0 + (xa @ a1) @ a2).astype(f32))
    g = jax.nn.sigmoid(xg @ g1) @ g2
    heads = lambda z: z.astype(f32).reshape(B, T, RWKV_H, RWKV_N)
    kk = heads(k * k_k)
    kk = kk / jnp.maximum(jnp.sqrt(jnp.sum(kk * kk, axis=-1, keepdims=True)), 1e-12)
    k = k.astype(f32) * (1.0 + (a - 1.0) * k_a.astype(f32))
    r_h, k_h, v_h, w_h, a_h = heads(r), heads(k), heads(v), heads(decay), heads(a)

    def step(S, inp):
        r_t, w_t, k_t, v_t, kk_t, a_t = inp
        sa = jnp.einsum('bhvk,bhk->bhv', S, -kk_t)
        S = (S * w_t[:, :, None, :] + sa[..., None] * (kk_t * a_t)[:, :, None, :]
             + v_t[..., None] * k_t[:, :, None, :])
        return S, jnp.einsum('bhvk,bhk->bhv', S, r_t)

    tm = lambda z: jnp.moveaxis(z, 1, 0)
    S0 = jnp.zeros((B, RWKV_H, RWKV_N, RWKV_N), f32)
    _, y = lax.scan(step, S0, (tm(r_h), tm(w_h), tm(k_h), tm(v_h), tm(kk), tm(a_h)))
    y = jnp.moveaxis(y, 0, 1)
    mean = jnp.mean(y, axis=-1, keepdims=True)
    var = jnp.mean(jnp.square(y - mean), axis=-1, keepdims=True)
    y = (y - mean) * lax.rsqrt(var + GN_EPS)
    y = y * ln_w.astype(f32).reshape(RWKV_H, RWKV_N) + ln_b.astype(f32).reshape(RWKV_H, RWKV_N)
    y = y + jnp.sum(r_h * k_h * r_k.astype(f32), axis=-1, keepdims=True) * v_h
    return (y.reshape(B, T, C).astype(h.dtype) * g) @ w_o


def moe_swiglu(h, router_w, w13, w2):
    B, T, C = h.shape
    hf = h.reshape(B * T, C)
    logits = (hf @ router_w).astype(jnp.float32)
    top_vals, top_idx = lax.top_k(logits, TOP_K)
    top_w = jax.nn.softmax(top_vals, axis=-1)
    combine = jnp.sum(jax.nn.one_hot(top_idx, N_EXPERTS, dtype=jnp.float32) * top_w[..., None], axis=1)
    out = jnp.zeros((B * T, C), jnp.float32)
    for e in range(N_EXPERTS):
        out = out + combine[:, e:e + 1] * swiglu(hf, w13[e], w2[e])
    return out.reshape(B, T, C).astype(h.dtype)


def setup_inputs(seed: int = 0) -> dict:
    key = jax.random.key(seed)
    ks = iter(jax.random.split(key, 48))
    D = D_MODEL

    def nrm(shape, scale):
        return jax.random.normal(next(ks), shape, jnp.float32) * scale

    def unif(shape, lo, hi):
        return jax.random.uniform(next(ks), shape, jnp.float32, lo, hi)

    return {
        'x': nrm((BATCH, SEQ, D), 1.0),
        'positions': jnp.broadcast_to(jnp.arange(SEQ, dtype=jnp.int32), (BATCH, SEQ)),
        'attn_norm': 1.0 + nrm((DEPTH, D), 0.05),
        'ffn_norm': 1.0 + nrm((DEPTH, D), 0.05),
        'final_norm': 1.0 + nrm((D,), 0.05),
        'w_in': nrm((N_EVEN, D, IN_COLS), D ** -0.5),
        'w_out': nrm((N_EVEN, MIX_W, D), MIX_W ** -0.5),
        'sinks': nrm((N_EVEN, A_HEADS), 0.5),
        'cmp_pe': nrm((N_EVEN, 2, CMP_LEN, HEAD_DIM), 0.1),
        'cmp_w1': nrm((N_EVEN, 2, CMP_LEN * HEAD_DIM, CMP_HIDDEN), (CMP_LEN * HEAD_DIM) ** -0.5),
        'cmp_b1': nrm((N_EVEN, 2, CMP_HIDDEN), 0.01),
        'cmp_w2': nrm((N_EVEN, 2, CMP_HIDDEN, HEAD_DIM), CMP_HIDDEN ** -0.5),
        'ffn_w13': nrm((N_EVEN, D, 2 * D_FF), D ** -0.5),
        'ffn_w2': nrm((N_EVEN, D_FF, D), D_FF ** -0.5),
        'tmix_mu': unif((N_ODD, 6, D), 0.0, 1.0),
        'tmix_w_rkv': nrm((N_ODD, 3, D, D), D ** -0.5),
        'decay_w0': unif((N_ODD, D), -6.5, -1.5),
        'decay_w1': nrm((N_ODD, D, DECAY_LORA), D ** -0.5),
        'decay_w2': nrm((N_ODD, DECAY_LORA, D), 0.5 * DECAY_LORA ** -0.5),
        'iclr_a0': nrm((N_ODD, D), 0.5),
        'iclr_a1': nrm((N_ODD, D, ICLR_LORA), D ** -0.5),
        'iclr_a2': nrm((N_ODD, ICLR_LORA, D), ICLR_LORA ** -0.5),
        'gate_g1': nrm((N_ODD, D, GATE_LORA), D ** -0.5),
        'gate_g2': nrm((N_ODD, GATE_LORA, D), GATE_LORA ** -0.5),
        'k_k': 0.85 + nrm((N_ODD, D), 0.05),
        'k_a': 1.0 + nrm((N_ODD, D), 0.05),
        'r_k': nrm((N_ODD, RWKV_H, RWKV_N), 0.1),
        'ln_x_w': 1.0 + nrm((N_ODD, D), 0.05),
        'ln_x_b': nrm((N_ODD, D), 0.01),
        'tmix_w_o': nrm((N_ODD, D, D), D ** -0.5),
        'router_w': nrm((N_ODD, D, N_EXPERTS), D ** -0.5),
        'moe_w13': nrm((N_ODD, N_EXPERTS, D, 2 * D_FF_EXPERT), D ** -0.5),
        'moe_w2': nrm((N_ODD, N_EXPERTS, D_FF_EXPERT, D), D_FF_EXPERT ** -0.5),
    }


def reference(x, positions, attn_norm, ffn_norm, final_norm, w_in, w_out, sinks, cmp_pe, cmp_w1,
              cmp_b1, cmp_w2, ffn_w13, ffn_w2, tmix_mu, tmix_w_rkv, decay_w0, decay_w1, decay_w2,
              iclr_a0, iclr_a1, iclr_a2, gate_g1, gate_g2, k_k, k_a, r_k, ln_x_w, ln_x_b, tmix_w_o,
              router_w, moe_w13, moe_w2):
    h = x
    for layer in range(DEPTH):
        i = layer // 2
        if layer % 2 == 0:
            h = h + attention_mix(rmsnorm(h, attn_norm[layer]), positions, w_in[i], w_out[i], sinks[i],
                                  cmp_pe[i], cmp_w1[i], cmp_b1[i], cmp_w2[i])
            h = h + swiglu(rmsnorm(h, ffn_norm[layer]), ffn_w13[i], ffn_w2[i])
        else:
            h = h + rwkv7_time_mix(rmsnorm(h, attn_norm[layer]), tmix_mu[i], tmix_w_rkv[i], decay_w0[i],
                                   decay_w1[i], decay_w2[i], iclr_a0[i], iclr_a1[i], iclr_a2[i],
                                   gate_g1[i], gate_g2[i], k_k[i], k_a[i], r_k[i], ln_x_w[i], ln_x_b[i],
                                   tmix_w_o[i])
            h = h + moe_swiglu(rmsnorm(h, ffn_norm[layer]), router_w[i], moe_w13[i], moe_w2[i])
    return rmsnorm(h, final_norm)
```

```cpp
#include <hip/hip_runtime.h>
#include <cstdio>
#include <cstdint>

#define GAS __attribute__((address_space(1)))
#define LAS __attribute__((address_space(3)))
typedef unsigned short bf16_t;
typedef short bf16x8 __attribute__((ext_vector_type(8)));
typedef short s16x4 __attribute__((ext_vector_type(4)));
typedef float f32x4 __attribute__((ext_vector_type(4)));
typedef float f32x2 __attribute__((ext_vector_type(2)));
typedef float f32x16 __attribute__((ext_vector_type(16)));
typedef unsigned u32x4 __attribute__((ext_vector_type(4)));
typedef unsigned u32x2 __attribute__((ext_vector_type(2)));
typedef __bf16 bf16x2_t __attribute__((ext_vector_type(2)));
#define DI __device__ __forceinline__

#ifndef MK_N_LAUNCHES
#define MK_N_LAUNCHES 1
#endif

constexpr int BATCH = 4, SEQ = 4096, DM = 2048, M = BATCH * SEQ;
constexpr int NP = 3328;
constexpr int IN_COLS = 3120;
constexpr int C_QA = 0, C_KA = 1024, C_VA = 1152, C_QB = 1280, C_KCMP = 2304, C_VCMP = 2432, C_KSEL = 2560, C_VSEL = 2688, C_KWIN = 2816, C_VWIN = 2944, C_GATE = 3072;
constexpr int DFF = 5632, DFFE = 7168, NEXP = 8;
constexpr float RMS_EPS = 1e-5f, GN_EPS = 64e-5f;
constexpr float LOG2E = 1.4426950408889634f;
constexpr float QSCALE = 0.125f * LOG2E;
constexpr int NWAVES = 8, NTHR = 512;
constexpr int MOE_ROWS = 2 * M + NEXP * 256;

constexpr size_t MiB = 1u << 20;
constexpr size_t al(size_t x) { return (x + 0xFFFFF) & ~(size_t)0xFFFFF; }
constexpr size_t WS_CTL = 0, CTL_ZERO_BYTES = 1 * MiB;
constexpr size_t WS_W_IN = 1 * MiB;
constexpr size_t WS_W_OUT = WS_W_IN + al((size_t)NP * DM * 2);
constexpr size_t WS_CMPW1 = WS_W_OUT + al((size_t)DM * DM * 2);
constexpr size_t WS_FFN13 = WS_CMPW1 + al((size_t)2 * 256 * 2048 * 2);
constexpr size_t WS_FFN2 = WS_FFN13 + al((size_t)2 * DFF * DM * 2);
constexpr size_t WS_WRKV = WS_FFN2 + al((size_t)DM * DFF * 2);
constexpr size_t WS_LORA1 = WS_WRKV + al((size_t)3 * DM * DM * 2);
constexpr size_t WS_LORA2 = WS_LORA1 + al((size_t)3 * 256 * DM * 2);
constexpr size_t WS_WO = WS_LORA2 + al((size_t)3 * DM * 256 * 2);
constexpr size_t WS_MOE13 = WS_WO + al((size_t)DM * DM * 2);
constexpr size_t WS_MOE2 = WS_MOE13 + al((size_t)NEXP * 2 * DFFE * DM * 2);
constexpr size_t WS_XN = WS_MOE2 + al((size_t)NEXP * DM * DFFE * 2);
constexpr size_t WS_P = WS_XN + al((size_t)M * DM * 2);
constexpr size_t WS_ROPE = WS_P + al((size_t)(M + 64) * NP * 2);
constexpr size_t WS_CMPB = WS_ROPE + al((size_t)M * 64 * 4);
constexpr size_t WS_HID = WS_CMPB + MiB;
constexpr size_t WS_KVC = WS_HID + al((size_t)2 * 2048 * 256 * 2);
constexpr size_t WS_O = WS_KVC + al((size_t)2 * 2048 * 64 * 2);
constexpr size_t WS_H = WS_O + al((size_t)M * DM * 2);
constexpr size_t WS_ACT = WS_H + al((size_t)M * DM * 4);
constexpr size_t WS_XS = WS_ACT + al((size_t)MOE_ROWS * DFFE * 2);
constexpr size_t WS_RKV = WS_XS + al((size_t)6 * M * DM * 2);
constexpr size_t WS_L1 = WS_RKV + al((size_t)3 * M * DM * 2);
constexpr size_t WS_DEC = WS_L1 + al((size_t)3 * M * 256 * 2);
constexpr size_t WS_AA = WS_DEC + al((size_t)M * DM * 4);
constexpr size_t WS_GG = WS_AA + al((size_t)M * DM * 4);
constexpr size_t WS_YRAW = WS_GG + al((size_t)M * DM * 2);
constexpr size_t WS_YG = WS_YRAW + al((size_t)M * DM * 4);
constexpr size_t WS_ROWTOK = WS_YG + al((size_t)M * DM * 2);
constexpr size_t WS_TOKSLOT = WS_ROWTOK + al((size_t)NEXP * M * 4);
constexpr size_t WS_Y2 = WS_TOKSLOT + al((size_t)M * 16);
constexpr size_t WS_END = WS_Y2 + al((size_t)MOE_ROWS * DM * 4);
constexpr int CW_BAR = 0;
constexpr int CW_MOECNT = 4096;

constexpr int RING_BYTES = 131072, LDSCTL_OFF = RING_BYTES, MISC_OFF = LDSCTL_OFF + 320, LDS_BYTES = 147456;

#define RLX_AGENT __ATOMIC_RELAXED, __HIP_MEMORY_SCOPE_AGENT
DI unsigned f2bf(float f) { unsigned u = __builtin_bit_cast(unsigned, f); return (u + 0x7fffu + ((u >> 16) & 1u)) >> 16; }
DI unsigned pk2(float lo, float hi) { f32x2 v = {lo, hi}; bf16x2_t b = __builtin_convertvector(v, bf16x2_t); return __builtin_bit_cast(unsigned, b); }
DI float bf2f(unsigned short b) { return __builtin_bit_cast(float, ((unsigned)b) << 16); }
DI float bflo(unsigned w) { return __builtin_bit_cast(float, w << 16); }
DI float bfhi(unsigned w) { return __builtin_bit_cast(float, w & 0xffff0000u); }
DI float wave_sum(float v) {
#pragma unroll
    for (int o = 1; o < 64; o <<= 1) v += __shfl_xor(v, o);
    return v;
}
DI int opq(int x) { asm volatile("" : "+v"(x)); return x; }
DI float ex2(float x) { return __builtin_amdgcn_exp2f(x); }
DI float sigmoidf_(float x) { return 1.0f / (1.0f + __expf(-x)); }
DI float siluf_(float x) { return x / (1.0f + __expf(-x)); }
DI float tanhf_(float x) { return 1.0f - 2.0f / (__expf(2.0f * x) + 1.0f); }

#define XB_TMO      128
#define XB_XCNT(j)  (256  + 64 * (j))
#define XB_XSUB(j)  (1280 + 64 * (j))
#define XB_XGEN(j)  (2304 + 64 * (j))
#define XB_TOP      3328
#define XB_TOPGEN   3392
#define XCD_BAR_WORDS 3456
#define XB_SPIN_CAP (1u << 22)
DI unsigned xb_ld(unsigned* p)              { return __hip_atomic_load(p, __ATOMIC_RELAXED, __HIP_MEMORY_SCOPE_AGENT); }
DI unsigned xb_add(unsigned* p, unsigned v) { return __hip_atomic_fetch_add(p, v, __ATOMIC_RELAXED, __HIP_MEMORY_SCOPE_AGENT); }
DI unsigned xb_xcc_id() { return (unsigned)__builtin_amdgcn_s_getreg((3 << 11) | 20) & 0xFu; }
#define XB_SPIN(cond, bar) do { unsigned _sp = 0; while (cond) { __builtin_amdgcn_s_sleep(1); \
    if ((++_sp & 255u) == 0u) { if (xb_ld(&(bar)[XB_TMO])) break; if (_sp > XB_SPIN_CAP) { atomicAdd(&(bar)[XB_TMO], 1u); break; } } } } while (0)
struct XcdBarrier { unsigned* bar; unsigned x; volatile LAS unsigned* st; };
DI XcdBarrier xcd_barrier_post(unsigned* bar, volatile LAS unsigned* st) {
    XcdBarrier b; b.bar = bar; b.x = xb_xcc_id(); b.st = st;
    if (threadIdx.x == 0) (void)xb_add(&bar[XB_XCNT(b.x)], 1u);
    return b;
}
DI void xcd_barrier_complete(unsigned* bar, unsigned x, unsigned& nloc, unsigned& nx) {
    const unsigned G = gridDim.x * gridDim.y * gridDim.z;
    unsigned sum, cnt, mine, sp = 0u;
    for (;;) {
        sum = 0u; cnt = 0u; mine = 0u;
#pragma unroll
        for (unsigned j = 0; j < 16; ++j) { const unsigned c = xb_ld(&bar[XB_XCNT(j)]); sum += c; cnt += (c > 0u) ? 1u : 0u; mine = (j == x) ? c : mine; }
        if (sum == G) break;
        __builtin_amdgcn_s_sleep(1);
        if ((++sp & 255u) == 0u) { if (xb_ld(&bar[XB_TMO])) break; if (sp > XB_SPIN_CAP) { atomicAdd(&bar[XB_TMO], 1u); break; } }
    }
    nloc = mine > 0u ? mine : 1u; nx = cnt > 0u ? cnt : 1u;
}
DI void xcd_barrier(const XcdBarrier& b) {
    asm volatile("s_waitcnt vmcnt(0)" ::: "memory");
    __syncthreads();
    if (threadIdx.x == 0) {
        unsigned* bar = b.bar;
        __builtin_amdgcn_s_waitcnt(0);
        unsigned nloc = b.st[0], nx = b.st[1];
        if (nloc == 0u) { xcd_barrier_complete(bar, b.x, nloc, nx); b.st[0] = nloc; b.st[1] = nx; }
        const unsigned old = xb_add(&bar[XB_XSUB(b.x)], 1u);
        const unsigned gen = old / nloc;
        if (old + 1u == (gen + 1u) * nloc) {
            __builtin_amdgcn_fence(__ATOMIC_RELEASE, "agent");
            asm volatile("s_waitcnt vmcnt(0)" ::: "memory");
            const unsigned og = xb_add(&bar[XB_TOP], 1u);
            const unsigned tg = og / nx;
            if (og + 1u == (tg + 1u) * nx) xb_add(&bar[XB_TOPGEN], 1u);
            else XB_SPIN(xb_ld(&bar[XB_TOPGEN]) == tg, bar);
            __builtin_amdgcn_fence(__ATOMIC_ACQUIRE, "agent");
            xb_add(&bar[XB_XGEN(b.x)], 1u);
            asm volatile("s_waitcnt vmcnt(0)" ::: "memory");
        } else {
            XB_SPIN(xb_ld(&bar[XB_XGEN(b.x)]) == gen, bar);
            __builtin_amdgcn_fence(__ATOMIC_ACQUIRE, "agent");
            asm volatile("s_waitcnt vmcnt(0)" ::: "memory");
        }
    }
    __syncthreads();
}

namespace pg8 {
constexpr int BM = 256, BK = 64, HALF = 128, HTB = HALF * BK * 2, STAGE_BYTES = 8 * HTB, NXCD = 8, WGM = 8;
__host__ __device__ __forceinline__ int lds_byte(int r, int c) { const int st = (r >> 4) * 2 + (c >> 5), rr = r & 15, cc = c & 31, ob = rr * 64 + cc * 2; return st * 1024 + (ob ^ (((ob >> 9) & 1) << 5)); }
__host__ __device__ __forceinline__ void stage_rc(int b, int& R, int& C) { const int st = b / 1024, sb = b % 1024, swz = sb ^ (((sb >> 9) & 1) << 5); R = (st >> 1) * 16 + swz / 64; C = (st & 1) * 32 + (swz % 64) / 2; }
__host__ __device__ __forceinline__ int perm32(int rho) { const int n = rho >> 4, i = rho & 15; return 8 * (i >> 2) + 4 * n + (i & 3); }

struct Unit { const char* a; const char* b; int pm, pn, g; };

DI int xcd_remap(int L, int nwg) { const int q = nwg / NXCD, r = nwg % NXCD, xcd = L % NXCD, off = L / NXCD; return (xcd < r ? xcd * (q + 1) : r * (q + 1) + (xcd - r) * q) + off; }
DI void tile_map(int idx, int nM, int nN, int& pm, int& pn) { const int nig = WGM * nN, gid = idx / nig, fm = gid * WGM, gsz = (nM - fm) < WGM ? (nM - fm) : WGM; pm = fm + ((idx % nig) % gsz); pn = (idx % nig) / gsz; }

template <class Epi, class Sched, bool GATHER>
DI void gemm_phase(LAS unsigned char* lds, const unsigned lda, const unsigned ka, const unsigned ldb, const int nt, const Sched& S, const Epi& E) {
    const int tid = threadIdx.x, wid = __builtin_amdgcn_readfirstlane(tid >> 6), lane = tid & 63, wr = wid >> 2, wc = wid & 3, fr = lane & 15, fq = lane >> 4;
    int Rr[2], Cc[2];
    unsigned vB[2], vA[2][2], vN[2][2];
#pragma unroll
    for (int i = 0; i < 2; ++i) { stage_rc(tid * 16 + i * 8192, Rr[i], Cc[i]); const int Rb = (Rr[i] & ~31) + perm32(Rr[i] & 31); vB[i] = (unsigned)Rb * ldb + (unsigned)Cc[i] * 2u; }
    const size_t kb = (size_t)(BK * 2);
    const size_t hB = (size_t)HALF * ldb;
    const unsigned ldsw = (unsigned)wid * 1024u;
    const int aoff = lds_byte(wr * 64 + fr, fq * 8), boff = lds_byte(wc * 32 + fr, fq * 8);
#define PG8_SA(b, h) (((b) * 2 + (h)) * HTB)
#define PG8_SB(b, h) ((4 + (b) * 2 + (h)) * HTB)
#define PG8_STAGE(bufoff, gbase, v0, v1) do { \
        __builtin_amdgcn_global_load_lds((const unsigned*)((const char*)(gbase) + (v0)), (LAS unsigned*)(lds + (bufoff) + ldsw), 16, 0, 0); \
        __builtin_amdgcn_global_load_lds((const unsigned*)((const char*)(gbase) + (v1)), (LAS unsigned*)(lds + (bufoff) + ldsw + 8192), 16, 0, 0); } while (0)
#define PG8_LDA(dst, b, h) do { _Pragma("unroll") for (int m = 0; m < 4; ++m) _Pragma("unroll") for (int k = 0; k < 2; ++k) dst[m][k] = *(const LAS bf16x8*)(lds + PG8_SA(b, h) + aoff + m * 2048 + k * 1024); } while (0)
#define PG8_LDB(dst, b, h) do { _Pragma("unroll") for (int n = 0; n < 2; ++n) _Pragma("unroll") for (int k = 0; k < 2; ++k) dst[n][k] = *(const LAS bf16x8*)(lds + PG8_SB(b, h) + boff + n * 2048 + k * 1024); } while (0)
#define PG8_MMA(ai, bj, At, Bt) do { __builtin_amdgcn_s_setprio(1); _Pragma("unroll") for (int m = 0; m < 4; ++m) _Pragma("unroll") for (int n = 0; n < 2; ++n) _Pragma("unroll") for (int k = 0; k < 2; ++k) \
        acc[ai][bj][m][n] = __builtin_amdgcn_mfma_f32_16x16x32_bf16(Bt[n][k], At[m][k], acc[ai][bj][m][n], 0, 0, 0); __builtin_amdgcn_s_setprio(0); } while (0)
#define PG8_WAIT_V(n) asm volatile("s_waitcnt vmcnt(" #n ")" ::: "memory")
#define PG8_WAIT_L(n) asm volatile("s_waitcnt lgkmcnt(" #n ")" ::: "memory")
#define PG8_BAR __builtin_amdgcn_s_barrier()
#define PG8_SCHED __builtin_amdgcn_sched_barrier(0)
    Unit cur, nxt; int ui = 0;
    if (!S.next(0, cur)) return;
#pragma unroll
    for (int h = 0; h < 2; ++h)
#pragma unroll
        for (int i = 0; i < 2; ++i) {
            if constexpr (GATHER) vA[h][i] = S.rowoff(cur, h * HALF + Rr[i]) + (unsigned)Cc[i] * 2u;
            else vA[h][i] = (unsigned)(h * HALF + Rr[i]) * lda + (unsigned)Cc[i] * 2u;
            vN[h][i] = vA[h][i];
        }
    f32x4 acc[2][2][4][2];
#pragma unroll
    for (int a = 0; a < 2; ++a)
#pragma unroll
        for (int b = 0; b < 2; ++b)
#pragma unroll
            for (int m = 0; m < 4; ++m)
#pragma unroll
                for (int n = 0; n < 2; ++n) acc[a][b][m][n] = (f32x4){0.f, 0.f, 0.f, 0.f};
    bf16x8 At[4][2], B0[2][2], B1[2][2];
    const char* cA = cur.a; const char* cB = cur.b;
    PG8_STAGE(PG8_SB(0, 0), cB, vB[0], vB[1]); PG8_STAGE(PG8_SB(0, 1), cB + hB, vB[0], vB[1]); PG8_STAGE(PG8_SA(0, 0), cA, vA[0][0], vA[0][1]); PG8_STAGE(PG8_SA(0, 1), cA, vA[1][0], vA[1][1]);
    if (wr == 1) PG8_BAR;
    PG8_WAIT_V(2); PG8_BAR;
    PG8_STAGE(PG8_SB(1, 0), cB + kb, vB[0], vB[1]); PG8_STAGE(PG8_SA(1, 0), cA + ka, vA[0][0], vA[0][1]); PG8_STAGE(PG8_SB(1, 1), cB + hB + kb, vB[0], vB[1]);
    PG8_WAIT_V(6); PG8_BAR;
    for (;;) {
        const bool has_next = S.next(ui + 1, nxt);
        const char* nA = has_next ? nxt.a : cA; const char* nB = has_next ? nxt.b : cB;
        if constexpr (GATHER) {
            if (has_next) {
#pragma unroll
                for (int h = 0; h < 2; ++h)
#pragma unroll
                    for (int i = 0; i < 2; ++i) vN[h][i] = S.rowoff(nxt, h * HALF + Rr[i]) + (unsigned)Cc[i] * 2u;
            }
        }
        for (int t = 0; t < nt; t += 2) {
            const bool last = (t == nt - 2);
            const char* a1 = cA + (size_t)(t + 1) * ka;
            const char* a2 = last ? nA : cA + (size_t)(t + 2) * ka; const char* b2 = last ? nB : cB + (size_t)(t + 2) * kb;
            const char* a3 = a2 + ka; const char* b3 = b2 + kb;
            unsigned x00 = vA[0][0], x01 = vA[0][1], x10 = vA[1][0], x11 = vA[1][1];
            if constexpr (GATHER) { if (last) { x00 = vN[0][0]; x01 = vN[0][1]; x10 = vN[1][0]; x11 = vN[1][1]; } }
            PG8_LDB(B0, 0, 0); PG8_LDB(B1, 0, 1); PG8_SCHED; PG8_LDA(At, 0, 0); PG8_STAGE(PG8_SA(1, 1), a1, vA[1][0], vA[1][1]);
            PG8_WAIT_V(8); PG8_WAIT_L(0); PG8_BAR; PG8_MMA(0, 0, At, B0); PG8_MMA(0, 1, At, B1); PG8_BAR; PG8_SCHED;
            PG8_LDA(At, 0, 1); PG8_STAGE(PG8_SB(0, 0), b2, vB[0], vB[1]); PG8_STAGE(PG8_SB(0, 1), b2 + hB, vB[0], vB[1]); PG8_STAGE(PG8_SA(0, 0), a2, x00, x01);
            PG8_WAIT_V(8); PG8_WAIT_L(0); PG8_BAR; PG8_MMA(1, 0, At, B0); PG8_MMA(1, 1, At, B1); PG8_BAR; PG8_SCHED;
            PG8_LDB(B0, 1, 0); PG8_LDB(B1, 1, 1); PG8_SCHED; PG8_LDA(At, 1, 0); PG8_STAGE(PG8_SA(0, 1), a2, x10, x11);
            PG8_WAIT_V(8); PG8_WAIT_L(0); PG8_BAR; PG8_MMA(0, 0, At, B0); PG8_MMA(0, 1, At, B1); PG8_BAR; PG8_SCHED;
            PG8_LDA(At, 1, 1); PG8_STAGE(PG8_SB(1, 0), b3, vB[0], vB[1]); PG8_STAGE(PG8_SB(1, 1), b3 + hB, vB[0], vB[1]); PG8_STAGE(PG8_SA(1, 0), a3, x00, x01);
            PG8_WAIT_V(8); PG8_WAIT_L(0); PG8_BAR; PG8_MMA(1, 0, At, B0); PG8_MMA(1, 1, At, B1); PG8_BAR; PG8_SCHED;
        }
        if (wr == 0) PG8_BAR;
        E(acc, cur, wr, wc, fr, fq);
        if (!has_next) break;
#pragma unroll
        for (int a = 0; a < 2; ++a)
#pragma unroll
            for (int b = 0; b < 2; ++b)
#pragma unroll
                for (int m = 0; m < 4; ++m)
#pragma unroll
                    for (int n = 0; n < 2; ++n) acc[a][b][m][n] = (f32x4){0.f, 0.f, 0.f, 0.f};
        cur = nxt; cA = nA; cB = nB; ++ui;
        if constexpr (GATHER) {
#pragma unroll
            for (int h = 0; h < 2; ++h)
#pragma unroll
                for (int i = 0; i < 2; ++i) vA[h][i] = vN[h][i];
        }
        if (wr == 1) PG8_BAR;
    }
    PG8_WAIT_V(0);
    PG8_BAR;
#undef PG8_SA
#undef PG8_SB
#undef PG8_STAGE
#undef PG8_LDA
#undef PG8_LDB
#undef PG8_MMA
#undef PG8_WAIT_V
#undef PG8_WAIT_L
#undef PG8_BAR
#undef PG8_SCHED
}
}

typedef f32x4 AccT[2][2][4][2];
DI void st_bf16x8(bf16_t* p, f32x4 v0, f32x4 v1) { u32x4 w; w.x = pk2(v0[0], v0[1]); w.y = pk2(v0[2], v0[3]); w.z = pk2(v1[0], v1[1]); w.w = pk2(v1[2], v1[3]); *(u32x4*)p = w; }

struct OrderSingle {
    const char* A; const char* Bt; unsigned lda, ldb; int nM, nN, nwg, G, c;
    DI bool next(int i, pg8::Unit& u) const {
        const long L = (long)i * G + c; if (L >= nwg) return false;
        const int w = pg8::xcd_remap((int)L, nwg); int pm, pn; pg8::tile_map(w, nM, nN, pm, pn);
        u.pm = pm; u.pn = pn; u.g = 0; u.a = A + (size_t)pm * 256 * lda; u.b = Bt + (size_t)pn * 256 * ldb; return true;
    }
    DI unsigned rowoff(const pg8::Unit&, int) const { return 0u; }
};
struct OrderMulti {
    const char* A[6]; const char* Bt[6]; int nN[6]; int start[7]; unsigned lda, ldb; int ng, nwg, G, c;
    DI bool next(int i, pg8::Unit& u) const {
        const long L = (long)i * G + c; if (L >= nwg) return false;
        const int w = pg8::xcd_remap((int)L, nwg);
        int g = 0; const char* a = A[0]; const char* b = Bt[0]; int nn = nN[0], st = start[0];
#pragma unroll
        for (int k = 1; k < 6; ++k) if (k < ng && w >= start[k]) { g = k; a = A[k]; b = Bt[k]; nn = nN[k]; st = start[k]; }
        int pm, pn; pg8::tile_map(w - st, 64, nn, pm, pn);
        u.pm = pm; u.pn = pn; u.g = g; u.a = a + (size_t)pm * 256 * lda; u.b = b + (size_t)pn * 256 * ldb; return true;
    }
    DI unsigned rowoff(const pg8::Unit&, int) const { return 0u; }
};
struct OrderCmp {
    const char* P; const char* Bt; int G, c;
    DI bool next(int i, pg8::Unit& u) const {
        const int L = i * G + c; if (L >= 16) return false;
        const int kv = L >> 3, bh = L & 7, b = bh >> 1, h = bh & 1;
        u.pm = bh; u.pn = 0; u.g = kv;
        u.a = P + ((size_t)b * SEQ * NP + (size_t)(C_KCMP + kv * 128 + h * 64)) * 2;
        u.b = Bt + (size_t)kv * 256 * 2048 * 2; return true;
    }
    DI unsigned rowoff(const pg8::Unit&, int) const { return 0u; }
};
struct OrderMoe {
    const char* A; const char* Bt; const int* rowtok; const LAS int* tab; unsigned lda, ldb; size_t bstride; int nN, nwg, G, c; bool gather;
    DI bool next(int i, pg8::Unit& u) const {
        const long L = (long)i * G + c; if (L >= nwg) return false;
        const int w = pg8::xcd_remap((int)L, nwg);
        const int tau = w / nN, pn = w % nN;
        int e = 0;
#pragma unroll
        for (int k = 1; k < 8; ++k) if (tau >= tab[k]) e = k;
        u.pm = tau; u.pn = pn; u.g = e;
        u.a = gather ? A : A + (size_t)tau * 256 * lda;
        u.b = Bt + (size_t)e * bstride + (size_t)pn * 256 * ldb; return true;
    }
    DI unsigned rowoff(const pg8::Unit& u, int row) const {
        const int e = u.g; const int ce = tab[16 + e], ts = tab[e];
        const int pos = (u.pm - ts) * 256 + row;
        const int tok = pos < ce ? rowtok[e * M + pos] : 0;
        return (unsigned)tok * lda;
    }
};

struct EpiInProj {
    bf16_t* P; const float* rope;
    DI void operator()(const AccT& acc, const pg8::Unit& u, int wr, int wc, int fr, int fq) const {
        const int row0 = u.pm * 256 + wr * 64 + fr;
#pragma unroll
        for (int bj = 0; bj < 2; ++bj) {
            const int cb = u.pn * 256 + bj * 128;
            const int col0 = cb + wc * 32 + 8 * fq;
            const bool do_rope = cb < C_VA;
            const float sc = (cb < C_KA || (cb >= C_QB && cb < C_KCMP)) ? QSCALE : 1.0f;
            const int uidx = 4 * (wc & 1) + fq;
#pragma unroll
            for (int ai = 0; ai < 2; ++ai)
#pragma unroll
                for (int m = 0; m < 4; ++m) {
                    const int row = row0 + ai * 128 + m * 16;
                    f32x4 v0 = acc[ai][bj][m][0], v1 = acc[ai][bj][m][1];
                    if (do_rope) {
                        const f32x4 cs = *(const f32x4*)(rope + (size_t)row * 64 + 4 * uidx), sn = *(const f32x4*)(rope + (size_t)row * 64 + 32 + 4 * uidx);
                        const f32x4 o0 = v0 * cs - v1 * sn, o1 = v1 * cs + v0 * sn; v0 = o0; v1 = o1;
                    }
                    v0 = v0 * sc; v1 = v1 * sc;
                    st_bf16x8(P + (size_t)row * NP + col0, v0, v1);
                }
        }
    }
};
struct EpiCmp1 {
    bf16_t* HID; const float* bias;
    DI void operator()(const AccT& acc, const pg8::Unit& u, int wr, int wc, int fr, int fq) const {
        const int row0 = wr * 64 + fr;
#pragma unroll
        for (int bj = 0; bj < 2; ++bj) {
            const int col0 = bj * 128 + wc * 32 + 8 * fq;
            const f32x4 b0 = *(const f32x4*)(bias + u.g * 256 + col0), b1 = *(const f32x4*)(bias + u.g * 256 + col0 + 4);
#pragma unroll
            for (int ai = 0; ai < 2; ++ai)
#pragma unroll
                for (int m = 0; m < 4; ++m) {
                    const int row = row0 + ai * 128 + m * 16;
                    f32x4 v0 = acc[ai][bj][m][0] + b0, v1 = acc[ai][bj][m][1] + b1;
#pragma unroll
                    for (int j = 0; j < 4; ++j) { v0[j] = siluf_(v0[j]); v1[j] = siluf_(v1[j]); }
                    st_bf16x8(HID + ((size_t)(u.g * 2048 + u.pm * 256 + row)) * 256 + col0, v0, v1);
                }
        }
    }
};
struct EpiResF32 {
    const float* res; float* out;
    DI void operator()(const AccT& acc, const pg8::Unit& u, int wr, int wc, int fr, int fq) const {
        const int row0 = u.pm * 256 + wr * 64 + fr;
#pragma unroll
        for (int ai = 0; ai < 2; ++ai)
#pragma unroll
            for (int m = 0; m < 4; ++m) {
                const size_t ro = (size_t)(row0 + ai * 128 + m * 16) * DM;
#pragma unroll
                for (int bj = 0; bj < 2; ++bj) {
                    const int col0 = u.pn * 256 + bj * 128 + wc * 32 + 8 * fq;
                    const f32x4 r0 = *(const f32x4*)(res + ro + col0), r1 = *(const f32x4*)(res + ro + col0 + 4);
                    *(f32x4*)(out + ro + col0) = r0 + acc[ai][bj][m][0]; *(f32x4*)(out + ro + col0 + 4) = r1 + acc[ai][bj][m][1];
                }
            }
    }
};
struct EpiSwiglu {
    bf16_t* ACT; int ldc;
    DI void operator()(const AccT& acc, const pg8::Unit& u, int wr, int wc, int fr, int fq) const {
        const int row0 = u.pm * 256 + wr * 64 + fr; const int col0 = u.pn * 128 + wc * 32 + 8 * fq;
#pragma unroll
        for (int ai = 0; ai < 2; ++ai)
#pragma unroll
            for (int m = 0; m < 4; ++m) {
                f32x4 v0, v1;
#pragma unroll
                for (int j = 0; j < 4; ++j) { v0[j] = siluf_(acc[ai][0][m][0][j]) * acc[ai][1][m][0][j]; v1[j] = siluf_(acc[ai][0][m][1][j]) * acc[ai][1][m][1][j]; }
                st_bf16x8(ACT + (size_t)(row0 + ai * 128 + m * 16) * ldc + col0, v0, v1);
            }
    }
};
struct EpiRkvLora1 {
    bf16_t* RKV; bf16_t* L1;
    DI void operator()(const AccT& acc, const pg8::Unit& u, int wr, int wc, int fr, int fq) const {
        const int row0 = u.pm * 256 + wr * 64 + fr; const int g = u.g;
        bf16_t* base = g < 3 ? RKV + (size_t)g * M * DM : L1 + (size_t)(g - 3) * M * 256;
        const int ldc = g < 3 ? DM : 256;
#pragma unroll
        for (int ai = 0; ai < 2; ++ai)
#pragma unroll
            for (int m = 0; m < 4; ++m)
#pragma unroll
                for (int bj = 0; bj < 2; ++bj) {
                    const int col0 = u.pn * 256 + bj * 128 + wc * 32 + 8 * fq;
                    f32x4 v0 = acc[ai][bj][m][0], v1 = acc[ai][bj][m][1];
                    if (g == 3) {
#pragma unroll
                        for (int j = 0; j < 4; ++j) { v0[j] = tanhf_(v0[j]); v1[j] = tanhf_(v1[j]); }
                    } else if (g == 5) {
#pragma unroll
                        for (int j = 0; j < 4; ++j) { v0[j] = sigmoidf_(v0[j]); v1[j] = sigmoidf_(v1[j]); }
                    }
                    st_bf16x8(base + (size_t)(row0 + ai * 128 + m * 16) * ldc + col0, v0, v1);
                }
    }
};
struct EpiLora2 {
    float* DEC; float* AA; bf16_t* GG; const float* w0; const float* a0;
    DI void operator()(const AccT& acc, const pg8::Unit& u, int wr, int wc, int fr_, int fq_) const {
        const int fr = opq(fr_), fq = opq(fq_);
        const int row0 = u.pm * 256 + wr * 64 + fr; const int g = u.g;
        const float* cvec = g == 0 ? w0 : a0;
        float* outf = g == 0 ? DEC : AA;
#pragma unroll
        for (int bj = 0; bj < 2; ++bj) {
            const int col0 = u.pn * 256 + bj * 128 + wc * 32 + 8 * fq;
            f32x4 c0 = (f32x4){0.f, 0.f, 0.f, 0.f}, c1 = c0;
            if (g < 2) { c0 = *(const f32x4*)(cvec + col0); c1 = *(const f32x4*)(cvec + col0 + 4); }
#pragma unroll
            for (int ai = 0; ai < 2; ++ai)
#pragma unroll
                for (int m = 0; m < 4; ++m) {
                    const size_t ro = (size_t)(row0 + ai * 128 + m * 16) * DM + col0;
                    f32x4 v0 = acc[ai][bj][m][0] + c0, v1 = acc[ai][bj][m][1] + c1;
                    if (g < 2) {
#pragma unroll
                        for (int j = 0; j < 4; ++j) { v0[j] = sigmoidf_(v0[j]); v1[j] = sigmoidf_(v1[j]); }
                        if (g == 0) {
#pragma unroll
                            for (int j = 0; j < 4; ++j) { v0[j] = __expf(-0.60653065971f * v0[j]); v1[j] = __expf(-0.60653065971f * v1[j]); }
                        }
                        *(f32x4*)(outf + ro) = v0; *(f32x4*)(outf + ro + 4) = v1;
                    } else st_bf16x8(GG + ro, v0, v1);
                    asm volatile("" ::: "memory");
                }
        }
    }
};
struct EpiF32 {
    float* out;
    DI void operator()(const AccT& acc, const pg8::Unit& u, int wr, int wc, int fr, int fq) const {
        const int row0 = u.pm * 256 + wr * 64 + fr;
#pragma unroll
        for (int ai = 0; ai < 2; ++ai)
#pragma unroll
            for (int m = 0; m < 4; ++m) {
                const size_t ro = (size_t)(row0 + ai * 128 + m * 16) * DM;
#pragma unroll
                for (int bj = 0; bj < 2; ++bj) {
                    const int col0 = u.pn * 256 + bj * 128 + wc * 32 + 8 * fq;
                    *(f32x4*)(out + ro + col0) = acc[ai][bj][m][0]; *(f32x4*)(out + ro + col0 + 4) = acc[ai][bj][m][1];
                }
            }
    }
};

struct Args { const float* in[33]; float* out; unsigned char* ws; int ph_lo, ph_hi, use_bar, pad; };
enum { I_X = 0, I_POS, I_ATTN_NORM, I_FFN_NORM, I_FINAL_NORM, I_W_IN, I_W_OUT, I_SINKS, I_CMP_PE, I_CMP_W1, I_CMP_B1, I_CMP_W2, I_FFN_W13, I_FFN_W2, I_MU, I_W_RKV, I_DECAY_W0, I_DECAY_W1,
       I_DECAY_W2, I_A0, I_A1, I_A2, I_G1, I_G2, I_K_K, I_K_A, I_R_K, I_LN_W, I_LN_B, I_W_O, I_ROUTER, I_MOE_W13, I_MOE_W2 };

struct Frame {
    LAS unsigned char* lds;
    int tid, lane, wave, G, gw, NGW;
    unsigned char* ws;
};

template <class F>
DI void transpose_item(const float* W, int Nsrc, int kvalid, bf16_t* WT, int Kd, const F& srccol, int k0, int n0, LAS float* scr, int lane) {
    const int sc = srccol(n0 + (lane & 31));
#pragma unroll 8
    for (int i = 0; i < 32; ++i) { const int kk = 2 * i + (lane >> 5); float v = 0.f; if (sc >= 0 && k0 + kk < kvalid) v = W[(size_t)(k0 + kk) * Nsrc + sc]; scr[kk * 33 + (lane & 31)] = v; }
    asm volatile("s_waitcnt lgkmcnt(0)" ::: "memory");
    const int c = lane & 7;
#pragma unroll
    for (int j = 0; j < 4; ++j) { const int n = (lane >> 3) + 8 * j; const LAS float* s = scr + (8 * c) * 33 + n;
        u32x4 o; o.x = pk2(s[0 * 33], s[1 * 33]); o.y = pk2(s[2 * 33], s[3 * 33]); o.z = pk2(s[4 * 33], s[5 * 33]); o.w = pk2(s[6 * 33], s[7 * 33]);
        *(u32x4*)(WT + (size_t)(n0 + n) * Kd + k0 + 8 * c) = o; }
    asm volatile("s_waitcnt lgkmcnt(0)" ::: "memory");
}
template <class F>
DI void transpose_matrix(const Frame& F_, const float* W, int Nsrc, int kvalid, bf16_t* WT, int Kd, int Nd, const F& srccol, LAS float* scr) {
    const int nkb = Kd / 64, nnb = Nd / 32, nitems = nkb * nnb;
    for (int it = F_.gw; it < nitems; it += F_.NGW) { const int kbi = it / nnb, nb = it % nnb; transpose_item(W, Nsrc, kvalid, WT, Kd, srccol, 64 * kbi, 32 * nb, scr, F_.lane); }
}
struct ColIdent { int n; DI int operator()(int c) const { return c < n ? c : -1; } };
struct ColInProj { DI int operator()(int c) const { if (c >= IN_COLS) return -1; if (c >= C_VA) return c; const int head = c >> 6, l = c & 63; const int o = (l & 7) < 4 ? 4 * (l >> 3) + (l & 3) : 32 + 4 * (l >> 3) + (l & 3); return head * 64 + o; } };
struct ColSwiglu { int F; DI int operator()(int c) const { const int t = c >> 8, r = c & 255; return r < 128 ? t * 128 + r : F + t * 128 + (r - 128); } };

DI void rms_row_load(const float* xrow, int lane, f32x4 (&v)[8], float& rstd) {
    float s = 0.f;
#pragma unroll
    for (int j = 0; j < 8; ++j) { v[j] = *(const f32x4*)(xrow + 4 * lane + 256 * j); s += (v[j].x * v[j].x + v[j].y * v[j].y) + (v[j].z * v[j].z + v[j].w * v[j].w); }
    rstd = 1.0f / sqrtf(wave_sum(s) * (1.0f / DM) + RMS_EPS);
}
DI void rms_row_to_bf16(const float* xrow, const float* g, bf16_t* orow, int lane) {
    f32x4 v[8]; float rstd; rms_row_load(xrow, lane, v, rstd);
#pragma unroll
    for (int j = 0; j < 8; ++j) { const f32x4 gg = *(const f32x4*)(g + 4 * lane + 256 * j); const f32x4 y = v[j] * rstd * gg;
        u32x2 w; w.x = pk2(y.x, y.y); w.y = pk2(y.z, y.w); *(u32x2*)(orow + 4 * lane + 256 * j) = w; }
}

namespace att {
constexpr int KPADB = 144;
constexpr int VPADB = 144;
constexpr int BUFB = 64 * KPADB + 64 * VPADB;
constexpr int OFF_ALPHA = 2 * BUFB;
constexpr int OFF_IMP = OFF_ALPHA + 8 * 256;
constexpr int OFF_SEL = OFF_IMP + 16384;
constexpr int OFF_RANK = OFF_SEL + 512;
constexpr int OFF_Q = 65536;
constexpr float NEGBIG = -1e30f;
DI int crow(int r, int h) { return (r & 3) + 8 * (r >> 2) + 4 * h; }
#define MFMA32(a, b, c) __builtin_amdgcn_mfma_f32_32x32x16_bf16((a), (b), (c), 0, 0, 0)

struct KVRegs { u32x4 k, v; };
DI void kv_load(KVRegs& r, const bf16_t* Kg, const bf16_t* Vg, size_t pitch, int tid) {
    const int key = tid >> 3, dc = tid & 7;
    r.k = *(const u32x4*)(Kg + (size_t)key * pitch + dc * 8); r.v = *(const u32x4*)(Vg + (size_t)key * pitch + dc * 8);
}
DI void kv_store(const KVRegs& r, LAS unsigned char* buf, int tid) {
    const int key = tid >> 3, dc = tid & 7;
    *(LAS u32x4*)(buf + key * KPADB + dc * 16) = r.k;
    LAS unsigned short* vt = (LAS unsigned short*)(buf + 64 * KPADB);
    const unsigned w[4] = {r.v.x, r.v.y, r.v.z, r.v.w};
#pragma unroll
    for (int i = 0; i < 4; ++i) { vt[(dc * 8 + 2 * i) * (VPADB / 2) + key] = (unsigned short)(w[i] & 0xffffu); vt[(dc * 8 + 2 * i + 1) * (VPADB / 2) + key] = (unsigned short)(w[i] >> 16); }
}

struct State { f32x16 O[2][2]; float m[2], l[2]; };
DI void state_init(State& s) {
#pragma unroll
    for (int a = 0; a < 2; ++a) { s.m[a] = NEGBIG; s.l[a] = 0.f;
#pragma unroll
        for (int b = 0; b < 2; ++b)
#pragma unroll
            for (int r = 0; r < 16; ++r) s.O[a][b][r] = 0.f; }
}
DI void row_scale(f32x16 (&O)[2], float f, LAS float* area, int c_, int h_) {
    const int c = opq(c_), h = opq(h_);
    area[c] = f;
    asm volatile("s_waitcnt lgkmcnt(0)" ::: "memory");
#pragma unroll
    for (int g4 = 0; g4 < 4; ++g4) { const f32x4 a = *(LAS f32x4*)(area + 8 * g4 + 4 * h);
#pragma unroll
        for (int j = 0; j < 4; ++j) { O[0][4 * g4 + j] *= a[j]; O[1][4 * g4 + j] *= a[j]; } }
    asm volatile("s_waitcnt lgkmcnt(0)" ::: "memory");
}
template <int MODE>
DI void tile_compute(State& st, const LAS unsigned char* qf, LAS unsigned char* buf, int kbase, const int (&tq)[2], int W, const unsigned long long (&sel)[2], int tile, LAS float* area, int c_, int h_) {
    const int c = opq(c_), h = opq(h_);
    LAS unsigned char* Kl = buf; LAS unsigned char* Vl = buf + 64 * KPADB;
#pragma unroll 1
    for (int kbk = 0; kbk < 2; ++kbk) {
        bf16x8 Pf[2][2];
        bf16x8 kf[4];
#pragma unroll
        for (int s = 0; s < 4; ++s) kf[s] = *(LAS bf16x8*)(Kl + (32 * kbk + c) * KPADB + (16 * s + 8 * h) * 2);
#pragma unroll
        for (int qb = 0; qb < 2; ++qb) {
            f32x16 S;
#pragma unroll
            for (int r = 0; r < 16; ++r) S[r] = 0.f;
#pragma unroll
            for (int s = 0; s < 4; ++s) { const bf16x8 q = *(const LAS bf16x8*)(qf + (qb * 4 + s) * 1024); S = MFMA32(kf[s], q, S); }
            float mx = NEGBIG;
            const bool bit = MODE == 2 ? (((sel[qb] >> tile) & 1ull) != 0ull) : true;
            const int dd = tq[qb] - (kbase + 32 * kbk + 4 * h);
#pragma unroll
            for (int r = 0; r < 16; ++r) { const int cr0 = (r & 3) + 8 * (r >> 2); bool valid;
                if (MODE == 0) valid = (cr0 <= dd) && (cr0 > dd - W);
                else if (MODE == 1) valid = (cr0 <= dd);
                else valid = (cr0 <= dd) && bit;
                S[r] = valid ? S[r] : NEGBIG; mx = fmaxf(mx, S[r]); }
            mx = fmaxf(mx, __shfl_xor(mx, 32));
            if (__any(mx > st.m[qb] + 8.0f)) {
                const float mnew = fmaxf(st.m[qb], mx); const float alpha = ex2(st.m[qb] - mnew);
                st.l[qb] *= alpha; st.m[qb] = mnew;
                row_scale(st.O[qb], alpha, area + qb * 32, c, h);
            }
            float ls = 0.f;
#pragma unroll
            for (int r = 0; r < 16; ++r) { S[r] = (S[r] > -1e29f) ? ex2(S[r] - st.m[qb]) : 0.f; ls += S[r]; }
            st.l[qb] += ls;
#pragma unroll
            for (int ks = 0; ks < 2; ++ks) { u32x4 w; w.x = pk2(S[8 * ks], S[8 * ks + 1]); w.y = pk2(S[8 * ks + 2], S[8 * ks + 3]); w.z = pk2(S[8 * ks + 4], S[8 * ks + 5]); w.w = pk2(S[8 * ks + 6], S[8 * ks + 7]);
                Pf[qb][ks] = __builtin_bit_cast(bf16x8, w); }
            __builtin_amdgcn_sched_barrier(0);
        }
#pragma unroll
        for (int ks = 0; ks < 2; ++ks)
#pragma unroll
            for (int db = 0; db < 2; ++db) {
                const s16x4 lo = *(LAS s16x4*)(Vl + (32 * db + c) * VPADB + (32 * kbk + 16 * ks + 4 * h) * 2);
                const s16x4 hi = *(LAS s16x4*)(Vl + (32 * db + c) * VPADB + (32 * kbk + 16 * ks + 8 + 4 * h) * 2);
                const bf16x8 vf = __builtin_shufflevector(lo, hi, 0, 1, 2, 3, 4, 5, 6, 7);
                st.O[0][db] = MFMA32(Pf[0][ks], vf, st.O[0][db]); st.O[1][db] = MFMA32(Pf[1][ks], vf, st.O[1][db]);
            }
        __builtin_amdgcn_sched_barrier(0);
    }
}
template <int MODE>
DI void run_pass(State& st, LAS unsigned char* lds, const bf16_t* Kg, const bf16_t* Vg, size_t pitch, int tlo, int thi, const int (&tq)[2], int W,
                 const unsigned long long (&sel)[2], int tid, int wave, int c, int h) {
    LAS float* area = (LAS float*)(lds + OFF_ALPHA) + wave * 64;
    const LAS unsigned char* qf = lds + OFF_Q + wave * 8192 + (c + 32 * h) * 16;
    KVRegs kr; kv_load(kr, Kg + (size_t)tlo * 64 * pitch, Vg + (size_t)tlo * 64 * pitch, pitch, tid);
    int bi = 0;
    for (int t = tlo; t <= thi; ++t) {
        LAS unsigned char* buf = lds + bi * BUFB;
        const int tid2 = opq(tid);
        kv_store(kr, buf, tid2);
        if (t < thi) kv_load(kr, Kg + (size_t)(t + 1) * 64 * pitch, Vg + (size_t)(t + 1) * 64 * pitch, pitch, tid2);
        __syncthreads();
        tile_compute<MODE>(st, qf, buf, t * 64, tq, W, sel, t, area, c, h);
        bi ^= 1;
    }
    __syncthreads();
}
DI void load_q(LAS unsigned char* lds, int wave, const bf16_t* Pbase  , int colbase, int c_, int h_) {
    const int c = opq(c_), h = opq(h_);
    LAS unsigned char* q = lds + OFF_Q + wave * 8192 + (c + 32 * h) * 16;
#pragma unroll
    for (int qb = 0; qb < 2; ++qb) { const bf16_t* p = Pbase + (size_t)(4 * qb + (c >> 3)) * NP + colbase + (c & 7) * 64 + 8 * h;
#pragma unroll
        for (int s = 0; s < 4; ++s) *(LAS bf16x8*)(q + (qb * 4 + s) * 1024) = *(const bf16x8*)(p + 16 * s); }
}
template <int MODE>
DI void emit_out(State& st, const float (&f)[2], LAS float* area, float* OBrow, bf16_t* Orow, int c_, int h_) {
    const int c = opq(c_), h = opq(h_);
#pragma unroll
    for (int qb = 0; qb < 2; ++qb) {
        area[qb * 32 + c] = f[qb];
        asm volatile("s_waitcnt lgkmcnt(0)" ::: "memory");
#pragma unroll
        for (int g4 = 0; g4 < 4; ++g4) { const f32x4 a = *(LAS f32x4*)(area + qb * 32 + 8 * g4 + 4 * h);
#pragma unroll
            for (int j = 0; j < 4; ++j) { const int cr = 8 * g4 + 4 * h + j; const int tokl = 4 * qb + (cr >> 3), hd = cr & 7;
#pragma unroll
                for (int db = 0; db < 2; ++db) { float v = st.O[qb][db][4 * g4 + j] * a[j];
                    float* ob = OBrow + (size_t)tokl * 1024 + hd * 64 + 32 * db + c; bf16_t* o = Orow + (size_t)tokl * DM + hd * 64 + 32 * db + c;
                    if (MODE == 0) *ob = v; else if (MODE == 1) *ob += v; else if (MODE == 2) *o = (bf16_t)f2bf(*ob + v); else *o = (bf16_t)f2bf(v); } }
            asm volatile("" ::: "memory"); }
        asm volatile("s_waitcnt lgkmcnt(0)" ::: "memory");
    }
}
}

DI void attn_unit_A(const Frame& F, const bf16_t* P, bf16_t* O, const float* sinks, int b, int kvh, int ch) {
    const int c = F.lane & 31, h = F.lane >> 5, w = F.wave;
    const int t0 = ch * 64;
    const bf16_t* Pb = P + (size_t)b * SEQ * NP;
    att::load_q(F.lds, w, Pb + (size_t)(t0 + 8 * w) * NP, C_QA + kvh * 512, c, h);
    int tq[2] = {t0 + 8 * w + (c >> 3), t0 + 8 * w + 4 + (c >> 3)};
    unsigned long long sel[2] = {0ull, 0ull};
    att::State st; att::state_init(st);
    const int tlo = ch >= 2 ? ch - 2 : 0;
    att::run_pass<0>(st, F.lds, Pb + C_KA + kvh * 64, Pb + C_VA + kvh * 64, NP, tlo, ch, tq, 128, sel, F.tid, w, c, h);
    const float sink2 = sinks[kvh * 8 + (c & 7)] * LOG2E;
    float f[2];
#pragma unroll
    for (int qb = 0; qb < 2; ++qb) { const float lt = st.l[qb] + __shfl_xor(st.l[qb], 32) + ex2(sink2 - st.m[qb]); f[qb] = 1.0f / lt; }
    LAS float* area = (LAS float*)(F.lds + att::OFF_ALPHA) + w * 64;
    att::emit_out<3>(st, f, area, nullptr, O + ((size_t)b * SEQ + t0 + 8 * w) * DM + kvh * 512, c, h);
}

DI void attn_unit_B(const Frame& F, const bf16_t* P, const bf16_t* KVC, bf16_t* O, float* OB, int b, int hkv, int ch) {
    const int c = F.lane & 31, h = F.lane >> 5, w = F.wave, lane = F.lane;
    const int t0 = ch * 64;
    const bf16_t* Pb = P + (size_t)b * SEQ * NP;
    LAS float* area = (LAS float*)(F.lds + att::OFF_ALPHA) + w * 64;
    LAS float* imp = (LAS float*)(F.lds + att::OFF_IMP);
    LAS unsigned long long* selbuf = (LAS unsigned long long*)(F.lds + att::OFF_SEL);
    LAS float* rank = (LAS float*)(F.lds + att::OFF_RANK) + w * 64;
    att::load_q(F.lds, w, Pb + (size_t)(t0 + 8 * w) * NP, C_QB + hkv * 512, c, h);
    const LAS unsigned char* qf = F.lds + att::OFF_Q + w * 8192 + (c + 32 * h) * 16;
    int tq[2] = {t0 + 8 * w + (c >> 3), t0 + 8 * w + 4 + (c >> 3)};
    unsigned long long sel[2] = {0ull, 0ull};
#define GATE(qb, j) sigmoidf_(bf2f(Pb[(size_t)tq[qb] * NP + C_GATE + hkv * 24 + (c & 7) * 3 + (j)]))
    for (int i = F.tid; i < 4096; i += NTHR) imp[i] = 0.f;
    float* OBrow = OB + ((size_t)b * SEQ + t0 + 8 * w) * 1024 + hkv * 512;
    bf16_t* Orow = O + ((size_t)b * SEQ + t0 + 8 * w) * DM + 1024 + hkv * 512;
    const bf16_t* Kc = KVC + (size_t)(0 * 2048 + (b * 2 + hkv) * 256) * 64;
    const bf16_t* Vc = KVC + (size_t)(1 * 2048 + (b * 2 + hkv) * 256) * 64;
    const int ntc = (4 * ch + 2) / 64;
    att::State st; att::state_init(st);
    int tqc[2] = {(tq[0] - 31) >> 4, (tq[1] - 31) >> 4};
    att::run_pass<1>(st, F.lds, Kc, Vc, 64, 0, ntc, tqc, 0, sel, F.tid, w, c, h);
    float ltot[2], f[2];
#pragma unroll
    for (int qb = 0; qb < 2; ++qb) { ltot[qb] = fmaxf(st.l[qb] + __shfl_xor(st.l[qb], 32), 1e-30f); f[qb] = GATE(qb, 0) / ltot[qb]; }
    att::emit_out<0>(st, f, area, OBrow, Orow, c, h);
    {
        att::KVRegs kr; att::kv_load(kr, Kc, Vc, 64, F.tid);
        int bi = 0;
        for (int t = 0; t <= ntc; ++t) {
            LAS unsigned char* buf = F.lds + bi * att::BUFB;
            att::kv_store(kr, buf, F.tid);
            if (t < ntc) att::kv_load(kr, Kc + (size_t)(t + 1) * 64 * 64, Vc + (size_t)(t + 1) * 64 * 64, 64, F.tid);
            __syncthreads();
#pragma unroll
            for (int kbk = 0; kbk < 2; ++kbk) {
#pragma unroll
                for (int qb = 0; qb < 2; ++qb) {
                    f32x16 S;
#pragma unroll
                    for (int r = 0; r < 16; ++r) S[r] = 0.f;
#pragma unroll
                    for (int s = 0; s < 4; ++s) { const bf16x8 kf = *(LAS bf16x8*)(buf + (32 * kbk + c) * att::KPADB + (16 * s + 8 * h) * 2); const bf16x8 q = *(const LAS bf16x8*)(qf + (qb * 4 + s) * 1024); S = MFMA32(kf, q, S); }
                    const float inv = 1.0f / ltot[qb];
                    const int q = 8 * w + 4 * qb + (c >> 3);
                    const int ddq = tqc[qb] - (t * 64 + 32 * kbk + 4 * h);
#pragma unroll
                    for (int g4 = 0; g4 < 4; ++g4) {
                        float s4 = 0.f, p3 = 0.f;
#pragma unroll
                        for (int j = 0; j < 4; ++j) { const float pv = (8 * g4 + j <= ddq) ? ex2(S[4 * g4 + j] - st.m[qb]) * inv : 0.f; s4 += pv; if (j == 3) p3 = pv; }
                        s4 += __shfl_xor(s4, 1); s4 += __shfl_xor(s4, 2); s4 += __shfl_xor(s4, 4);
                        p3 += __shfl_xor(p3, 1); p3 += __shfl_xor(p3, 2); p3 += __shfl_xor(p3, 4);
                        const int n0 = t * 16 + 8 * kbk + 2 * g4 + h;
                        if ((c & 7) == 0) { (void)__hip_atomic_fetch_add(&imp[q * 64 + n0], s4, __ATOMIC_RELAXED, __HIP_MEMORY_SCOPE_WORKGROUP); if (n0 + 1 < 64) (void)__hip_atomic_fetch_add(&imp[q * 64 + n0 + 1], p3, __ATOMIC_RELAXED, __HIP_MEMORY_SCOPE_WORKGROUP); }
                    }
                    __builtin_amdgcn_sched_barrier(0);
                }
            }
            bi ^= 1;
        }
        __syncthreads();
    }
    {
        const int cur = ch;
        for (int qq = 0; qq < 8; ++qq) {
            const int q = 8 * w + qq;
            float v = imp[q * 64 + lane];
            if (lane > cur) v = -1e9f; else if (lane == 0 || lane > cur - 2) v = 1e9f;
            rank[lane] = v;
            asm volatile("s_waitcnt lgkmcnt(0)" ::: "memory");
            int rk = 0;
#pragma unroll 8
            for (int mth = 0; mth < 64; ++mth) { const float o = rank[mth]; rk += (o > v || (o == v && mth < lane)) ? 1 : 0; }
            const unsigned long long msk = __ballot(rk < 16);
            if (lane == 0) selbuf[q] = msk;
            asm volatile("s_waitcnt lgkmcnt(0)" ::: "memory");
        }
        __syncthreads();
        sel[0] = selbuf[8 * w + (c >> 3)]; sel[1] = selbuf[8 * w + 4 + (c >> 3)];
    }
    att::state_init(st);
    att::run_pass<2>(st, F.lds, Pb + C_KSEL + hkv * 64, Pb + C_VSEL + hkv * 64, NP, 0, ch, tq, 0, sel, F.tid, w, c, h);
#pragma unroll
    for (int qb = 0; qb < 2; ++qb) { const float lt = fmaxf(st.l[qb] + __shfl_xor(st.l[qb], 32), 1e-30f); f[qb] = GATE(qb, 1) / lt; }
    att::emit_out<1>(st, f, area, OBrow, Orow, c, h);
    att::state_init(st);
    att::run_pass<0>(st, F.lds, Pb + C_KWIN + hkv * 64, Pb + C_VWIN + hkv * 64, NP, ch >= 8 ? ch - 8 : 0, ch, tq, 512, sel, F.tid, w, c, h);
#pragma unroll
    for (int qb = 0; qb < 2; ++qb) { const float lt = fmaxf(st.l[qb] + __shfl_xor(st.l[qb], 32), 1e-30f); f[qb] = GATE(qb, 2) / lt; }
    att::emit_out<2>(st, f, area, OBrow, Orow, c, h);
#undef GATE
    __syncthreads();
}

namespace scan {
constexpr int TC = 32;
constexpr int STEPB = 5 * 256 + 128;
constexpr int CHB = TC * STEPB;
constexpr int OFF_Y = 2 * CHB;
constexpr int YB = TC * 32 * 4;
template <int CTRL> DI float dpp_f(float x) { return __builtin_bit_cast(float, __builtin_amdgcn_update_dpp(0, __builtin_bit_cast(int, x), CTRL, 0xf, 0xf, false)); }
DI float row_sum16(float x) { x += dpp_f<0xB1>(x); x += dpp_f<0x4E>(x); x += dpp_f<0x141>(x); x += dpp_f<0x140>(x); return x; }
}
DI void scan_fill(const Frame& F, LAS unsigned char* buf, const bf16_t* RKV, const float* DEC, const float* AA, const float* kk_w, const float* ka_w, int b, int hd, int half, int tch) {
    const int lw = F.wave - 4, lane = F.lane;
    const float kkw = kk_w[hd * 64 + lane], kaw = ka_w[hd * 64 + lane];
#pragma unroll 2
    for (int s = lw; s < scan::TC; s += 4) {
        const size_t tok = (size_t)b * SEQ + (size_t)tch * scan::TC + s;
        const size_t o = tok * DM + hd * 64 + lane;
        const float r = bf2f(RKV[o]), k = bf2f(RKV[(size_t)M * DM + o]), v = bf2f(RKV[(size_t)2 * M * DM + o]);
        const float dec = DEC[o], a = AA[o];
        const float kx = k * kkw;
        const float nrm = sqrtf(wave_sum(kx * kx));
        const float kk = kx / fmaxf(nrm, 1e-12f);
        const float kp = k * (1.0f + (a - 1.0f) * kaw);
        LAS float* sp = (LAS float*)(buf + s * scan::STEPB);
        sp[lane] = dec; sp[64 + lane] = -kk; sp[128 + lane] = kk * a; sp[192 + lane] = kp; sp[256 + lane] = r;
        if ((lane >> 5) == half) sp[320 + (lane & 31)] = v;
    }
}
DI void scan_flush(const Frame& F, LAS unsigned char* ybuf, float* YRAW, int b, int hd, int half, int tch) {
    const int lw = F.wave - 4, lane = F.lane;
    for (int s = 2 * lw; s < scan::TC; s += 8) {
        const int ss = s + (lane >> 5);
        const size_t tok = (size_t)b * SEQ + (size_t)tch * scan::TC + ss;
        YRAW[tok * DM + hd * 64 + half * 32 + (lane & 31)] = ((LAS float*)ybuf)[ss * 32 + (lane & 31)];
    }
}
DI void phase_scan(const Frame& F, const bf16_t* RKV, const float* DEC, const float* AA, const float* kk_w, const float* ka_w, float* YRAW) {
    for (int vb = blockIdx.x; vb < 256; vb += F.G) {
        const int bh = vb >> 1, half = vb & 1, b = bh >> 5, hd = bh & 31;
        const int w = F.wave, lane = F.lane;
        const int rp = lane >> 4, cg = lane & 15;
        const int row0 = 8 * w + 2 * rp;
        float S0[4] = {0.f, 0.f, 0.f, 0.f}, S1[4] = {0.f, 0.f, 0.f, 0.f};
        constexpr int NCH = SEQ / scan::TC;
        if (w >= 4) scan_fill(F, F.lds, RKV, DEC, AA, kk_w, ka_w, b, hd, half, 0);
        __syncthreads();
        for (int ch = 0; ch < NCH; ++ch) {
            LAS unsigned char* buf = F.lds + (ch & 1) * scan::CHB;
            LAS float* yb = (LAS float*)(F.lds + scan::OFF_Y + (ch & 1) * scan::YB);
            if (w < 4) {
#pragma unroll 4
                for (int s = 0; s < scan::TC; ++s) {
                    const LAS float* sp = (const LAS float*)(buf + s * scan::STEPB);
                    const f32x4 w4 = *(const LAS f32x4*)(sp + 4 * cg), nk4 = *(const LAS f32x4*)(sp + 64 + 4 * cg), b4 = *(const LAS f32x4*)(sp + 128 + 4 * cg),
                                k4 = *(const LAS f32x4*)(sp + 192 + 4 * cg), r4 = *(const LAS f32x4*)(sp + 256 + 4 * cg);
                    const f32x2 v2 = *(const LAS f32x2*)(sp + 320 + row0);
                    float sa0 = (S0[0] * nk4[0] + S0[1] * nk4[1]) + (S0[2] * nk4[2] + S0[3] * nk4[3]);
                    float sa1 = (S1[0] * nk4[0] + S1[1] * nk4[1]) + (S1[2] * nk4[2] + S1[3] * nk4[3]);
                    sa0 = scan::row_sum16(sa0); sa1 = scan::row_sum16(sa1);
                    float y0 = 0.f, y1 = 0.f;
#pragma unroll
                    for (int i = 0; i < 4; ++i) {
                        S0[i] = S0[i] * w4[i] + (sa0 * b4[i] + v2[0] * k4[i]);
                        S1[i] = S1[i] * w4[i] + (sa1 * b4[i] + v2[1] * k4[i]);
                        y0 += S0[i] * r4[i]; y1 += S1[i] * r4[i];
                    }
                    y0 = scan::row_sum16(y0); y1 = scan::row_sum16(y1);
                    if (cg == 0) { yb[s * 32 + row0] = y0; yb[s * 32 + row0 + 1] = y1; }
                }
            } else {
                if (ch + 1 < NCH) scan_fill(F, F.lds + ((ch + 1) & 1) * scan::CHB, RKV, DEC, AA, kk_w, ka_w, b, hd, half, ch + 1);
                if (ch > 0) scan_flush(F, F.lds + scan::OFF_Y + ((ch - 1) & 1) * scan::YB, YRAW, b, hd, half, ch - 1);
            }
            __syncthreads();
        }
        if (w >= 4) scan_flush(F, F.lds + scan::OFF_Y + ((NCH - 1) & 1) * scan::YB, YRAW, b, hd, half, NCH - 1);
        __syncthreads();
    }
}

constexpr int NPHASE = 19;
__global__ void __launch_bounds__(NTHR, 2) mk_fwd(Args args) {
    extern __shared__ __attribute__((aligned(16))) unsigned char lds_raw[];
    Frame F;
    F.lds = (LAS unsigned char*)lds_raw;
    F.tid = threadIdx.x; F.lane = F.tid & 63; F.wave = __builtin_amdgcn_readfirstlane(F.tid >> 6);
    F.G = gridDim.x; F.gw = blockIdx.x * NWAVES + F.wave; F.NGW = F.G * NWAVES; F.ws = args.ws;
    unsigned char* ws = args.ws;
    unsigned* ctl = (unsigned*)(ws + WS_CTL);
    volatile LAS unsigned* MISC = (volatile LAS unsigned*)(F.lds + MISC_OFF);
    for (int u = F.tid; u < (LDS_BYTES - LDSCTL_OFF) / 4; u += NTHR) ((LAS unsigned*)(F.lds + LDSCTL_OFF))[u] = 0u;
    __syncthreads();
    XcdBarrier bar; bar.bar = ctl + CW_BAR; bar.x = 0; bar.st = nullptr;
    if (args.use_bar) bar = xcd_barrier_post(ctl + CW_BAR, MISC + 8);
    const int lo = args.ph_lo, hi = args.ph_hi;
#ifndef PH_MASK
#define PH_MASK 0xFFFFFFFFu
#endif
#define IN(k) (((PH_MASK >> (k)) & 1u) && lo <= (k) && (k) < hi)
#define SEAM(k) do { if (IN(k) && IN((k) + 1)) xcd_barrier(bar); } while (0)

    bf16_t* W_IN = (bf16_t*)(ws + WS_W_IN); bf16_t* W_OUT = (bf16_t*)(ws + WS_W_OUT); bf16_t* CMPW1 = (bf16_t*)(ws + WS_CMPW1);
    bf16_t* FFN13 = (bf16_t*)(ws + WS_FFN13); bf16_t* FFN2 = (bf16_t*)(ws + WS_FFN2); bf16_t* WRKV = (bf16_t*)(ws + WS_WRKV);
    bf16_t* LORA1 = (bf16_t*)(ws + WS_LORA1); bf16_t* LORA2 = (bf16_t*)(ws + WS_LORA2); bf16_t* WO = (bf16_t*)(ws + WS_WO);
    bf16_t* MOE13 = (bf16_t*)(ws + WS_MOE13); bf16_t* MOE2 = (bf16_t*)(ws + WS_MOE2);
    bf16_t* XN = (bf16_t*)(ws + WS_XN); bf16_t* P = (bf16_t*)(ws + WS_P); float* ROPE = (float*)(ws + WS_ROPE); float* CMPB = (float*)(ws + WS_CMPB);
    bf16_t* HID = (bf16_t*)(ws + WS_HID); bf16_t* KVC = (bf16_t*)(ws + WS_KVC); bf16_t* O = (bf16_t*)(ws + WS_O); float* H = (float*)(ws + WS_H);
    bf16_t* ACT = (bf16_t*)(ws + WS_ACT); bf16_t* XS = (bf16_t*)(ws + WS_XS); bf16_t* RKV = (bf16_t*)(ws + WS_RKV); bf16_t* L1 = (bf16_t*)(ws + WS_L1);
    float* DEC = (float*)(ws + WS_DEC); float* AA = (float*)(ws + WS_AA); bf16_t* GG = (bf16_t*)(ws + WS_GG); float* YRAW = (float*)(ws + WS_YRAW); bf16_t* YG = (bf16_t*)(ws + WS_YG);
    int* ROWTOK = (int*)(ws + WS_ROWTOK); int* TOKSLOT = (int*)(ws + WS_TOKSLOT); float* Y2 = (float*)(ws + WS_Y2);
    float* OB = YRAW;
    LAS unsigned char* ring = F.lds;

    if (IN(0)) {
        LAS float* scr = (LAS float*)(F.lds + F.wave * 16384);
        transpose_matrix(F, args.in[I_W_IN], IN_COLS, DM, W_IN, DM, NP, ColInProj{}, scr);
        transpose_matrix(F, args.in[I_W_OUT], DM, DM, W_OUT, DM, DM, ColIdent{DM}, scr);
        for (int kv = 0; kv < 2; ++kv) transpose_matrix(F, args.in[I_CMP_W1] + (size_t)kv * 2048 * 256, 256, 2048, CMPW1 + (size_t)kv * 256 * 2048, 2048, 256, ColIdent{256}, scr);
        transpose_matrix(F, args.in[I_FFN_W13], 2 * DFF, DM, FFN13, DM, 2 * DFF, ColSwiglu{DFF}, scr);
        transpose_matrix(F, args.in[I_FFN_W2], DM, DFF, FFN2, DFF, DM, ColIdent{DM}, scr);
        for (int i = 0; i < 3; ++i) transpose_matrix(F, args.in[I_W_RKV] + (size_t)i * DM * DM, DM, DM, WRKV + (size_t)i * DM * DM, DM, DM, ColIdent{DM}, scr);
        transpose_matrix(F, args.in[I_DECAY_W1], 96, DM, LORA1, DM, 256, ColIdent{96}, scr);
        transpose_matrix(F, args.in[I_A1], 96, DM, LORA1 + (size_t)256 * DM, DM, 256, ColIdent{96}, scr);
        transpose_matrix(F, args.in[I_G1], 256, DM, LORA1 + (size_t)512 * DM, DM, 256, ColIdent{256}, scr);
        transpose_matrix(F, args.in[I_DECAY_W2], DM, 96, LORA2, 256, DM, ColIdent{DM}, scr);
        transpose_matrix(F, args.in[I_A2], DM, 96, LORA2 + (size_t)DM * 256, 256, DM, ColIdent{DM}, scr);
        transpose_matrix(F, args.in[I_G2], DM, 256, LORA2 + (size_t)2 * DM * 256, 256, DM, ColIdent{DM}, scr);
        transpose_matrix(F, args.in[I_W_O], DM, DM, WO, DM, DM, ColIdent{DM}, scr);
        for (int e = 0; e < NEXP; ++e) transpose_matrix(F, args.in[I_MOE_W13] + (size_t)e * DM * 2 * DFFE, 2 * DFFE, DM, MOE13 + (size_t)e * 2 * DFFE * DM, DM, 2 * DFFE, ColSwiglu{DFFE}, scr);
        for (int e = 0; e < NEXP; ++e) transpose_matrix(F, args.in[I_MOE_W2] + (size_t)e * DFFE * DM, DM, DFFE, MOE2 + (size_t)e * DM * DFFE, DFFE, DM, ColIdent{DM}, scr);
        for (int m = F.gw; m < M; m += F.NGW) rms_row_to_bf16(args.in[I_X] + (size_t)m * DM, args.in[I_ATTN_NORM], XN + (size_t)m * DM, F.lane);
        { const int* pos = (const int*)args.in[I_POS];
          for (int i = blockIdx.x * NTHR + F.tid; i < M * 32; i += F.G * NTHR) { const int m = i >> 5, j = i & 31;
              const float inv = powf(150000.0f, -(float)j / 32.0f); const float ang = (float)pos[m] * inv; float sn, cs; sincosf(ang, &sn, &cs);
              ROPE[(size_t)m * 64 + j] = cs; ROPE[(size_t)m * 64 + 32 + j] = sn; } }
        if (F.gw < 512) { const int kv = F.gw >> 8, j = F.gw & 255; const float* pe = args.in[I_CMP_PE] + kv * 2048; const float* w1 = args.in[I_CMP_W1] + (size_t)kv * 2048 * 256;
            float s = 0.f; for (int i = F.lane; i < 2048; i += 64) s += pe[i] * w1[(size_t)i * 256 + j];
            s = wave_sum(s); if (F.lane == 0) CMPB[kv * 256 + j] = s + args.in[I_CMP_B1][kv * 256 + j]; }
    }
    SEAM(0);
    if (IN(1)) {
        OrderSingle S{(const char*)XN, (const char*)W_IN, DM * 2, DM * 2, 64, NP / 256, 64 * (NP / 256), F.G, (int)blockIdx.x};
        EpiInProj E{P, ROPE};
        pg8::gemm_phase<EpiInProj, OrderSingle, false>(ring, DM * 2, 128, DM * 2, DM / 64, S, E);
    }
    SEAM(1);
    if (IN(2)) {
        OrderCmp S{(const char*)P, (const char*)CMPW1, F.G, (int)blockIdx.x};
        EpiCmp1 E{HID, CMPB};
        pg8::gemm_phase<EpiCmp1, OrderCmp, false>(ring, 16 * NP * 2, NP * 2, 2048 * 2, 32, S, E);
    }
    SEAM(2);
    if (IN(3)) {
        for (int it = blockIdx.x * NTHR + F.tid; it < 2 * 2048 * 16; it += F.G * NTHR) {
            const int dq = it & 15, row = (it >> 4) & 2047, kv = it >> 15;
            const bf16_t* hr = HID + ((size_t)kv * 2048 + row) * 256; const float* w2 = args.in[I_CMP_W2] + (size_t)kv * 256 * 64 + dq * 4;
            f32x4 a = (f32x4){0.f, 0.f, 0.f, 0.f};
            for (int j = 0; j < 256; j += 2) { const unsigned hw = *(const unsigned*)(hr + j); a += bflo(hw) * *(const f32x4*)(w2 + (size_t)j * 64); a += bfhi(hw) * *(const f32x4*)(w2 + (size_t)(j + 1) * 64); }
            u32x2 o; o.x = pk2(a.x, a.y); o.y = pk2(a.z, a.w); *(u32x2*)(KVC + ((size_t)kv * 2048 + row) * 64 + dq * 4) = o;
        }
    }
    SEAM(3);
    if (IN(4)) {
        for (int vb = blockIdx.x; vb < 256; vb += F.G) {
            const int bh = vb >> 5, p = vb & 31;
#pragma unroll 1
            for (int k = 0; k < 2; ++k) attn_unit_B(F, P, KVC, O, OB, bh >> 1, bh & 1, k == 0 ? 63 - p : p);
#pragma unroll 1
            for (int k = 0; k < 2; ++k) { const int id = 2 * vb + k; attn_unit_A(F, P, O, args.in[I_SINKS], id >> 7, (id >> 6) & 1, id & 63); }
        }
    }
    SEAM(4);
    if (IN(5)) {
        OrderSingle S{(const char*)O, (const char*)W_OUT, DM * 2, DM * 2, 64, 8, 512, F.G, (int)blockIdx.x};
        EpiResF32 E{args.in[I_X], H};
        pg8::gemm_phase<EpiResF32, OrderSingle, false>(ring, DM * 2, 128, DM * 2, DM / 64, S, E);
    }
    SEAM(5);
    if (IN(6)) { for (int m = F.gw; m < M; m += F.NGW) rms_row_to_bf16(H + (size_t)m * DM, args.in[I_FFN_NORM], XN + (size_t)m * DM, F.lane); }
    SEAM(6);
    if (IN(7)) {
        OrderSingle S{(const char*)XN, (const char*)FFN13, DM * 2, DM * 2, 64, 2 * DFF / 256, 64 * (2 * DFF / 256), F.G, (int)blockIdx.x};
        EpiSwiglu E{ACT, DFF};
        pg8::gemm_phase<EpiSwiglu, OrderSingle, false>(ring, DM * 2, 128, DM * 2, DM / 64, S, E);
    }
    SEAM(7);
    if (IN(8)) {
        OrderSingle S{(const char*)ACT, (const char*)FFN2, DFF * 2, DFF * 2, 64, 8, 512, F.G, (int)blockIdx.x};
        EpiResF32 E{H, H};
        pg8::gemm_phase<EpiResF32, OrderSingle, false>(ring, DFF * 2, 128, DFF * 2, DFF / 64, S, E);
    }
    SEAM(8);
    if (IN(9)) {
        const float* g = args.in[I_ATTN_NORM] + DM; const float* mu = args.in[I_MU];
        for (int m = F.gw; m < M; m += F.NGW) {
            f32x4 v[8], pv[8]; float rs, prs = 0.f;
            rms_row_load(H + (size_t)m * DM, F.lane, v, rs);
            const bool has_prev = (m % SEQ) != 0;
            if (has_prev) rms_row_load(H + (size_t)(m - 1) * DM, F.lane, pv, prs);
#pragma unroll
            for (int j = 0; j < 8; ++j) {
                const int col = 4 * F.lane + 256 * j; const f32x4 gg = *(const f32x4*)(g + col);
                const f32x4 hn = v[j] * rs * gg; f32x4 hp = (f32x4){0.f, 0.f, 0.f, 0.f}; if (has_prev) hp = pv[j] * prs * gg;
                const f32x4 xx = hp - hn;
#pragma unroll
                for (int i = 0; i < 6; ++i) { const f32x4 mm = *(const f32x4*)(mu + (size_t)i * DM + col); const f32x4 y = hn + xx * mm;
                    u32x2 w; w.x = pk2(y.x, y.y); w.y = pk2(y.z, y.w); *(u32x2*)(XS + ((size_t)i * M + m) * DM + col) = w; }
            }
        }
    }
    SEAM(9);
    if (IN(10)) {
        OrderMulti S{};
        for (int g = 0; g < 6; ++g) { S.A[g] = (const char*)(XS + (size_t)g * M * DM); S.Bt[g] = g < 3 ? (const char*)(WRKV + (size_t)g * DM * DM) : (const char*)(LORA1 + (size_t)(g - 3) * 256 * DM); S.nN[g] = g < 3 ? 8 : 1; }
        S.start[0] = 0; for (int g = 0; g < 6; ++g) S.start[g + 1] = S.start[g] + 64 * S.nN[g];
        S.lda = DM * 2; S.ldb = DM * 2; S.ng = 6; S.nwg = S.start[6]; S.G = F.G; S.c = (int)blockIdx.x;
        EpiRkvLora1 E{RKV, L1};
        pg8::gemm_phase<EpiRkvLora1, OrderMulti, false>(ring, DM * 2, 128, DM * 2, DM / 64, S, E);
    }
    SEAM(10);
    if (IN(11)) {
        OrderMulti S{};
        for (int g = 0; g < 3; ++g) { S.A[g] = (const char*)(L1 + (size_t)g * M * 256); S.Bt[g] = (const char*)(LORA2 + (size_t)g * DM * 256); S.nN[g] = 8; }
        for (int g = 3; g < 6; ++g) { S.A[g] = S.A[0]; S.Bt[g] = S.Bt[0]; S.nN[g] = 0; }
        S.start[0] = 0; for (int g = 0; g < 6; ++g) S.start[g + 1] = S.start[g] + 64 * S.nN[g];
        S.lda = 256 * 2; S.ldb = 256 * 2; S.ng = 3; S.nwg = S.start[3]; S.G = F.G; S.c = (int)blockIdx.x;
        EpiLora2 E{DEC, AA, GG, args.in[I_DECAY_W0], args.in[I_A0]};
        pg8::gemm_phase<EpiLora2, OrderMulti, false>(ring, 256 * 2, 128, 256 * 2, 4, S, E);
    }
    SEAM(11);
    if (IN(12)) phase_scan(F, RKV, DEC, AA, args.in[I_K_K], args.in[I_K_A], YRAW);
    SEAM(12);
    if (IN(13)) {
        const float* lnw = args.in[I_LN_W]; const float* lnb = args.in[I_LN_B]; const float* rk = args.in[I_R_K]; const float* kaw = args.in[I_K_A];
        for (int m = F.gw; m < M; m += F.NGW) {
            for (int hd = 0; hd < 32; ++hd) {
                const size_t o = (size_t)m * DM + hd * 64 + F.lane; const int ch = hd * 64 + F.lane;
                const float y = YRAW[o];
                const float mean = wave_sum(y) * (1.0f / 64.0f); const float d = y - mean; const float var = wave_sum(d * d) * (1.0f / 64.0f);
                float yn = d * (1.0f / sqrtf(var + GN_EPS)) * lnw[ch] + lnb[ch];
                const float r = bf2f(RKV[o]), k = bf2f(RKV[(size_t)M * DM + o]), v = bf2f(RKV[(size_t)2 * M * DM + o]);
                const float a = AA[o]; const float kp = k * (1.0f + (a - 1.0f) * kaw[ch]);
                const float bonus = wave_sum(r * kp * rk[ch]);
                yn += bonus * v;
                YG[o] = (bf16_t)f2bf(yn * bf2f(GG[o]));
            }
        }
    }
    SEAM(13);
    if (IN(14)) {
        OrderSingle S{(const char*)YG, (const char*)WO, DM * 2, DM * 2, 64, 8, 512, F.G, (int)blockIdx.x};
        EpiResF32 E{H, H};
        pg8::gemm_phase<EpiResF32, OrderSingle, false>(ring, DM * 2, 128, DM * 2, DM / 64, S, E);
    }
    SEAM(14);
    if (IN(15)) {
        LAS int* t_e = (LAS int*)F.lds;
        LAS float* t_w = (LAS float*)(F.lds + 512);
        LAS int* t_p = (LAS int*)(F.lds + 1024);
        const float* g = args.in[I_FFN_NORM] + DM; const float* rw = args.in[I_ROUTER];
        for (int base = blockIdx.x * 64; base < M; base += F.G * 64) {
            for (int qq = 0; qq < 8; ++qq) {
                const int lt = F.wave * 8 + qq, m = base + lt;
                f32x4 v[8]; float rs; rms_row_load(H + (size_t)m * DM, F.lane, v, rs);
                float lg[8] = {0.f, 0.f, 0.f, 0.f, 0.f, 0.f, 0.f, 0.f};
#pragma unroll
                for (int j = 0; j < 8; ++j) {
                    const int col = 4 * F.lane + 256 * j; const f32x4 gg = *(const f32x4*)(g + col); const f32x4 y = v[j] * rs * gg;
                    u32x2 w; w.x = pk2(y.x, y.y); w.y = pk2(y.z, y.w); *(u32x2*)(XN + (size_t)m * DM + col) = w;
#pragma unroll
                    for (int e4 = 0; e4 < 4; ++e4) { const f32x4 r0 = *(const f32x4*)(rw + (size_t)(col + e4) * 8), r1 = *(const f32x4*)(rw + (size_t)(col + e4) * 8 + 4); const float yy = y[e4];
                        lg[0] += yy * r0.x; lg[1] += yy * r0.y; lg[2] += yy * r0.z; lg[3] += yy * r0.w; lg[4] += yy * r1.x; lg[5] += yy * r1.y; lg[6] += yy * r1.z; lg[7] += yy * r1.w; }
                }
#pragma unroll
                for (int e = 0; e < 8; ++e) lg[e] = wave_sum(lg[e]);
                if (F.lane == 0) {
                    int i0 = 0; float v0 = lg[0];
#pragma unroll
                    for (int e = 1; e < 8; ++e) if (lg[e] > v0) { v0 = lg[e]; i0 = e; }
                    int i1 = -1; float v1 = -3.0e38f;
#pragma unroll
                    for (int e = 0; e < 8; ++e) if (e != i0 && (i1 < 0 || lg[e] > v1)) { v1 = lg[e]; i1 = e; }
                    const float w1 = 1.0f / (1.0f + expf(v0 - v1)), w0 = 1.0f - w1;
                    t_e[lt * 2] = i0; t_e[lt * 2 + 1] = i1; t_w[lt * 2] = w0; t_w[lt * 2 + 1] = w1;
                }
            }
            __syncthreads();
            if (F.tid < 8) {
                const int e = F.tid; int n = 0;
                for (int i = 0; i < 128; ++i) if (t_e[i] == e) { t_p[i] = n; ++n; }
                const int basep = n ? (int)__hip_atomic_fetch_add(ctl + CW_MOECNT + 64 * e, (unsigned)n, RLX_AGENT) : 0;
                for (int i = 0; i < 128; ++i) if (t_e[i] == e) t_p[i] += basep;
            }
            __syncthreads();
            if (F.tid < 128) { const int lt = F.tid >> 1, k = F.tid & 1, m = base + lt; const int e = t_e[F.tid], pos = t_p[F.tid];
                ROWTOK[e * M + pos] = m; TOKSLOT[m * 4 + k * 2] = e; TOKSLOT[m * 4 + k * 2 + 1] = pos; ((float*)TOKSLOT)[(size_t)M * 4 + m * 2 + k] = t_w[F.tid]; }
            __syncthreads();
        }
    }
    SEAM(15);
#define MOE_TABLE() do { if (F.tid == 0) { int ts_ = 0; for (int e = 0; e < 8; ++e) { const int ce = (int)__hip_atomic_load(ctl + CW_MOECNT + 64 * e, RLX_AGENT); moetab[16 + e] = ce; moetab[e] = ts_; ts_ += (ce + 255) >> 8; } moetab[8] = ts_; } __syncthreads(); } while (0)
    LAS int* moetab = (LAS int*)(F.lds + MISC_OFF + 256);
    if (IN(16)) {
        MOE_TABLE();
        OrderMoe SM; SM.tab = moetab;
        SM.A = (const char*)XN; SM.Bt = (const char*)MOE13; SM.rowtok = ROWTOK; SM.lda = DM * 2; SM.ldb = DM * 2; SM.bstride = (size_t)2 * DFFE * DM * 2; SM.nN = 2 * DFFE / 256;
        SM.nwg = moetab[8] * SM.nN; SM.G = F.G; SM.c = (int)blockIdx.x; SM.gather = true;
        EpiSwiglu E{ACT, DFFE};
        pg8::gemm_phase<EpiSwiglu, OrderMoe, true>(ring, DM * 2, 128, DM * 2, DM / 64, SM, E);
    }
    SEAM(16);
    if (IN(17)) {
        MOE_TABLE();
        OrderMoe SM; SM.tab = moetab;
        SM.A = (const char*)ACT; SM.Bt = (const char*)MOE2; SM.rowtok = ROWTOK; SM.lda = DFFE * 2; SM.ldb = DFFE * 2; SM.bstride = (size_t)DM * DFFE * 2; SM.nN = 8;
        SM.nwg = moetab[8] * SM.nN; SM.G = F.G; SM.c = (int)blockIdx.x; SM.gather = false;
        EpiF32 E{Y2};
        pg8::gemm_phase<EpiF32, OrderMoe, false>(ring, DFFE * 2, 128, DFFE * 2, DFFE / 64, SM, E);
    }
    SEAM(17);
    if (IN(18)) {
        MOE_TABLE();
        const float* g = args.in[I_FINAL_NORM];
        for (int m = F.gw; m < M; m += F.NGW) {
            const int e0 = TOKSLOT[m * 4], p0 = TOKSLOT[m * 4 + 1], e1 = TOKSLOT[m * 4 + 2], p1 = TOKSLOT[m * 4 + 3];
            const float w0 = ((const float*)TOKSLOT)[(size_t)M * 4 + m * 2], w1 = ((const float*)TOKSLOT)[(size_t)M * 4 + m * 2 + 1];
            const int ts0 = moetab[e0], ts1 = moetab[e1];
            const float* y0 = Y2 + ((size_t)ts0 * 256 + p0) * DM; const float* y1 = Y2 + ((size_t)ts1 * 256 + p1) * DM; const float* hr = H + (size_t)m * DM;
            f32x4 v[8]; float s = 0.f;
#pragma unroll
            for (int j = 0; j < 8; ++j) { const int col = 4 * F.lane + 256 * j; v[j] = *(const f32x4*)(hr + col) + (w0 * *(const f32x4*)(y0 + col) + w1 * *(const f32x4*)(y1 + col));
                s += (v[j].x * v[j].x + v[j].y * v[j].y) + (v[j].z * v[j].z + v[j].w * v[j].w); }
            const float rstd = 1.0f / sqrtf(wave_sum(s) * (1.0f / DM) + RMS_EPS);
#pragma unroll
            for (int j = 0; j < 8; ++j) { const int col = 4 * F.lane + 256 * j; *(f32x4*)(args.out + (size_t)m * DM + col) = v[j] * rstd * *(const f32x4*)(g + col); }
        }
    }
#undef IN
#undef SEAM
}

extern "C" void kernel_launch(void* const* d_in, const int* in_sizes, int n_in, void* d_out, int out_size, void* d_ws, size_t ws_size, hipStream_t stream) {
    static int grid = 0;
    if (grid == 0) {
        if (n_in != 33 || out_size != M * DM || ws_size < WS_END) { fprintf(stderr, "kernel_launch: unexpected shapes (n_in %d, out %d, ws %zu < %zu)\n", n_in, out_size, ws_size, (size_t)WS_END); grid = -1; return; }
        int dev = 0, cus = 0, per_cu = 0;
        if (hipGetDevice(&dev) != hipSuccess || hipDeviceGetAttribute(&cus, hipDeviceAttributeMultiprocessorCount, dev) != hipSuccess) { grid = -1; return; }
        if (hipFuncSetAttribute((const void*)mk_fwd, hipFuncAttributeMaxDynamicSharedMemorySize, LDS_BYTES) != hipSuccess) { fprintf(stderr, "kernel_launch: hipFuncSetAttribute failed\n"); grid = -1; return; }
        if (hipOccupancyMaxActiveBlocksPerMultiprocessor(&per_cu, (const void*)mk_fwd, NTHR, LDS_BYTES) != hipSuccess || per_cu < 1) fprintf(stderr, "kernel_launch: occupancy query reports %d\n", per_cu);
        (void)hipGetLastError();
        grid = cus < 256 ? cus : 256;
    }
    if (grid < 0) return;
    if (hipMemsetAsync((char*)d_ws + WS_CTL, 0, CTL_ZERO_BYTES, stream) != hipSuccess) return;
    Args a{};
    for (int i = 0; i < 33; ++i) a.in[i] = (const float*)d_in[i];
    a.out = (float*)d_out; a.ws = (unsigned char*)d_ws; a.pad = 0;
    if (MK_N_LAUNCHES == 1) {
        a.ph_lo = 0; a.ph_hi = NPHASE; a.use_bar = 1;
        hipLaunchKernelGGL(mk_fwd, dim3(grid), dim3(NTHR), LDS_BYTES, stream, a);
    } else {
        for (int p = 0; p < NPHASE; ++p) { a.ph_lo = p; a.ph_hi = p + 1; a.use_bar = 0; hipLaunchKernelGGL(mk_fwd, dim3(grid), dim3(NTHR), LDS_BYTES, stream, a); }
    }
}
```

```cpp
#include <hip/hip_runtime.h>
#include <cstdio>
#include <cstdint>

#define GAS __attribute__((address_space(1)))
#define LAS __attribute__((address_space(3)))
typedef unsigned short bf16_t;
typedef short bf16x8 __attribute__((ext_vector_type(8)));
typedef short s16x4 __attribute__((ext_vector_type(4)));
typedef float f32x4 __attribute__((ext_vector_type(4)));
typedef float f32x2 __attribute__((ext_vector_type(2)));
typedef float f32x16 __attribute__((ext_vector_type(16)));
typedef unsigned u32x4 __attribute__((ext_vector_type(4)));
typedef unsigned u32x2 __attribute__((ext_vector_type(2)));
typedef __bf16 bf16x2_t __attribute__((ext_vector_type(2)));
#define DI __device__ __forceinline__

#ifndef MK_N_LAUNCHES
#define MK_N_LAUNCHES 1
#endif

constexpr int BATCH = 4, SEQ = 4096, DM = 2048, M = BATCH * SEQ;
constexpr int NP = 3328;
constexpr int IN_COLS = 3120;
constexpr int C_QA = 0, C_KA = 1024, C_VA = 1152, C_QB = 1280, C_KCMP = 2304, C_VCMP = 2432, C_KSEL = 2560, C_VSEL = 2688, C_KWIN = 2816, C_VWIN = 2944, C_GATE = 3072;
constexpr int DFF = 5632, DFFE = 7168, NEXP = 8;
constexpr float RMS_EPS = 1e-5f, GN_EPS = 64e-5f;
constexpr float LOG2E = 1.4426950408889634f;
constexpr float QSCALE = 0.125f * LOG2E;
constexpr int NWAVES = 8, NTHR = 512;
constexpr int MOE_ROWS = 2 * M + NEXP * 256;

constexpr size_t MiB = 1u << 20;
constexpr size_t al(size_t x) { return (x + 0xFFFFF) & ~(size_t)0xFFFFF; }
constexpr size_t WS_CTL = 0, CTL_ZERO_BYTES = 1 * MiB;
constexpr size_t WS_W_IN = 1 * MiB;
constexpr size_t WS_W_OUT = WS_W_IN + al((size_t)NP * DM * 2);
constexpr size_t WS_CMPW1 = WS_W_OUT + al((size_t)DM * DM * 2);
constexpr size_t WS_FFN13 = WS_CMPW1 + al((size_t)2 * 256 * 2048 * 2);
constexpr size_t WS_FFN2 = WS_FFN13 + al((size_t)2 * DFF * DM * 2);
constexpr size_t WS_WRKV = WS_FFN2 + al((size_t)DM * DFF * 2);
constexpr size_t WS_LORA1 = WS_WRKV + al((size_t)3 * DM * DM * 2);
constexpr size_t WS_LORA2 = WS_LORA1 + al((size_t)3 * 256 * DM * 2);
constexpr size_t WS_WO = WS_LORA2 + al((size_t)3 * DM * 256 * 2);
constexpr size_t WS_MOE13 = WS_WO + al((size_t)DM * DM * 2);
constexpr size_t WS_MOE2 = WS_MOE13 + al((size_t)NEXP * 2 * DFFE * DM * 2);
constexpr size_t WS_XN = WS_MOE2 + al((size_t)NEXP * DM * DFFE * 2);
constexpr size_t WS_P = WS_XN + al((size_t)M * DM * 2);
constexpr size_t WS_ROPE = WS_P + al((size_t)(M + 64) * NP * 2);
constexpr size_t WS_CMPB = WS_ROPE + al((size_t)M * 64 * 4);
constexpr size_t WS_HID = WS_CMPB + MiB;
constexpr size_t WS_KVC = WS_HID + al((size_t)2 * 2048 * 256 * 2);
constexpr size_t WS_O = WS_KVC + al((size_t)2 * 2048 * 64 * 2);
constexpr size_t WS_H = WS_O + al((size_t)M * DM * 2);
constexpr size_t WS_ACT = WS_H + al((size_t)M * DM * 4);
constexpr size_t WS_XS = WS_ACT + al((size_t)MOE_ROWS * DFFE * 2);
constexpr size_t WS_RKV = WS_XS + al((size_t)6 * M * DM * 2);
constexpr size_t WS_L1 = WS_RKV + al((size_t)3 * M * DM * 2);
constexpr size_t WS_DEC = WS_L1 + al((size_t)3 * M * 256 * 2);
constexpr size_t WS_AA = WS_DEC + al((size_t)M * DM * 4);
constexpr size_t WS_GG = WS_AA + al((size_t)M * DM * 4);
constexpr size_t WS_YRAW = WS_GG + al((size_t)M * DM * 2);
constexpr size_t WS_YG = WS_YRAW + al((size_t)M * DM * 4);
constexpr size_t WS_ROWTOK = WS_YG + al((size_t)M * DM * 2);
constexpr size_t WS_TOKSLOT = WS_ROWTOK + al((size_t)NEXP * M * 4);
constexpr size_t WS_Y2 = WS_TOKSLOT + al((size_t)M * 16);
constexpr size_t WS_END = WS_Y2 + al((size_t)MOE_ROWS * DM * 4);
constexpr int CW_BAR = 0;
constexpr int CW_MOECNT = 4096;

constexpr int RING_BYTES = 131072, LDSCTL_OFF = RING_BYTES, MISC_OFF = LDSCTL_OFF + 320, LDS_BYTES = 147456;

#define RLX_AGENT __ATOMIC_RELAXED, __HIP_MEMORY_SCOPE_AGENT
DI unsigned f2bf(float f) { unsigned u = __builtin_bit_cast(unsigned, f); return (u + 0x7fffu + ((u >> 16) & 1u)) >> 16; }
DI unsigned pk2(float lo, float hi) { f32x2 v = {lo, hi}; bf16x2_t b = __builtin_convertvector(v, bf16x2_t); return __builtin_bit_cast(unsigned, b); }
DI float bf2f(unsigned short b) { return __builtin_bit_cast(float, ((unsigned)b) << 16); }
DI float bflo(unsigned w) { return __builtin_bit_cast(float, w << 16); }
DI float bfhi(unsigned w) { return __builtin_bit_cast(float, w & 0xffff0000u); }
DI float wave_sum(float v) {
#pragma unroll
    for (int o = 1; o < 64; o <<= 1) v += __shfl_xor(v, o);
    return v;
}
DI int opq(int x) { asm volatile("" : "+v"(x)); return x; }
DI float ex2(float x) { return __builtin_amdgcn_exp2f(x); }
DI float sigmoidf_(float x) { return 1.0f / (1.0f + __expf(-x)); }
DI float siluf_(float x) { return x / (1.0f + __expf(-x)); }
DI float tanhf_(float x) { return 1.0f - 2.0f / (__expf(2.0f * x) + 1.0f); }

#define XB_TMO      128
#define XB_XCNT(j)  (256  + 64 * (j))
#define XB_XSUB(j)  (1280 + 64 * (j))
#define XB_XGEN(j)  (2304 + 64 * (j))
#define XB_TOP      3328
#define XB_TOPGEN   3392
#define XCD_BAR_WORDS 3456
#define XB_SPIN_CAP (1u << 22)
DI unsigned xb_ld(unsigned* p)              { return __hip_atomic_load(p, __ATOMIC_RELAXED, __HIP_MEMORY_SCOPE_AGENT); }
DI unsigned xb_add(unsigned* p, unsigned v) { return __hip_atomic_fetch_add(p, v, __ATOMIC_RELAXED, __HIP_MEMORY_SCOPE_AGENT); }
DI unsigned xb_xcc_id() { return (unsigned)__builtin_amdgcn_s_getreg((3 << 11) | 20) & 0xFu; }
#define XB_SPIN(cond, bar) do { unsigned _sp = 0; while (cond) { __builtin_amdgcn_s_sleep(1); \
    if ((++_sp & 255u) == 0u) { if (xb_ld(&(bar)[XB_TMO])) break; if (_sp > XB_SPIN_CAP) { atomicAdd(&(bar)[XB_TMO], 1u); break; } } } } while (0)
struct XcdBarrier { unsigned* bar; unsigned x; volatile LAS unsigned* st; };
DI XcdBarrier xcd_barrier_post(unsigned* bar, volatile LAS unsigned* st) {
    XcdBarrier b; b.bar = bar; b.x = xb_xcc_id(); b.st = st;
    if (threadIdx.x == 0) (void)xb_add(&bar[XB_XCNT(b.x)], 1u);
    return b;
}
DI void xcd_barrier_complete(unsigned* bar, unsigned x, unsigned& nloc, unsigned& nx) {
    const unsigned G = gridDim.x * gridDim.y * gridDim.z;
    unsigned sum, cnt, mine, sp = 0u;
    for (;;) {
        sum = 0u; cnt = 0u; mine = 0u;
#pragma unroll
        for (unsigned j = 0; j < 16; ++j) { const unsigned c = xb_ld(&bar[XB_XCNT(j)]); sum += c; cnt += (c > 0u) ? 1u : 0u; mine = (j == x) ? c : mine; }
        if (sum == G) break;
        __builtin_amdgcn_s_sleep(1);
        if ((++sp & 255u) == 0u) { if (xb_ld(&bar[XB_TMO])) break; if (sp > XB_SPIN_CAP) { atomicAdd(&bar[XB_TMO], 1u); break; } }
    }
    nloc = mine > 0u ? mine : 1u; nx = cnt > 0u ? cnt : 1u;
}
DI void xcd_barrier(const XcdBarrier& b) {
    asm volatile("s_waitcnt vmcnt(0)" ::: "memory");
    __syncthreads();
    if (threadIdx.x == 0) {
        unsigned* bar = b.bar;
        __builtin_amdgcn_s_waitcnt(0);
        unsigned nloc = b.st[0], nx = b.st[1];
        if (nloc == 0u) { xcd_barrier_complete(bar, b.x, nloc, nx); b.st[0] = nloc; b.st[1] = nx; }
        const unsigned old = xb_add(&bar[XB_XSUB(b.x)], 1u);
        const unsigned gen = old / nloc;
        if (old + 1u == (gen + 1u) * nloc) {
            __builtin_amdgcn_fence(__ATOMIC_RELEASE, "agent");
            asm volatile("s_waitcnt vmcnt(0)" ::: "memory");
            const unsigned og = xb_add(&bar[XB_TOP], 1u);
            const unsigned tg = og / nx;
            if (og + 1u == (tg + 1u) * nx) xb_add(&bar[XB_TOPGEN], 1u);
            else XB_SPIN(xb_ld(&bar[XB_TOPGEN]) == tg, bar);
            __builtin_amdgcn_fence(__ATOMIC_ACQUIRE, "agent");
            xb_add(&bar[XB_XGEN(b.x)], 1u);
            asm volatile("s_waitcnt vmcnt(0)" ::: "memory");
        } else {
            XB_SPIN(xb_ld(&bar[XB_XGEN(b.x)]) == gen, bar);
            __builtin_amdgcn_fence(__ATOMIC_ACQUIRE, "agent");
            asm volatile("s_waitcnt vmcnt(0)" ::: "memory");
        }
    }
    __syncthreads();
}

namespace pg8 {
constexpr int BM = 256, BK = 64, HALF = 128, HTB = HALF * BK * 2, STAGE_BYTES = 8 * HTB, NXCD = 8, WGM = 8;
__host__ __device__ __forceinline__ int lds_byte(int r, int c) { const int st = (r >> 4) * 2 + (c >> 5), rr = r & 15, cc = c & 31, ob = rr * 64 + cc * 2; return st * 1024 + (ob ^ (((ob >> 9) & 1) << 5)); }
__host__ __device__ __forceinline__ void stage_rc(int b, int& R, int& C) { const int st = b / 1024, sb = b % 1024, swz = sb ^ (((sb >> 9) & 1) << 5); R = (st >> 1) * 16 + swz / 64; C = (st & 1) * 32 + (swz % 64) / 2; }
__host__ __device__ __forceinline__ int perm32(int rho) { const int n = rho >> 4, i = rho & 15; return 8 * (i >> 2) + 4 * n + (i & 3); }

struct Unit { const char* a; const char* b; int pm, pn, g; };

DI int xcd_remap(int L, int nwg) { const int q = nwg / NXCD, r = nwg % NXCD, xcd = L % NXCD, off = L / NXCD; return (xcd < r ? xcd * (q + 1) : r * (q + 1) + (xcd - r) * q) + off; }
DI void tile_map(int idx, int nM, int nN, int& pm, int& pn) { const int nig = WGM * nN, gid = idx / nig, fm = gid * WGM, gsz = (nM - fm) < WGM ? (nM - fm) : WGM; pm = fm + ((idx % nig) % gsz); pn = (idx % nig) / gsz; }

template <class Epi, class Sched, bool GATHER>
DI void gemm_phase(LAS unsigned char* lds, const unsigned lda, const unsigned ka, const unsigned ldb, const int nt, const Sched& S, const Epi& E) {
    const int tid = threadIdx.x, wid = __builtin_amdgcn_readfirstlane(tid >> 6), lane = tid & 63, wr = wid >> 2, wc = wid & 3, fr = lane & 15, fq = lane >> 4;
    int Rr[2], Cc[2];
    unsigned vB[2], vA[2][2], vN[2][2];
#pragma unroll
    for (int i = 0; i < 2; ++i) { stage_rc(tid * 16 + i * 8192, Rr[i], Cc[i]); const int Rb = (Rr[i] & ~31) + perm32(Rr[i] & 31); vB[i] = (unsigned)Rb * ldb + (unsigned)Cc[i] * 2u; }
    const size_t kb = (size_t)(BK * 2);
    const size_t hB = (size_t)HALF * ldb;
    const unsigned ldsw = (unsigned)wid * 1024u;
    const int aoff = lds_byte(wr * 64 + fr, fq * 8), boff = lds_byte(wc * 32 + fr, fq * 8);
#define PG8_SA(b, h) (((b) * 2 + (h)) * HTB)
#define PG8_SB(b, h) ((4 + (b) * 2 + (h)) * HTB)
#define PG8_STAGE(bufoff, gbase, v0, v1) do { \
        __builtin_amdgcn_global_load_lds((const unsigned*)((const char*)(gbase) + (v0)), (LAS unsigned*)(lds + (bufoff) + ldsw), 16, 0, 0); \
        __builtin_amdgcn_global_load_lds((const unsigned*)((const char*)(gbase) + (v1)), (LAS unsigned*)(lds + (bufoff) + ldsw + 8192), 16, 0, 0); } while (0)
#define PG8_LDA(dst, b, h) do { _Pragma("unroll") for (int m = 0; m < 4; ++m) _Pragma("unroll") for (int k = 0; k < 2; ++k) dst[m][k] = *(const LAS bf16x8*)(lds + PG8_SA(b, h) + aoff + m * 2048 + k * 1024); } while (0)
#define PG8_LDB(dst, b, h) do { _Pragma("unroll") for (int n = 0; n < 2; ++n) _Pragma("unroll") for (int k = 0; k < 2; ++k) dst[n][k] = *(const LAS bf16x8*)(lds + PG8_SB(b, h) + boff + n * 2048 + k * 1024); } while (0)
#define PG8_MMA(ai, bj, At, Bt) do { __builtin_amdgcn_s_setprio(1); _Pragma("unroll") for (int m = 0; m < 4; ++m) _Pragma("unroll") for (int n = 0; n < 2; ++n) _Pragma("unroll") for (int k = 0; k < 2; ++k) \
        acc[ai][bj][m][n] = __builtin_amdgcn_mfma_f32_16x16x32_bf16(Bt[n][k], At[m][k], acc[ai][bj][m][n], 0, 0, 0); __builtin_amdgcn_s_setprio(0); } while (0)
#define PG8_WAIT_V(n) asm volatile("s_waitcnt vmcnt(" #n ")" ::: "memory")
#define PG8_WAIT_L(n) asm volatile("s_waitcnt lgkmcnt(" #n ")" ::: "memory")
#define PG8_BAR __builtin_amdgcn_s_barrier()
#define PG8_SCHED __builtin_amdgcn_sched_barrier(0)
    Unit cur, nxt; int ui = 0;
    if (!S.next(0, cur)) return;
#pragma unroll
    for (int h = 0; h < 2; ++h)
#pragma unroll
        for (int i = 0; i < 2; ++i) {
            if constexpr (GATHER) vA[h][i] = S.rowoff(cur, h * HALF + Rr[i]) + (unsigned)Cc[i] * 2u;
            else vA[h][i] = (unsigned)(h * HALF + Rr[i]) * lda + (unsigned)Cc[i] * 2u;
            vN[h][i] = vA[h][i];
        }
    f32x4 acc[2][2][4][2];
#pragma unroll
    for (int a = 0; a < 2; ++a)
#pragma unroll
        for (int b = 0; b < 2; ++b)
#pragma unroll
            for (int m = 0; m < 4; ++m)
#pragma unroll
                for (int n = 0; n < 2; ++n) acc[a][b][m][n] = (f32x4){0.f, 0.f, 0.f, 0.f};
    bf16x8 At[4][2], B0[2][2], B1[2][2];
    const char* cA = cur.a; const char* cB = cur.b;
    PG8_STAGE(PG8_SB(0, 0), cB, vB[0], vB[1]); PG8_STAGE(PG8_SB(0, 1), cB + hB, vB[0], vB[1]); PG8_STAGE(PG8_SA(0, 0), cA, vA[0][0], vA[0][1]); PG8_STAGE(PG8_SA(0, 1), cA, vA[1][0], vA[1][1]);
    if (wr == 1) PG8_BAR;
    PG8_WAIT_V(2); PG8_BAR;
    PG8_STAGE(PG8_SB(1, 0), cB + kb, vB[0], vB[1]); PG8_STAGE(PG8_SA(1, 0), cA + ka, vA[0][0], vA[0][1]); PG8_STAGE(PG8_SB(1, 1), cB + hB + kb, vB[0], vB[1]);
    PG8_WAIT_V(6); PG8_BAR;
    for (;;) {
        const bool has_next = S.next(ui + 1, nxt);
        const char* nA = has_next ? nxt.a : cA; const char* nB = has_next ? nxt.b : cB;
        if constexpr (GATHER) {
            if (has_next) {
#pragma unroll
                for (int h = 0; h < 2; ++h)
#pragma unroll
                    for (int i = 0; i < 2; ++i) vN[h][i] = S.rowoff(nxt, h * HALF + Rr[i]) + (unsigned)Cc[i] * 2u;
            }
        }
        for (int t = 0; t < nt; t += 2) {
            const bool last = (t == nt - 2);
            const char* a1 = cA + (size_t)(t + 1) * ka;
            const char* a2 = last ? nA : cA + (size_t)(t + 2) * ka; const char* b2 = last ? nB : cB + (size_t)(t + 2) * kb;
            const char* a3 = a2 + ka; const char* b3 = b2 + kb;
            unsigned x00 = vA[0][0], x01 = vA[0][1], x10 = vA[1][0], x11 = vA[1][1];
            if constexpr (GATHER) { if (last) { x00 = vN[0][0]; x01 = vN[0][1]; x10 = vN[1][0]; x11 = vN[1][1]; } }
            PG8_LDB(B0, 0, 0); PG8_LDB(B1, 0, 1); PG8_SCHED; PG8_LDA(At, 0, 0); PG8_STAGE(PG8_SA(1, 1), a1, vA[1][0], vA[1][1]);
            PG8_WAIT_V(8); PG8_WAIT_L(0); PG8_BAR; PG8_MMA(0, 0, At, B0); PG8_MMA(0, 1, At, B1); PG8_BAR; PG8_SCHED;
            PG8_LDA(At, 0, 1); PG8_STAGE(PG8_SB(0, 0), b2, vB[0], vB[1]); PG8_STAGE(PG8_SB(0, 1), b2 + hB, vB[0], vB[1]); PG8_STAGE(PG8_SA(0, 0), a2, x00, x01);
            PG8_WAIT_V(8); PG8_WAIT_L(0); PG8_BAR; PG8_MMA(1, 0, At, B0); PG8_MMA(1, 1, At, B1); PG8_BAR; PG8_SCHED;
            PG8_LDB(B0, 1, 0); PG8_LDB(B1, 1, 1); PG8_SCHED; PG8_LDA(At, 1, 0); PG8_STAGE(PG8_SA(0, 1), a2, x10, x11);
            PG8_WAIT_V(8); PG8_WAIT_L(0); PG8_BAR; PG8_MMA(0, 0, At, B0); PG8_MMA(0, 1, At, B1); PG8_BAR; PG8_SCHED;
            PG8_LDA(At, 1, 1); PG8_STAGE(PG8_SB(1, 0), b3, vB[0], vB[1]); PG8_STAGE(PG8_SB(1, 1), b3 + hB, vB[0], vB[1]); PG8_STAGE(PG8_SA(1, 0), a3, x00, x01);
            PG8_WAIT_V(8); PG8_WAIT_L(0); PG8_BAR; PG8_MMA(1, 0, At, B0); PG8_MMA(1, 1, At, B1); PG8_BAR; PG8_SCHED;
        }
        if (wr == 0) PG8_BAR;
        E(acc, cur, wr, wc, fr, fq);
        if (!has_next) break;
#pragma unroll
        for (int a = 0; a < 2; ++a)
#pragma unroll
            for (int b = 0; b < 2; ++b)
#pragma unroll
                for (int m = 0; m < 4; ++m)
#pragma unroll
                    for (int n = 0; n < 2; ++n) acc[a][b][m][n] = (f32x4){0.f, 0.f, 0.f, 0.f};
        cur = nxt; cA = nA; cB = nB; ++ui;
        if constexpr (GATHER) {
#pragma unroll
            for (int h = 0; h < 2; ++h)
#pragma unroll
                for (int i = 0; i < 2; ++i) vA[h][i] = vN[h][i];
        }
        if (wr == 1) PG8_BAR;
    }
    PG8_WAIT_V(0);
    PG8_BAR;
#undef PG8_SA
#undef PG8_SB
#undef PG8_STAGE
#undef PG8_LDA
#undef PG8_LDB
#undef PG8_MMA
#undef PG8_WAIT_V
#undef PG8_WAIT_L
#undef PG8_BAR
#undef PG8_SCHED
}
}

typedef f32x4 AccT[2][2][4][2];
DI void st_bf16x8(bf16_t* p, f32x4 v0, f32x4 v1) { u32x4 w; w.x = pk2(v0[0], v0[1]); w.y = pk2(v0[2], v0[3]); w.z = pk2(v1[0], v1[1]); w.w = pk2(v1[2], v1[3]); *(u32x4*)p = w; }

struct OrderSingle {
    const char* A; const char* Bt; unsigned lda, ldb; int nM, nN, nwg, G, c;
    DI bool next(int i, pg8::Unit& u) const {
        const long L = (long)i * G + c; if (L >= nwg) return false;
        const int w = pg8::xcd_remap((int)L, nwg); int pm, pn; pg8::tile_map(w, nM, nN, pm, pn);
        u.pm = pm; u.pn = pn; u.g = 0; u.a = A + (size_t)pm * 256 * lda; u.b = Bt + (size_t)pn * 256 * ldb; return true;
    }
    DI unsigned rowoff(const pg8::Unit&, int) const { return 0u; }
};
struct OrderMulti {
    const char* A[6]; const char* Bt[6]; int nN[6]; int start[7]; unsigned lda, ldb; int ng, nwg, G, c;
    DI bool next(int i, pg8::Unit& u) const {
        const long L = (long)i * G + c; if (L >= nwg) return false;
        const int w = pg8::xcd_remap((int)L, nwg);
        int g = 0; const char* a = A[0]; const char* b = Bt[0]; int nn = nN[0], st = start[0];
#pragma unroll
        for (int k = 1; k < 6; ++k) if (k < ng && w >= start[k]) { g = k; a = A[k]; b = Bt[k]; nn = nN[k]; st = start[k]; }
        int pm, pn; pg8::tile_map(w - st, 64, nn, pm, pn);
        u.pm = pm; u.pn = pn; u.g = g; u.a = a + (size_t)pm * 256 * lda; u.b = b + (size_t)pn * 256 * ldb; return true;
    }
    DI unsigned rowoff(const pg8::Unit&, int) const { return 0u; }
};
struct OrderCmp {
    const char* P; const char* Bt; int G, c;
    DI bool next(int i, pg8::Unit& u) const {
        const int L = i * G + c; if (L >= 16) return false;
        const int kv = L >> 3, bh = L & 7, b = bh >> 1, h = bh & 1;
        u.pm = bh; u.pn = 0; u.g = kv;
        u.a = P + ((size_t)b * SEQ * NP + (size_t)(C_KCMP + kv * 128 + h * 64)) * 2;
        u.b = Bt + (size_t)kv * 256 * 2048 * 2; return true;
    }
    DI unsigned rowoff(const pg8::Unit&, int) const { return 0u; }
};
struct OrderMoe {
    const char* A; const char* Bt; const int* rowtok; const LAS int* tab; unsigned lda, ldb; size_t bstride; int nN, nwg, G, c; bool gather;
    DI bool next(int i, pg8::Unit& u) const {
        const long L = (long)i * G + c; if (L >= nwg) return false;
        const int w = (int)L;
        const int tau = w / nN, pn = w % nN;
        int e = 0;
#pragma unroll
        for (int k = 1; k < 8; ++k) if (tau >= tab[k]) e = k;
        u.pm = tau; u.pn = pn; u.g = e;
        u.a = gather ? A : A + (size_t)tau * 256 * lda;
        u.b = Bt + (size_t)e * bstride + (size_t)pn * 256 * ldb; return true;
    }
    DI unsigned rowoff(const pg8::Unit& u, int row) const {
        const int e = u.g; const int ce = tab[16 + e], ts = tab[e];
        const int pos = (u.pm - ts) * 256 + row;
        const int tok = pos < ce ? rowtok[e * M + pos] : 0;
        return (unsigned)tok * lda;
    }
};

struct EpiInProj {
    bf16_t* P; const float* rope;
    DI void operator()(const AccT& acc, const pg8::Unit& u, int wr, int wc, int fr, int fq) const {
        const int row0 = u.pm * 256 + wr * 64 + fr;
#pragma unroll
        for (int bj = 0; bj < 2; ++bj) {
            const int cb = u.pn * 256 + bj * 128;
            const int col0 = cb + wc * 32 + 8 * fq;
            const bool do_rope = cb < C_VA;
            const float sc = (cb < C_KA || (cb >= C_QB && cb < C_KCMP)) ? QSCALE : 1.0f;
            const int uidx = 4 * (wc & 1) + fq;
#pragma unroll
            for (int ai = 0; ai < 2; ++ai)
#pragma unroll
                for (int m = 0; m < 4; ++m) {
                    const int row = row0 + ai * 128 + m * 16;
                    f32x4 v0 = acc[ai][bj][m][0], v1 = acc[ai][bj][m][1];
                    if (do_rope) {
                        const f32x4 cs = *(const f32x4*)(rope + (size_t)row * 64 + 4 * uidx), sn = *(const f32x4*)(rope + (size_t)row * 64 + 32 + 4 * uidx);
                        const f32x4 o0 = v0 * cs - v1 * sn, o1 = v1 * cs + v0 * sn; v0 = o0; v1 = o1;
                    }
                    v0 = v0 * sc; v1 = v1 * sc;
                    st_bf16x8(P + (size_t)row * NP + col0, v0, v1);
                }
        }
    }
};
struct EpiCmp1 {
    bf16_t* HID; const float* bias;
    DI void operator()(const AccT& acc, const pg8::Unit& u, int wr, int wc, int fr, int fq) const {
        const int row0 = wr * 64 + fr;
#pragma unroll
        for (int bj = 0; bj < 2; ++bj) {
            const int col0 = bj * 128 + wc * 32 + 8 * fq;
            const f32x4 b0 = *(const f32x4*)(bias + u.g * 256 + col0), b1 = *(const f32x4*)(bias + u.g * 256 + col0 + 4);
#pragma unroll
            for (int ai = 0; ai < 2; ++ai)
#pragma unroll
                for (int m = 0; m < 4; ++m) {
                    const int row = row0 + ai * 128 + m * 16;
                    f32x4 v0 = acc[ai][bj][m][0] + b0, v1 = acc[ai][bj][m][1] + b1;
#pragma unroll
                    for (int j = 0; j < 4; ++j) { v0[j] = siluf_(v0[j]); v1[j] = siluf_(v1[j]); }
                    st_bf16x8(HID + ((size_t)(u.g * 2048 + u.pm * 256 + row)) * 256 + col0, v0, v1);
                }
        }
    }
};
struct EpiResF32 {
    const float* res; float* out;
    DI void operator()(const AccT& acc, const pg8::Unit& u, int wr, int wc, int fr, int fq) const {
        const int row0 = u.pm * 256 + wr * 64 + fr;
#pragma unroll
        for (int ai = 0; ai < 2; ++ai)
#pragma unroll
            for (int m = 0; m < 4; ++m) {
                const size_t ro = (size_t)(row0 + ai * 128 + m * 16) * DM;
#pragma unroll
                for (int bj = 0; bj < 2; ++bj) {
                    const int col0 = u.pn * 256 + bj * 128 + wc * 32 + 8 * fq;
                    const f32x4 r0 = *(const f32x4*)(res + ro + col0), r1 = *(const f32x4*)(res + ro + col0 + 4);
                    *(f32x4*)(out + ro + col0) = r0 + acc[ai][bj][m][0]; *(f32x4*)(out + ro + col0 + 4) = r1 + acc[ai][bj][m][1];
                }
            }
    }
};
struct EpiSwiglu {
    bf16_t* ACT; int ldc;
    DI void operator()(const AccT& acc, const pg8::Unit& u, int wr, int wc, int fr, int fq) const {
        const int row0 = u.pm * 256 + wr * 64 + fr; const int col0 = u.pn * 128 + wc * 32 + 8 * fq;
#pragma unroll
        for (int ai = 0; ai < 2; ++ai)
#pragma unroll
            for (int m = 0; m < 4; ++m) {
                f32x4 v0, v1;
#pragma unroll
                for (int j = 0; j < 4; ++j) { v0[j] = siluf_(acc[ai][0][m][0][j]) * acc[ai][1][m][0][j]; v1[j] = siluf_(acc[ai][0][m][1][j]) * acc[ai][1][m][1][j]; }
                st_bf16x8(ACT + (size_t)(row0 + ai * 128 + m * 16) * ldc + col0, v0, v1);
            }
    }
};
struct EpiRkvLora1 {
    bf16_t* RKV; bf16_t* L1;
    DI void operator()(const AccT& acc, const pg8::Unit& u, int wr, int wc, int fr, int fq) const {
        const int row0 = u.pm * 256 + wr * 64 + fr; const int g = u.g;
        bf16_t* base = g < 3 ? RKV + (size_t)g * M * DM : L1 + (size_t)(g - 3) * M * 256;
        const int ldc = g < 3 ? DM : 256;
#pragma unroll
        for (int ai = 0; ai < 2; ++ai)
#pragma unroll
            for (int m = 0; m < 4; ++m)
#pragma unroll
                for (int bj = 0; bj < 2; ++bj) {
                    const int col0 = u.pn * 256 + bj * 128 + wc * 32 + 8 * fq;
                    f32x4 v0 = acc[ai][bj][m][0], v1 = acc[ai][bj][m][1];
                    if (g == 3) {
#pragma unroll
                        for (int j = 0; j < 4; ++j) { v0[j] = tanhf_(v0[j]); v1[j] = tanhf_(v1[j]); }
                    } else if (g == 5) {
#pragma unroll
                        for (int j = 0; j < 4; ++j) { v0[j] = sigmoidf_(v0[j]); v1[j] = sigmoidf_(v1[j]); }
                    }
                    st_bf16x8(base + (size_t)(row0 + ai * 128 + m * 16) * ldc + col0, v0, v1);
                }
    }
};
struct EpiLora2 {
    float* DEC; float* AA; bf16_t* GG; const float* w0; const float* a0;
    DI void operator()(const AccT& acc, const pg8::Unit& u, int wr, int wc, int fr_, int fq_) const {
        const int fr = opq(fr_), fq = opq(fq_);
        const int row0 = u.pm * 256 + wr * 64 + fr; const int g = u.g;
        const float* cvec = g == 0 ? w0 : a0;
        float* outf = g == 0 ? DEC : AA;
#pragma unroll
        for (int bj = 0; bj < 2; ++bj) {
            const int col0 = u.pn * 256 + bj * 128 + wc * 32 + 8 * fq;
            f32x4 c0 = (f32x4){0.f, 0.f, 0.f, 0.f}, c1 = c0;
            if (g < 2) { c0 = *(const f32x4*)(cvec + col0); c1 = *(const f32x4*)(cvec + col0 + 4); }
#pragma unroll
            for (int ai = 0; ai < 2; ++ai)
#pragma unroll
                for (int m = 0; m < 4; ++m) {
                    const size_t ro = (size_t)(row0 + ai * 128 + m * 16) * DM + col0;
                    f32x4 v0 = acc[ai][bj][m][0] + c0, v1 = acc[ai][bj][m][1] + c1;
                    if (g < 2) {
#pragma unroll
                        for (int j = 0; j < 4; ++j) { v0[j] = sigmoidf_(v0[j]); v1[j] = sigmoidf_(v1[j]); }
                        if (g == 0) {
#pragma unroll
                            for (int j = 0; j < 4; ++j) { v0[j] = __expf(-0.60653065971f * v0[j]); v1[j] = __expf(-0.60653065971f * v1[j]); }
                        }
                        *(f32x4*)(outf + ro) = v0; *(f32x4*)(outf + ro + 4) = v1;
                    } else st_bf16x8(GG + ro, v0, v1);
                    asm volatile("" ::: "memory");
                }
        }
    }
};
struct EpiF32 {
    float* out;
    DI void operator()(const AccT& acc, const pg8::Unit& u, int wr, int wc, int fr, int fq) const {
        const int row0 = u.pm * 256 + wr * 64 + fr;
#pragma unroll
        for (int ai = 0; ai < 2; ++ai)
#pragma unroll
            for (int m = 0; m < 4; ++m) {
                const size_t ro = (size_t)(row0 + ai * 128 + m * 16) * DM;
#pragma unroll
                for (int bj = 0; bj < 2; ++bj) {
                    const int col0 = u.pn * 256 + bj * 128 + wc * 32 + 8 * fq;
                    *(f32x4*)(out + ro + col0) = acc[ai][bj][m][0]; *(f32x4*)(out + ro + col0 + 4) = acc[ai][bj][m][1];
                }
            }
    }
};

struct Args { const float* in[33]; float* out; unsigned char* ws; int ph_lo, ph_hi, use_bar, pad; };
enum { I_X = 0, I_POS, I_ATTN_NORM, I_FFN_NORM, I_FINAL_NORM, I_W_IN, I_W_OUT, I_SINKS, I_CMP_PE, I_CMP_W1, I_CMP_B1, I_CMP_W2, I_FFN_W13, I_FFN_W2, I_MU, I_W_RKV, I_DECAY_W0, I_DECAY_W1,
       I_DECAY_W2, I_A0, I_A1, I_A2, I_G1, I_G2, I_K_K, I_K_A, I_R_K, I_LN_W, I_LN_B, I_W_O, I_ROUTER, I_MOE_W13, I_MOE_W2 };

struct Frame {
    LAS unsigned char* lds;
    int tid, lane, wave, G, gw, NGW;
    unsigned char* ws;
};

template <class F>
DI void transpose_item(const float* W, int Nsrc, int kvalid, bf16_t* WT, int Kd, const F& srccol, int k0, int n0, LAS float* scr, int lane) {
    const int sc = srccol(n0 + (lane & 31));
#pragma unroll 8
    for (int i = 0; i < 32; ++i) { const int kk = 2 * i + (lane >> 5); float v = 0.f; if (sc >= 0 && k0 + kk < kvalid) v = W[(size_t)(k0 + kk) * Nsrc + sc]; scr[kk * 33 + (lane & 31)] = v; }
    asm volatile("s_waitcnt lgkmcnt(0)" ::: "memory");
    const int c = lane & 7;
#pragma unroll
    for (int j = 0; j < 4; ++j) { const int n = (lane >> 3) + 8 * j; const LAS float* s = scr + (8 * c) * 33 + n;
        u32x4 o; o.x = pk2(s[0 * 33], s[1 * 33]); o.y = pk2(s[2 * 33], s[3 * 33]); o.z = pk2(s[4 * 33], s[5 * 33]); o.w = pk2(s[6 * 33], s[7 * 33]);
        *(u32x4*)(WT + (size_t)(n0 + n) * Kd + k0 + 8 * c) = o; }
    asm volatile("s_waitcnt lgkmcnt(0)" ::: "memory");
}
template <class F>
DI void transpose_matrix(const Frame& F_, const float* W, int Nsrc, int kvalid, bf16_t* WT, int Kd, int Nd, const F& srccol, LAS float* scr) {
    const int nkb = Kd / 64, nnb = Nd / 32, nitems = nkb * nnb;
    for (int it = F_.gw; it < nitems; it += F_.NGW) { const int kbi = it / nnb, nb = it % nnb; transpose_item(W, Nsrc, kvalid, WT, Kd, srccol, 64 * kbi, 32 * nb, scr, F_.lane); }
}
struct ColIdent { int n; DI int operator()(int c) const { return c < n ? c : -1; } };
struct ColInProj { DI int operator()(int c) const { if (c >= IN_COLS) return -1; if (c >= C_VA) return c; const int head = c >> 6, l = c & 63; const int o = (l & 7) < 4 ? 4 * (l >> 3) + (l & 3) : 32 + 4 * (l >> 3) + (l & 3); return head * 64 + o; } };
struct ColSwiglu { int F; DI int operator()(int c) const { const int t = c >> 8, r = c & 255; return r < 128 ? t * 128 + r : F + t * 128 + (r - 128); } };

DI void rms_row_load(const float* xrow, int lane, f32x4 (&v)[8], float& rstd) {
    float s = 0.f;
#pragma unroll
    for (int j = 0; j < 8; ++j) { v[j] = *(const f32x4*)(xrow + 4 * lane + 256 * j); s += (v[j].x * v[j].x + v[j].y * v[j].y) + (v[j].z * v[j].z + v[j].w * v[j].w); }
    rstd = 1.0f / sqrtf(wave_sum(s) * (1.0f / DM) + RMS_EPS);
}
DI void rms_row_to_bf16(const float* xrow, const float* g, bf16_t* orow, int lane) {
    f32x4 v[8]; float rstd; rms_row_load(xrow, lane, v, rstd);
#pragma unroll
    for (int j = 0; j < 8; ++j) { const f32x4 gg = *(const f32x4*)(g + 4 * lane + 256 * j); const f32x4 y = v[j] * rstd * gg;
        u32x2 w; w.x = pk2(y.x, y.y); w.y = pk2(y.z, y.w); *(u32x2*)(orow + 4 * lane + 256 * j) = w; }
}

namespace att {
constexpr int KPADB = 144;
constexpr int VPADB = 144;
constexpr int BUFB = 64 * KPADB + 64 * VPADB;
constexpr int OFF_ALPHA = 2 * BUFB;
constexpr int OFF_IMP = OFF_ALPHA + 8 * 256;
constexpr int OFF_SEL = OFF_IMP + 16384;
constexpr int OFF_RANK = OFF_SEL + 512;
constexpr int OFF_Q = 65536;
constexpr float NEGBIG = -1e30f;
DI int crow(int r, int h) { return (r & 3) + 8 * (r >> 2) + 4 * h; }
#define MFMA32(a, b, c) __builtin_amdgcn_mfma_f32_32x32x16_bf16((a), (b), (c), 0, 0, 0)

struct KVRegs { u32x4 k, v; };
DI void kv_load(KVRegs& r, const bf16_t* Kg, const bf16_t* Vg, size_t pitch, int tid) {
    const int key = tid >> 3, dc = tid & 7;
    r.k = *(const u32x4*)(Kg + (size_t)key * pitch + dc * 8); r.v = *(const u32x4*)(Vg + (size_t)key * pitch + dc * 8);
}
DI void kv_store(const KVRegs& r, LAS unsigned char* buf, int tid) {
    const int key = tid >> 3, dc = tid & 7;
    *(LAS u32x4*)(buf + key * KPADB + dc * 16) = r.k;
    LAS unsigned short* vt = (LAS unsigned short*)(buf + 64 * KPADB);
    const unsigned w[4] = {r.v.x, r.v.y, r.v.z, r.v.w};
#pragma unroll
    for (int i = 0; i < 4; ++i) { vt[(dc * 8 + 2 * i) * (VPADB / 2) + key] = (unsigned short)(w[i] & 0xffffu); vt[(dc * 8 + 2 * i + 1) * (VPADB / 2) + key] = (unsigned short)(w[i] >> 16); }
}

struct State { f32x16 O[2][2]; float m[2], l[2]; };
DI void state_init(State& s) {
#pragma unroll
    for (int a = 0; a < 2; ++a) { s.m[a] = NEGBIG; s.l[a] = 0.f;
#pragma unroll
        for (int b = 0; b < 2; ++b)
#pragma unroll
            for (int r = 0; r < 16; ++r) s.O[a][b][r] = 0.f; }
}
DI void row_scale(f32x16 (&O)[2], float f, LAS float* area, int c_, int h_) {
    const int c = opq(c_), h = opq(h_);
    area[c] = f;
    asm volatile("s_waitcnt lgkmcnt(0)" ::: "memory");
#pragma unroll
    for (int g4 = 0; g4 < 4; ++g4) { const f32x4 a = *(LAS f32x4*)(area + 8 * g4 + 4 * h);
#pragma unroll
        for (int j = 0; j < 4; ++j) { O[0][4 * g4 + j] *= a[j]; O[1][4 * g4 + j] *= a[j]; } }
    asm volatile("s_waitcnt lgkmcnt(0)" ::: "memory");
}
template <int MODE>
DI void tile_compute(State& st, const LAS unsigned char* qf, LAS unsigned char* buf, int kbase, const int (&tq)[2], int W, const unsigned long long (&sel)[2], int tile, LAS float* area, int c_, int h_) {
    const int c = opq(c_), h = opq(h_);
    LAS unsigned char* Kl = buf; LAS unsigned char* Vl = buf + 64 * KPADB;
#pragma unroll 1
    for (int kbk = 0; kbk < 2; ++kbk) {
        bf16x8 Pf[2][2];
        bf16x8 kf[4];
#pragma unroll
        for (int s = 0; s < 4; ++s) kf[s] = *(LAS bf16x8*)(Kl + (32 * kbk + c) * KPADB + (16 * s + 8 * h) * 2);
#pragma unroll
        for (int qb = 0; qb < 2; ++qb) {
            f32x16 S;
#pragma unroll
            for (int r = 0; r < 16; ++r) S[r] = 0.f;
#pragma unroll
            for (int s = 0; s < 4; ++s) { const bf16x8 q = *(const LAS bf16x8*)(qf + (qb * 4 + s) * 1024); S = MFMA32(kf[s], q, S); }
            float mx = NEGBIG;
            const bool bit = MODE == 2 ? (((sel[qb] >> tile) & 1ull) != 0ull) : true;
            const int dd = tq[qb] - (kbase + 32 * kbk + 4 * h);
#pragma unroll
            for (int r = 0; r < 16; ++r) { const int cr0 = (r & 3) + 8 * (r >> 2); bool valid;
                if (MODE == 0) valid = (cr0 <= dd) && (cr0 > dd - W);
                else if (MODE == 1) valid = (cr0 <= dd);
                else valid = (cr0 <= dd) && bit;
                S[r] = valid ? S[r] : NEGBIG; mx = fmaxf(mx, S[r]); }
            mx = fmaxf(mx, __shfl_xor(mx, 32));
            if (__any(mx > st.m[qb] + 8.0f)) {
                const float mnew = fmaxf(st.m[qb], mx); const float alpha = ex2(st.m[qb] - mnew);
                st.l[qb] *= alpha; st.m[qb] = mnew;
                row_scale(st.O[qb], alpha, area + qb * 32, c, h);
            }
            float ls = 0.f;
#pragma unroll
            for (int r = 0; r < 16; ++r) { S[r] = (S[r] > -1e29f) ? ex2(S[r] - st.m[qb]) : 0.f; ls += S[r]; }
            st.l[qb] += ls;
#pragma unroll
            for (int ks = 0; ks < 2; ++ks) { u32x4 w; w.x = pk2(S[8 * ks], S[8 * ks + 1]); w.y = pk2(S[8 * ks + 2], S[8 * ks + 3]); w.z = pk2(S[8 * ks + 4], S[8 * ks + 5]); w.w = pk2(S[8 * ks + 6], S[8 * ks + 7]);
                Pf[qb][ks] = __builtin_bit_cast(bf16x8, w); }
            __builtin_amdgcn_sched_barrier(0);
        }
#pragma unroll
        for (int ks = 0; ks < 2; ++ks)
#pragma unroll
            for (int db = 0; db < 2; ++db) {
                const s16x4 lo = *(LAS s16x4*)(Vl + (32 * db + c) * VPADB + (32 * kbk + 16 * ks + 4 * h) * 2);
                const s16x4 hi = *(LAS s16x4*)(Vl + (32 * db + c) * VPADB + (32 * kbk + 16 * ks + 8 + 4 * h) * 2);
                const bf16x8 vf = __builtin_shufflevector(lo, hi, 0, 1, 2, 3, 4, 5, 6, 7);
                st.O[0][db] = MFMA32(Pf[0][ks], vf, st.O[0][db]); st.O[1][db] = MFMA32(Pf[1][ks], vf, st.O[1][db]);
            }
        __builtin_amdgcn_sched_barrier(0);
    }
}
template <int MODE>
DI void run_pass(State& st, LAS unsigned char* lds, const bf16_t* Kg, const bf16_t* Vg, size_t pitch, int tlo, int thi, const int (&tq)[2], int W,
                 const unsigned long long (&sel)[2], int tid, int wave, int c, int h) {
    LAS float* area = (LAS float*)(lds + OFF_ALPHA) + wave * 64;
    const LAS unsigned char* qf = lds + OFF_Q + wave * 8192 + (c + 32 * h) * 16;
    KVRegs kr; kv_load(kr, Kg + (size_t)tlo * 64 * pitch, Vg + (size_t)tlo * 64 * pitch, pitch, tid);
    int bi = 0;
    for (int t = tlo; t <= thi; ++t) {
        LAS unsigned char* buf = lds + bi * BUFB;
        const int tid2 = opq(tid);
        kv_store(kr, buf, tid2);
        if (t < thi) kv_load(kr, Kg + (size_t)(t + 1) * 64 * pitch, Vg + (size_t)(t + 1) * 64 * pitch, pitch, tid2);
        __syncthreads();
        tile_compute<MODE>(st, qf, buf, t * 64, tq, W, sel, t, area, c, h);
        bi ^= 1;
    }
    __syncthreads();
}
DI void load_q(LAS unsigned char* lds, int wave, const bf16_t* Pbase  , int colbase, int c_, int h_) {
    const int c = opq(c_), h = opq(h_);
    LAS unsigned char* q = lds + OFF_Q + wave * 8192 + (c + 32 * h) * 16;
#pragma unroll
    for (int qb = 0; qb < 2; ++qb) { const bf16_t* p = Pbase + (size_t)(4 * qb + (c >> 3)) * NP + colbase + (c & 7) * 64 + 8 * h;
#pragma unroll
        for (int s = 0; s < 4; ++s) *(LAS bf16x8*)(q + (qb * 4 + s) * 1024) = *(const bf16x8*)(p + 16 * s); }
}
template <int MODE>
DI void emit_out(State& st, const float (&f)[2], LAS float* area, float* OBrow, bf16_t* Orow, int c_, int h_) {
    const int c = opq(c_), h = opq(h_);
#pragma unroll
    for (int qb = 0; qb < 2; ++qb) {
        area[qb * 32 + c] = f[qb];
        asm volatile("s_waitcnt lgkmcnt(0)" ::: "memory");
#pragma unroll
        for (int g4 = 0; g4 < 4; ++g4) { const f32x4 a = *(LAS f32x4*)(area + qb * 32 + 8 * g4 + 4 * h);
#pragma unroll
            for (int j = 0; j < 4; ++j) { const int cr = 8 * g4 + 4 * h + j; const int tokl = 4 * qb + (cr >> 3), hd = cr & 7;
#pragma unroll
                for (int db = 0; db < 2; ++db) { float v = st.O[qb][db][4 * g4 + j] * a[j];
                    float* ob = OBrow + (size_t)tokl * 1024 + hd * 64 + 32 * db + c; bf16_t* o = Orow + (size_t)tokl * DM + hd * 64 + 32 * db + c;
                    if (MODE == 0) *ob = v; else if (MODE == 1) *ob += v; else if (MODE == 2) *o = (bf16_t)f2bf(*ob + v); else *o = (bf16_t)f2bf(v); } }
            asm volatile("" ::: "memory"); }
        asm volatile("s_waitcnt lgkmcnt(0)" ::: "memory");
    }
}
}

DI void attn_unit_A(const Frame& F, const bf16_t* P, bf16_t* O, const float* sinks, int b, int kvh, int ch) {
    const int c = F.lane & 31, h = F.lane >> 5, w = F.wave;
    const int t0 = ch * 64;
    const bf16_t* Pb = P + (size_t)b * SEQ * NP;
    att::load_q(F.lds, w, Pb + (size_t)(t0 + 8 * w) * NP, C_QA + kvh * 512, c, h);
    int tq[2] = {t0 + 8 * w + (c >> 3), t0 + 8 * w + 4 + (c >> 3)};
    unsigned long long sel[2] = {0ull, 0ull};
    att::State st; att::state_init(st);
    const int tlo = ch >= 2 ? ch - 2 : 0;
    att::run_pass<0>(st, F.lds, Pb + C_KA + kvh * 64, Pb + C_VA + kvh * 64, NP, tlo, ch, tq, 128, sel, F.tid, w, c, h);
    const float sink2 = sinks[kvh * 8 + (c & 7)] * LOG2E;
    float f[2];
#pragma unroll
    for (int qb = 0; qb < 2; ++qb) { const float lt = st.l[qb] + __shfl_xor(st.l[qb], 32) + ex2(sink2 - st.m[qb]); f[qb] = 1.0f / lt; }
    LAS float* area = (LAS float*)(F.lds + att::OFF_ALPHA) + w * 64;
    att::emit_out<3>(st, f, area, nullptr, O + ((size_t)b * SEQ + t0 + 8 * w) * DM + kvh * 512, c, h);
}

DI void attn_unit_B(const Frame& F, const bf16_t* P, const bf16_t* KVC, bf16_t* O, float* OB, int b, int hkv, int ch) {
    const int c = F.lane & 31, h = F.lane >> 5, w = F.wave, lane = F.lane;
    const int t0 = ch * 64;
    const bf16_t* Pb = P + (size_t)b * SEQ * NP;
    LAS float* area = (LAS float*)(F.lds + att::OFF_ALPHA) + w * 64;
    LAS float* imp = (LAS float*)(F.lds + att::OFF_IMP);
    LAS unsigned long long* selbuf = (LAS unsigned long long*)(F.lds + att::OFF_SEL);
    LAS float* rank = (LAS float*)(F.lds + att::OFF_RANK) + w * 64;
    att::load_q(F.lds, w, Pb + (size_t)(t0 + 8 * w) * NP, C_QB + hkv * 512, c, h);
    const LAS unsigned char* qf = F.lds + att::OFF_Q + w * 8192 + (c + 32 * h) * 16;
    int tq[2] = {t0 + 8 * w + (c >> 3), t0 + 8 * w + 4 + (c >> 3)};
    unsigned long long sel[2] = {0ull, 0ull};
#define GATE(qb, j) sigmoidf_(bf2f(Pb[(size_t)tq[qb] * NP + C_GATE + hkv * 24 + (c & 7) * 3 + (j)]))
    for (int i = F.tid; i < 4096; i += NTHR) imp[i] = 0.f;
    float* OBrow = OB + ((size_t)b * SEQ + t0 + 8 * w) * 1024 + hkv * 512;
    bf16_t* Orow = O + ((size_t)b * SEQ + t0 + 8 * w) * DM + 1024 + hkv * 512;
    const bf16_t* Kc = KVC + (size_t)(0 * 2048 + (b * 2 + hkv) * 256) * 64;
    const bf16_t* Vc = KVC + (size_t)(1 * 2048 + (b * 2 + hkv) * 256) * 64;
    const int ntc = (4 * ch + 2) / 64;
    att::State st; att::state_init(st);
    int tqc[2] = {(tq[0] - 31) >> 4, (tq[1] - 31) >> 4};
    att::run_pass<1>(st, F.lds, Kc, Vc, 64, 0, ntc, tqc, 0, sel, F.tid, w, c, h);
    float ltot[2], f[2];
#pragma unroll
    for (int qb = 0; qb < 2; ++qb) { ltot[qb] = fmaxf(st.l[qb] + __shfl_xor(st.l[qb], 32), 1e-30f); f[qb] = GATE(qb, 0) / ltot[qb]; }
    att::emit_out<0>(st, f, area, OBrow, Orow, c, h);
    {
        att::KVRegs kr; att::kv_load(kr, Kc, Vc, 64, F.tid);
        int bi = 0;
        for (int t = 0; t <= ntc; ++t) {
            LAS unsigned char* buf = F.lds + bi * att::BUFB;
            att::kv_store(kr, buf, F.tid);
            if (t < ntc) att::kv_load(kr, Kc + (size_t)(t + 1) * 64 * 64, Vc + (size_t)(t + 1) * 64 * 64, 64, F.tid);
            __syncthreads();
#pragma unroll
            for (int kbk = 0; kbk < 2; ++kbk) {
#pragma unroll
                for (int qb = 0; qb < 2; ++qb) {
                    f32x16 S;
#pragma unroll
                    for (int r = 0; r < 16; ++r) S[r] = 0.f;
#pragma unroll
                    for (int s = 0; s < 4; ++s) { const bf16x8 kf = *(LAS bf16x8*)(buf + (32 * kbk + c) * att::KPADB + (16 * s + 8 * h) * 2); const bf16x8 q = *(const LAS bf16x8*)(qf + (qb * 4 + s) * 1024); S = MFMA32(kf, q, S); }
                    const float inv = 1.0f / ltot[qb];
                    const int q = 8 * w + 4 * qb + (c >> 3);
                    const int ddq = tqc[qb] - (t * 64 + 32 * kbk + 4 * h);
#pragma unroll
                    for (int g4 = 0; g4 < 4; ++g4) {
                        float s4 = 0.f, p3 = 0.f;
#pragma unroll
                        for (int j = 0; j < 4; ++j) { const float pv = (8 * g4 + j <= ddq) ? ex2(S[4 * g4 + j] - st.m[qb]) * inv : 0.f; s4 += pv; if (j == 3) p3 = pv; }
                        s4 += __shfl_xor(s4, 1); s4 += __shfl_xor(s4, 2); s4 += __shfl_xor(s4, 4);
                        p3 += __shfl_xor(p3, 1); p3 += __shfl_xor(p3, 2); p3 += __shfl_xor(p3, 4);
                        const int n0 = t * 16 + 8 * kbk + 2 * g4 + h;
                        if ((c & 7) == 0) { (void)__hip_atomic_fetch_add(&imp[q * 64 + n0], s4, __ATOMIC_RELAXED, __HIP_MEMORY_SCOPE_WORKGROUP); if (n0 + 1 < 64) (void)__hip_atomic_fetch_add(&imp[q * 64 + n0 + 1], p3, __ATOMIC_RELAXED, __HIP_MEMORY_SCOPE_WORKGROUP); }
                    }
                    __builtin_amdgcn_sched_barrier(0);
                }
            }
            bi ^= 1;
        }
        __syncthreads();
    }
    {
        const int cur = ch;
        for (int qq = 0; qq < 8; ++qq) {
            const int q = 8 * w + qq;
            float v = imp[q * 64 + lane];
            if (lane > cur) v = -1e9f; else if (lane == 0 || lane > cur - 2) v = 1e9f;
            rank[lane] = v;
            asm volatile("s_waitcnt lgkmcnt(0)" ::: "memory");
            int rk = 0;
#pragma unroll 8
            for (int mth = 0; mth < 64; ++mth) { const float o = rank[mth]; rk += (o > v || (o == v && mth < lane)) ? 1 : 0; }
            const unsigned long long msk = __ballot(rk < 16);
            if (lane == 0) selbuf[q] = msk;
            asm volatile("s_waitcnt lgkmcnt(0)" ::: "memory");
        }
        __syncthreads();
        sel[0] = selbuf[8 * w + (c >> 3)]; sel[1] = selbuf[8 * w + 4 + (c >> 3)];
    }
    att::state_init(st);
    att::run_pass<2>(st, F.lds, Pb + C_KSEL + hkv * 64, Pb + C_VSEL + hkv * 64, NP, 0, ch, tq, 0, sel, F.tid, w, c, h);
#pragma unroll
    for (int qb = 0; qb < 2; ++qb) { const float lt = fmaxf(st.l[qb] + __shfl_xor(st.l[qb], 32), 1e-30f); f[qb] = GATE(qb, 1) / lt; }
    att::emit_out<1>(st, f, area, OBrow, Orow, c, h);
    att::state_init(st);
    att::run_pass<0>(st, F.lds, Pb + C_KWIN + hkv * 64, Pb + C_VWIN + hkv * 64, NP, ch >= 8 ? ch - 8 : 0, ch, tq, 512, sel, F.tid, w, c, h);
#pragma unroll
    for (int qb = 0; qb < 2; ++qb) { const float lt = fmaxf(st.l[qb] + __shfl_xor(st.l[qb], 32), 1e-30f); f[qb] = GATE(qb, 2) / lt; }
    att::emit_out<2>(st, f, area, OBrow, Orow, c, h);
#undef GATE
    __syncthreads();
}

namespace scan {
constexpr int TC = 32;
constexpr int STEPB = 5 * 256 + 128;
constexpr int CHB = TC * STEPB;
constexpr int OFF_Y = 2 * CHB;
constexpr int YB = TC * 32 * 4;
template <int CTRL> DI float dpp_f(float x) { return __builtin_bit_cast(float, __builtin_amdgcn_update_dpp(0, __builtin_bit_cast(int, x), CTRL, 0xf, 0xf, false)); }
DI float row_sum16(float x) { x += dpp_f<0xB1>(x); x += dpp_f<0x4E>(x); x += dpp_f<0x141>(x); x += dpp_f<0x140>(x); return x; }
}
struct ScanRegs { unsigned short r[8], k[8], v[8]; float dec[8], a[8]; };
DI void scan_issue(const Frame& F, ScanRegs& R, const bf16_t* RKV, const float* DEC, const float* AA, int b, int hd, int tch) {
    const int lw = F.wave - 4, lane = F.lane;
#pragma unroll
    for (int i = 0; i < 8; ++i) {
        const size_t tok = (size_t)b * SEQ + (size_t)tch * scan::TC + lw + 4 * i;
        const size_t o = tok * DM + hd * 64 + lane;
        R.r[i] = RKV[o]; R.k[i] = RKV[(size_t)M * DM + o]; R.v[i] = RKV[(size_t)2 * M * DM + o]; R.dec[i] = DEC[o]; R.a[i] = AA[o];
    }
}
DI void scan_fill(const Frame& F, const ScanRegs& R, LAS unsigned char* buf, float kkw, float kaw, int half) {
    const int lw = F.wave - 4, lane = F.lane;
#pragma unroll
    for (int i = 0; i < 8; ++i) {
        const int s = lw + 4 * i;
        const float r = bf2f(R.r[i]), k = bf2f(R.k[i]), v = bf2f(R.v[i]), dec = R.dec[i], a = R.a[i];
        const float kx = k * kkw;
        const float nrm = sqrtf(wave_sum(kx * kx));
        const float kk = kx / fmaxf(nrm, 1e-12f);
        const float kp = k * (1.0f + (a - 1.0f) * kaw);
        LAS float* sp = (LAS float*)(buf + s * scan::STEPB);
        sp[lane] = dec; sp[64 + lane] = -kk; sp[128 + lane] = kk * a; sp[192 + lane] = kp; sp[256 + lane] = r;
        if ((lane >> 5) == half) sp[320 + (lane & 31)] = v;
    }
}
DI void scan_flush(const Frame& F, LAS unsigned char* ybuf, float* YRAW, int b, int hd, int half, int tch) {
    const int lw = F.wave - 4, lane = F.lane;
    for (int s = 2 * lw; s < scan::TC; s += 8) {
        const int ss = s + (lane >> 5);
        const size_t tok = (size_t)b * SEQ + (size_t)tch * scan::TC + ss;
        YRAW[tok * DM + hd * 64 + half * 32 + (lane & 31)] = ((LAS float*)ybuf)[ss * 32 + (lane & 31)];
    }
}
DI void phase_scan(const Frame& F, const bf16_t* RKV, const float* DEC, const float* AA, const float* kk_w, const float* ka_w, float* YRAW) {
    for (int vb = blockIdx.x; vb < 256; vb += F.G) {
        const int bh = vb >> 1, half = vb & 1, b = bh >> 5, hd = bh & 31;
        const int w = F.wave, lane = F.lane;
        const int rp = lane >> 4, cg = lane & 15;
        const int row0 = 8 * w + 2 * rp;
        float S0[4] = {0.f, 0.f, 0.f, 0.f}, S1[4] = {0.f, 0.f, 0.f, 0.f};
        constexpr int NCH = SEQ / scan::TC;
        ScanRegs SR; float kkw = 0.f, kaw = 0.f;
        if (w >= 4) { kkw = kk_w[hd * 64 + lane]; kaw = ka_w[hd * 64 + lane]; scan_issue(F, SR, RKV, DEC, AA, b, hd, 0); scan_fill(F, SR, F.lds, kkw, kaw, half); scan_issue(F, SR, RKV, DEC, AA, b, hd, 1); }
        __syncthreads();
        for (int ch = 0; ch < NCH; ++ch) {
            LAS unsigned char* buf = F.lds + (ch & 1) * scan::CHB;
            LAS float* yb = (LAS float*)(F.lds + scan::OFF_Y + (ch & 1) * scan::YB);
            if (w < 4) {
#pragma unroll 4
                for (int s = 0; s < scan::TC; ++s) {
                    const LAS float* sp = (const LAS float*)(buf + s * scan::STEPB);
                    const f32x4 w4 = *(const LAS f32x4*)(sp + 4 * cg), nk4 = *(const LAS f32x4*)(sp + 64 + 4 * cg), b4 = *(const LAS f32x4*)(sp + 128 + 4 * cg),
                                k4 = *(const LAS f32x4*)(sp + 192 + 4 * cg), r4 = *(const LAS f32x4*)(sp + 256 + 4 * cg);
                    const f32x2 v2 = *(const LAS f32x2*)(sp + 320 + row0);
                    float sa0 = (S0[0] * nk4[0] + S0[1] * nk4[1]) + (S0[2] * nk4[2] + S0[3] * nk4[3]);
                    float sa1 = (S1[0] * nk4[0] + S1[1] * nk4[1]) + (S1[2] * nk4[2] + S1[3] * nk4[3]);
                    sa0 = scan::row_sum16(sa0); sa1 = scan::row_sum16(sa1);
                    float y0 = 0.f, y1 = 0.f;
#pragma unroll
                    for (int i = 0; i < 4; ++i) {
                        S0[i] = S0[i] * w4[i] + (sa0 * b4[i] + v2[0] * k4[i]);
                        S1[i] = S1[i] * w4[i] + (sa1 * b4[i] + v2[1] * k4[i]);
                        y0 += S0[i] * r4[i]; y1 += S1[i] * r4[i];
                    }
                    y0 = scan::row_sum16(y0); y1 = scan::row_sum16(y1);
                    if (cg == 0) { yb[s * 32 + row0] = y0; yb[s * 32 + row0 + 1] = y1; }
                }
            } else {
                if (ch + 1 < NCH) scan_fill(F, SR, F.lds + ((ch + 1) & 1) * scan::CHB, kkw, kaw, half);
                if (ch + 2 < NCH) scan_issue(F, SR, RKV, DEC, AA, b, hd, ch + 2);
                if (ch > 0) scan_flush(F, F.lds + scan::OFF_Y + ((ch - 1) & 1) * scan::YB, YRAW, b, hd, half, ch - 1);
            }
            __syncthreads();
        }
        if (w >= 4) scan_flush(F, F.lds + scan::OFF_Y + ((NCH - 1) & 1) * scan::YB, YRAW, b, hd, half, NCH - 1);
        __syncthreads();
    }
}

constexpr int NPHASE = 19;
__global__ void __launch_bounds__(NTHR, 2) mk_fwd(Args args) {
    extern __shared__ __attribute__((aligned(16))) unsigned char lds_raw[];
    Frame F;
    F.lds = (LAS unsigned char*)lds_raw;
    F.tid = threadIdx.x; F.lane = F.tid & 63; F.wave = __builtin_amdgcn_readfirstlane(F.tid >> 6);
    F.G = gridDim.x; F.gw = blockIdx.x * NWAVES + F.wave; F.NGW = F.G * NWAVES; F.ws = args.ws;
    unsigned char* ws = args.ws;
    unsigned* ctl = (unsigned*)(ws + WS_CTL);
    volatile LAS unsigned* MISC = (volatile LAS unsigned*)(F.lds + MISC_OFF);
    for (int u = F.tid; u < (LDS_BYTES - LDSCTL_OFF) / 4; u += NTHR) ((LAS unsigned*)(F.lds + LDSCTL_OFF))[u] = 0u;
    __syncthreads();
    XcdBarrier bar; bar.bar = ctl + CW_BAR; bar.x = 0; bar.st = nullptr;
    if (args.use_bar) bar = xcd_barrier_post(ctl + CW_BAR, MISC + 8);
    const int lo = args.ph_lo, hi = args.ph_hi;
#ifndef PH_MASK
#define PH_MASK 0xFFFFFFFFu
#endif
#define IN(k) (((PH_MASK >> (k)) & 1u) && lo <= (k) && (k) < hi)
#define SEAM(k) do { if (IN(k) && IN((k) + 1)) xcd_barrier(bar); } while (0)
#ifndef REPEAT_MASK
#define REPEAT_MASK 0u
#endif
#define REPS(k) ((((REPEAT_MASK) >> (k)) & 1u) ? 2 : 1)
#define PH(k) if (IN(k)) for (int rep_ = 0; rep_ < REPS(k); ++rep_, (rep_ < REPS(k) ? xcd_barrier(bar) : (void)0))

    bf16_t* W_IN = (bf16_t*)(ws + WS_W_IN); bf16_t* W_OUT = (bf16_t*)(ws + WS_W_OUT); bf16_t* CMPW1 = (bf16_t*)(ws + WS_CMPW1);
    bf16_t* FFN13 = (bf16_t*)(ws + WS_FFN13); bf16_t* FFN2 = (bf16_t*)(ws + WS_FFN2); bf16_t* WRKV = (bf16_t*)(ws + WS_WRKV);
    bf16_t* LORA1 = (bf16_t*)(ws + WS_LORA1); bf16_t* LORA2 = (bf16_t*)(ws + WS_LORA2); bf16_t* WO = (bf16_t*)(ws + WS_WO);
    bf16_t* MOE13 = (bf16_t*)(ws + WS_MOE13); bf16_t* MOE2 = (bf16_t*)(ws + WS_MOE2);
    bf16_t* XN = (bf16_t*)(ws + WS_XN); bf16_t* P = (bf16_t*)(ws + WS_P); float* ROPE = (float*)(ws + WS_ROPE); float* CMPB = (float*)(ws + WS_CMPB);
    bf16_t* HID = (bf16_t*)(ws + WS_HID); bf16_t* KVC = (bf16_t*)(ws + WS_KVC); bf16_t* O = (bf16_t*)(ws + WS_O); float* H = (float*)(ws + WS_H);
    bf16_t* ACT = (bf16_t*)(ws + WS_ACT); bf16_t* XS = (bf16_t*)(ws + WS_XS); bf16_t* RKV = (bf16_t*)(ws + WS_RKV); bf16_t* L1 = (bf16_t*)(ws + WS_L1);
    float* DEC = (float*)(ws + WS_DEC); float* AA = (float*)(ws + WS_AA); bf16_t* GG = (bf16_t*)(ws + WS_GG); float* YRAW = (float*)(ws + WS_YRAW); bf16_t* YG = (bf16_t*)(ws + WS_YG);
    int* ROWTOK = (int*)(ws + WS_ROWTOK); int* TOKSLOT = (int*)(ws + WS_TOKSLOT); float* Y2 = (float*)(ws + WS_Y2);
    float* OB = YRAW;
    LAS unsigned char* ring = F.lds;

    PH(0) {
        LAS float* scr = (LAS float*)(F.lds + F.wave * 16384);
        transpose_matrix(F, args.in[I_W_IN], IN_COLS, DM, W_IN, DM, NP, ColInProj{}, scr);
        transpose_matrix(F, args.in[I_W_OUT], DM, DM, W_OUT, DM, DM, ColIdent{DM}, scr);
        for (int kv = 0; kv < 2; ++kv) transpose_matrix(F, args.in[I_CMP_W1] + (size_t)kv * 2048 * 256, 256, 2048, CMPW1 + (size_t)kv * 256 * 2048, 2048, 256, ColIdent{256}, scr);
        transpose_matrix(F, args.in[I_FFN_W13], 2 * DFF, DM, FFN13, DM, 2 * DFF, ColSwiglu{DFF}, scr);
        transpose_matrix(F, args.in[I_FFN_W2], DM, DFF, FFN2, DFF, DM, ColIdent{DM}, scr);
        for (int i = 0; i < 3; ++i) transpose_matrix(F, args.in[I_W_RKV] + (size_t)i * DM * DM, DM, DM, WRKV + (size_t)i * DM * DM, DM, DM, ColIdent{DM}, scr);
        transpose_matrix(F, args.in[I_DECAY_W1], 96, DM, LORA1, DM, 256, ColIdent{96}, scr);
        transpose_matrix(F, args.in[I_A1], 96, DM, LORA1 + (size_t)256 * DM, DM, 256, ColIdent{96}, scr);
        transpose_matrix(F, args.in[I_G1], 256, DM, LORA1 + (size_t)512 * DM, DM, 256, ColIdent{256}, scr);
        transpose_matrix(F, args.in[I_DECAY_W2], DM, 96, LORA2, 256, DM, ColIdent{DM}, scr);
        transpose_matrix(F, args.in[I_A2], DM, 96, LORA2 + (size_t)DM * 256, 256, DM, ColIdent{DM}, scr);
        transpose_matrix(F, args.in[I_G2], DM, 256, LORA2 + (size_t)2 * DM * 256, 256, DM, ColIdent{DM}, scr);
        transpose_matrix(F, args.in[I_W_O], DM, DM, WO, DM, DM, ColIdent{DM}, scr);
        for (int e = 0; e < NEXP; ++e) transpose_matrix(F, args.in[I_MOE_W13] + (size_t)e * DM * 2 * DFFE, 2 * DFFE, DM, MOE13 + (size_t)e * 2 * DFFE * DM, DM, 2 * DFFE, ColSwiglu{DFFE}, scr);
        for (int e = 0; e < NEXP; ++e) transpose_matrix(F, args.in[I_MOE_W2] + (size_t)e * DFFE * DM, DM, DFFE, MOE2 + (size_t)e * DM * DFFE, DFFE, DM, ColIdent{DM}, scr);
        for (int m = F.gw; m < M; m += F.NGW) rms_row_to_bf16(args.in[I_X] + (size_t)m * DM, args.in[I_ATTN_NORM], XN + (size_t)m * DM, F.lane);
        { const int* pos = (const int*)args.in[I_POS];
          for (int i = blockIdx.x * NTHR + F.tid; i < M * 32; i += F.G * NTHR) { const int m = i >> 5, j = i & 31;
              const float inv = powf(150000.0f, -(float)j / 32.0f); const float ang = (float)pos[m] * inv; float sn, cs; sincosf(ang, &sn, &cs);
              ROPE[(size_t)m * 64 + j] = cs; ROPE[(size_t)m * 64 + 32 + j] = sn; } }
        if (F.gw < 512) { const int kv = F.gw >> 8, j = F.gw & 255; const float* pe = args.in[I_CMP_PE] + kv * 2048; const float* w1 = args.in[I_CMP_W1] + (size_t)kv * 2048 * 256;
            float s = 0.f; for (int i = F.lane; i < 2048; i += 64) s += pe[i] * w1[(size_t)i * 256 + j];
            s = wave_sum(s); if (F.lane == 0) CMPB[kv * 256 + j] = s + args.in[I_CMP_B1][kv * 256 + j]; }
    }
    SEAM(0);
    PH(1) {
        OrderSingle S{(const char*)XN, (const char*)W_IN, DM * 2, DM * 2, 64, NP / 256, 64 * (NP / 256), F.G, (int)blockIdx.x};
        EpiInProj E{P, ROPE};
        pg8::gemm_phase<EpiInProj, OrderSingle, false>(ring, DM * 2, 128, DM * 2, DM / 64, S, E);
    }
    SEAM(1);
    PH(2) {
        OrderCmp S{(const char*)P, (const char*)CMPW1, F.G, (int)blockIdx.x};
        EpiCmp1 E{HID, CMPB};
        pg8::gemm_phase<EpiCmp1, OrderCmp, false>(ring, 16 * NP * 2, NP * 2, 2048 * 2, 32, S, E);
    }
    SEAM(2);
    PH(3) {
        for (int it = blockIdx.x * NTHR + F.tid; it < 2 * 2048 * 16; it += F.G * NTHR) {
            const int dq = it & 15, row = (it >> 4) & 2047, kv = it >> 15;
            const bf16_t* hr = HID + ((size_t)kv * 2048 + row) * 256; const float* w2 = args.in[I_CMP_W2] + (size_t)kv * 256 * 64 + dq * 4;
            f32x4 a = (f32x4){0.f, 0.f, 0.f, 0.f};
            for (int j = 0; j < 256; j += 2) { const unsigned hw = *(const unsigned*)(hr + j); a += bflo(hw) * *(const f32x4*)(w2 + (size_t)j * 64); a += bfhi(hw) * *(const f32x4*)(w2 + (size_t)(j + 1) * 64); }
            u32x2 o; o.x = pk2(a.x, a.y); o.y = pk2(a.z, a.w); *(u32x2*)(KVC + ((size_t)kv * 2048 + row) * 64 + dq * 4) = o;
        }
    }
    SEAM(3);
    PH(4) {
        for (int vb = blockIdx.x; vb < 256; vb += F.G) {
            const int bh = vb >> 5, p = vb & 31;
#pragma unroll 1
            for (int k = 0; k < 2; ++k) attn_unit_B(F, P, KVC, O, OB, bh >> 1, bh & 1, k == 0 ? 63 - p : p);
#pragma unroll 1
            for (int k = 0; k < 2; ++k) { const int id = 2 * vb + k; attn_unit_A(F, P, O, args.in[I_SINKS], id >> 7, (id >> 6) & 1, id & 63); }
        }
    }
    SEAM(4);
    PH(5) {
        OrderSingle S{(const char*)O, (const char*)W_OUT, DM * 2, DM * 2, 64, 8, 512, F.G, (int)blockIdx.x};
        EpiResF32 E{args.in[I_X], H};
        pg8::gemm_phase<EpiResF32, OrderSingle, false>(ring, DM * 2, 128, DM * 2, DM / 64, S, E);
    }
    SEAM(5);
    PH(6) { for (int m = F.gw; m < M; m += F.NGW) rms_row_to_bf16(H + (size_t)m * DM, args.in[I_FFN_NORM], XN + (size_t)m * DM, F.lane); }
    SEAM(6);
    PH(7) {
        OrderSingle S{(const char*)XN, (const char*)FFN13, DM * 2, DM * 2, 64, 2 * DFF / 256, 64 * (2 * DFF / 256), F.G, (int)blockIdx.x};
        EpiSwiglu E{ACT, DFF};
        pg8::gemm_phase<EpiSwiglu, OrderSingle, false>(ring, DM * 2, 128, DM * 2, DM / 64, S, E);
    }
    SEAM(7);
    PH(8) {
        OrderSingle S{(const char*)ACT, (const char*)FFN2, DFF * 2, DFF * 2, 64, 8, 512, F.G, (int)blockIdx.x};
        EpiResF32 E{H, H};
        pg8::gemm_phase<EpiResF32, OrderSingle, false>(ring, DFF * 2, 128, DFF * 2, DFF / 64, S, E);
    }
    SEAM(8);
    PH(9) {
        const float* g = args.in[I_ATTN_NORM] + DM; const float* mu = args.in[I_MU];
        for (int m = F.gw; m < M; m += F.NGW) {
            f32x4 v[8], pv[8]; float rs, prs = 0.f;
            rms_row_load(H + (size_t)m * DM, F.lane, v, rs);
            const bool has_prev = (m % SEQ) != 0;
            if (has_prev) rms_row_load(H + (size_t)(m - 1) * DM, F.lane, pv, prs);
#pragma unroll
            for (int j = 0; j < 8; ++j) {
                const int col = 4 * F.lane + 256 * j; const f32x4 gg = *(const f32x4*)(g + col);
                const f32x4 hn = v[j] * rs * gg; f32x4 hp = (f32x4){0.f, 0.f, 0.f, 0.f}; if (has_prev) hp = pv[j] * prs * gg;
                const f32x4 xx = hp - hn;
#pragma unroll
                for (int i = 0; i < 6; ++i) { const f32x4 mm = *(const f32x4*)(mu + (size_t)i * DM + col); const f32x4 y = hn + xx * mm;
                    u32x2 w; w.x = pk2(y.x, y.y); w.y = pk2(y.z, y.w); *(u32x2*)(XS + ((size_t)i * M + m) * DM + col) = w; }
            }
        }
    }
    SEAM(9);
    PH(10) {
        OrderMulti S{};
        for (int g = 0; g < 6; ++g) { S.A[g] = (const char*)(XS + (size_t)g * M * DM); S.Bt[g] = g < 3 ? (const char*)(WRKV + (size_t)g * DM * DM) : (const char*)(LORA1 + (size_t)(g - 3) * 256 * DM); S.nN[g] = g < 3 ? 8 : 1; }
        S.start[0] = 0; for (int g = 0; g < 6; ++g) S.start[g + 1] = S.start[g] + 64 * S.nN[g];
        S.lda = DM * 2; S.ldb = DM * 2; S.ng = 6; S.nwg = S.start[6]; S.G = F.G; S.c = (int)blockIdx.x;
        EpiRkvLora1 E{RKV, L1};
        pg8::gemm_phase<EpiRkvLora1, OrderMulti, false>(ring, DM * 2, 128, DM * 2, DM / 64, S, E);
    }
    SEAM(10);
    PH(11) {
        OrderMulti S{};
        for (int g = 0; g < 3; ++g) { S.A[g] = (const char*)(L1 + (size_t)g * M * 256); S.Bt[g] = (const char*)(LORA2 + (size_t)g * DM * 256); S.nN[g] = 8; }
        for (int g = 3; g < 6; ++g) { S.A[g] = S.A[0]; S.Bt[g] = S.Bt[0]; S.nN[g] = 0; }
        S.start[0] = 0; for (int g = 0; g < 6; ++g) S.start[g + 1] = S.start[g] + 64 * S.nN[g];
        S.lda = 256 * 2; S.ldb = 256 * 2; S.ng = 3; S.nwg = S.start[3]; S.G = F.G; S.c = (int)blockIdx.x;
        EpiLora2 E{DEC, AA, GG, args.in[I_DECAY_W0], args.in[I_A0]};
        pg8::gemm_phase<EpiLora2, OrderMulti, false>(ring, 256 * 2, 128, 256 * 2, 4, S, E);
    }
    SEAM(11);
    PH(12) phase_scan(F, RKV, DEC, AA, args.in[I_K_K], args.in[I_K_A], YRAW);
    SEAM(12);
    PH(13) {
        const float* lnw = args.in[I_LN_W]; const float* lnb = args.in[I_LN_B]; const float* rk = args.in[I_R_K]; const float* kaw = args.in[I_K_A];
        for (int m = F.gw; m < M; m += F.NGW) {
            for (int hd = 0; hd < 32; ++hd) {
                const size_t o = (size_t)m * DM + hd * 64 + F.lane; const int ch = hd * 64 + F.lane;
                const float y = YRAW[o];
                const float mean = wave_sum(y) * (1.0f / 64.0f); const float d = y - mean; const float var = wave_sum(d * d) * (1.0f / 64.0f);
                float yn = d * (1.0f / sqrtf(var + GN_EPS)) * lnw[ch] + lnb[ch];
                const float r = bf2f(RKV[o]), k = bf2f(RKV[(size_t)M * DM + o]), v = bf2f(RKV[(size_t)2 * M * DM + o]);
                const float a = AA[o]; const float kp = k * (1.0f + (a - 1.0f) * kaw[ch]);
                const float bonus = wave_sum(r * kp * rk[ch]);
                yn += bonus * v;
                YG[o] = (bf16_t)f2bf(yn * bf2f(GG[o]));
            }
        }
    }
    SEAM(13);
    PH(14) {
        OrderSingle S{(const char*)YG, (const char*)WO, DM * 2, DM * 2, 64, 8, 512, F.G, (int)blockIdx.x};
        EpiResF32 E{H, H};
        pg8::gemm_phase<EpiResF32, OrderSingle, false>(ring, DM * 2, 128, DM * 2, DM / 64, S, E);
    }
    SEAM(14);
    PH(15) {
        LAS int* t_e = (LAS int*)F.lds;
        LAS float* t_w = (LAS float*)(F.lds + 512);
        LAS int* t_p = (LAS int*)(F.lds + 1024);
        const float* g = args.in[I_FFN_NORM] + DM; const float* rw = args.in[I_ROUTER];
        for (int base = blockIdx.x * 64; base < M; base += F.G * 64) {
            for (int qq = 0; qq < 8; ++qq) {
                const int lt = F.wave * 8 + qq, m = base + lt;
                f32x4 v[8]; float rs; rms_row_load(H + (size_t)m * DM, F.lane, v, rs);
                float lg[8] = {0.f, 0.f, 0.f, 0.f, 0.f, 0.f, 0.f, 0.f};
#pragma unroll
                for (int j = 0; j < 8; ++j) {
                    const int col = 4 * F.lane + 256 * j; const f32x4 gg = *(const f32x4*)(g + col); const f32x4 y = v[j] * rs * gg;
                    u32x2 w; w.x = pk2(y.x, y.y); w.y = pk2(y.z, y.w); *(u32x2*)(XN + (size_t)m * DM + col) = w;
#pragma unroll
                    for (int e4 = 0; e4 < 4; ++e4) { const f32x4 r0 = *(const f32x4*)(rw + (size_t)(col + e4) * 8), r1 = *(const f32x4*)(rw + (size_t)(col + e4) * 8 + 4); const float yy = y[e4];
                        lg[0] += yy * r0.x; lg[1] += yy * r0.y; lg[2] += yy * r0.z; lg[3] += yy * r0.w; lg[4] += yy * r1.x; lg[5] += yy * r1.y; lg[6] += yy * r1.z; lg[7] += yy * r1.w; }
                }
#pragma unroll
                for (int e = 0; e < 8; ++e) lg[e] = wave_sum(lg[e]);
                if (F.lane == 0) {
                    int i0 = 0; float v0 = lg[0];
#pragma unroll
                    for (int e = 1; e < 8; ++e) if (lg[e] > v0) { v0 = lg[e]; i0 = e; }
                    int i1 = -1; float v1 = -3.0e38f;
#pragma unroll
                    for (int e = 0; e < 8; ++e) if (e != i0 && (i1 < 0 || lg[e] > v1)) { v1 = lg[e]; i1 = e; }
                    const float w1 = 1.0f / (1.0f + expf(v0 - v1)), w0 = 1.0f - w1;
                    t_e[lt * 2] = i0; t_e[lt * 2 + 1] = i1; t_w[lt * 2] = w0; t_w[lt * 2 + 1] = w1;
                }
            }
            __syncthreads();
            if (F.tid < 8) {
                const int e = F.tid; int n = 0;
                for (int i = 0; i < 128; ++i) if (t_e[i] == e) { t_p[i] = n; ++n; }
                const int basep = n ? (int)__hip_atomic_fetch_add(ctl + CW_MOECNT + 64 * e, (unsigned)n, RLX_AGENT) : 0;
                for (int i = 0; i < 128; ++i) if (t_e[i] == e) t_p[i] += basep;
            }
            __syncthreads();
            if (F.tid < 128) { const int lt = F.tid >> 1, k = F.tid & 1, m = base + lt; const int e = t_e[F.tid], pos = t_p[F.tid];
                ROWTOK[e * M + pos] = m; TOKSLOT[m * 4 + k * 2] = e; TOKSLOT[m * 4 + k * 2 + 1] = pos; ((float*)TOKSLOT)[(size_t)M * 4 + m * 2 + k] = t_w[F.tid]; }
            __syncthreads();
        }
    }
    SEAM(15);
#define MOE_TABLE() do { if (F.tid == 0) { int ts_ = 0; for (int e = 0; e < 8; ++e) { const int ce = (int)__hip_atomic_load(ctl + CW_MOECNT + 64 * e, RLX_AGENT); moetab[16 + e] = ce; moetab[e] = ts_; ts_ += (ce + 255) >> 8; } moetab[8] = ts_; } __syncthreads(); } while (0)
    LAS int* moetab = (LAS int*)(F.lds + MISC_OFF + 256);
    PH(16) {
        MOE_TABLE();
        OrderMoe SM; SM.tab = moetab;
        SM.A = (const char*)XN; SM.Bt = (const char*)MOE13; SM.rowtok = ROWTOK; SM.lda = DM * 2; SM.ldb = DM * 2; SM.bstride = (size_t)2 * DFFE * DM * 2; SM.nN = 2 * DFFE / 256;
        SM.nwg = moetab[8] * SM.nN; SM.G = F.G; SM.c = (int)blockIdx.x; SM.gather = true;
        EpiSwiglu E{ACT, DFFE};
        pg8::gemm_phase<EpiSwiglu, OrderMoe, true>(ring, DM * 2, 128, DM * 2, DM / 64, SM, E);
    }
    SEAM(16);
    PH(17) {
        MOE_TABLE();
        OrderMoe SM; SM.tab = moetab;
        SM.A = (const char*)ACT; SM.Bt = (const char*)MOE2; SM.rowtok = ROWTOK; SM.lda = DFFE * 2; SM.ldb = DFFE * 2; SM.bstride = (size_t)DM * DFFE * 2; SM.nN = 8;
        SM.nwg = moetab[8] * SM.nN; SM.G = F.G; SM.c = (int)blockIdx.x; SM.gather = false;
        EpiF32 E{Y2};
        pg8::gemm_phase<EpiF32, OrderMoe, false>(ring, DFFE * 2, 128, DFFE * 2, DFFE / 64, SM, E);
    }
    SEAM(17);
    PH(18) {
        MOE_TABLE();
        const float* g = args.in[I_FINAL_NORM];
        for (int m = F.gw; m < M; m += F.NGW) {
            const int e0 = TOKSLOT[m * 4], p0 = TOKSLOT[m * 4 + 1], e1 = TOKSLOT[m * 4 + 2], p1 = TOKSLOT[m * 4 + 3];
            const float w0 = ((const float*)TOKSLOT)[(size_t)M * 4 + m * 2], w1 = ((const float*)TOKSLOT)[(size_t)M * 4 + m * 2 + 1];
            const int ts0 = moetab[e0], ts1 = moetab[e1];
            const float* y0 = Y2 + ((size_t)ts0 * 256 + p0) * DM; const float* y1 = Y2 + ((size_t)ts1 * 256 + p1) * DM; const float* hr = H + (size_t)m * DM;
            f32x4 v[8]; float s = 0.f;
#pragma unroll
            for (int j = 0; j < 8; ++j) { const int col = 4 * F.lane + 256 * j; v[j] = *(const f32x4*)(hr + col) + (w0 * *(const f32x4*)(y0 + col) + w1 * *(const f32x4*)(y1 + col));
                s += (v[j].x * v[j].x + v[j].y * v[j].y) + (v[j].z * v[j].z + v[j].w * v[j].w); }
            const float rstd = 1.0f / sqrtf(wave_sum(s) * (1.0f / DM) + RMS_EPS);
#pragma unroll
            for (int j = 0; j < 8; ++j) { const int col = 4 * F.lane + 256 * j; *(f32x4*)(args.out + (size_t)m * DM + col) = v[j] * rstd * *(const f32x4*)(g + col); }
        }
    }
#undef IN
#undef SEAM
}

extern "C" void kernel_launch(void* const* d_in, const int* in_sizes, int n_in, void* d_out, int out_size, void* d_ws, size_t ws_size, hipStream_t stream) {
    static int grid = 0;
    if (grid == 0) {
        if (n_in != 33 || out_size != M * DM || ws_size < WS_END) { fprintf(stderr, "kernel_launch: unexpected shapes (n_in %d, out %d, ws %zu < %zu)\n", n_in, out_size, ws_size, (size_t)WS_END); grid = -1; return; }
        int dev = 0, cus = 0, per_cu = 0;
        if (hipGetDevice(&dev) != hipSuccess || hipDeviceGetAttribute(&cus, hipDeviceAttributeMultiprocessorCount, dev) != hipSuccess) { grid = -1; return; }
        if (hipFuncSetAttribute((const void*)mk_fwd, hipFuncAttributeMaxDynamicSharedMemorySize, LDS_BYTES) != hipSuccess) { fprintf(stderr, "kernel_launch: hipFuncSetAttribute failed\n"); grid = -1; return; }
        if (hipOccupancyMaxActiveBlocksPerMultiprocessor(&per_cu, (const void*)mk_fwd, NTHR, LDS_BYTES) != hipSuccess || per_cu < 1) fprintf(stderr, "kernel_launch: occupancy query reports %d\n", per_cu);
        (void)hipGetLastError();
        grid = cus < 256 ? cus : 256;
    }
    if (grid < 0) return;
    if (hipMemsetAsync((char*)d_ws + WS_CTL, 0, CTL_ZERO_BYTES, stream) != hipSuccess) return;
    Args a{};
    for (int i = 0; i < 33; ++i) a.in[i] = (const float*)d_in[i];
    a.out = (float*)d_out; a.ws = (unsigned char*)d_ws; a.pad = 0;
    if (MK_N_LAUNCHES == 1) {
        a.ph_lo = 0; a.ph_hi = NPHASE; a.use_bar = 1;
        hipLaunchKernelGGL(mk_fwd, dim3(grid), dim3(NTHR), LDS_BYTES, stream, a);
    } else {
        for (int p = 0; p < NPHASE; ++p) { a.ph_lo = p; a.ph_hi = p + 1; a.use_bar = 0; hipLaunchKernelGGL(mk_fwd, dim3(grid), dim3(NTHR), LDS_BYTES, stream, a); }
    }
}
```

```cpp
#include <hip/hip_runtime.h>
#include <cstdio>
#include <cstdint>

#define GAS __attribute__((address_space(1)))
#define LAS __attribute__((address_space(3)))
typedef unsigned short bf16_t;
typedef short bf16x8 __attribute__((ext_vector_type(8)));
typedef short s16x4 __attribute__((ext_vector_type(4)));
typedef float f32x4 __attribute__((ext_vector_type(4)));
typedef float f32x2 __attribute__((ext_vector_type(2)));
typedef float f32x16 __attribute__((ext_vector_type(16)));
typedef unsigned u32x4 __attribute__((ext_vector_type(4)));
typedef unsigned u32x2 __attribute__((ext_vector_type(2)));
typedef __bf16 bf16x2_t __attribute__((ext_vector_type(2)));
#define DI __device__ __forceinline__

#ifndef MK_N_LAUNCHES
#define MK_N_LAUNCHES 1
#endif

constexpr int BATCH = 4, SEQ = 4096, DM = 2048, M = BATCH * SEQ;
constexpr int NP = 3328;
constexpr int IN_COLS = 3120;
constexpr int C_QA = 0, C_KA = 1024, C_VA = 1152, C_QB = 1280, C_KCMP = 2304, C_VCMP = 2432, C_KSEL = 2560, C_VSEL = 2688, C_KWIN = 2816, C_VWIN = 2944, C_GATE = 3072;
constexpr int DFF = 5632, DFFE = 7168, NEXP = 8;
constexpr float RMS_EPS = 1e-5f, GN_EPS = 64e-5f;
constexpr float LOG2E = 1.4426950408889634f;
constexpr float QSCALE = 0.125f * LOG2E;
constexpr int NWAVES = 8, NTHR = 512;
constexpr int MOE_ROWS = 2 * M + NEXP * 256;

constexpr size_t MiB = 1u << 20;
constexpr size_t al(size_t x) { return (x + 0xFFFFF) & ~(size_t)0xFFFFF; }
constexpr size_t WS_CTL = 0, CTL_ZERO_BYTES = 1 * MiB;
constexpr size_t WS_W_IN = 1 * MiB;
constexpr size_t WS_W_OUT = WS_W_IN + al((size_t)NP * DM * 2);
constexpr size_t WS_CMPW1 = WS_W_OUT + al((size_t)DM * DM * 2);
constexpr size_t WS_FFN13 = WS_CMPW1 + al((size_t)2 * 256 * 2048 * 2);
constexpr size_t WS_FFN2 = WS_FFN13 + al((size_t)2 * DFF * DM * 2);
constexpr size_t WS_WRKV = WS_FFN2 + al((size_t)DM * DFF * 2);
constexpr size_t WS_LORA1 = WS_WRKV + al((size_t)3 * DM * DM * 2);
constexpr size_t WS_LORA2 = WS_LORA1 + al((size_t)3 * 256 * DM * 2);
constexpr size_t WS_WO = WS_LORA2 + al((size_t)3 * DM * 256 * 2);
constexpr size_t WS_MOE13 = WS_WO + al((size_t)DM * DM * 2);
constexpr size_t WS_MOE2 = WS_MOE13 + al((size_t)NEXP * 2 * DFFE * DM * 2);
constexpr size_t WS_XN = WS_MOE2 + al((size_t)NEXP * DM * DFFE * 2);
constexpr size_t WS_P = WS_XN + al((size_t)M * DM * 2);
constexpr size_t WS_ROPE = WS_P + al((size_t)(M + 64) * NP * 2);
constexpr size_t WS_CMPB = WS_ROPE + al((size_t)M * 64 * 4);
constexpr size_t WS_HID = WS_CMPB + MiB;
constexpr size_t WS_KVC = WS_HID + al((size_t)2 * 2048 * 256 * 2);
constexpr size_t WS_O = WS_KVC + al((size_t)2 * 2048 * 64 * 2);
constexpr size_t WS_H = WS_O + al((size_t)M * DM * 2);
constexpr size_t WS_ACT = WS_H + al((size_t)M * DM * 4);
constexpr size_t WS_XS = WS_ACT + al((size_t)MOE_ROWS * DFFE * 2);
constexpr size_t WS_RKV = WS_XS + al((size_t)6 * M * DM * 2);
constexpr size_t WS_L1 = WS_RKV + al((size_t)3 * M * DM * 2);
constexpr size_t WS_DEC = WS_L1 + al((size_t)3 * M * 256 * 2);
constexpr size_t WS_AA = WS_DEC + al((size_t)M * DM * 4);
constexpr size_t WS_GG = WS_AA + al((size_t)M * DM * 4);
constexpr size_t WS_YRAW = WS_GG + al((size_t)M * DM * 2);
constexpr size_t WS_YG = WS_YRAW + al((size_t)M * DM * 4);
constexpr size_t WS_ROWTOK = WS_YG + al((size_t)M * DM * 2);
constexpr size_t WS_TOKSLOT = WS_ROWTOK + al((size_t)NEXP * M * 4);
constexpr size_t WS_Y2 = WS_TOKSLOT + al((size_t)M * 16);
constexpr size_t WS_END = WS_Y2 + al((size_t)MOE_ROWS * DM * 4);
constexpr int CW_BAR = 0;
constexpr int CW_MOECNT = 4096;

constexpr int RING_BYTES = 131072, LDSCTL_OFF = 135168, MISC_OFF = LDSCTL_OFF + 320, LDS_BYTES = 147456;

#define RLX_AGENT __ATOMIC_RELAXED, __HIP_MEMORY_SCOPE_AGENT
DI unsigned f2bf(float f) { unsigned u = __builtin_bit_cast(unsigned, f); return (u + 0x7fffu + ((u >> 16) & 1u)) >> 16; }
DI unsigned pk2(float lo, float hi) { f32x2 v = {lo, hi}; bf16x2_t b = __builtin_convertvector(v, bf16x2_t); return __builtin_bit_cast(unsigned, b); }
DI float bf2f(unsigned short b) { return __builtin_bit_cast(float, ((unsigned)b) << 16); }
DI float bflo(unsigned w) { return __builtin_bit_cast(float, w << 16); }
DI float bfhi(unsigned w) { return __builtin_bit_cast(float, w & 0xffff0000u); }
DI float wave_sum(float v) {
#pragma unroll
    for (int o = 1; o < 64; o <<= 1) v += __shfl_xor(v, o);
    return v;
}
DI int opq(int x) { asm volatile("" : "+v"(x)); return x; }
DI float ex2(float x) { return __builtin_amdgcn_exp2f(x); }
DI float sigmoidf_(float x) { return 1.0f / (1.0f + __expf(-x)); }
DI float siluf_(float x) { return x / (1.0f + __expf(-x)); }
DI float tanhf_(float x) { return 1.0f - 2.0f / (__expf(2.0f * x) + 1.0f); }

#define XB_TMO      128
#define XB_XCNT(j)  (256  + 64 * (j))
#define XB_XSUB(j)  (1280 + 64 * (j))
#define XB_XGEN(j)  (2304 + 64 * (j))
#define XB_TOP      3328
#define XB_TOPGEN   3392
#define XCD_BAR_WORDS 3456
#define XB_SPIN_CAP (1u << 22)
DI unsigned xb_ld(unsigned* p)              { return __hip_atomic_load(p, __ATOMIC_RELAXED, __HIP_MEMORY_SCOPE_AGENT); }
DI unsigned xb_add(unsigned* p, unsigned v) { return __hip_atomic_fetch_add(p, v, __ATOMIC_RELAXED, __HIP_MEMORY_SCOPE_AGENT); }
DI unsigned xb_xcc_id() { return (unsigned)__builtin_amdgcn_s_getreg((3 << 11) | 20) & 0xFu; }
#define XB_SPIN(cond, bar) do { unsigned _sp = 0; while (cond) { __builtin_amdgcn_s_sleep(1); \
    if ((++_sp & 255u) == 0u) { if (xb_ld(&(bar)[XB_TMO])) break; if (_sp > XB_SPIN_CAP) { atomicAdd(&(bar)[XB_TMO], 1u); break; } } } } while (0)
struct XcdBarrier { unsigned* bar; unsigned x; volatile LAS unsigned* st; };
DI XcdBarrier xcd_barrier_post(unsigned* bar, volatile LAS unsigned* st) {
    XcdBarrier b; b.bar = bar; b.x = xb_xcc_id(); b.st = st;
    if (threadIdx.x == 0) (void)xb_add(&bar[XB_XCNT(b.x)], 1u);
    return b;
}
DI void xcd_barrier_complete(unsigned* bar, unsigned x, unsigned& nloc, unsigned& nx) {
    const unsigned G = gridDim.x * gridDim.y * gridDim.z;
    unsigned sum, cnt, mine, sp = 0u;
    for (;;) {
        sum = 0u; cnt = 0u; mine = 0u;
#pragma unroll
        for (unsigned j = 0; j < 16; ++j) { const unsigned c = xb_ld(&bar[XB_XCNT(j)]); sum += c; cnt += (c > 0u) ? 1u : 0u; mine = (j == x) ? c : mine; }
        if (sum == G) break;
        __builtin_amdgcn_s_sleep(1);
        if ((++sp & 255u) == 0u) { if (xb_ld(&bar[XB_TMO])) break; if (sp > XB_SPIN_CAP) { atomicAdd(&bar[XB_TMO], 1u); break; } }
    }
    nloc = mine > 0u ? mine : 1u; nx = cnt > 0u ? cnt : 1u;
}
DI void xcd_barrier(const XcdBarrier& b) {
    asm volatile("s_waitcnt vmcnt(0)" ::: "memory");
    __syncthreads();
    if (threadIdx.x == 0) {
        unsigned* bar = b.bar;
        __builtin_amdgcn_s_waitcnt(0);
        unsigned nloc = b.st[0], nx = b.st[1];
        if (nloc == 0u) { xcd_barrier_complete(bar, b.x, nloc, nx); b.st[0] = nloc; b.st[1] = nx; }
        const unsigned old = xb_add(&bar[XB_XSUB(b.x)], 1u);
        const unsigned gen = old / nloc;
        if (old + 1u == (gen + 1u) * nloc) {
            __builtin_amdgcn_fence(__ATOMIC_RELEASE, "agent");
            asm volatile("s_waitcnt vmcnt(0)" ::: "memory");
            const unsigned og = xb_add(&bar[XB_TOP], 1u);
            const unsigned tg = og / nx;
            if (og + 1u == (tg + 1u) * nx) xb_add(&bar[XB_TOPGEN], 1u);
            else XB_SPIN(xb_ld(&bar[XB_TOPGEN]) == tg, bar);
            __builtin_amdgcn_fence(__ATOMIC_ACQUIRE, "agent");
            xb_add(&bar[XB_XGEN(b.x)], 1u);
            asm volatile("s_waitcnt vmcnt(0)" ::: "memory");
        } else {
            XB_SPIN(xb_ld(&bar[XB_XGEN(b.x)]) == gen, bar);
            __builtin_amdgcn_fence(__ATOMIC_ACQUIRE, "agent");
            asm volatile("s_waitcnt vmcnt(0)" ::: "memory");
        }
    }
    __syncthreads();
}

namespace pg8 {
constexpr int BM = 256, BK = 64, HALF = 128, HTB = HALF * BK * 2, STAGE_BYTES = 8 * HTB, NXCD = 8, WGM = 8;
__host__ __device__ __forceinline__ int lds_byte(int r, int c) { const int st = (r >> 4) * 2 + (c >> 5), rr = r & 15, cc = c & 31, ob = rr * 64 + cc * 2; return st * 1024 + (ob ^ (((ob >> 9) & 1) << 5)); }
__host__ __device__ __forceinline__ void stage_rc(int b, int& R, int& C) { const int st = b / 1024, sb = b % 1024, swz = sb ^ (((sb >> 9) & 1) << 5); R = (st >> 1) * 16 + swz / 64; C = (st & 1) * 32 + (swz % 64) / 2; }
__host__ __device__ __forceinline__ int perm32(int rho) { const int n = rho >> 4, i = rho & 15; return 8 * (i >> 2) + 4 * n + (i & 3); }

struct Unit { const char* a; const char* b; int pm, pn, g; };

DI int xcd_remap(int L, int nwg) { const int q = nwg / NXCD, r = nwg % NXCD, xcd = L % NXCD, off = L / NXCD; return (xcd < r ? xcd * (q + 1) : r * (q + 1) + (xcd - r) * q) + off; }
DI void tile_map(int idx, int nM, int nN, int& pm, int& pn) { const int nig = WGM * nN, gid = idx / nig, fm = gid * WGM, gsz = (nM - fm) < WGM ? (nM - fm) : WGM; pm = fm + ((idx % nig) % gsz); pn = (idx % nig) / gsz; }

template <class Epi, class Sched, bool GATHER>
DI void gemm_phase(LAS unsigned char* lds, const unsigned lda, const unsigned ka, const unsigned ldb, const int nt, const Sched& S, const Epi& E) {
    const int tid = threadIdx.x, wid = __builtin_amdgcn_readfirstlane(tid >> 6), lane = tid & 63, wr = wid >> 2, wc = wid & 3, fr = lane & 15, fq = lane >> 4;
    int Rr[2], Cc[2];
    unsigned vB[2], vA[2][2], vN[2][2];
#pragma unroll
    for (int i = 0; i < 2; ++i) { stage_rc(tid * 16 + i * 8192, Rr[i], Cc[i]); const int Rb = (Rr[i] & ~31) + perm32(Rr[i] & 31); vB[i] = (unsigned)Rb * ldb + (unsigned)Cc[i] * 2u; }
    const size_t kb = (size_t)(BK * 2);
    const size_t hB = (size_t)HALF * ldb;
    const unsigned ldsw = (unsigned)wid * 1024u;
    const int aoff = lds_byte(wr * 64 + fr, fq * 8), boff = lds_byte(wc * 32 + fr, fq * 8);
#define PG8_SA(b, h) (((b) * 2 + (h)) * HTB)
#define PG8_SB(b, h) ((4 + (b) * 2 + (h)) * HTB)
#define PG8_STAGE(bufoff, gbase, v0, v1) do { \
        __builtin_amdgcn_global_load_lds((const unsigned*)((const char*)(gbase) + (v0)), (LAS unsigned*)(lds + (bufoff) + ldsw), 16, 0, 0); \
        __builtin_amdgcn_global_load_lds((const unsigned*)((const char*)(gbase) + (v1)), (LAS unsigned*)(lds + (bufoff) + ldsw + 8192), 16, 0, 0); } while (0)
#define PG8_LDA(dst, b, h) do { _Pragma("unroll") for (int m = 0; m < 4; ++m) _Pragma("unroll") for (int k = 0; k < 2; ++k) dst[m][k] = *(const LAS bf16x8*)(lds + PG8_SA(b, h) + aoff + m * 2048 + k * 1024); } while (0)
#define PG8_LDB(dst, b, h) do { _Pragma("unroll") for (int n = 0; n < 2; ++n) _Pragma("unroll") for (int k = 0; k < 2; ++k) dst[n][k] = *(const LAS bf16x8*)(lds + PG8_SB(b, h) + boff + n * 2048 + k * 1024); } while (0)
#define PG8_MMA(ai, bj, At, Bt) do { __builtin_amdgcn_s_setprio(1); _Pragma("unroll") for (int m = 0; m < 4; ++m) _Pragma("unroll") for (int n = 0; n < 2; ++n) _Pragma("unroll") for (int k = 0; k < 2; ++k) \
        acc[ai][bj][m][n] = __builtin_amdgcn_mfma_f32_16x16x32_bf16(Bt[n][k], At[m][k], acc[ai][bj][m][n], 0, 0, 0); __builtin_amdgcn_s_setprio(0); } while (0)
#define PG8_WAIT_V(n) asm volatile("s_waitcnt vmcnt(" #n ")" ::: "memory")
#define PG8_WAIT_L(n) asm volatile("s_waitcnt lgkmcnt(" #n ")" ::: "memory")
#define PG8_BAR __builtin_amdgcn_s_barrier()
#define PG8_SCHED __builtin_amdgcn_sched_barrier(0)
    Unit cur, nxt; int ui = 0;
    if (!S.next(0, cur)) return;
#pragma unroll
    for (int h = 0; h < 2; ++h)
#pragma unroll
        for (int i = 0; i < 2; ++i) {
            if constexpr (GATHER) vA[h][i] = S.rowoff(cur, h * HALF + Rr[i]) + (unsigned)Cc[i] * 2u;
            else vA[h][i] = (unsigned)(h * HALF + Rr[i]) * lda + (unsigned)Cc[i] * 2u;
            vN[h][i] = vA[h][i];
        }
    f32x4 acc[2][2][4][2];
#pragma unroll
    for (int a = 0; a < 2; ++a)
#pragma unroll
        for (int b = 0; b < 2; ++b)
#pragma unroll
            for (int m = 0; m < 4; ++m)
#pragma unroll
                for (int n = 0; n < 2; ++n) acc[a][b][m][n] = (f32x4){0.f, 0.f, 0.f, 0.f};
    bf16x8 At[4][2], B0[2][2], B1[2][2];
    const char* cA = cur.a; const char* cB = cur.b;
    PG8_STAGE(PG8_SB(0, 0), cB, vB[0], vB[1]); PG8_STAGE(PG8_SB(0, 1), cB + hB, vB[0], vB[1]); PG8_STAGE(PG8_SA(0, 0), cA, vA[0][0], vA[0][1]); PG8_STAGE(PG8_SA(0, 1), cA, vA[1][0], vA[1][1]);
    if (wr == 1) PG8_BAR;
    PG8_WAIT_V(2); PG8_BAR;
    PG8_STAGE(PG8_SB(1, 0), cB + kb, vB[0], vB[1]); PG8_STAGE(PG8_SA(1, 0), cA + ka, vA[0][0], vA[0][1]); PG8_STAGE(PG8_SB(1, 1), cB + hB + kb, vB[0], vB[1]);
    PG8_WAIT_V(6); PG8_BAR;
    for (;;) {
        const bool has_next = S.next(ui + 1, nxt);
        const char* nA = has_next ? nxt.a : cA; const char* nB = has_next ? nxt.b : cB;
        if constexpr (GATHER) {
            if (has_next) {
#pragma unroll
                for (int h = 0; h < 2; ++h)
#pragma unroll
                    for (int i = 0; i < 2; ++i) vN[h][i] = S.rowoff(nxt, h * HALF + Rr[i]) + (unsigned)Cc[i] * 2u;
            }
        }
        for (int t = 0; t < nt; t += 2) {
            const bool last = (t == nt - 2);
            const char* a1 = cA + (size_t)(t + 1) * ka;
            const char* a2 = last ? nA : cA + (size_t)(t + 2) * ka; const char* b2 = last ? nB : cB + (size_t)(t + 2) * kb;
            const char* a3 = a2 + ka; const char* b3 = b2 + kb;
            unsigned x00 = vA[0][0], x01 = vA[0][1], x10 = vA[1][0], x11 = vA[1][1];
            if constexpr (GATHER) { if (last) { x00 = vN[0][0]; x01 = vN[0][1]; x10 = vN[1][0]; x11 = vN[1][1]; } }
            PG8_LDB(B0, 0, 0); PG8_LDB(B1, 0, 1); PG8_SCHED; PG8_LDA(At, 0, 0); PG8_STAGE(PG8_SA(1, 1), a1, vA[1][0], vA[1][1]);
            PG8_WAIT_V(8); PG8_WAIT_L(0); PG8_BAR; PG8_MMA(0, 0, At, B0); PG8_MMA(0, 1, At, B1); PG8_BAR; PG8_SCHED;
            PG8_LDA(At, 0, 1); PG8_STAGE(PG8_SB(0, 0), b2, vB[0], vB[1]); PG8_STAGE(PG8_SB(0, 1), b2 + hB, vB[0], vB[1]); PG8_STAGE(PG8_SA(0, 0), a2, x00, x01);
            PG8_WAIT_V(8); PG8_WAIT_L(0); PG8_BAR; PG8_MMA(1, 0, At, B0); PG8_MMA(1, 1, At, B1); PG8_BAR; PG8_SCHED;
            PG8_LDB(B0, 1, 0); PG8_LDB(B1, 1, 1); PG8_SCHED; PG8_LDA(At, 1, 0); PG8_STAGE(PG8_SA(0, 1), a2, x10, x11);
            PG8_WAIT_V(8); PG8_WAIT_L(0); PG8_BAR; PG8_MMA(0, 0, At, B0); PG8_MMA(0, 1, At, B1); PG8_BAR; PG8_SCHED;
            PG8_LDA(At, 1, 1); PG8_STAGE(PG8_SB(1, 0), b3, vB[0], vB[1]); PG8_STAGE(PG8_SB(1, 1), b3 + hB, vB[0], vB[1]); PG8_STAGE(PG8_SA(1, 0), a3, x00, x01);
            PG8_WAIT_V(8); PG8_WAIT_L(0); PG8_BAR; PG8_MMA(1, 0, At, B0); PG8_MMA(1, 1, At, B1); PG8_BAR; PG8_SCHED;
        }
        if (wr == 0) PG8_BAR;
        E(acc, cur, wr, wc, fr, fq);
        if (!has_next) break;
#pragma unroll
        for (int a = 0; a < 2; ++a)
#pragma unroll
            for (int b = 0; b < 2; ++b)
#pragma unroll
                for (int m = 0; m < 4; ++m)
#pragma unroll
                    for (int n = 0; n < 2; ++n) acc[a][b][m][n] = (f32x4){0.f, 0.f, 0.f, 0.f};
        cur = nxt; cA = nA; cB = nB; ++ui;
        if constexpr (GATHER) {
#pragma unroll
            for (int h = 0; h < 2; ++h)
#pragma unroll
                for (int i = 0; i < 2; ++i) vA[h][i] = vN[h][i];
        }
        if (wr == 1) PG8_BAR;
    }
    PG8_WAIT_V(0);
    PG8_BAR;
#undef PG8_SA
#undef PG8_SB
#undef PG8_STAGE
#undef PG8_LDA
#undef PG8_LDB
#undef PG8_MMA
#undef PG8_WAIT_V
#undef PG8_WAIT_L
#undef PG8_BAR
#undef PG8_SCHED
}
}

typedef f32x4 AccT[2][2][4][2];
DI void st_bf16x8(bf16_t* p, f32x4 v0, f32x4 v1) { u32x4 w; w.x = pk2(v0[0], v0[1]); w.y = pk2(v0[2], v0[3]); w.z = pk2(v1[0], v1[1]); w.w = pk2(v1[2], v1[3]); *(u32x4*)p = w; }

struct OrderSingle {
    const char* A; const char* Bt; unsigned lda, ldb; int nM, nN, nwg, G, c;
    DI bool next(int i, pg8::Unit& u) const {
        const long L = (long)i * G + c; if (L >= nwg) return false;
        const int w = pg8::xcd_remap((int)L, nwg); int pm, pn; pg8::tile_map(w, nM, nN, pm, pn);
        u.pm = pm; u.pn = pn; u.g = 0; u.a = A + (size_t)pm * 256 * lda; u.b = Bt + (size_t)pn * 256 * ldb; return true;
    }
    DI unsigned rowoff(const pg8::Unit&, int) const { return 0u; }
};
struct OrderMulti {
    const char* A[6]; const char* Bt[6]; int nN[6]; int start[7]; unsigned lda, ldb; int ng, nwg, G, c;
    DI bool next(int i, pg8::Unit& u) const {
        const long L = (long)i * G + c; if (L >= nwg) return false;
        const int w = pg8::xcd_remap((int)L, nwg);
        int g = 0; const char* a = A[0]; const char* b = Bt[0]; int nn = nN[0], st = start[0];
#pragma unroll
        for (int k = 1; k < 6; ++k) if (k < ng && w >= start[k]) { g = k; a = A[k]; b = Bt[k]; nn = nN[k]; st = start[k]; }
        int pm, pn; pg8::tile_map(w - st, 64, nn, pm, pn);
        u.pm = pm; u.pn = pn; u.g = g; u.a = a + (size_t)pm * 256 * lda; u.b = b + (size_t)pn * 256 * ldb; return true;
    }
    DI unsigned rowoff(const pg8::Unit&, int) const { return 0u; }
};
struct OrderCmp {
    const char* P; const char* Bt; int G, c;
    DI bool next(int i, pg8::Unit& u) const {
        const int L = i * G + c; if (L >= 16) return false;
        const int kv = L >> 3, bh = L & 7, b = bh >> 1, h = bh & 1;
        u.pm = bh; u.pn = 0; u.g = kv;
        u.a = P + ((size_t)b * SEQ * NP + (size_t)(C_KCMP + kv * 128 + h * 64)) * 2;
        u.b = Bt + (size_t)kv * 256 * 2048 * 2; return true;
    }
    DI unsigned rowoff(const pg8::Unit&, int) const { return 0u; }
};
struct OrderMoe {
    const char* A; const char* Bt; const int* rowtok; const LAS int* tab; unsigned lda, ldb; size_t bstride; int nN, nwg, G, c; bool gather;
    DI bool next(int i, pg8::Unit& u) const {
        const long L = (long)i * G + c; if (L >= nwg) return false;
        const int w = (int)L;
        const int tau = w / nN, pn = w % nN;
        int e = 0;
#pragma unroll
        for (int k = 1; k < 8; ++k) if (tau >= tab[k]) e = k;
        u.pm = tau; u.pn = pn; u.g = e;
        u.a = gather ? A : A + (size_t)tau * 256 * lda;
        u.b = Bt + (size_t)e * bstride + (size_t)pn * 256 * ldb; return true;
    }
    DI unsigned rowoff(const pg8::Unit& u, int row) const {
        const int e = u.g; const int ce = tab[16 + e], ts = tab[e];
        const int pos = (u.pm - ts) * 256 + row;
        const int tok = pos < ce ? rowtok[e * M + pos] : 0;
        return (unsigned)tok * lda;
    }
};

struct EpiInProj {
    bf16_t* P; const float* rope;
    DI void operator()(const AccT& acc, const pg8::Unit& u, int wr, int wc, int fr, int fq) const {
        const int row0 = u.pm * 256 + wr * 64 + fr;
#pragma unroll
        for (int bj = 0; bj < 2; ++bj) {
            const int cb = u.pn * 256 + bj * 128;
            const int col0 = cb + wc * 32 + 8 * fq;
            const bool do_rope = cb < C_VA;
            const float sc = (cb < C_KA || (cb >= C_QB && cb < C_KCMP)) ? QSCALE : 1.0f;
            const int uidx = 4 * (wc & 1) + fq;
#pragma unroll
            for (int ai = 0; ai < 2; ++ai)
#pragma unroll
                for (int m = 0; m < 4; ++m) {
                    const int row = row0 + ai * 128 + m * 16;
                    f32x4 v0 = acc[ai][bj][m][0], v1 = acc[ai][bj][m][1];
                    if (do_rope) {
                        const f32x4 cs = *(const f32x4*)(rope + (size_t)row * 64 + 4 * uidx), sn = *(const f32x4*)(rope + (size_t)row * 64 + 32 + 4 * uidx);
                        const f32x4 o0 = v0 * cs - v1 * sn, o1 = v1 * cs + v0 * sn; v0 = o0; v1 = o1;
                    }
                    v0 = v0 * sc; v1 = v1 * sc;
                    st_bf16x8(P + (size_t)row * NP + col0, v0, v1);
                }
        }
    }
};
struct EpiCmp1 {
    bf16_t* HID; const float* bias;
    DI void operator()(const AccT& acc, const pg8::Unit& u, int wr, int wc, int fr, int fq) const {
        const int row0 = wr * 64 + fr;
#pragma unroll
        for (int bj = 0; bj < 2; ++bj) {
            const int col0 = bj * 128 + wc * 32 + 8 * fq;
            const f32x4 b0 = *(const f32x4*)(bias + u.g * 256 + col0), b1 = *(const f32x4*)(bias + u.g * 256 + col0 + 4);
#pragma unroll
            for (int ai = 0; ai < 2; ++ai)
#pragma unroll
                for (int m = 0; m < 4; ++m) {
                    const int row = row0 + ai * 128 + m * 16;
                    f32x4 v0 = acc[ai][bj][m][0] + b0, v1 = acc[ai][bj][m][1] + b1;
#pragma unroll
                    for (int j = 0; j < 4; ++j) { v0[j] = siluf_(v0[j]); v1[j] = siluf_(v1[j]); }
                    st_bf16x8(HID + ((size_t)(u.g * 2048 + u.pm * 256 + row)) * 256 + col0, v0, v1);
                }
        }
    }
};
struct EpiResF32 {
    const float* res; float* out;
    DI void operator()(const AccT& acc, const pg8::Unit& u, int wr, int wc, int fr, int fq) const {
        const int row0 = u.pm * 256 + wr * 64 + fr;
#pragma unroll
        for (int ai = 0; ai < 2; ++ai)
#pragma unroll
            for (int m = 0; m < 4; ++m) {
                const size_t ro = (size_t)(row0 + ai * 128 + m * 16) * DM;
#pragma unroll
                for (int bj = 0; bj < 2; ++bj) {
                    const int col0 = u.pn * 256 + bj * 128 + wc * 32 + 8 * fq;
                    const f32x4 r0 = *(const f32x4*)(res + ro + col0), r1 = *(const f32x4*)(res + ro + col0 + 4);
                    *(f32x4*)(out + ro + col0) = r0 + acc[ai][bj][m][0]; *(f32x4*)(out + ro + col0 + 4) = r1 + acc[ai][bj][m][1];
                }
            }
    }
};
struct EpiSwiglu {
    bf16_t* ACT; int ldc;
    DI void operator()(const AccT& acc, const pg8::Unit& u, int wr, int wc, int fr, int fq) const {
        const int row0 = u.pm * 256 + wr * 64 + fr; const int col0 = u.pn * 128 + wc * 32 + 8 * fq;
#pragma unroll
        for (int ai = 0; ai < 2; ++ai)
#pragma unroll
            for (int m = 0; m < 4; ++m) {
                f32x4 v0, v1;
#pragma unroll
                for (int j = 0; j < 4; ++j) { v0[j] = siluf_(acc[ai][0][m][0][j]) * acc[ai][1][m][0][j]; v1[j] = siluf_(acc[ai][0][m][1][j]) * acc[ai][1][m][1][j]; }
                st_bf16x8(ACT + (size_t)(row0 + ai * 128 + m * 16) * ldc + col0, v0, v1);
            }
    }
};
struct EpiRkvLora1 {
    bf16_t* RKV; bf16_t* L1;
    DI void operator()(const AccT& acc, const pg8::Unit& u, int wr, int wc, int fr, int fq) const {
        const int row0 = u.pm * 256 + wr * 64 + fr; const int g = u.g;
        bf16_t* base = g < 3 ? RKV + (size_t)g * M * DM : L1 + (size_t)(g - 3) * M * 256;
        const int ldc = g < 3 ? DM : 256;
#pragma unroll
        for (int ai = 0; ai < 2; ++ai)
#pragma unroll
            for (int m = 0; m < 4; ++m)
#pragma unroll
                for (int bj = 0; bj < 2; ++bj) {
                    const int col0 = u.pn * 256 + bj * 128 + wc * 32 + 8 * fq;
                    f32x4 v0 = acc[ai][bj][m][0], v1 = acc[ai][bj][m][1];
                    if (g == 3) {
#pragma unroll
                        for (int j = 0; j < 4; ++j) { v0[j] = tanhf_(v0[j]); v1[j] = tanhf_(v1[j]); }
                    } else if (g == 5) {
#pragma unroll
                        for (int j = 0; j < 4; ++j) { v0[j] = sigmoidf_(v0[j]); v1[j] = sigmoidf_(v1[j]); }
                    }
                    st_bf16x8(base + (size_t)(row0 + ai * 128 + m * 16) * ldc + col0, v0, v1);
                }
    }
};
struct EpiLora2 {
    float* DEC; float* AA; bf16_t* GG; const float* w0; const float* a0;
    DI void operator()(const AccT& acc, const pg8::Unit& u, int wr, int wc, int fr_, int fq_) const {
        const int fr = opq(fr_), fq = opq(fq_);
        const int row0 = u.pm * 256 + wr * 64 + fr; const int g = u.g;
        const float* cvec = g == 0 ? w0 : a0;
        float* outf = g == 0 ? DEC : AA;
#pragma unroll
        for (int bj = 0; bj < 2; ++bj) {
            const int col0 = u.pn * 256 + bj * 128 + wc * 32 + 8 * fq;
            f32x4 c0 = (f32x4){0.f, 0.f, 0.f, 0.f}, c1 = c0;
            if (g < 2) { c0 = *(const f32x4*)(cvec + col0); c1 = *(const f32x4*)(cvec + col0 + 4); }
#pragma unroll
            for (int ai = 0; ai < 2; ++ai)
#pragma unroll
                for (int m = 0; m < 4; ++m) {
                    const size_t ro = (size_t)(row0 + ai * 128 + m * 16) * DM + col0;
                    f32x4 v0 = acc[ai][bj][m][0] + c0, v1 = acc[ai][bj][m][1] + c1;
                    if (g < 2) {
#pragma unroll
                        for (int j = 0; j < 4; ++j) { v0[j] = sigmoidf_(v0[j]); v1[j] = sigmoidf_(v1[j]); }
                        if (g == 0) {
#pragma unroll
                            for (int j = 0; j < 4; ++j) { v0[j] = __expf(-0.60653065971f * v0[j]); v1[j] = __expf(-0.60653065971f * v1[j]); }
                        }
                        *(f32x4*)(outf + ro) = v0; *(f32x4*)(outf + ro + 4) = v1;
                    } else st_bf16x8(GG + ro, v0, v1);
                    asm volatile("" ::: "memory");
                }
        }
    }
};
struct EpiF32 {
    float* out;
    DI void operator()(const AccT& acc, const pg8::Unit& u, int wr, int wc, int fr, int fq) const {
        const int row0 = u.pm * 256 + wr * 64 + fr;
#pragma unroll
        for (int ai = 0; ai < 2; ++ai)
#pragma unroll
            for (int m = 0; m < 4; ++m) {
                const size_t ro = (size_t)(row0 + ai * 128 + m * 16) * DM;
#pragma unroll
                for (int bj = 0; bj < 2; ++bj) {
                    const int col0 = u.pn * 256 + bj * 128 + wc * 32 + 8 * fq;
                    *(f32x4*)(out + ro + col0) = acc[ai][bj][m][0]; *(f32x4*)(out + ro + col0 + 4) = acc[ai][bj][m][1];
                }
            }
    }
};

struct Args { const float* in[33]; float* out; unsigned char* ws; int ph_lo, ph_hi, use_bar, pad; };
enum { I_X = 0, I_POS, I_ATTN_NORM, I_FFN_NORM, I_FINAL_NORM, I_W_IN, I_W_OUT, I_SINKS, I_CMP_PE, I_CMP_W1, I_CMP_B1, I_CMP_W2, I_FFN_W13, I_FFN_W2, I_MU, I_W_RKV, I_DECAY_W0, I_DECAY_W1,
       I_DECAY_W2, I_A0, I_A1, I_A2, I_G1, I_G2, I_K_K, I_K_A, I_R_K, I_LN_W, I_LN_B, I_W_O, I_ROUTER, I_MOE_W13, I_MOE_W2 };

struct Frame {
    LAS unsigned char* lds;
    int tid, lane, wave, G, gw, NGW;
    unsigned char* ws;
};

template <class F>
DI void transpose_item(const float* W, int Nsrc, int kvalid, bf16_t* WT, int Kd, const F& map, int k0, int n0, LAS float* scr, int lane) {
    const int s0 = map.src0(n0);
    const int rsub = lane >> 4, col = s0 + 4 * (lane & 15);
    f32x4 v[16];
#pragma unroll
    for (int i = 0; i < 16; ++i) { const int k = k0 + 4 * i + rsub; v[i] = (f32x4){0.f, 0.f, 0.f, 0.f}; if (k < kvalid && col < Nsrc) v[i] = *(const f32x4*)(W + (size_t)k * Nsrc + col); }
#pragma unroll
    for (int i = 0; i < 16; ++i) { LAS float* d = scr + (4 * i + rsub) * 65 + 4 * (lane & 15); d[0] = v[i].x; d[1] = v[i].y; d[2] = v[i].z; d[3] = v[i].w; }
    asm volatile("s_waitcnt lgkmcnt(0)" ::: "memory");
    const int c = lane & 7;
#pragma unroll
    for (int j = 0; j < 8; ++j) { const int nl = (lane >> 3) + 8 * j; const LAS float* s = scr + (8 * c) * 65 + map.perm(n0, nl);
        u32x4 o; o.x = pk2(s[0 * 65], s[1 * 65]); o.y = pk2(s[2 * 65], s[3 * 65]); o.z = pk2(s[4 * 65], s[5 * 65]); o.w = pk2(s[6 * 65], s[7 * 65]);
        *(u32x4*)(WT + (size_t)(n0 + nl) * Kd + k0 + 8 * c) = o; }
    asm volatile("s_waitcnt lgkmcnt(0)" ::: "memory");
}
template <class F>
DI void transpose_matrix(const Frame& F_, const float* W, int Nsrc, int kvalid, bf16_t* WT, int Kd, int Nd, const F& map, LAS float* scr) {
    const int nkb = Kd / 64, nnb = Nd / 64, nitems = nkb * nnb;
    for (int it = F_.gw; it < nitems; it += F_.NGW) { const int kbi = it / nnb, nb = it % nnb; transpose_item(W, Nsrc, kvalid, WT, Kd, map, 64 * kbi, 64 * nb, scr, F_.lane); }
}
struct ColIdent { DI int src0(int n0) const { return n0; } DI int perm(int, int nl) const { return nl; } };
struct ColInProj { DI int src0(int n0) const { return n0; }
    DI int perm(int n0, int l) const { return n0 < C_VA ? ((l & 7) < 4 ? 4 * (l >> 3) + (l & 3) : 32 + 4 * (l >> 3) + (l & 3)) : l; } };
struct ColSwiglu { int F; DI int src0(int n0) const { const int t = n0 >> 8, r = n0 & 255; return r < 128 ? t * 128 + r : F + t * 128 + (r - 128); } DI int perm(int, int nl) const { return nl; } };

DI void rms_row_load(const float* xrow, int lane, f32x4 (&v)[8], float& rstd) {
    float s = 0.f;
#pragma unroll
    for (int j = 0; j < 8; ++j) { v[j] = *(const f32x4*)(xrow + 4 * lane + 256 * j); s += (v[j].x * v[j].x + v[j].y * v[j].y) + (v[j].z * v[j].z + v[j].w * v[j].w); }
    rstd = 1.0f / sqrtf(wave_sum(s) * (1.0f / DM) + RMS_EPS);
}
DI void rms_row_to_bf16(const float* xrow, const float* g, bf16_t* orow, int lane) {
    f32x4 v[8]; float rstd; rms_row_load(xrow, lane, v, rstd);
#pragma unroll
    for (int j = 0; j < 8; ++j) { const f32x4 gg = *(const f32x4*)(g + 4 * lane + 256 * j); const f32x4 y = v[j] * rstd * gg;
        u32x2 w; w.x = pk2(y.x, y.y); w.y = pk2(y.z, y.w); *(u32x2*)(orow + 4 * lane + 256 * j) = w; }
}

namespace att {
constexpr int KPADB = 144;
constexpr int VPADB = 144;
constexpr int BUFB = 64 * KPADB + 64 * VPADB;
constexpr int OFF_ALPHA = 2 * BUFB;
constexpr int OFF_IMP = OFF_ALPHA + 8 * 256;
constexpr int OFF_SEL = OFF_IMP + 16384;
constexpr int OFF_RANK = OFF_SEL + 512;
constexpr int OFF_Q = 65536;
constexpr float NEGBIG = -1e30f;
DI int crow(int r, int h) { return (r & 3) + 8 * (r >> 2) + 4 * h; }
#define MFMA32(a, b, c) __builtin_amdgcn_mfma_f32_32x32x16_bf16((a), (b), (c), 0, 0, 0)

struct KVRegs { u32x4 k, v; };
DI void kv_load(KVRegs& r, const bf16_t* Kg, const bf16_t* Vg, size_t pitch, int tid) {
    const int key = tid >> 3, dc = tid & 7;
    r.k = *(const u32x4*)(Kg + (size_t)key * pitch + dc * 8); r.v = *(const u32x4*)(Vg + (size_t)key * pitch + dc * 8);
}
DI void kv_store(const KVRegs& r, LAS unsigned char* buf, int tid) {
    const int key = tid >> 3, dc = tid & 7;
    *(LAS u32x4*)(buf + key * KPADB + dc * 16) = r.k;
    LAS unsigned short* vt = (LAS unsigned short*)(buf + 64 * KPADB);
    const unsigned w[4] = {r.v.x, r.v.y, r.v.z, r.v.w};
#pragma unroll
    for (int i = 0; i < 4; ++i) { vt[(dc * 8 + 2 * i) * (VPADB / 2) + key] = (unsigned short)(w[i] & 0xffffu); vt[(dc * 8 + 2 * i + 1) * (VPADB / 2) + key] = (unsigned short)(w[i] >> 16); }
}

struct State { f32x16 O[2][2]; float m[2], l[2]; };
DI void state_init(State& s) {
#pragma unroll
    for (int a = 0; a < 2; ++a) { s.m[a] = NEGBIG; s.l[a] = 0.f;
#pragma unroll
        for (int b = 0; b < 2; ++b)
#pragma unroll
            for (int r = 0; r < 16; ++r) s.O[a][b][r] = 0.f; }
}
DI void row_scale(f32x16 (&O)[2], float f, LAS float* area, int c_, int h_) {
    const int c = opq(c_), h = opq(h_);
    area[c] = f;
    asm volatile("s_waitcnt lgkmcnt(0)" ::: "memory");
#pragma unroll
    for (int g4 = 0; g4 < 4; ++g4) { const f32x4 a = *(LAS f32x4*)(area + 8 * g4 + 4 * h);
#pragma unroll
        for (int j = 0; j < 4; ++j) { O[0][4 * g4 + j] *= a[j]; O[1][4 * g4 + j] *= a[j]; } }
    asm volatile("s_waitcnt lgkmcnt(0)" ::: "memory");
}
template <int MODE>
DI void tile_compute(State& st, const LAS unsigned char* qf, LAS unsigned char* buf, int kbase, const int (&tq)[2], int W, const unsigned long long (&sel)[2], int tile, LAS float* area, int c_, int h_) {
    const int c = opq(c_), h = opq(h_);
    LAS unsigned char* Kl = buf; LAS unsigned char* Vl = buf + 64 * KPADB;
#pragma unroll 1
    for (int kbk = 0; kbk < 2; ++kbk) {
        bf16x8 Pf[2][2];
        bf16x8 kf[4];
#pragma unroll
        for (int s = 0; s < 4; ++s) kf[s] = *(LAS bf16x8*)(Kl + (32 * kbk + c) * KPADB + (16 * s + 8 * h) * 2);
#pragma unroll
        for (int qb = 0; qb < 2; ++qb) {
            f32x16 S;
#pragma unroll
            for (int r = 0; r < 16; ++r) S[r] = 0.f;
#pragma unroll
            for (int s = 0; s < 4; ++s) { const bf16x8 q = *(const LAS bf16x8*)(qf + (qb * 4 + s) * 1024); S = MFMA32(kf[s], q, S); }
            float mx = NEGBIG;
            const bool bit = MODE == 2 ? (((sel[qb] >> tile) & 1ull) != 0ull) : true;
            const int dd = tq[qb] - (kbase + 32 * kbk + 4 * h);
#pragma unroll
            for (int r = 0; r < 16; ++r) { const int cr0 = (r & 3) + 8 * (r >> 2); bool valid;
                if (MODE == 0) valid = (cr0 <= dd) && (cr0 > dd - W);
                else if (MODE == 1) valid = (cr0 <= dd);
                else valid = (cr0 <= dd) && bit;
                S[r] = valid ? S[r] : NEGBIG; mx = fmaxf(mx, S[r]); }
            mx = fmaxf(mx, __shfl_xor(mx, 32));
            if (__any(mx > st.m[qb] + 8.0f)) {
                const float mnew = fmaxf(st.m[qb], mx); const float alpha = ex2(st.m[qb] - mnew);
                st.l[qb] *= alpha; st.m[qb] = mnew;
                row_scale(st.O[qb], alpha, area + qb * 32, c, h);
            }
            float ls = 0.f;
#pragma unroll
            for (int r = 0; r < 16; ++r) { S[r] = (S[r] > -1e29f) ? ex2(S[r] - st.m[qb]) : 0.f; ls += S[r]; }
            st.l[qb] += ls;
#pragma unroll
            for (int ks = 0; ks < 2; ++ks) { u32x4 w; w.x = pk2(S[8 * ks], S[8 * ks + 1]); w.y = pk2(S[8 * ks + 2], S[8 * ks + 3]); w.z = pk2(S[8 * ks + 4], S[8 * ks + 5]); w.w = pk2(S[8 * ks + 6], S[8 * ks + 7]);
                Pf[qb][ks] = __builtin_bit_cast(bf16x8, w); }
            __builtin_amdgcn_sched_barrier(0);
        }
#pragma unroll
        for (int ks = 0; ks < 2; ++ks)
#pragma unroll
            for (int db = 0; db < 2; ++db) {
                const s16x4 lo = *(LAS s16x4*)(Vl + (32 * db + c) * VPADB + (32 * kbk + 16 * ks + 4 * h) * 2);
                const s16x4 hi = *(LAS s16x4*)(Vl + (32 * db + c) * VPADB + (32 * kbk + 16 * ks + 8 + 4 * h) * 2);
                const bf16x8 vf = __builtin_shufflevector(lo, hi, 0, 1, 2, 3, 4, 5, 6, 7);
                st.O[0][db] = MFMA32(Pf[0][ks], vf, st.O[0][db]); st.O[1][db] = MFMA32(Pf[1][ks], vf, st.O[1][db]);
            }
        __builtin_amdgcn_sched_barrier(0);
    }
}
template <int MODE>
DI void run_pass(State& st, LAS unsigned char* lds, const bf16_t* Kg, const bf16_t* Vg, size_t pitch, int tlo, int thi, const int (&tq)[2], int W,
                 const unsigned long long (&sel)[2], int tid, int wave, int c, int h) {
    LAS float* area = (LAS float*)(lds + OFF_ALPHA) + wave * 64;
    const LAS unsigned char* qf = lds + OFF_Q + wave * 8192 + (c + 32 * h) * 16;
    KVRegs kr; kv_load(kr, Kg + (size_t)tlo * 64 * pitch, Vg + (size_t)tlo * 64 * pitch, pitch, tid);
    int bi = 0;
    for (int t = tlo; t <= thi; ++t) {
        LAS unsigned char* buf = lds + bi * BUFB;
        const int tid2 = opq(tid);
        kv_store(kr, buf, tid2);
        if (t < thi) kv_load(kr, Kg + (size_t)(t + 1) * 64 * pitch, Vg + (size_t)(t + 1) * 64 * pitch, pitch, tid2);
        __syncthreads();
        tile_compute<MODE>(st, qf, buf, t * 64, tq, W, sel, t, area, c, h);
        bi ^= 1;
    }
    __syncthreads();
}
DI void load_q(LAS unsigned char* lds, int wave, const bf16_t* Pbase  , int colbase, int c_, int h_) {
    const int c = opq(c_), h = opq(h_);
    LAS unsigned char* q = lds + OFF_Q + wave * 8192 + (c + 32 * h) * 16;
#pragma unroll
    for (int qb = 0; qb < 2; ++qb) { const bf16_t* p = Pbase + (size_t)(4 * qb + (c >> 3)) * NP + colbase + (c & 7) * 64 + 8 * h;
#pragma unroll
        for (int s = 0; s < 4; ++s) *(LAS bf16x8*)(q + (qb * 4 + s) * 1024) = *(const bf16x8*)(p + 16 * s); }
}
template <int MODE>
DI void emit_out(State& st, const float (&f)[2], LAS float* area, float* OBrow, bf16_t* Orow, int c_, int h_) {
    const int c = opq(c_), h = opq(h_);
#pragma unroll
    for (int qb = 0; qb < 2; ++qb) {
        area[qb * 32 + c] = f[qb];
        asm volatile("s_waitcnt lgkmcnt(0)" ::: "memory");
#pragma unroll
        for (int g4 = 0; g4 < 4; ++g4) { const f32x4 a = *(LAS f32x4*)(area + qb * 32 + 8 * g4 + 4 * h);
#pragma unroll
            for (int j = 0; j < 4; ++j) { const int cr = 8 * g4 + 4 * h + j; const int tokl = 4 * qb + (cr >> 3), hd = cr & 7;
#pragma unroll
                for (int db = 0; db < 2; ++db) { float v = st.O[qb][db][4 * g4 + j] * a[j];
                    float* ob = OBrow + (size_t)tokl * 1024 + hd * 64 + 32 * db + c; bf16_t* o = Orow + (size_t)tokl * DM + hd * 64 + 32 * db + c;
                    if (MODE == 0) *ob = v; else if (MODE == 1) *ob += v; else if (MODE == 2) *o = (bf16_t)f2bf(*ob + v); else *o = (bf16_t)f2bf(v); } }
            asm volatile("" ::: "memory"); }
        asm volatile("s_waitcnt lgkmcnt(0)" ::: "memory");
    }
}
}

DI void attn_unit_A(const Frame& F, const bf16_t* P, bf16_t* O, const float* sinks, int b, int kvh, int ch) {
    const int c = F.lane & 31, h = F.lane >> 5, w = F.wave;
    const int t0 = ch * 64;
    const bf16_t* Pb = P + (size_t)b * SEQ * NP;
    att::load_q(F.lds, w, Pb + (size_t)(t0 + 8 * w) * NP, C_QA + kvh * 512, c, h);
    int tq[2] = {t0 + 8 * w + (c >> 3), t0 + 8 * w + 4 + (c >> 3)};
    unsigned long long sel[2] = {0ull, 0ull};
    att::State st; att::state_init(st);
    const int tlo = ch >= 2 ? ch - 2 : 0;
    att::run_pass<0>(st, F.lds, Pb + C_KA + kvh * 64, Pb + C_VA + kvh * 64, NP, tlo, ch, tq, 128, sel, F.tid, w, c, h);
    const float sink2 = sinks[kvh * 8 + (c & 7)] * LOG2E;
    float f[2];
#pragma unroll
    for (int qb = 0; qb < 2; ++qb) { const float lt = st.l[qb] + __shfl_xor(st.l[qb], 32) + ex2(sink2 - st.m[qb]); f[qb] = 1.0f / lt; }
    LAS float* area = (LAS float*)(F.lds + att::OFF_ALPHA) + w * 64;
    att::emit_out<3>(st, f, area, nullptr, O + ((size_t)b * SEQ + t0 + 8 * w) * DM + kvh * 512, c, h);
}

DI void attn_unit_B(const Frame& F, const bf16_t* P, const bf16_t* KVC, bf16_t* O, float* OB, int b, int hkv, int ch) {
    const int c = F.lane & 31, h = F.lane >> 5, w = F.wave, lane = F.lane;
    const int t0 = ch * 64;
    const bf16_t* Pb = P + (size_t)b * SEQ * NP;
    LAS float* area = (LAS float*)(F.lds + att::OFF_ALPHA) + w * 64;
    LAS float* imp = (LAS float*)(F.lds + att::OFF_IMP);
    LAS unsigned long long* selbuf = (LAS unsigned long long*)(F.lds + att::OFF_SEL);
    LAS float* rank = (LAS float*)(F.lds + att::OFF_RANK) + w * 64;
    att::load_q(F.lds, w, Pb + (size_t)(t0 + 8 * w) * NP, C_QB + hkv * 512, c, h);
    const LAS unsigned char* qf = F.lds + att::OFF_Q + w * 8192 + (c + 32 * h) * 16;
    int tq[2] = {t0 + 8 * w + (c >> 3), t0 + 8 * w + 4 + (c >> 3)};
    unsigned long long sel[2] = {0ull, 0ull};
#define GATE(qb, j) sigmoidf_(bf2f(Pb[(size_t)tq[qb] * NP + C_GATE + hkv * 24 + (c & 7) * 3 + (j)]))
    for (int i = F.tid; i < 4096; i += NTHR) imp[i] = 0.f;
    float* OBrow = OB + ((size_t)b * SEQ + t0 + 8 * w) * 1024 + hkv * 512;
    bf16_t* Orow = O + ((size_t)b * SEQ + t0 + 8 * w) * DM + 1024 + hkv * 512;
    const bf16_t* Kc = KVC + (size_t)(0 * 2048 + (b * 2 + hkv) * 256) * 64;
    const bf16_t* Vc = KVC + (size_t)(1 * 2048 + (b * 2 + hkv) * 256) * 64;
    const int ntc = (4 * ch + 2) / 64;
    att::State st; att::state_init(st);
    int tqc[2] = {(tq[0] - 31) >> 4, (tq[1] - 31) >> 4};
    att::run_pass<1>(st, F.lds, Kc, Vc, 64, 0, ntc, tqc, 0, sel, F.tid, w, c, h);
    float ltot[2], f[2];
#pragma unroll
    for (int qb = 0; qb < 2; ++qb) { ltot[qb] = fmaxf(st.l[qb] + __shfl_xor(st.l[qb], 32), 1e-30f); f[qb] = GATE(qb, 0) / ltot[qb]; }
    att::emit_out<0>(st, f, area, OBrow, Orow, c, h);
    {
        att::KVRegs kr; att::kv_load(kr, Kc, Vc, 64, F.tid);
        int bi = 0;
        for (int t = 0; t <= ntc; ++t) {
            LAS unsigned char* buf = F.lds + bi * att::BUFB;
            att::kv_store(kr, buf, F.tid);
            if (t < ntc) att::kv_load(kr, Kc + (size_t)(t + 1) * 64 * 64, Vc + (size_t)(t + 1) * 64 * 64, 64, F.tid);
            __syncthreads();
#pragma unroll
            for (int kbk = 0; kbk < 2; ++kbk) {
#pragma unroll
                for (int qb = 0; qb < 2; ++qb) {
                    f32x16 S;
#pragma unroll
                    for (int r = 0; r < 16; ++r) S[r] = 0.f;
#pragma unroll
                    for (int s = 0; s < 4; ++s) { const bf16x8 kf = *(LAS bf16x8*)(buf + (32 * kbk + c) * att::KPADB + (16 * s + 8 * h) * 2); const bf16x8 q = *(const LAS bf16x8*)(qf + (qb * 4 + s) * 1024); S = MFMA32(kf, q, S); }
                    const float inv = 1.0f / ltot[qb];
                    const int q = 8 * w + 4 * qb + (c >> 3);
                    const int ddq = tqc[qb] - (t * 64 + 32 * kbk + 4 * h);
#pragma unroll
                    for (int g4 = 0; g4 < 4; ++g4) {
                        float s4 = 0.f, p3 = 0.f;
#pragma unroll
                        for (int j = 0; j < 4; ++j) { const float pv = (8 * g4 + j <= ddq) ? ex2(S[4 * g4 + j] - st.m[qb]) * inv : 0.f; s4 += pv; if (j == 3) p3 = pv; }
                        s4 += __shfl_xor(s4, 1); s4 += __shfl_xor(s4, 2); s4 += __shfl_xor(s4, 4);
                        p3 += __shfl_xor(p3, 1); p3 += __shfl_xor(p3, 2); p3 += __shfl_xor(p3, 4);
                        const int n0 = t * 16 + 8 * kbk + 2 * g4 + h;
                        if ((c & 7) == 0) { (void)__hip_atomic_fetch_add(&imp[q * 64 + n0], s4, __ATOMIC_RELAXED, __HIP_MEMORY_SCOPE_WORKGROUP); if (n0 + 1 < 64) (void)__hip_atomic_fetch_add(&imp[q * 64 + n0 + 1], p3, __ATOMIC_RELAXED, __HIP_MEMORY_SCOPE_WORKGROUP); }
                    }
                    __builtin_amdgcn_sched_barrier(0);
                }
            }
            bi ^= 1;
        }
        __syncthreads();
    }
    {
        const int cur = ch;
        for (int qq = 0; qq < 8; ++qq) {
            const int q = 8 * w + qq;
            float v = imp[q * 64 + lane];
            if (lane > cur) v = -1e9f; else if (lane == 0 || lane > cur - 2) v = 1e9f;
            rank[lane] = v;
            asm volatile("s_waitcnt lgkmcnt(0)" ::: "memory");
            int rk = 0;
#pragma unroll 8
            for (int mth = 0; mth < 64; ++mth) { const float o = rank[mth]; rk += (o > v || (o == v && mth < lane)) ? 1 : 0; }
            const unsigned long long msk = __ballot(rk < 16);
            if (lane == 0) selbuf[q] = msk;
            asm volatile("s_waitcnt lgkmcnt(0)" ::: "memory");
        }
        __syncthreads();
        sel[0] = selbuf[8 * w + (c >> 3)]; sel[1] = selbuf[8 * w + 4 + (c >> 3)];
    }
    att::state_init(st);
    att::run_pass<2>(st, F.lds, Pb + C_KSEL + hkv * 64, Pb + C_VSEL + hkv * 64, NP, 0, ch, tq, 0, sel, F.tid, w, c, h);
#pragma unroll
    for (int qb = 0; qb < 2; ++qb) { const float lt = fmaxf(st.l[qb] + __shfl_xor(st.l[qb], 32), 1e-30f); f[qb] = GATE(qb, 1) / lt; }
    att::emit_out<1>(st, f, area, OBrow, Orow, c, h);
    att::state_init(st);
    att::run_pass<0>(st, F.lds, Pb + C_KWIN + hkv * 64, Pb + C_VWIN + hkv * 64, NP, ch >= 8 ? ch - 8 : 0, ch, tq, 512, sel, F.tid, w, c, h);
#pragma unroll
    for (int qb = 0; qb < 2; ++qb) { const float lt = fmaxf(st.l[qb] + __shfl_xor(st.l[qb], 32), 1e-30f); f[qb] = GATE(qb, 2) / lt; }
    att::emit_out<2>(st, f, area, OBrow, Orow, c, h);
#undef GATE
    __syncthreads();
}

namespace scan {
constexpr int TC = 32;
constexpr int STEPB = 5 * 256 + 128;
constexpr int CHB = TC * STEPB;
constexpr int OFF_Y = 2 * CHB;
constexpr int YB = TC * 32 * 4;
template <int CTRL> DI float dpp_f(float x) { return __builtin_bit_cast(float, __builtin_amdgcn_update_dpp(0, __builtin_bit_cast(int, x), CTRL, 0xf, 0xf, false)); }
DI float row_sum16(float x) { x += dpp_f<0xB1>(x); x += dpp_f<0x4E>(x); x += dpp_f<0x141>(x); x += dpp_f<0x140>(x); return x; }
}
struct ScanRegs { unsigned short r[8], k[8], v[8]; float dec[8], a[8]; };
DI void scan_issue(const Frame& F, ScanRegs& R, const bf16_t* RKV, const float* DEC, const float* AA, int b, int hd, int tch) {
    const int lw = F.wave - 4, lane = F.lane;
#pragma unroll
    for (int i = 0; i < 8; ++i) {
        const size_t tok = (size_t)b * SEQ + (size_t)tch * scan::TC + lw + 4 * i;
        const size_t o = tok * DM + hd * 64 + lane;
        R.r[i] = RKV[o]; R.k[i] = RKV[(size_t)M * DM + o]; R.v[i] = RKV[(size_t)2 * M * DM + o]; R.dec[i] = DEC[o]; R.a[i] = AA[o];
    }
}
DI void scan_fill(const Frame& F, const ScanRegs& R, LAS unsigned char* buf, float kkw, float kaw, int half) {
    const int lw = F.wave - 4, lane = F.lane;
#pragma unroll
    for (int i = 0; i < 8; ++i) {
        const int s = lw + 4 * i;
        const float r = bf2f(R.r[i]), k = bf2f(R.k[i]), v = bf2f(R.v[i]), dec = R.dec[i], a = R.a[i];
        const float kx = k * kkw;
        const float nrm = sqrtf(wave_sum(kx * kx));
        const float kk = kx / fmaxf(nrm, 1e-12f);
        const float kp = k * (1.0f + (a - 1.0f) * kaw);
        LAS float* sp = (LAS float*)(buf + s * scan::STEPB);
        sp[lane] = dec; sp[64 + lane] = -kk; sp[128 + lane] = kk * a; sp[192 + lane] = kp; sp[256 + lane] = r;
        if ((lane >> 5) == half) sp[320 + (lane & 31)] = v;
    }
}
DI void scan_flush(const Frame& F, LAS unsigned char* ybuf, float* YRAW, int b, int hd, int half, int tch) {
    const int lw = F.wave - 4, lane = F.lane;
    for (int s = 2 * lw; s < scan::TC; s += 8) {
        const int ss = s + (lane >> 5);
        const size_t tok = (size_t)b * SEQ + (size_t)tch * scan::TC + ss;
        YRAW[tok * DM + hd * 64 + half * 32 + (lane & 31)] = ((LAS float*)ybuf)[ss * 32 + (lane & 31)];
    }
}
DI void phase_scan(const Frame& F, const bf16_t* RKV, const float* DEC, const float* AA, const float* kk_w, const float* ka_w, float* YRAW) {
    for (int vb = blockIdx.x; vb < 256; vb += F.G) {
        const int bh = vb >> 1, half = vb & 1, b = bh >> 5, hd = bh & 31;
        const int w = F.wave, lane = F.lane;
        const int rp = lane >> 4, cg = lane & 15;
        const int row0 = 8 * w + 2 * rp;
        float S0[4] = {0.f, 0.f, 0.f, 0.f}, S1[4] = {0.f, 0.f, 0.f, 0.f};
        constexpr int NCH = SEQ / scan::TC;
        ScanRegs SR; float kkw = 0.f, kaw = 0.f;
        if (w >= 4) { kkw = kk_w[hd * 64 + lane]; kaw = ka_w[hd * 64 + lane]; scan_issue(F, SR, RKV, DEC, AA, b, hd, 0); scan_fill(F, SR, F.lds, kkw, kaw, half); scan_issue(F, SR, RKV, DEC, AA, b, hd, 1); }
        __syncthreads();
        for (int ch = 0; ch < NCH; ++ch) {
            LAS unsigned char* buf = F.lds + (ch & 1) * scan::CHB;
            LAS float* yb = (LAS float*)(F.lds + scan::OFF_Y + (ch & 1) * scan::YB);
            if (w < 4) {
#pragma unroll 4
                for (int s = 0; s < scan::TC; ++s) {
                    const LAS float* sp = (const LAS float*)(buf + s * scan::STEPB);
                    const f32x4 w4 = *(const LAS f32x4*)(sp + 4 * cg), nk4 = *(const LAS f32x4*)(sp + 64 + 4 * cg), b4 = *(const LAS f32x4*)(sp + 128 + 4 * cg),
                                k4 = *(const LAS f32x4*)(sp + 192 + 4 * cg), r4 = *(const LAS f32x4*)(sp + 256 + 4 * cg);
                    const f32x2 v2 = *(const LAS f32x2*)(sp + 320 + row0);
                    float sa0 = (S0[0] * nk4[0] + S0[1] * nk4[1]) + (S0[2] * nk4[2] + S0[3] * nk4[3]);
                    float sa1 = (S1[0] * nk4[0] + S1[1] * nk4[1]) + (S1[2] * nk4[2] + S1[3] * nk4[3]);
                    sa0 = scan::row_sum16(sa0); sa1 = scan::row_sum16(sa1);
                    float y0 = 0.f, y1 = 0.f;
#pragma unroll
                    for (int i = 0; i < 4; ++i) {
                        S0[i] = S0[i] * w4[i] + (sa0 * b4[i] + v2[0] * k4[i]);
                        S1[i] = S1[i] * w4[i] + (sa1 * b4[i] + v2[1] * k4[i]);
                        y0 += S0[i] * r4[i]; y1 += S1[i] * r4[i];
                    }
                    y0 = scan::row_sum16(y0); y1 = scan::row_sum16(y1);
                    if (cg == 0) { yb[s * 32 + row0] = y0; yb[s * 32 + row0 + 1] = y1; }
                }
            } else {
                if (ch + 1 < NCH) scan_fill(F, SR, F.lds + ((ch + 1) & 1) * scan::CHB, kkw, kaw, half);
                if (ch + 2 < NCH) scan_issue(F, SR, RKV, DEC, AA, b, hd, ch + 2);
                if (ch > 0) scan_flush(F, F.lds + scan::OFF_Y + ((ch - 1) & 1) * scan::YB, YRAW, b, hd, half, ch - 1);
            }
            __syncthreads();
        }
        if (w >= 4) scan_flush(F, F.lds + scan::OFF_Y + ((NCH - 1) & 1) * scan::YB, YRAW, b, hd, half, NCH - 1);
        __syncthreads();
    }
}

constexpr int NPHASE = 19;
__global__ void __launch_bounds__(NTHR, 2) mk_fwd(Args args) {
    extern __shared__ __attribute__((aligned(16))) unsigned char lds_raw[];
    Frame F;
    F.lds = (LAS unsigned char*)lds_raw;
    F.tid = threadIdx.x; F.lane = F.tid & 63; F.wave = __builtin_amdgcn_readfirstlane(F.tid >> 6);
    F.G = gridDim.x; F.gw = blockIdx.x * NWAVES + F.wave; F.NGW = F.G * NWAVES; F.ws = args.ws;
    unsigned char* ws = args.ws;
    unsigned* ctl = (unsigned*)(ws + WS_CTL);
    volatile LAS unsigned* MISC = (volatile LAS unsigned*)(F.lds + MISC_OFF);
    for (int u = F.tid; u < (LDS_BYTES - LDSCTL_OFF) / 4; u += NTHR) ((LAS unsigned*)(F.lds + LDSCTL_OFF))[u] = 0u;
    __syncthreads();
    XcdBarrier bar; bar.bar = ctl + CW_BAR; bar.x = 0; bar.st = nullptr;
    if (args.use_bar) bar = xcd_barrier_post(ctl + CW_BAR, MISC + 8);
    const int lo = args.ph_lo, hi = args.ph_hi;
#ifndef PH_MASK
#define PH_MASK 0xFFFFFFFFu
#endif
#define IN(k) (((PH_MASK >> (k)) & 1u) && lo <= (k) && (k) < hi)
#define SEAM(k) do { if (IN(k) && IN((k) + 1)) xcd_barrier(bar); } while (0)
#ifndef REPEAT_MASK
#define REPEAT_MASK 0u
#endif
#define REPS(k) ((((REPEAT_MASK) >> (k)) & 1u) ? 2 : 1)
#define PH(k) if (IN(k)) for (int rep_ = 0; rep_ < REPS(k); ++rep_, (rep_ < REPS(k) ? xcd_barrier(bar) : (void)0))

    bf16_t* W_IN = (bf16_t*)(ws + WS_W_IN); bf16_t* W_OUT = (bf16_t*)(ws + WS_W_OUT); bf16_t* CMPW1 = (bf16_t*)(ws + WS_CMPW1);
    bf16_t* FFN13 = (bf16_t*)(ws + WS_FFN13); bf16_t* FFN2 = (bf16_t*)(ws + WS_FFN2); bf16_t* WRKV = (bf16_t*)(ws + WS_WRKV);
    bf16_t* LORA1 = (bf16_t*)(ws + WS_LORA1); bf16_t* LORA2 = (bf16_t*)(ws + WS_LORA2); bf16_t* WO = (bf16_t*)(ws + WS_WO);
    bf16_t* MOE13 = (bf16_t*)(ws + WS_MOE13); bf16_t* MOE2 = (bf16_t*)(ws + WS_MOE2);
    bf16_t* XN = (bf16_t*)(ws + WS_XN); bf16_t* P = (bf16_t*)(ws + WS_P); float* ROPE = (float*)(ws + WS_ROPE); float* CMPB = (float*)(ws + WS_CMPB);
    bf16_t* HID = (bf16_t*)(ws + WS_HID); bf16_t* KVC = (bf16_t*)(ws + WS_KVC); bf16_t* O = (bf16_t*)(ws + WS_O); float* H = (float*)(ws + WS_H);
    bf16_t* ACT = (bf16_t*)(ws + WS_ACT); bf16_t* XS = (bf16_t*)(ws + WS_XS); bf16_t* RKV = (bf16_t*)(ws + WS_RKV); bf16_t* L1 = (bf16_t*)(ws + WS_L1);
    float* DEC = (float*)(ws + WS_DEC); float* AA = (float*)(ws + WS_AA); bf16_t* GG = (bf16_t*)(ws + WS_GG); float* YRAW = (float*)(ws + WS_YRAW); bf16_t* YG = (bf16_t*)(ws + WS_YG);
    int* ROWTOK = (int*)(ws + WS_ROWTOK); int* TOKSLOT = (int*)(ws + WS_TOKSLOT); float* Y2 = (float*)(ws + WS_Y2);
    float* OB = YRAW;
    LAS unsigned char* ring = F.lds;

    PH(0) {
        LAS float* scr = (LAS float*)(F.lds + F.wave * 16640);
        transpose_matrix(F, args.in[I_W_IN], IN_COLS, DM, W_IN, DM, NP, ColInProj{}, scr);
        transpose_matrix(F, args.in[I_W_OUT], DM, DM, W_OUT, DM, DM, ColIdent{}, scr);
        for (int kv = 0; kv < 2; ++kv) transpose_matrix(F, args.in[I_CMP_W1] + (size_t)kv * 2048 * 256, 256, 2048, CMPW1 + (size_t)kv * 256 * 2048, 2048, 256, ColIdent{}, scr);
        transpose_matrix(F, args.in[I_FFN_W13], 2 * DFF, DM, FFN13, DM, 2 * DFF, ColSwiglu{DFF}, scr);
        transpose_matrix(F, args.in[I_FFN_W2], DM, DFF, FFN2, DFF, DM, ColIdent{}, scr);
        for (int i = 0; i < 3; ++i) transpose_matrix(F, args.in[I_W_RKV] + (size_t)i * DM * DM, DM, DM, WRKV + (size_t)i * DM * DM, DM, DM, ColIdent{}, scr);
        transpose_matrix(F, args.in[I_DECAY_W1], 96, DM, LORA1, DM, 256, ColIdent{}, scr);
        transpose_matrix(F, args.in[I_A1], 96, DM, LORA1 + (size_t)256 * DM, DM, 256, ColIdent{}, scr);
        transpose_matrix(F, args.in[I_G1], 256, DM, LORA1 + (size_t)512 * DM, DM, 256, ColIdent{}, scr);
        transpose_matrix(F, args.in[I_DECAY_W2], DM, 96, LORA2, 256, DM, ColIdent{}, scr);
        transpose_matrix(F, args.in[I_A2], DM, 96, LORA2 + (size_t)DM * 256, 256, DM, ColIdent{}, scr);
        transpose_matrix(F, args.in[I_G2], DM, 256, LORA2 + (size_t)2 * DM * 256, 256, DM, ColIdent{}, scr);
        transpose_matrix(F, args.in[I_W_O], DM, DM, WO, DM, DM, ColIdent{}, scr);
        for (int e = 0; e < NEXP; ++e) transpose_matrix(F, args.in[I_MOE_W13] + (size_t)e * DM * 2 * DFFE, 2 * DFFE, DM, MOE13 + (size_t)e * 2 * DFFE * DM, DM, 2 * DFFE, ColSwiglu{DFFE}, scr);
        for (int e = 0; e < NEXP; ++e) transpose_matrix(F, args.in[I_MOE_W2] + (size_t)e * DFFE * DM, DM, DFFE, MOE2 + (size_t)e * DM * DFFE, DFFE, DM, ColIdent{}, scr);
        for (int m = F.gw; m < M; m += F.NGW) rms_row_to_bf16(args.in[I_X] + (size_t)m * DM, args.in[I_ATTN_NORM], XN + (size_t)m * DM, F.lane);
        { const int* pos = (const int*)args.in[I_POS];
          for (int i = blockIdx.x * NTHR + F.tid; i < M * 32; i += F.G * NTHR) { const int m = i >> 5, j = i & 31;
              const float inv = powf(150000.0f, -(float)j / 32.0f); const float ang = (float)pos[m] * inv; float sn, cs; sincosf(ang, &sn, &cs);
              ROPE[(size_t)m * 64 + j] = cs; ROPE[(size_t)m * 64 + 32 + j] = sn; } }
        if (F.gw < 512) { const int kv = F.gw >> 8, j = F.gw & 255; const float* pe = args.in[I_CMP_PE] + kv * 2048; const float* w1 = args.in[I_CMP_W1] + (size_t)kv * 2048 * 256;
            float s = 0.f; for (int i = F.lane; i < 2048; i += 64) s += pe[i] * w1[(size_t)i * 256 + j];
            s = wave_sum(s); if (F.lane == 0) CMPB[kv * 256 + j] = s + args.in[I_CMP_B1][kv * 256 + j]; }
    }
    SEAM(0);
    PH(1) {
        OrderSingle S{(const char*)XN, (const char*)W_IN, DM * 2, DM * 2, 64, NP / 256, 64 * (NP / 256), F.G, (int)blockIdx.x};
        EpiInProj E{P, ROPE};
        pg8::gemm_phase<EpiInProj, OrderSingle, false>(ring, DM * 2, 128, DM * 2, DM / 64, S, E);
    }
    SEAM(1);
    PH(2) {
        OrderCmp S{(const char*)P, (const char*)CMPW1, F.G, (int)blockIdx.x};
        EpiCmp1 E{HID, CMPB};
        pg8::gemm_phase<EpiCmp1, OrderCmp, false>(ring, 16 * NP * 2, NP * 2, 2048 * 2, 32, S, E);
    }
    SEAM(2);
    PH(3) {
        for (int it = blockIdx.x * NTHR + F.tid; it < 2 * 2048 * 16; it += F.G * NTHR) {
            const int dq = it & 15, row = (it >> 4) & 2047, kv = it >> 15;
            const bf16_t* hr = HID + ((size_t)kv * 2048 + row) * 256; const float* w2 = args.in[I_CMP_W2] + (size_t)kv * 256 * 64 + dq * 4;
            f32x4 a = (f32x4){0.f, 0.f, 0.f, 0.f};
            for (int j = 0; j < 256; j += 2) { const unsigned hw = *(const unsigned*)(hr + j); a += bflo(hw) * *(const f32x4*)(w2 + (size_t)j * 64); a += bfhi(hw) * *(const f32x4*)(w2 + (size_t)(j + 1) * 64); }
            u32x2 o; o.x = pk2(a.x, a.y); o.y = pk2(a.z, a.w); *(u32x2*)(KVC + ((size_t)kv * 2048 + row) * 64 + dq * 4) = o;
        }
    }
    SEAM(3);
    PH(4) {
        for (int vb = blockIdx.x; vb < 256; vb += F.G) {
            const int bh = vb >> 5, p = vb & 31;
#pragma unroll 1
            for (int k = 0; k < 2; ++k) attn_unit_B(F, P, KVC, O, OB, bh >> 1, bh & 1, k == 0 ? 63 - p : p);
#pragma unroll 1
            for (int k = 0; k < 2; ++k) { const int id = 2 * vb + k; attn_unit_A(F, P, O, args.in[I_SINKS], id >> 7, (id >> 6) & 1, id & 63); }
        }
    }
    SEAM(4);
    PH(5) {
        OrderSingle S{(const char*)O, (const char*)W_OUT, DM * 2, DM * 2, 64, 8, 512, F.G, (int)blockIdx.x};
        EpiResF32 E{args.in[I_X], H};
        pg8::gemm_phase<EpiResF32, OrderSingle, false>(ring, DM * 2, 128, DM * 2, DM / 64, S, E);
    }
    SEAM(5);
    PH(6) { for (int m = F.gw; m < M; m += F.NGW) rms_row_to_bf16(H + (size_t)m * DM, args.in[I_FFN_NORM], XN + (size_t)m * DM, F.lane); }
    SEAM(6);
    PH(7) {
        OrderSingle S{(const char*)XN, (const char*)FFN13, DM * 2, DM * 2, 64, 2 * DFF / 256, 64 * (2 * DFF / 256), F.G, (int)blockIdx.x};
        EpiSwiglu E{ACT, DFF};
        pg8::gemm_phase<EpiSwiglu, OrderSingle, false>(ring, DM * 2, 128, DM * 2, DM / 64, S, E);
    }
    SEAM(7);
    PH(8) {
        OrderSingle S{(const char*)ACT, (const char*)FFN2, DFF * 2, DFF * 2, 64, 8, 512, F.G, (int)blockIdx.x};
        EpiResF32 E{H, H};
        pg8::gemm_phase<EpiResF32, OrderSingle, false>(ring, DFF * 2, 128, DFF * 2, DFF / 64, S, E);
    }
    SEAM(8);
    PH(9) {
        const float* g = args.in[I_ATTN_NORM] + DM; const float* mu = args.in[I_MU];
        for (int m = F.gw; m < M; m += F.NGW) {
            f32x4 v[8], pv[8]; float rs, prs = 0.f;
            rms_row_load(H + (size_t)m * DM, F.lane, v, rs);
            const bool has_prev = (m % SEQ) != 0;
            if (has_prev) rms_row_load(H + (size_t)(m - 1) * DM, F.lane, pv, prs);
#pragma unroll
            for (int j = 0; j < 8; ++j) {
                const int col = 4 * F.lane + 256 * j; const f32x4 gg = *(const f32x4*)(g + col);
                const f32x4 hn = v[j] * rs * gg; f32x4 hp = (f32x4){0.f, 0.f, 0.f, 0.f}; if (has_prev) hp = pv[j] * prs * gg;
                const f32x4 xx = hp - hn;
#pragma unroll
                for (int i = 0; i < 6; ++i) { const f32x4 mm = *(const f32x4*)(mu + (size_t)i * DM + col); const f32x4 y = hn + xx * mm;
                    u32x2 w; w.x = pk2(y.x, y.y); w.y = pk2(y.z, y.w); *(u32x2*)(XS + ((size_t)i * M + m) * DM + col) = w; }
            }
        }
    }
    SEAM(9);
    PH(10) {
        OrderMulti S{};
        for (int g = 0; g < 6; ++g) { S.A[g] = (const char*)(XS + (size_t)g * M * DM); S.Bt[g] = g < 3 ? (const char*)(WRKV + (size_t)g * DM * DM) : (const char*)(LORA1 + (size_t)(g - 3) * 256 * DM); S.nN[g] = g < 3 ? 8 : 1; }
        S.start[0] = 0; for (int g = 0; g < 6; ++g) S.start[g + 1] = S.start[g] + 64 * S.nN[g];
        S.lda = DM * 2; S.ldb = DM * 2; S.ng = 6; S.nwg = S.start[6]; S.G = F.G; S.c = (int)blockIdx.x;
        EpiRkvLora1 E{RKV, L1};
        pg8::gemm_phase<EpiRkvLora1, OrderMulti, false>(ring, DM * 2, 128, DM * 2, DM / 64, S, E);
    }
    SEAM(10);
    PH(11) {
        OrderMulti S{};
        for (int g = 0; g < 3; ++g) { S.A[g] = (const char*)(L1 + (size_t)g * M * 256); S.Bt[g] = (const char*)(LORA2 + (size_t)g * DM * 256); S.nN[g] = 8; }
        for (int g = 3; g < 6; ++g) { S.A[g] = S.A[0]; S.Bt[g] = S.Bt[0]; S.nN[g] = 0; }
        S.start[0] = 0; for (int g = 0; g < 6; ++g) S.start[g + 1] = S.start[g] + 64 * S.nN[g];
        S.lda = 256 * 2; S.ldb = 256 * 2; S.ng = 3; S.nwg = S.start[3]; S.G = F.G; S.c = (int)blockIdx.x;
        EpiLora2 E{DEC, AA, GG, args.in[I_DECAY_W0], args.in[I_A0]};
        pg8::gemm_phase<EpiLora2, OrderMulti, false>(ring, 256 * 2, 128, 256 * 2, 4, S, E);
    }
    SEAM(11);
    PH(12) phase_scan(F, RKV, DEC, AA, args.in[I_K_K], args.in[I_K_A], YRAW);
    SEAM(12);
    PH(13) {
        const float* lnw = args.in[I_LN_W]; const float* lnb = args.in[I_LN_B]; const float* rk = args.in[I_R_K]; const float* kaw = args.in[I_K_A];
        for (int m = F.gw; m < M; m += F.NGW) {
            for (int hd = 0; hd < 32; ++hd) {
                const size_t o = (size_t)m * DM + hd * 64 + F.lane; const int ch = hd * 64 + F.lane;
                const float y = YRAW[o];
                const float mean = wave_sum(y) * (1.0f / 64.0f); const float d = y - mean; const float var = wave_sum(d * d) * (1.0f / 64.0f);
                float yn = d * (1.0f / sqrtf(var + GN_EPS)) * lnw[ch] + lnb[ch];
                const float r = bf2f(RKV[o]), k = bf2f(RKV[(size_t)M * DM + o]), v = bf2f(RKV[(size_t)2 * M * DM + o]);
                const float a = AA[o]; const float kp = k * (1.0f + (a - 1.0f) * kaw[ch]);
                const float bonus = wave_sum(r * kp * rk[ch]);
                yn += bonus * v;
                YG[o] = (bf16_t)f2bf(yn * bf2f(GG[o]));
            }
        }
    }
    SEAM(13);
    PH(14) {
        OrderSingle S{(const char*)YG, (const char*)WO, DM * 2, DM * 2, 64, 8, 512, F.G, (int)blockIdx.x};
        EpiResF32 E{H, H};
        pg8::gemm_phase<EpiResF32, OrderSingle, false>(ring, DM * 2, 128, DM * 2, DM / 64, S, E);
    }
    SEAM(14);
    PH(15) {
        LAS int* t_e = (LAS int*)F.lds;
        LAS float* t_w = (LAS float*)(F.lds + 512);
        LAS int* t_p = (LAS int*)(F.lds + 1024);
        const float* g = args.in[I_FFN_NORM] + DM; const float* rw = args.in[I_ROUTER];
        for (int base = blockIdx.x * 64; base < M; base += F.G * 64) {
            for (int qq = 0; qq < 8; ++qq) {
                const int lt = F.wave * 8 + qq, m = base + lt;
                f32x4 v[8]; float rs; rms_row_load(H + (size_t)m * DM, F.lane, v, rs);
                float lg[8] = {0.f, 0.f, 0.f, 0.f, 0.f, 0.f, 0.f, 0.f};
#pragma unroll
                for (int j = 0; j < 8; ++j) {
                    const int col = 4 * F.lane + 256 * j; const f32x4 gg = *(const f32x4*)(g + col); const f32x4 y = v[j] * rs * gg;
                    u32x2 w; w.x = pk2(y.x, y.y); w.y = pk2(y.z, y.w); *(u32x2*)(XN + (size_t)m * DM + col) = w;
#pragma unroll
                    for (int e4 = 0; e4 < 4; ++e4) { const f32x4 r0 = *(const f32x4*)(rw + (size_t)(col + e4) * 8), r1 = *(const f32x4*)(rw + (size_t)(col + e4) * 8 + 4); const float yy = y[e4];
                        lg[0] += yy * r0.x; lg[1] += yy * r0.y; lg[2] += yy * r0.z; lg[3] += yy * r0.w; lg[4] += yy * r1.x; lg[5] += yy * r1.y; lg[6] += yy * r1.z; lg[7] += yy * r1.w; }
                }
#pragma unroll
                for (int e = 0; e < 8; ++e) lg[e] = wave_sum(lg[e]);
                if (F.lane == 0) {
                    int i0 = 0; float v0 = lg[0];
#pragma unroll
                    for (int e = 1; e < 8; ++e) if (lg[e] > v0) { v0 = lg[e]; i0 = e; }
                    int i1 = -1; float v1 = -3.0e38f;
#pragma unroll
                    for (int e = 0; e < 8; ++e) if (e != i0 && (i1 < 0 || lg[e] > v1)) { v1 = lg[e]; i1 = e; }
                    const float w1 = 1.0f / (1.0f + expf(v0 - v1)), w0 = 1.0f - w1;
                    t_e[lt * 2] = i0; t_e[lt * 2 + 1] = i1; t_w[lt * 2] = w0; t_w[lt * 2 + 1] = w1;
                }
            }
            __syncthreads();
            if (F.tid < 8) {
                const int e = F.tid; int n = 0;
                for (int i = 0; i < 128; ++i) if (t_e[i] == e) { t_p[i] = n; ++n; }
                const int basep = n ? (int)__hip_atomic_fetch_add(ctl + CW_MOECNT + 64 * e, (unsigned)n, RLX_AGENT) : 0;
                for (int i = 0; i < 128; ++i) if (t_e[i] == e) t_p[i] += basep;
            }
            __syncthreads();
            if (F.tid < 128) { const int lt = F.tid >> 1, k = F.tid & 1, m = base + lt; const int e = t_e[F.tid], pos = t_p[F.tid];
                ROWTOK[e * M + pos] = m; TOKSLOT[m * 4 + k * 2] = e; TOKSLOT[m * 4 + k * 2 + 1] = pos; ((float*)TOKSLOT)[(size_t)M * 4 + m * 2 + k] = t_w[F.tid]; }
            __syncthreads();
        }
    }
    SEAM(15);
#define MOE_TABLE() do { if (F.tid == 0) { int ts_ = 0; for (int e = 0; e < 8; ++e) { const int ce = (int)__hip_atomic_load(ctl + CW_MOECNT + 64 * e, RLX_AGENT); moetab[16 + e] = ce; moetab[e] = ts_; ts_ += (ce + 255) >> 8; } moetab[8] = ts_; } __syncthreads(); } while (0)
    LAS int* moetab = (LAS int*)(F.lds + MISC_OFF + 256);
    PH(16) {
        MOE_TABLE();
        OrderMoe SM; SM.tab = moetab;
        SM.A = (const char*)XN; SM.Bt = (const char*)MOE13; SM.rowtok = ROWTOK; SM.lda = DM * 2; SM.ldb = DM * 2; SM.bstride = (size_t)2 * DFFE * DM * 2; SM.nN = 2 * DFFE / 256;
        SM.nwg = moetab[8] * SM.nN; SM.G = F.G; SM.c = (int)blockIdx.x; SM.gather = true;
        EpiSwiglu E{ACT, DFFE};
        pg8::gemm_phase<EpiSwiglu, OrderMoe, true>(ring, DM * 2, 128, DM * 2, DM / 64, SM, E);
    }
    SEAM(16);
    PH(17) {
        MOE_TABLE();
        OrderMoe SM; SM.tab = moetab;
        SM.A = (const char*)ACT; SM.Bt = (const char*)MOE2; SM.rowtok = ROWTOK; SM.lda = DFFE * 2; SM.ldb = DFFE * 2; SM.bstride = (size_t)DM * DFFE * 2; SM.nN = 8;
        SM.nwg = moetab[8] * SM.nN; SM.G = F.G; SM.c = (int)blockIdx.x; SM.gather = false;
        EpiF32 E{Y2};
        pg8::gemm_phase<EpiF32, OrderMoe, false>(ring, DFFE * 2, 128, DFFE * 2, DFFE / 64, SM, E);
    }
    SEAM(17);
    PH(18) {
        MOE_TABLE();
        const float* g = args.in[I_FINAL_NORM];
        for (int m = F.gw; m < M; m += F.NGW) {
            const int e0 = TOKSLOT[m * 4], p0 = TOKSLOT[m * 4 + 1], e1 = TOKSLOT[m * 4 + 2], p1 = TOKSLOT[m * 4 + 3];
            const float w0 = ((const float*)TOKSLOT)[(size_t)M * 4 + m * 2], w1 = ((const float*)TOKSLOT)[(size_t)M * 4 + m * 2 + 1];
            const int ts0 = moetab[e0], ts1 = moetab[e1];
            const float* y0 = Y2 + ((size_t)ts0 * 256 + p0) * DM; const float* y1 = Y2 + ((size_t)ts1 * 256 + p1) * DM; const float* hr = H + (size_t)m * DM;
            f32x4 v[8]; float s = 0.f;
#pragma unroll
            for (int j = 0; j < 8; ++j) { const int col = 4 * F.lane + 256 * j; v[j] = *(const f32x4*)(hr + col) + (w0 * *(const f32x4*)(y0 + col) + w1 * *(const f32x4*)(y1 + col));
                s += (v[j].x * v[j].x + v[j].y * v[j].y) + (v[j].z * v[j].z + v[j].w * v[j].w); }
            const float rstd = 1.0f / sqrtf(wave_sum(s) * (1.0f / DM) + RMS_EPS);
#pragma unroll
            for (int j = 0; j < 8; ++j) { const int col = 4 * F.lane + 256 * j; *(f32x4*)(args.out + (size_t)m * DM + col) = v[j] * rstd * *(const f32x4*)(g + col); }
        }
    }
#undef IN
#undef SEAM
}

extern "C" void kernel_launch(void* const* d_in, const int* in_sizes, int n_in, void* d_out, int out_size, void* d_ws, size_t ws_size, hipStream_t stream) {
    static int grid = 0;
    if (grid == 0) {
        if (n_in != 33 || out_size != M * DM || ws_size < WS_END) { fprintf(stderr, "kernel_launch: unexpected shapes (n_in %d, out %d, ws %zu < %zu)\n", n_in, out_size, ws_size, (size_t)WS_END); grid = -1; return; }
        int dev = 0, cus = 0, per_cu = 0;
        if (hipGetDevice(&dev) != hipSuccess || hipDeviceGetAttribute(&cus, hipDeviceAttributeMultiprocessorCount, dev) != hipSuccess) { grid = -1; return; }
        if (hipFuncSetAttribute((const void*)mk_fwd, hipFuncAttributeMaxDynamicSharedMemorySize, LDS_BYTES) != hipSuccess) { fprintf(stderr, "kernel_launch: hipFuncSetAttribute failed\n"); grid = -1; return; }
        if (hipOccupancyMaxActiveBlocksPerMultiprocessor(&per_cu, (const void*)mk_fwd, NTHR, LDS_BYTES) != hipSuccess || per_cu < 1) fprintf(stderr, "kernel_launch: occupancy query reports %d\n", per_cu);
        (void)hipGetLastError();
        grid = cus < 256 ? cus : 256;
    }
    if (grid < 0) return;
    if (hipMemsetAsync((char*)d_ws + WS_CTL, 0, CTL_ZERO_BYTES, stream) != hipSuccess) return;
    Args a{};
    for (int i = 0; i < 33; ++i) a.in[i] = (const float*)d_in[i];
    a.out = (float*)d_out; a.ws = (unsigned char*)d_ws; a.pad = 0;
    if (MK_N_LAUNCHES == 1) {
        a.ph_lo = 0; a.ph_hi = NPHASE; a.use_bar = 1;
        hipLaunchKernelGGL(mk_fwd, dim3(grid), dim3(NTHR), LDS_BYTES, stream, a);
    } else {
        for (int p = 0; p < NPHASE; ++p) { a.ph_lo = p; a.ph_hi = p + 1; a.use_bar = 0; hipLaunchKernelGGL(mk_fwd, dim3(grid), dim3(NTHR), LDS_BYTES, stream, a); }
    }
}
```

```cpp
#include <hip/hip_runtime.h>
#include <cstdio>
#include <cstdint>

#define GAS __attribute__((address_space(1)))
#define LAS __attribute__((address_space(3)))
typedef unsigned short bf16_t;
typedef short bf16x8 __attribute__((ext_vector_type(8)));
typedef short s16x4 __attribute__((ext_vector_type(4)));
typedef float f32x4 __attribute__((ext_vector_type(4)));
typedef float f32x2 __attribute__((ext_vector_type(2)));
typedef float f32x16 __attribute__((ext_vector_type(16)));
typedef unsigned u32x4 __attribute__((ext_vector_type(4)));
typedef unsigned u32x2 __attribute__((ext_vector_type(2)));
typedef __bf16 bf16x2_t __attribute__((ext_vector_type(2)));
typedef int i32x8 __attribute__((ext_vector_type(8)));
typedef int i32x4 __attribute__((ext_vector_type(4)));
#define DI __device__ __forceinline__

#ifndef MK_N_LAUNCHES
#define MK_N_LAUNCHES 1
#endif

constexpr int BATCH = 4, SEQ = 4096, DM = 2048, M = BATCH * SEQ;
constexpr int NP = 3328;
constexpr int IN_COLS = 3120;
constexpr int C_QA = 0, C_KA = 1024, C_VA = 1152, C_QB = 1280, C_KCMP = 2304, C_VCMP = 2432, C_KSEL = 2560, C_VSEL = 2688, C_KWIN = 2816, C_VWIN = 2944, C_GATE = 3072;
constexpr int DFF = 5632, DFFE = 7168, NEXP = 8;
constexpr float RMS_EPS = 1e-5f, GN_EPS = 64e-5f;
constexpr float LOG2E = 1.4426950408889634f;
constexpr float QSCALE = 0.125f * LOG2E;
constexpr int NWAVES = 8, NTHR = 512;
constexpr int MOE_ROWS = 2 * M + NEXP * 256;

constexpr size_t MiB = 1u << 20;
constexpr size_t al(size_t x) { return (x + 0xFFFFF) & ~(size_t)0xFFFFF; }
constexpr size_t WS_CTL = 0, CTL_ZERO_BYTES = 1 * MiB;
constexpr size_t WS_W_IN = 1 * MiB;
constexpr size_t WS_W_OUT = WS_W_IN + al((size_t)NP * DM * 2);
constexpr size_t WS_CMPW1 = WS_W_OUT + al((size_t)DM * DM * 2);
constexpr size_t WS_FFN13 = WS_CMPW1 + al((size_t)2 * 256 * 2048 * 2);
constexpr size_t WS_FFN2 = WS_FFN13 + al((size_t)2 * DFF * DM * 2);
constexpr size_t WS_WRKV = WS_FFN2 + al((size_t)DM * DFF * 2);
constexpr size_t WS_LORA1 = WS_WRKV + al((size_t)3 * DM * DM * 2);
constexpr size_t WS_LORA2 = WS_LORA1 + al((size_t)3 * 256 * DM * 2);
constexpr size_t WS_WO = WS_LORA2 + al((size_t)3 * DM * 256 * 2);
constexpr size_t WS_MOE13 = WS_WO + al((size_t)DM * DM * 2);
constexpr size_t WS_MOE2 = WS_MOE13 + al((size_t)NEXP * 2 * DFFE * DM * 2);
constexpr size_t WS_XN = WS_MOE2 + al((size_t)NEXP * DM * DFFE * 2);
constexpr size_t WS_P = WS_XN + al((size_t)M * DM * 2);
constexpr size_t WS_ROPE = WS_P + al((size_t)(M + 64) * NP * 2);
constexpr size_t WS_CMPB = WS_ROPE + al((size_t)M * 64 * 4);
constexpr size_t WS_HID = WS_CMPB + MiB;
constexpr size_t WS_KVC = WS_HID + al((size_t)2 * 2048 * 256 * 2);
constexpr size_t WS_O = WS_KVC + al((size_t)2 * 2048 * 64 * 2);
constexpr size_t WS_H = WS_O + al((size_t)M * DM * 2);
constexpr size_t WS_ACT = WS_H + al((size_t)M * DM * 4);
constexpr size_t WS_XS = WS_ACT + al((size_t)MOE_ROWS * DFFE * 2);
constexpr size_t WS_RKV = WS_XS + al((size_t)6 * M * DM * 2);
constexpr size_t WS_L1 = WS_RKV + al((size_t)3 * M * DM * 2);
constexpr size_t WS_DEC = WS_L1 + al((size_t)3 * M * 256 * 2);
constexpr size_t WS_AA = WS_DEC + al((size_t)M * DM * 4);
constexpr size_t WS_GG = WS_AA + al((size_t)M * DM * 4);
constexpr size_t WS_YRAW = WS_GG + al((size_t)M * DM * 2);
constexpr size_t WS_YG = WS_YRAW + al((size_t)M * DM * 4);
constexpr size_t WS_ROWTOK = WS_YG + al((size_t)M * DM * 2);
constexpr size_t WS_TOKSLOT = WS_ROWTOK + al((size_t)NEXP * M * 4);
constexpr size_t WS_Y2 = WS_TOKSLOT + al((size_t)M * 16);
constexpr size_t WS_END = WS_Y2 + al((size_t)MOE_ROWS * DM * 4);
constexpr int CW_BAR = 0;
constexpr int CW_MOECNT = 4096;

constexpr int RING_BYTES = 131072, LDSCTL_OFF = 135168, MISC_OFF = LDSCTL_OFF + 320, LDS_BYTES = 147456;

#define RLX_AGENT __ATOMIC_RELAXED, __HIP_MEMORY_SCOPE_AGENT
DI unsigned f2bf(float f) { unsigned u = __builtin_bit_cast(unsigned, f); return (u + 0x7fffu + ((u >> 16) & 1u)) >> 16; }
DI unsigned pk2(float lo, float hi) { f32x2 v = {lo, hi}; bf16x2_t b = __builtin_convertvector(v, bf16x2_t); return __builtin_bit_cast(unsigned, b); }
DI unsigned pk4_fp8(float a, float b, float c, float d) { int p = __builtin_amdgcn_cvt_pk_fp8_f32(a, b, 0, false); p = __builtin_amdgcn_cvt_pk_fp8_f32(c, d, p, true); return (unsigned)p; }
DI float bf2f(unsigned short b) { return __builtin_bit_cast(float, ((unsigned)b) << 16); }
DI float bflo(unsigned w) { return __builtin_bit_cast(float, w << 16); }
DI float bfhi(unsigned w) { return __builtin_bit_cast(float, w & 0xffff0000u); }
DI float wave_sum(float v) {
#pragma unroll
    for (int o = 1; o < 64; o <<= 1) v += __shfl_xor(v, o);
    return v;
}
DI int opq(int x) { asm volatile("" : "+v"(x)); return x; }
DI const float* opqp(const float* p) { asm volatile("" : "+s"(p)); return p; }
DI float ex2(float x) { return __builtin_amdgcn_exp2f(x); }
DI float sigmoidf_(float x) { return __builtin_amdgcn_rcpf(1.0f + __expf(-x)); }
DI float siluf_(float x) { return x * __builtin_amdgcn_rcpf(1.0f + __expf(-x)); }
DI float tanhf_(float x) { return 1.0f - 2.0f * __builtin_amdgcn_rcpf(__expf(2.0f * x) + 1.0f); }

#define XB_TMO      128
#define XB_XCNT(j)  (256  + 64 * (j))
#define XB_XSUB(j)  (1280 + 64 * (j))
#define XB_XGEN(j)  (2304 + 64 * (j))
#define XB_TOP      3328
#define XB_TOPGEN   3392
#define XCD_BAR_WORDS 3456
#define XB_SPIN_CAP (1u << 22)
DI unsigned xb_ld(unsigned* p)              { return __hip_atomic_load(p, __ATOMIC_RELAXED, __HIP_MEMORY_SCOPE_AGENT); }
DI unsigned xb_add(unsigned* p, unsigned v) { return __hip_atomic_fetch_add(p, v, __ATOMIC_RELAXED, __HIP_MEMORY_SCOPE_AGENT); }
DI unsigned xb_xcc_id() { return (unsigned)__builtin_amdgcn_s_getreg((3 << 11) | 20) & 0xFu; }
#define XB_SPIN(cond, bar) do { unsigned _sp = 0; while (cond) { __builtin_amdgcn_s_sleep(1); \
    if ((++_sp & 255u) == 0u) { if (xb_ld(&(bar)[XB_TMO])) break; if (_sp > XB_SPIN_CAP) { atomicAdd(&(bar)[XB_TMO], 1u); break; } } } } while (0)
struct XcdBarrier { unsigned* bar; unsigned x; volatile LAS unsigned* st; };
DI XcdBarrier xcd_barrier_post(unsigned* bar, volatile LAS unsigned* st) {
    XcdBarrier b; b.bar = bar; b.x = xb_xcc_id(); b.st = st;
    if (threadIdx.x == 0) (void)xb_add(&bar[XB_XCNT(b.x)], 1u);
    return b;
}
DI void xcd_barrier_complete(unsigned* bar, unsigned x, unsigned& nloc, unsigned& nx) {
    const unsigned G = gridDim.x * gridDim.y * gridDim.z;
    unsigned sum, cnt, mine, sp = 0u;
    for (;;) {
        sum = 0u; cnt = 0u; mine = 0u;
#pragma unroll
        for (unsigned j = 0; j < 16; ++j) { const unsigned c = xb_ld(&bar[XB_XCNT(j)]); sum += c; cnt += (c > 0u) ? 1u : 0u; mine = (j == x) ? c : mine; }
        if (sum == G) break;
        __builtin_amdgcn_s_sleep(1);
        if ((++sp & 255u) == 0u) { if (xb_ld(&bar[XB_TMO])) break; if (sp > XB_SPIN_CAP) { atomicAdd(&bar[XB_TMO], 1u); break; } }
    }
    nloc = mine > 0u ? mine : 1u; nx = cnt > 0u ? cnt : 1u;
}
DI void xcd_barrier(const XcdBarrier& b) {
    asm volatile("s_waitcnt vmcnt(0)" ::: "memory");
    __syncthreads();
    if (threadIdx.x == 0) {
        unsigned* bar = b.bar;
        __builtin_amdgcn_s_waitcnt(0);
        unsigned nloc = b.st[0], nx = b.st[1];
        if (nloc == 0u) { xcd_barrier_complete(bar, b.x, nloc, nx); b.st[0] = nloc; b.st[1] = nx; }
        const unsigned old = xb_add(&bar[XB_XSUB(b.x)], 1u);
        const unsigned gen = old / nloc;
        if (old + 1u == (gen + 1u) * nloc) {
            __builtin_amdgcn_fence(__ATOMIC_RELEASE, "agent");
            asm volatile("s_waitcnt vmcnt(0)" ::: "memory");
            const unsigned og = xb_add(&bar[XB_TOP], 1u);
            const unsigned tg = og / nx;
            if (og + 1u == (tg + 1u) * nx) xb_add(&bar[XB_TOPGEN], 1u);
            else XB_SPIN(xb_ld(&bar[XB_TOPGEN]) == tg, bar);
            __builtin_amdgcn_fence(__ATOMIC_ACQUIRE, "agent");
            xb_add(&bar[XB_XGEN(b.x)], 1u);
            asm volatile("s_waitcnt vmcnt(0)" ::: "memory");
        } else {
            XB_SPIN(xb_ld(&bar[XB_XGEN(b.x)]) == gen, bar);
            __builtin_amdgcn_fence(__ATOMIC_ACQUIRE, "agent");
            asm volatile("s_waitcnt vmcnt(0)" ::: "memory");
        }
    }
    __syncthreads();
}

namespace pg8 {
constexpr int BM = 256, BK = 64, HALF = 128, HTB = HALF * BK * 2, STAGE_BYTES = 8 * HTB, NXCD = 8, WGM = 4;
__host__ __device__ __forceinline__ int lds_byte(int r, int c) { const int st = (r >> 4) * 2 + (c >> 5), rr = r & 15, cc = c & 31, ob = rr * 64 + cc * 2; return st * 1024 + (ob ^ (((ob >> 9) & 1) << 5)); }
__host__ __device__ __forceinline__ void stage_rc(int b, int& R, int& C) { const int st = b / 1024, sb = b % 1024, swz = sb ^ (((sb >> 9) & 1) << 5); R = (st >> 1) * 16 + swz / 64; C = (st & 1) * 32 + (swz % 64) / 2; }
__host__ __device__ __forceinline__ int perm32(int rho) { const int n = rho >> 4, i = rho & 15; return 8 * (i >> 2) + 4 * n + (i & 3); }

struct Unit { const char* a; const char* b; int pm, pn, g; unsigned ka; };

DI int xcd_remap(int L, int nwg) { const int q = nwg / NXCD, r = nwg % NXCD, xcd = L % NXCD, off = L / NXCD; return (xcd < r ? xcd * (q + 1) : r * (q + 1) + (xcd - r) * q) + off; }
DI void tile_map(int idx, int nM, int nN, int& pm, int& pn) { const int nig = WGM * nN, gid = idx / nig, fm = gid * WGM, gsz = (nM - fm) < WGM ? (nM - fm) : WGM; pm = fm + ((idx % nig) % gsz); pn = (idx % nig) / gsz; }

template <class Epi, class Sched, bool GATHER, bool FP8 = false>
DI void gemm_phase(LAS unsigned char* lds, const unsigned lda, const unsigned ka, const unsigned ldb, const int nt, const Sched& S, const Epi& E, const int scaleA = 0x7f7f7f7f, const int scaleB = 0x7f7f7f7f) {
    const int tid = threadIdx.x, wid = __builtin_amdgcn_readfirstlane(tid >> 6), lane = tid & 63, wr = wid >> 2, wc = wid & 3, fr = lane & 15, fq = lane >> 4;
    int Rr[2], Cc[2];
    unsigned vB[2], vA[2][2], vN[2][2];
#pragma unroll
    for (int i = 0; i < 2; ++i) { stage_rc(tid * 16 + i * 8192, Rr[i], Cc[i]); const int Rb = (Rr[i] & ~31) + perm32(Rr[i] & 31); vB[i] = (unsigned)Rb * ldb + (unsigned)Cc[i] * 2u; }
    const size_t kb = (size_t)(BK * 2);
    const size_t hB = (size_t)HALF * ldb;
    const unsigned ldsw = (unsigned)wid * 1024u;
    const int aoff = lds_byte(wr * 64 + fr, fq * 8), boff = lds_byte(wc * 32 + fr, fq * 8);
#define PG8_SA(b, h) (((b) * 2 + (h)) * HTB)
#define PG8_SB(b, h) ((4 + (b) * 2 + (h)) * HTB)
#define PG8_STAGE(bufoff, gbase, v0, v1) do { \
        __builtin_amdgcn_global_load_lds((const unsigned*)((const char*)(gbase) + (v0)), (LAS unsigned*)(lds + (bufoff) + ldsw), 16, 0, 0); \
        __builtin_amdgcn_global_load_lds((const unsigned*)((const char*)(gbase) + (v1)), (LAS unsigned*)(lds + (bufoff) + ldsw + 8192), 16, 0, 0); } while (0)
#define PG8_LDA(dst, b, h) do { _Pragma("unroll") for (int m = 0; m < 4; ++m) { const i32x4 f0_ = *(const LAS i32x4*)(lds + PG8_SA(b, h) + aoff + m * 2048), f1_ = *(const LAS i32x4*)(lds + PG8_SA(b, h) + aoff + m * 2048 + 1024); \
        dst[m] = __builtin_shufflevector(f0_, f1_, 0, 1, 2, 3, 4, 5, 6, 7); } } while (0)
#define PG8_LDB(dst, b, h) do { _Pragma("unroll") for (int n = 0; n < 2; ++n) { const i32x4 f0_ = *(const LAS i32x4*)(lds + PG8_SB(b, h) + boff + n * 2048), f1_ = *(const LAS i32x4*)(lds + PG8_SB(b, h) + boff + n * 2048 + 1024); \
        dst[n] = __builtin_shufflevector(f0_, f1_, 0, 1, 2, 3, 4, 5, 6, 7); } } while (0)
#define PG8_MMA(ai, bj, At, Bt) do { __builtin_amdgcn_s_setprio(1); \
        if constexpr (FP8) { _Pragma("unroll") for (int m = 0; m < 4; ++m) _Pragma("unroll") for (int n = 0; n < 2; ++n) \
            asm volatile("v_mfma_scale_f32_16x16x128_f8f6f4 %0, %1, %2, %0, %3, %4 op_sel_hi:[0,0,0]" : "+v"(acc[ai][bj][m][n]) : "v"(Bt[n]), "v"(At[m]), "v"(scaleB), "v"(scaleA)); } \
        else { _Pragma("unroll") for (int m = 0; m < 4; ++m) _Pragma("unroll") for (int n = 0; n < 2; ++n) { \
            acc[ai][bj][m][n] = __builtin_amdgcn_mfma_f32_16x16x32_bf16(__builtin_bit_cast(bf16x8, __builtin_shufflevector(Bt[n], Bt[n], 0, 1, 2, 3)), __builtin_bit_cast(bf16x8, __builtin_shufflevector(At[m], At[m], 0, 1, 2, 3)), acc[ai][bj][m][n], 0, 0, 0); \
            acc[ai][bj][m][n] = __builtin_amdgcn_mfma_f32_16x16x32_bf16(__builtin_bit_cast(bf16x8, __builtin_shufflevector(Bt[n], Bt[n], 4, 5, 6, 7)), __builtin_bit_cast(bf16x8, __builtin_shufflevector(At[m], At[m], 4, 5, 6, 7)), acc[ai][bj][m][n], 0, 0, 0); } } __builtin_amdgcn_s_setprio(0); } while (0)
#define PG8_WAIT_V(n) asm volatile("s_waitcnt vmcnt(" #n ")" ::: "memory")
#define PG8_WAIT_L(n) asm volatile("s_waitcnt lgkmcnt(" #n ")" ::: "memory")
#define PG8_BAR __builtin_amdgcn_s_barrier()
#define PG8_SCHED __builtin_amdgcn_sched_barrier(0)
    Unit cur, nxt; int ui = 0;
    if (!S.next(0, cur)) return;
#pragma unroll
    for (int h = 0; h < 2; ++h)
#pragma unroll
        for (int i = 0; i < 2; ++i) {
            if constexpr (GATHER) vA[h][i] = S.rowoff(cur, h * HALF + Rr[i]) + (unsigned)Cc[i] * 2u;
            else vA[h][i] = (unsigned)(h * HALF + Rr[i]) * lda + (unsigned)Cc[i] * 2u;
            vN[h][i] = vA[h][i];
        }
    f32x4 acc[2][2][4][2];
#pragma unroll
    for (int a = 0; a < 2; ++a)
#pragma unroll
        for (int b = 0; b < 2; ++b)
#pragma unroll
            for (int m = 0; m < 4; ++m)
#pragma unroll
                for (int n = 0; n < 2; ++n) acc[a][b][m][n] = (f32x4){0.f, 0.f, 0.f, 0.f};
    i32x8 At[4], B0[2], B1[2];
    const char* cA = cur.a; const char* cB = cur.b;
    PG8_STAGE(PG8_SB(0, 0), cB, vB[0], vB[1]); PG8_STAGE(PG8_SB(0, 1), cB + hB, vB[0], vB[1]); PG8_STAGE(PG8_SA(0, 0), cA, vA[0][0], vA[0][1]); PG8_STAGE(PG8_SA(0, 1), cA, vA[1][0], vA[1][1]);
    if (wr == 1) PG8_BAR;
    PG8_WAIT_V(2); PG8_BAR;
    PG8_STAGE(PG8_SB(1, 0), cB + kb, vB[0], vB[1]); PG8_STAGE(PG8_SA(1, 0), cA + cur.ka, vA[0][0], vA[0][1]); PG8_STAGE(PG8_SB(1, 1), cB + hB + kb, vB[0], vB[1]);
    PG8_WAIT_V(6); PG8_BAR;
    for (;;) {
        const bool has_next = S.next(ui + 1, nxt);
        const char* nA = has_next ? nxt.a : cA; const char* nB = has_next ? nxt.b : cB; const unsigned nka = has_next ? nxt.ka : cur.ka;
        if constexpr (GATHER) {
            if (has_next) {
#pragma unroll
                for (int h = 0; h < 2; ++h)
#pragma unroll
                    for (int i = 0; i < 2; ++i) vN[h][i] = S.rowoff(nxt, h * HALF + Rr[i]) + (unsigned)Cc[i] * 2u;
            }
        }
        for (int t = 0; t < nt; t += 2) {
            const bool last = (t == nt - 2);
            const char* a1 = cA + (size_t)(t + 1) * cur.ka;
            const char* a2 = last ? nA : cA + (size_t)(t + 2) * cur.ka; const char* b2 = last ? nB : cB + (size_t)(t + 2) * kb;
            const char* a3 = a2 + (last ? nka : cur.ka); const char* b3 = b2 + kb;
            unsigned x00 = vA[0][0], x01 = vA[0][1], x10 = vA[1][0], x11 = vA[1][1];
            if constexpr (GATHER) { if (last) { x00 = vN[0][0]; x01 = vN[0][1]; x10 = vN[1][0]; x11 = vN[1][1]; } }
            PG8_LDB(B0, 0, 0); PG8_LDB(B1, 0, 1); PG8_SCHED; PG8_LDA(At, 0, 0); PG8_STAGE(PG8_SA(1, 1), a1, vA[1][0], vA[1][1]);
            PG8_WAIT_V(8); PG8_WAIT_L(0); PG8_BAR; PG8_MMA(0, 0, At, B0); PG8_MMA(0, 1, At, B1); PG8_BAR; PG8_SCHED;
            PG8_LDA(At, 0, 1); PG8_STAGE(PG8_SB(0, 0), b2, vB[0], vB[1]); PG8_STAGE(PG8_SB(0, 1), b2 + hB, vB[0], vB[1]); PG8_STAGE(PG8_SA(0, 0), a2, x00, x01);
            PG8_WAIT_V(8); PG8_WAIT_L(0); PG8_BAR; PG8_MMA(1, 0, At, B0); PG8_MMA(1, 1, At, B1); PG8_BAR; PG8_SCHED;
            PG8_LDB(B0, 1, 0); PG8_LDB(B1, 1, 1); PG8_SCHED; PG8_LDA(At, 1, 0); PG8_STAGE(PG8_SA(0, 1), a2, x10, x11);
            PG8_WAIT_V(8); PG8_WAIT_L(0); PG8_BAR; PG8_MMA(0, 0, At, B0); PG8_MMA(0, 1, At, B1); PG8_BAR; PG8_SCHED;
            PG8_LDA(At, 1, 1); PG8_STAGE(PG8_SB(1, 0), b3, vB[0], vB[1]); PG8_STAGE(PG8_SB(1, 1), b3 + hB, vB[0], vB[1]); PG8_STAGE(PG8_SA(1, 0), a3, x00, x01);
            PG8_WAIT_V(8); PG8_WAIT_L(0); PG8_BAR; PG8_MMA(1, 0, At, B0); PG8_MMA(1, 1, At, B1); PG8_BAR; PG8_SCHED;
        }
        if (wr == 0) PG8_BAR;
        if constexpr (FP8) asm volatile("s_nop 15\n\ts_nop 15" ::: "memory");
        E(acc, cur, wr, wc, fr, fq);
        if (!has_next) break;
#pragma unroll
        for (int a = 0; a < 2; ++a)
#pragma unroll
            for (int b = 0; b < 2; ++b)
#pragma unroll
                for (int m = 0; m < 4; ++m)
#pragma unroll
                    for (int n = 0; n < 2; ++n) acc[a][b][m][n] = (f32x4){0.f, 0.f, 0.f, 0.f};
        cur = nxt; cA = nA; cB = nB; ++ui;
        if constexpr (GATHER) {
#pragma unroll
            for (int h = 0; h < 2; ++h)
#pragma unroll
                for (int i = 0; i < 2; ++i) vA[h][i] = vN[h][i];
        }
        if (wr == 1) PG8_BAR;
    }
    PG8_WAIT_V(0);
    PG8_BAR;
#undef PG8_SA
#undef PG8_SB
#undef PG8_STAGE
#undef PG8_LDA
#undef PG8_LDB
#undef PG8_MMA
#undef PG8_WAIT_V
#undef PG8_WAIT_L
#undef PG8_BAR
#undef PG8_SCHED
}
}

typedef f32x4 AccT[2][2][4][2];
DI void st_bf16x8(bf16_t* p, f32x4 v0, f32x4 v1) { u32x4 w; w.x = pk2(v0[0], v0[1]); w.y = pk2(v0[2], v0[3]); w.z = pk2(v1[0], v1[1]); w.w = pk2(v1[2], v1[3]); *(u32x4*)p = w; }

struct OrderSingle {
    const char* A; const char* Bt; unsigned lda, ldb; int nM, nN, nwg, G, c;
    DI bool next(int i, pg8::Unit& u) const {
        const long L = (long)i * G + c; if (L >= nwg) return false;
        const int w = pg8::xcd_remap((int)L, nwg); int pm, pn; pg8::tile_map(w, nM, nN, pm, pn);
        u.pm = pm; u.pn = pn; u.g = 0; u.ka = 128u; u.a = A + (size_t)pm * 256 * lda; u.b = Bt + (size_t)pn * 256 * ldb; return true;
    }
    DI unsigned rowoff(const pg8::Unit&, int) const { return 0u; }
};
struct OrderMulti {
    const char* A[6]; const char* Bt[6]; int nN[6]; int start[7]; unsigned lda, ldb; int ng, nwg, G, c;
    DI bool next(int i, pg8::Unit& u) const {
        const long L = (long)i * G + c; if (L >= nwg) return false;
        const int w = pg8::xcd_remap((int)L, nwg);
        int g = 0; const char* a = A[0]; const char* b = Bt[0]; int nn = nN[0], st = start[0];
#pragma unroll
        for (int k = 1; k < 6; ++k) if (k < ng && w >= start[k]) { g = k; a = A[k]; b = Bt[k]; nn = nN[k]; st = start[k]; }
        int pm, pn; pg8::tile_map(w - st, 64, nn, pm, pn);
        u.pm = pm; u.pn = pn; u.g = g; u.ka = 128u; u.a = a + (size_t)pm * 256 * lda; u.b = b + (size_t)pn * 256 * ldb; return true;
    }
    DI unsigned rowoff(const pg8::Unit&, int) const { return 0u; }
};
struct OrderCmp {
    const char* P; const char* Bt; const char* XNp; const char* Wg; int G, c;
    DI bool next(int i, pg8::Unit& u) const {
        const int L = i * G + c; if (L >= 80) return false;
        if (L < 16) { const int kv = L >> 3, bh = L & 7, b = bh >> 1, h = bh & 1;
            u.pm = bh; u.pn = 0; u.g = kv; u.ka = (unsigned)(NP * 2);
            u.a = P + ((size_t)b * SEQ * NP + (size_t)(C_KCMP + kv * 128 + h * 64)) * 2;
            u.b = Bt + (size_t)kv * 256 * 2048 * 2; }
        else { const int pm = L - 16; u.pm = pm; u.pn = 12; u.g = 2; u.ka = 128u; u.a = XNp + (size_t)pm * 256 * DM * 2; u.b = Wg; }
        return true;
    }
    DI unsigned rowoff(const pg8::Unit& u, int row) const { return (unsigned)row * (u.g == 2 ? (unsigned)(DM * 2) : (unsigned)(16 * NP * 2)); }
};
struct OrderMoe {
    const char* A; const char* Bt; const int* rowtok; const LAS int* tab; unsigned lda, ldb; size_t bstride; int nN, nwg, G, c; bool gather, xcdrows;
    DI bool next(int i, pg8::Unit& u) const {
        int tau, pn;
        if (xcdrows) {
            const int x = c & 7, q = c >> 3, rpr = (G >> 3) >> 1;
            tau = i * (G >> 3) + x * ((G >> 3) >> 3) + (q >> 3); pn = q & 7; (void)rpr;
            if (tau >= nwg / nN) return false;
        } else {
            const long L = (long)i * G + c; if (L >= nwg) return false;
            const int w = (int)L; tau = w / nN; pn = w % nN;
        }
        int e = 0;
#pragma unroll
        for (int k = 1; k < 8; ++k) if (tau >= tab[k]) e = k;
        u.pm = tau; u.pn = pn; u.g = e; u.ka = 128u;
        u.a = gather ? A : A + (size_t)tau * 256 * lda;
        u.b = Bt + (size_t)e * bstride + (size_t)pn * 256 * ldb; return true;
    }
    DI unsigned rowoff(const pg8::Unit& u, int row) const {
        const int e = u.g; const int ce = tab[16 + e], ts = tab[e];
        const int pos = (u.pm - ts) * 256 + row;
        const int tok = pos < ce ? rowtok[e * M + pos] : 0;
        return (unsigned)tok * lda;
    }
};

struct EpiInProj {
    bf16_t* P; const float* rope;
    DI void operator()(const AccT& acc, const pg8::Unit& u, int wr, int wc, int fr, int fq) const {
        const int row0 = u.pm * 256 + wr * 64 + fr;
#pragma unroll
        for (int bj = 0; bj < 2; ++bj) {
            const int cb = u.pn * 256 + bj * 128;
            const int col0 = cb + wc * 32 + 8 * fq;
            const bool do_rope = cb < C_VA;
            const float sc = (cb < C_KA || (cb >= C_QB && cb < C_KCMP)) ? QSCALE : 1.0f;
            const int uidx = 4 * (wc & 1) + fq;
#pragma unroll
            for (int ai = 0; ai < 2; ++ai)
#pragma unroll
                for (int m = 0; m < 4; ++m) {
                    const int row = row0 + ai * 128 + m * 16;
                    f32x4 v0 = acc[ai][bj][m][0], v1 = acc[ai][bj][m][1];
                    if (do_rope) {
                        const f32x4 cs = *(const f32x4*)(rope + (size_t)row * 64 + 4 * uidx), sn = *(const f32x4*)(rope + (size_t)row * 64 + 32 + 4 * uidx);
                        const f32x4 o0 = v0 * cs - v1 * sn, o1 = v1 * cs + v0 * sn; v0 = o0; v1 = o1;
                    }
                    v0 = v0 * sc; v1 = v1 * sc;
                    st_bf16x8(P + (size_t)row * NP + col0, v0, v1);
                }
        }
    }
};
struct EpiCmp1 {
    bf16_t* HID; const float* bias; bf16_t* P;
    DI void operator()(const AccT& acc, const pg8::Unit& u, int wr, int wc, int fr, int fq) const {
        const int row0 = wr * 64 + fr;
        if (u.g == 2) {
#pragma unroll
            for (int bj = 0; bj < 2; ++bj)
#pragma unroll
                for (int ai = 0; ai < 2; ++ai)
#pragma unroll
                    for (int m = 0; m < 4; ++m) st_bf16x8(P + (size_t)(u.pm * 256 + row0 + ai * 128 + m * 16) * NP + C_GATE + bj * 128 + wc * 32 + 8 * fq, acc[ai][bj][m][0], acc[ai][bj][m][1]);
            return;
        }
#pragma unroll
        for (int bj = 0; bj < 2; ++bj) {
            const int col0 = bj * 128 + wc * 32 + 8 * fq;
            const f32x4 b0 = *(const f32x4*)(bias + u.g * 256 + col0), b1 = *(const f32x4*)(bias + u.g * 256 + col0 + 4);
#pragma unroll
            for (int ai = 0; ai < 2; ++ai)
#pragma unroll
                for (int m = 0; m < 4; ++m) {
                    const int row = row0 + ai * 128 + m * 16;
                    f32x4 v0 = acc[ai][bj][m][0] + b0, v1 = acc[ai][bj][m][1] + b1;
#pragma unroll
                    for (int j = 0; j < 4; ++j) { v0[j] = siluf_(v0[j]); v1[j] = siluf_(v1[j]); }
                    st_bf16x8(HID + ((size_t)(u.g * 2048 + u.pm * 256 + row)) * 256 + col0, v0, v1);
                }
        }
    }
};
struct EpiResF32 {
    const float* res; float* out;
    DI void operator()(const AccT& acc, const pg8::Unit& u, int wr, int wc, int fr, int fq) const {
        const int row0 = u.pm * 256 + wr * 64 + fr;
#pragma unroll
        for (int ai = 0; ai < 2; ++ai)
#pragma unroll
            for (int m = 0; m < 4; ++m) {
                const size_t ro = (size_t)(row0 + ai * 128 + m * 16) * DM;
#pragma unroll
                for (int bj = 0; bj < 2; ++bj) {
                    const int col0 = u.pn * 256 + bj * 128 + wc * 32 + 8 * fq;
                    const f32x4 r0 = *(const f32x4*)(res + ro + col0), r1 = *(const f32x4*)(res + ro + col0 + 4);
                    *(f32x4*)(out + ro + col0) = r0 + acc[ai][bj][m][0]; *(f32x4*)(out + ro + col0 + 4) = r1 + acc[ai][bj][m][1];
                }
            }
    }
};
struct EpiSwiglu {
    bf16_t* ACT; int ldc;
    DI void operator()(const AccT& acc, const pg8::Unit& u, int wr, int wc, int fr, int fq) const {
        const int row0 = u.pm * 256 + wr * 64 + fr; const int col0 = u.pn * 128 + wc * 32 + 8 * fq;
#pragma unroll
        for (int ai = 0; ai < 2; ++ai)
#pragma unroll
            for (int m = 0; m < 4; ++m) {
                f32x4 v0, v1;
#pragma unroll
                for (int j = 0; j < 4; ++j) { v0[j] = siluf_(acc[ai][0][m][0][j]) * acc[ai][1][m][0][j]; v1[j] = siluf_(acc[ai][0][m][1][j]) * acc[ai][1][m][1][j]; }
                st_bf16x8(ACT + (size_t)(row0 + ai * 128 + m * 16) * ldc + col0, v0, v1);
            }
    }
};
struct EpiSwiglu8 {
    unsigned char* ACT; int ldc;
    DI void operator()(const AccT& acc, const pg8::Unit& u, int wr, int wc, int fr, int fq) const {
        const int row0 = u.pm * 256 + wr * 64 + fr; const int col0 = u.pn * 128 + wc * 32 + 8 * fq;
#pragma unroll
        for (int ai = 0; ai < 2; ++ai)
#pragma unroll
            for (int m = 0; m < 4; ++m) {
                f32x4 v0, v1;
#pragma unroll
                for (int j = 0; j < 4; ++j) { v0[j] = siluf_(acc[ai][0][m][0][j]) * acc[ai][1][m][0][j]; v1[j] = siluf_(acc[ai][0][m][1][j]) * acc[ai][1][m][1][j]; }
                u32x2 o; o.x = pk4_fp8(v0[0], v0[1], v0[2], v0[3]); o.y = pk4_fp8(v1[0], v1[1], v1[2], v1[3]);
                *(u32x2*)(ACT + (size_t)(row0 + ai * 128 + m * 16) * ldc + col0) = o;
            }
    }
};
struct EpiRkvLora1 {
    bf16_t* RKV; bf16_t* L1;
    DI void operator()(const AccT& acc, const pg8::Unit& u, int wr, int wc, int fr, int fq) const {
        const int row0 = u.pm * 256 + wr * 64 + fr; const int g = u.g;
        bf16_t* base = g < 3 ? RKV + (size_t)g * M * DM : L1 + (size_t)(g - 3) * M * 256;
        const int ldc = g < 3 ? DM : 256;
#pragma unroll
        for (int ai = 0; ai < 2; ++ai)
#pragma unroll
            for (int m = 0; m < 4; ++m)
#pragma unroll
                for (int bj = 0; bj < 2; ++bj) {
                    const int col0 = u.pn * 256 + bj * 128 + wc * 32 + 8 * fq;
                    f32x4 v0 = acc[ai][bj][m][0], v1 = acc[ai][bj][m][1];
                    if (g == 3) {
#pragma unroll
                        for (int j = 0; j < 4; ++j) { v0[j] = tanhf_(v0[j]); v1[j] = tanhf_(v1[j]); }
                    } else if (g == 5) {
#pragma unroll
                        for (int j = 0; j < 4; ++j) { v0[j] = sigmoidf_(v0[j]); v1[j] = sigmoidf_(v1[j]); }
                    }
                    st_bf16x8(base + (size_t)(row0 + ai * 128 + m * 16) * ldc + col0, v0, v1);
                }
    }
};
struct EpiLora2 {
    float* DEC; bf16_t* AA; bf16_t* GG; const float* w0; const float* a0;
    DI void operator()(const AccT& acc, const pg8::Unit& u, int wr, int wc, int fr_, int fq_) const {
        const int fr = opq(fr_), fq = opq(fq_);
        const int row0 = u.pm * 256 + wr * 64 + fr; const int g = u.g;
        const float* cvec = g == 0 ? w0 : a0;
#pragma unroll
        for (int bj = 0; bj < 2; ++bj) {
            const int col0 = u.pn * 256 + bj * 128 + wc * 32 + 8 * fq;
            f32x4 c0 = (f32x4){0.f, 0.f, 0.f, 0.f}, c1 = c0;
            if (g < 2) { c0 = *(const f32x4*)(cvec + col0); c1 = *(const f32x4*)(cvec + col0 + 4); }
#pragma unroll
            for (int ai = 0; ai < 2; ++ai)
#pragma unroll
                for (int m = 0; m < 4; ++m) {
                    const size_t ro = (size_t)(row0 + ai * 128 + m * 16) * DM + col0;
                    f32x4 v0 = acc[ai][bj][m][0] + c0, v1 = acc[ai][bj][m][1] + c1;
                    if (g < 2) {
#pragma unroll
                        for (int j = 0; j < 4; ++j) { v0[j] = sigmoidf_(v0[j]); v1[j] = sigmoidf_(v1[j]); }
                        if (g == 0) {
#pragma unroll
                            for (int j = 0; j < 4; ++j) { v0[j] = __expf(-0.60653065971f * v0[j]); v1[j] = __expf(-0.60653065971f * v1[j]); }
                            *(f32x4*)(DEC + ro) = v0; *(f32x4*)(DEC + ro + 4) = v1;
                        } else st_bf16x8(AA + ro, v0, v1);
                    } else st_bf16x8(GG + ro, v0, v1);
                    asm volatile("" ::: "memory");
                }
        }
    }
};
struct EpiBf16Out {
    bf16_t* out;
    DI void operator()(const AccT& acc, const pg8::Unit& u, int wr, int wc, int fr, int fq) const {
        const int row0 = u.pm * 256 + wr * 64 + fr;
#pragma unroll
        for (int ai = 0; ai < 2; ++ai)
#pragma unroll
            for (int m = 0; m < 4; ++m) {
                const size_t ro = (size_t)(row0 + ai * 128 + m * 16) * DM;
#pragma unroll
                for (int bj = 0; bj < 2; ++bj) { const int col0 = u.pn * 256 + bj * 128 + wc * 32 + 8 * fq; st_bf16x8(out + ro + col0, acc[ai][bj][m][0], acc[ai][bj][m][1]); }
            }
    }
};

struct Args { const float* in[33]; float* out; unsigned char* ws; int ph_lo, ph_hi, use_bar, pad; };
enum { I_X = 0, I_POS, I_ATTN_NORM, I_FFN_NORM, I_FINAL_NORM, I_W_IN, I_W_OUT, I_SINKS, I_CMP_PE, I_CMP_W1, I_CMP_B1, I_CMP_W2, I_FFN_W13, I_FFN_W2, I_MU, I_W_RKV, I_DECAY_W0, I_DECAY_W1,
       I_DECAY_W2, I_A0, I_A1, I_A2, I_G1, I_G2, I_K_K, I_K_A, I_R_K, I_LN_W, I_LN_B, I_W_O, I_ROUTER, I_MOE_W13, I_MOE_W2 };

struct Frame {
    LAS unsigned char* lds;
    int tid, lane, wave, G, gw, NGW;
    unsigned char* ws;
};

template <class F>
DI void transpose_item(const float* W, int Nsrc, int kvalid, bf16_t* WT, int Kd, const F& map, int k0, int n0, LAS float* scr, int lane) {
    const int s0 = map.src0(n0);
    const int rsub = lane >> 4, col = s0 + 4 * (lane & 15);
    f32x4 v[16];
#pragma unroll
    for (int i = 0; i < 16; ++i) { const int k = k0 + 4 * i + rsub; v[i] = (f32x4){0.f, 0.f, 0.f, 0.f}; if (k < kvalid && col < Nsrc) v[i] = *(const f32x4*)(W + (size_t)k * Nsrc + col); }
#pragma unroll
    for (int i = 0; i < 16; ++i) { LAS float* d = scr + (4 * i + rsub) * 65 + 4 * (lane & 15); d[0] = v[i].x; d[1] = v[i].y; d[2] = v[i].z; d[3] = v[i].w; }
    asm volatile("s_waitcnt lgkmcnt(0)" ::: "memory");
    const int c = lane & 7;
#pragma unroll
    for (int j = 0; j < 8; ++j) { const int nl = (lane >> 3) + 8 * j; const LAS float* s = scr + (8 * c) * 65 + map.perm(n0, nl);
        u32x4 o; o.x = pk2(s[0 * 65], s[1 * 65]); o.y = pk2(s[2 * 65], s[3 * 65]); o.z = pk2(s[4 * 65], s[5 * 65]); o.w = pk2(s[6 * 65], s[7 * 65]);
        *(u32x4*)(WT + (size_t)(n0 + nl) * Kd + k0 + 8 * c) = o; }
    asm volatile("s_waitcnt lgkmcnt(0)" ::: "memory");
}
template <class F>
DI void t8_load(f32x4 (&v)[16], const float* W, int Nsrc, int kvalid, const F& map, int k0, int n0, int lane) {
    const int s0 = map.src0(n0); const int rsub = lane >> 4, col = s0 + 4 * (lane & 15);
#pragma unroll
    for (int i = 0; i < 16; ++i) { const int k = k0 + 4 * i + rsub; v[i] = (f32x4){0.f, 0.f, 0.f, 0.f}; if (k < kvalid && col < Nsrc) v[i] = __builtin_nontemporal_load((const f32x4*)(W + (size_t)k * Nsrc + col)); }
}
template <class F>
DI void t8_store(const f32x4 (&v)[16], unsigned char* WT, int Kd, const F& map, int k0, int n0, LAS float* scr, int lane, float mul) {
    const int rsub = lane >> 4;
#pragma unroll
    for (int i = 0; i < 16; ++i) { LAS float* d = scr + (4 * i + rsub) * 65 + 4 * (lane & 15); d[0] = v[i].x; d[1] = v[i].y; d[2] = v[i].z; d[3] = v[i].w; }
    asm volatile("s_waitcnt lgkmcnt(0)" ::: "memory");
    const int c = lane & 7;
#pragma unroll
    for (int j = 0; j < 8; ++j) { const int nl = (lane >> 3) + 8 * j; const LAS float* s = scr + (8 * c) * 65 + map.perm(n0, nl);
        u32x2 o; o.x = pk4_fp8(s[0 * 65] * mul, s[1 * 65] * mul, s[2 * 65] * mul, s[3 * 65] * mul); o.y = pk4_fp8(s[4 * 65] * mul, s[5 * 65] * mul, s[6 * 65] * mul, s[7 * 65] * mul);
        *(u32x2*)(WT + (size_t)(n0 + nl) * Kd + k0 + 8 * c) = o; }
    asm volatile("s_waitcnt lgkmcnt(0)" ::: "memory");
}
template <class F>
DI void transpose_matrix8(const Frame& F_, const float* W, int Nsrc, int kvalid, unsigned char* WT, int Kd, int Nd, const F& map, LAS float* scr, float mul) {
    const int nkb = Kd / 64, nnb = Nd / 64, nitems = nkb * nnb;
    for (int it = F_.gw; it < nitems; it += 2 * F_.NGW) {
        const int it2 = it + F_.NGW; const bool two = it2 < nitems;
        const int k0a = 64 * (it / nnb), n0a = 64 * (it % nnb), k0b = two ? 64 * (it2 / nnb) : k0a, n0b = two ? 64 * (it2 % nnb) : n0a;
        f32x4 va[16], vb[16];
        t8_load(va, W, Nsrc, kvalid, map, k0a, n0a, F_.lane);
        if (two) t8_load(vb, W, Nsrc, kvalid, map, k0b, n0b, F_.lane);
        t8_store(va, WT, Kd, map, k0a, n0a, scr, F_.lane, mul);
        if (two) t8_store(vb, WT, Kd, map, k0b, n0b, scr, F_.lane, mul);
    }
}
template <class F>
DI void transpose_matrix(const Frame& F_, const float* W, int Nsrc, int kvalid, bf16_t* WT, int Kd, int Nd, const F& map, LAS float* scr, int first, int stride) {
    const int nkb = Kd / 64, nnb = Nd / 64, nitems = nkb * nnb;
    for (int it = first; it < nitems; it += stride) { const int kbi = it / nnb, nb = it % nnb; transpose_item(W, Nsrc, kvalid, WT, Kd, map, 64 * kbi, 64 * nb, scr, F_.lane); }
}
struct ColIdent { DI int src0(int n0) const { return n0; } DI int perm(int, int nl) const { return nl; } };
struct ColInProj { DI int src0(int n0) const { return n0; }
    DI int perm(int n0, int l) const { return n0 < C_VA ? ((l & 7) < 4 ? 4 * (l >> 3) + (l & 3) : 32 + 4 * (l >> 3) + (l & 3)) : l; } };
struct ColSwiglu { int F; DI int src0(int n0) const { const int t = n0 >> 8, r = n0 & 255; return r < 128 ? t * 128 + r : F + t * 128 + (r - 128); } DI int perm(int, int nl) const { return nl; } };

DI void rms_row_load(const float* xrow, int lane, f32x4 (&v)[8], float& rstd) {
    float s = 0.f;
#pragma unroll
    for (int j = 0; j < 8; ++j) { v[j] = *(const f32x4*)(xrow + 4 * lane + 256 * j); s += (v[j].x * v[j].x + v[j].y * v[j].y) + (v[j].z * v[j].z + v[j].w * v[j].w); }
    rstd = 1.0f / sqrtf(wave_sum(s) * (1.0f / DM) + RMS_EPS);
}
DI void rms_row_to_bf16(const float* xrow, const float* g, bf16_t* orow, int lane) {
    f32x4 v[8]; float rstd; rms_row_load(xrow, lane, v, rstd);
#pragma unroll
    for (int j = 0; j < 8; ++j) { const f32x4 gg = *(const f32x4*)(g + 4 * lane + 256 * j); const f32x4 y = v[j] * rstd * gg;
        u32x2 w; w.x = pk2(y.x, y.y); w.y = pk2(y.z, y.w); *(u32x2*)(orow + 4 * lane + 256 * j) = w; }
}

namespace att {
constexpr int KPADB = 144;
constexpr int VPADB = 144;
constexpr int BUFB = 64 * KPADB + 64 * VPADB;
constexpr int OFF_ALPHA = 2 * BUFB;
constexpr int OFF_IMP = OFF_ALPHA + 8 * 256;
constexpr int OFF_SEL = OFF_IMP + 16384;
constexpr int OFF_RANK = OFF_SEL + 512;
constexpr int OFF_Q = 65536;
constexpr float NEGBIG = -1e30f;
DI int crow(int r, int h) { return (r & 3) + 8 * (r >> 2) + 4 * h; }
#define MFMA32(a, b, c) __builtin_amdgcn_mfma_f32_32x32x16_bf16((a), (b), (c), 0, 0, 0)

struct KVRegs { u32x4 k, v; };
DI void kv_load(KVRegs& r, const bf16_t* Kg, const bf16_t* Vg, size_t pitch, int tid) {
    const int key = tid >> 3, dc = tid & 7;
    r.k = *(const u32x4*)(Kg + (size_t)key * pitch + dc * 8); r.v = *(const u32x4*)(Vg + (size_t)key * pitch + dc * 8);
}
DI void kv_store(const KVRegs& r, LAS unsigned char* buf, int tid) {
    const int key = tid >> 3, dc = tid & 7;
    *(LAS u32x4*)(buf + key * KPADB + dc * 16) = r.k;
    LAS unsigned short* vt = (LAS unsigned short*)(buf + 64 * KPADB);
    const unsigned w[4] = {r.v.x, r.v.y, r.v.z, r.v.w};
#pragma unroll
    for (int i = 0; i < 4; ++i) { vt[(dc * 8 + 2 * i) * (VPADB / 2) + key] = (unsigned short)(w[i] & 0xffffu); vt[(dc * 8 + 2 * i + 1) * (VPADB / 2) + key] = (unsigned short)(w[i] >> 16); }
}

struct State { f32x16 O[2][2]; float m[2], l[2]; };
DI void state_init(State& s) {
#pragma unroll
    for (int a = 0; a < 2; ++a) { s.m[a] = NEGBIG; s.l[a] = 0.f;
#pragma unroll
        for (int b = 0; b < 2; ++b)
#pragma unroll
            for (int r = 0; r < 16; ++r) s.O[a][b][r] = 0.f; }
}
DI void row_scale(f32x16 (&O)[2], float f, LAS float* area, int c_, int h_) {
    const int c = opq(c_), h = opq(h_);
    area[c] = f;
    asm volatile("s_waitcnt lgkmcnt(0)" ::: "memory");
#pragma unroll
    for (int g4 = 0; g4 < 4; ++g4) { const f32x4 a = *(LAS f32x4*)(area + 8 * g4 + 4 * h);
#pragma unroll
        for (int j = 0; j < 4; ++j) { O[0][4 * g4 + j] *= a[j]; O[1][4 * g4 + j] *= a[j]; } }
    asm volatile("s_waitcnt lgkmcnt(0)" ::: "memory");
}
template <int MODE, bool MASKED>
DI void softmax_block(State& st, f32x16& S, int qb, int kpos0, const int (&tq)[2], int W, bool bit, LAS float* area, int c, int h) {
    if constexpr (MASKED) {
        float mx = NEGBIG;
        const int dd = tq[qb] - kpos0;
#pragma unroll
        for (int r = 0; r < 16; ++r) { const int cr0 = (r & 3) + 8 * (r >> 2); bool valid;
            if (MODE == 0) valid = (cr0 <= dd) && (cr0 > dd - W);
            else if (MODE == 1) valid = (cr0 <= dd);
            else valid = (cr0 <= dd) && bit;
            S[r] = valid ? S[r] : NEGBIG; mx = fmaxf(mx, S[r]); }
        mx = fmaxf(mx, __shfl_xor(mx, 32));
        if (__any(mx > st.m[qb] + 8.0f)) {
            const float mnew = fmaxf(st.m[qb], mx); const float alpha = ex2(st.m[qb] - mnew);
            st.l[qb] *= alpha; st.m[qb] = mnew;
            row_scale(st.O[qb], alpha, area + qb * 32, c, h);
        }
        float ls = 0.f;
#pragma unroll
        for (int r = 0; r < 16; ++r) { S[r] = (S[r] > -1e29f) ? ex2(S[r] - st.m[qb]) : 0.f; ls += S[r]; }
        st.l[qb] += ls;
    } else {
        float mx = fmaxf(fmaxf(fmaxf(S[0], S[1]), fmaxf(S[2], S[3])), fmaxf(fmaxf(S[4], S[5]), fmaxf(S[6], S[7])));
        mx = fmaxf(mx, fmaxf(fmaxf(fmaxf(S[8], S[9]), fmaxf(S[10], S[11])), fmaxf(fmaxf(S[12], S[13]), fmaxf(S[14], S[15]))));
        if (MODE == 2) mx = bit ? mx : NEGBIG;
        mx = fmaxf(mx, __shfl_xor(mx, 32));
        if (__any(mx > st.m[qb] + 8.0f)) {
            const float mnew = fmaxf(st.m[qb], mx); const float alpha = ex2(st.m[qb] - mnew);
            st.l[qb] *= alpha; st.m[qb] = mnew;
            row_scale(st.O[qb], alpha, area + qb * 32, c, h);
        }
        const float mref = (MODE == 2 && !bit) ? 3.0e38f : st.m[qb];
        float ls = 0.f;
#pragma unroll
        for (int r = 0; r < 16; ++r) { S[r] = ex2(S[r] - mref); ls += S[r]; }
        st.l[qb] += ls;
    }
}
DI void pack_p(bf16x8 (&Pf)[2], const f32x16& S) {
#pragma unroll
    for (int ks = 0; ks < 2; ++ks) { u32x4 w; w.x = pk2(S[8 * ks], S[8 * ks + 1]); w.y = pk2(S[8 * ks + 2], S[8 * ks + 3]); w.z = pk2(S[8 * ks + 4], S[8 * ks + 5]); w.w = pk2(S[8 * ks + 6], S[8 * ks + 7]);
        Pf[ks] = __builtin_bit_cast(bf16x8, w); }
}
template <int MODE, bool MASKED>
DI void tile_compute(State& st, const LAS unsigned char* qf, LAS unsigned char* buf, int kbase, const int (&tq)[2], int W, const unsigned long long (&sel)[2], int tile, LAS float* area, int c_, int h_) {
    const int c = opq(c_), h = opq(h_);
    LAS unsigned char* Kl = buf; LAS unsigned char* Vl = buf + 64 * KPADB;
    const bool bit0 = MODE == 2 ? (((sel[0] >> tile) & 1ull) != 0ull) : true, bit1 = MODE == 2 ? (((sel[1] >> tile) & 1ull) != 0ull) : true;
#pragma unroll 1
    for (int kbk = 0; kbk < 2; ++kbk) {
        bf16x8 kf[4];
#pragma unroll
        for (int s = 0; s < 4; ++s) kf[s] = *(LAS bf16x8*)(Kl + (32 * kbk + c) * KPADB + (16 * s + 8 * h) * 2);
        f32x16 S0, S1;
#pragma unroll
        for (int r = 0; r < 16; ++r) { S0[r] = 0.f; S1[r] = 0.f; }
#pragma unroll
        for (int s = 0; s < 4; ++s) { const bf16x8 q = *(const LAS bf16x8*)(qf + s * 1024); S0 = MFMA32(kf[s], q, S0); }
#pragma unroll
        for (int s = 0; s < 4; ++s) { const bf16x8 q = *(const LAS bf16x8*)(qf + (4 + s) * 1024); S1 = MFMA32(kf[s], q, S1); }
        const LAS unsigned char* vbase = Vl + opq(c * VPADB + h * 8) + kbk * 64;
        bf16x8 vf[2][2];
#pragma unroll
        for (int ks = 0; ks < 2; ++ks)
#pragma unroll
            for (int db = 0; db < 2; ++db) {
                const s16x4 lo = *(const LAS s16x4*)(vbase + 32 * db * VPADB + 32 * ks);
                const s16x4 hi = *(const LAS s16x4*)(vbase + 32 * db * VPADB + 32 * ks + 16);
                vf[ks][db] = __builtin_shufflevector(lo, hi, 0, 1, 2, 3, 4, 5, 6, 7);
            }
        __builtin_amdgcn_sched_barrier(0);
        const int kpos0 = kbase + 32 * kbk + 4 * h;
        bf16x8 Pf[2];
        softmax_block<MODE, MASKED>(st, S0, 0, kpos0, tq, W, bit0, area, c, h);
        pack_p(Pf, S0);
        __builtin_amdgcn_sched_barrier(0);
#pragma unroll
        for (int ks = 0; ks < 2; ++ks)
#pragma unroll
            for (int db = 0; db < 2; ++db) st.O[0][db] = MFMA32(Pf[ks], vf[ks][db], st.O[0][db]);
        softmax_block<MODE, MASKED>(st, S1, 1, kpos0, tq, W, bit1, area, c, h);
        pack_p(Pf, S1);
        __builtin_amdgcn_sched_barrier(0);
#pragma unroll
        for (int ks = 0; ks < 2; ++ks)
#pragma unroll
            for (int db = 0; db < 2; ++db) st.O[1][db] = MFMA32(Pf[ks], vf[ks][db], st.O[1][db]);
    }
}
template <int MODE>
DI void run_pass(State& st, LAS unsigned char* lds, const bf16_t* Kg, const bf16_t* Vg, size_t pitch, int tlo, int thi, const int (&tq)[2], int W,
                 const unsigned long long (&sel)[2], int tid, int wave, int c, int h) {
    LAS float* area = (LAS float*)(lds + OFF_ALPHA) + wave * 64;
    const LAS unsigned char* qf = lds + OFF_Q + wave * 8192 + (c + 32 * h) * 16;
    KVRegs kr; kv_load(kr, Kg + (size_t)tlo * 64 * pitch, Vg + (size_t)tlo * 64 * pitch, pitch, tid);
    int bi = 0;
    for (int t = tlo; t <= thi; ++t) {
        LAS unsigned char* buf = lds + bi * BUFB;
        const int tid2 = opq(tid);
        kv_store(kr, buf, tid2);
        if (t < thi) kv_load(kr, Kg + (size_t)(t + 1) * 64 * pitch, Vg + (size_t)(t + 1) * 64 * pitch, pitch, tid2);
        __syncthreads();
        const bool masked = (MODE == 1) || (t == thi) || (MODE == 0 && t == thi - W / 64);
        if (masked) tile_compute<MODE, true>(st, qf, buf, t * 64, tq, W, sel, t, area, c, h);
        else tile_compute<MODE, false>(st, qf, buf, t * 64, tq, W, sel, t, area, c, h);
        bi ^= 1;
    }
    __syncthreads();
}
DI void load_q(LAS unsigned char* lds, int wave, const bf16_t* Pbase  , int colbase, int c_, int h_) {
    const int c = opq(c_), h = opq(h_);
    LAS unsigned char* q = lds + OFF_Q + wave * 8192 + (c + 32 * h) * 16;
#pragma unroll
    for (int qb = 0; qb < 2; ++qb) { const bf16_t* p = Pbase + (size_t)(4 * qb + (c >> 3)) * NP + colbase + (c & 7) * 64 + 8 * h;
#pragma unroll
        for (int s = 0; s < 4; ++s) *(LAS bf16x8*)(q + (qb * 4 + s) * 1024) = *(const bf16x8*)(p + 16 * s); }
}
template <bool ACC>
DI void emit_out(State& st, const float (&f)[2], LAS float* area, LAS unsigned char* lds, int wave, bf16_t* Orow, int c_, int h_, int lane_) {
    const int c = opq(c_), h = opq(h_), lane = opq(lane_);
    LAS unsigned char* slice = lds + wave * 4608;
#pragma unroll
    for (int qb = 0; qb < 2; ++qb) {
        area[qb * 32 + c] = f[qb];
        asm volatile("s_waitcnt lgkmcnt(0)" ::: "memory");
#pragma unroll
        for (int g4 = 0; g4 < 4; ++g4) { const f32x4 a = *(LAS f32x4*)(area + qb * 32 + 8 * g4 + 4 * h);
#pragma unroll
            for (int j = 0; j < 4; ++j)
#pragma unroll
                for (int db = 0; db < 2; ++db)
                    *(LAS unsigned short*)(slice + (8 * g4 + 4 * h + j) * KPADB + (32 * db + c) * 2) = (unsigned short)f2bf(st.O[qb][db][4 * g4 + j] * a[j]); }
        asm volatile("s_waitcnt lgkmcnt(0)" ::: "memory");
        u32x4 v[4], o[4];
#pragma unroll
        for (int i = 0; i < 4; ++i) v[i] = *(LAS u32x4*)(slice + ((lane >> 3) + 8 * i) * KPADB + (lane & 7) * 16);
        if (ACC) {
#pragma unroll
            for (int i = 0; i < 4; ++i) { const int row = (lane >> 3) + 8 * i; o[i] = *(const u32x4*)(Orow + (size_t)(4 * qb + (row >> 3)) * DM + (row & 7) * 64 + (lane & 7) * 8); }
#pragma unroll
            for (int i = 0; i < 4; ++i) { const unsigned a[4] = {v[i].x, v[i].y, v[i].z, v[i].w}, bb[4] = {o[i].x, o[i].y, o[i].z, o[i].w}; unsigned r[4];
#pragma unroll
                for (int k = 0; k < 4; ++k) r[k] = pk2(bflo(a[k]) + bflo(bb[k]), bfhi(a[k]) + bfhi(bb[k]));
                v[i] = (u32x4){r[0], r[1], r[2], r[3]}; }
        }
#pragma unroll
        for (int i = 0; i < 4; ++i) { const int row = (lane >> 3) + 8 * i; *(u32x4*)(Orow + (size_t)(4 * qb + (row >> 3)) * DM + (row & 7) * 64 + (lane & 7) * 8) = v[i]; }
        asm volatile("s_waitcnt lgkmcnt(0)" ::: "memory");
    }
}
}

DI void attn_unit_A(const Frame& F, const bf16_t* P, bf16_t* O, const float* sinks, int b, int kvh, int ch) {
    const int lane = opq(F.lane), tid = F.wave * 64 + lane;
    const int c = lane & 31, h = lane >> 5, w = F.wave;
    const int t0 = ch * 64;
    const bf16_t* Pb = P + (size_t)b * SEQ * NP;
    att::load_q(F.lds, w, Pb + (size_t)(t0 + 8 * w) * NP, C_QA + kvh * 512, c, h);
    int tq[2] = {t0 + 8 * w + (c >> 3), t0 + 8 * w + 4 + (c >> 3)};
    unsigned long long sel[2] = {0ull, 0ull};
    att::State st; att::state_init(st);
    const int tlo = ch >= 2 ? ch - 2 : 0;
    att::run_pass<0>(st, F.lds, Pb + C_KA + kvh * 64, Pb + C_VA + kvh * 64, NP, tlo, ch, tq, 128, sel, tid, w, c, h);
    const float sink2 = sinks[kvh * 8 + (c & 7)] * LOG2E;
    float f[2];
#pragma unroll
    for (int qb = 0; qb < 2; ++qb) { const float lt = st.l[qb] + __shfl_xor(st.l[qb], 32) + ex2(sink2 - st.m[qb]); f[qb] = 1.0f / lt; }
    LAS float* area = (LAS float*)(F.lds + att::OFF_ALPHA) + w * 64;
    att::emit_out<false>(st, f, area, F.lds, w, O + ((size_t)b * SEQ + t0 + 8 * w) * DM + kvh * 512, c, h, lane);
    __syncthreads();
}

DI void attn_unit_B(const Frame& F, const bf16_t* P, const bf16_t* KVC, bf16_t* O, float* OB, int b, int hkv, int ch) {
    const int lane = opq(F.lane), tid = F.wave * 64 + lane;
    const int c = lane & 31, h = lane >> 5, w = F.wave;
    const int t0 = ch * 64;
    const bf16_t* Pb = P + (size_t)b * SEQ * NP;
    LAS float* area = (LAS float*)(F.lds + att::OFF_ALPHA) + w * 64;
    LAS float* imp = (LAS float*)(F.lds + att::OFF_IMP);
    LAS unsigned long long* selbuf = (LAS unsigned long long*)(F.lds + att::OFF_SEL);
    LAS float* rank = (LAS float*)(F.lds + att::OFF_RANK) + w * 64;
    att::load_q(F.lds, w, Pb + (size_t)(t0 + 8 * w) * NP, C_QB + hkv * 512, c, h);
    const LAS unsigned char* qf = F.lds + att::OFF_Q + w * 8192 + (c + 32 * h) * 16;
    int tq[2] = {t0 + 8 * w + (c >> 3), t0 + 8 * w + 4 + (c >> 3)};
    unsigned long long sel[2] = {0ull, 0ull};
#define GATE(qb, j) sigmoidf_(bf2f(Pb[(size_t)tq[qb] * NP + C_GATE + hkv * 24 + (c & 7) * 3 + (j)]))
    for (int i = tid; i < 4096; i += NTHR) imp[i] = 0.f;
    bf16_t* Orow = O + ((size_t)b * SEQ + t0 + 8 * w) * DM + 1024 + hkv * 512;
    const bf16_t* Kc = KVC + (size_t)(0 * 2048 + (b * 2 + hkv) * 256) * 64;
    const bf16_t* Vc = KVC + (size_t)(1 * 2048 + (b * 2 + hkv) * 256) * 64;
    const int ntc = (4 * ch + 2) / 64;
    att::State st; att::state_init(st);
    int tqc[2] = {(tq[0] - 31) >> 4, (tq[1] - 31) >> 4};
    att::run_pass<1>(st, F.lds, Kc, Vc, 64, 0, ntc, tqc, 0, sel, tid, w, c, h);
    float ltot[2], f[2];
#pragma unroll
    for (int qb = 0; qb < 2; ++qb) { ltot[qb] = fmaxf(st.l[qb] + __shfl_xor(st.l[qb], 32), 1e-30f); f[qb] = GATE(qb, 0) / ltot[qb]; }
    att::emit_out<false>(st, f, area, F.lds, w, Orow, c, h, lane);
    __syncthreads();
    {
        att::KVRegs kr; att::kv_load(kr, Kc, Vc, 64, tid);
        int bi = 0;
        for (int t = 0; t <= ntc; ++t) {
            LAS unsigned char* buf = F.lds + bi * att::BUFB;
            att::kv_store(kr, buf, tid);
            if (t < ntc) att::kv_load(kr, Kc + (size_t)(t + 1) * 64 * 64, Vc + (size_t)(t + 1) * 64 * 64, 64, tid);
            __syncthreads();
#pragma unroll
            for (int kbk = 0; kbk < 2; ++kbk) {
#pragma unroll
                for (int qb = 0; qb < 2; ++qb) {
                    f32x16 S;
#pragma unroll
                    for (int r = 0; r < 16; ++r) S[r] = 0.f;
#pragma unroll
                    for (int s = 0; s < 4; ++s) { const bf16x8 kf = *(LAS bf16x8*)(buf + (32 * kbk + c) * att::KPADB + (16 * s + 8 * h) * 2); const bf16x8 q = *(const LAS bf16x8*)(qf + (qb * 4 + s) * 1024); S = MFMA32(kf, q, S); }
                    const float inv = 1.0f / ltot[qb];
                    const int q = 8 * w + 4 * qb + (c >> 3);
                    const int ddq = tqc[qb] - (t * 64 + 32 * kbk + 4 * h);
#pragma unroll
                    for (int g4 = 0; g4 < 4; ++g4) {
                        float s4 = 0.f, p3 = 0.f;
#pragma unroll
                        for (int j = 0; j < 4; ++j) { const float pv = (8 * g4 + j <= ddq) ? ex2(S[4 * g4 + j] - st.m[qb]) * inv : 0.f; s4 += pv; if (j == 3) p3 = pv; }
                        s4 += __shfl_xor(s4, 1); s4 += __shfl_xor(s4, 2); s4 += __shfl_xor(s4, 4);
                        p3 += __shfl_xor(p3, 1); p3 += __shfl_xor(p3, 2); p3 += __shfl_xor(p3, 4);
                        const int n0 = t * 16 + 8 * kbk + 2 * g4 + h;
                        if ((c & 7) == 0) { (void)__hip_atomic_fetch_add(&imp[q * 64 + n0], s4, __ATOMIC_RELAXED, __HIP_MEMORY_SCOPE_WORKGROUP); if (n0 + 1 < 64) (void)__hip_atomic_fetch_add(&imp[q * 64 + n0 + 1], p3, __ATOMIC_RELAXED, __HIP_MEMORY_SCOPE_WORKGROUP); }
                    }
                    __builtin_amdgcn_sched_barrier(0);
                }
            }
            bi ^= 1;
        }
        __syncthreads();
    }
    {
        const int cur = ch;
        for (int qq = 0; qq < 8; ++qq) {
            const int q = 8 * w + qq;
            float v = imp[q * 64 + lane];
            if (lane > cur) v = -1e9f; else if (lane == 0 || lane > cur - 2) v = 1e9f;
            rank[lane] = v;
            asm volatile("s_waitcnt lgkmcnt(0)" ::: "memory");
            int rk = 0;
#pragma unroll 8
            for (int mth = 0; mth < 64; ++mth) { const float o = rank[mth]; rk += (o > v || (o == v && mth < lane)) ? 1 : 0; }
            const unsigned long long msk = __ballot(rk < 16);
            if (lane == 0) selbuf[q] = msk;
            asm volatile("s_waitcnt lgkmcnt(0)" ::: "memory");
        }
        __syncthreads();
        sel[0] = selbuf[8 * w + (c >> 3)]; sel[1] = selbuf[8 * w + 4 + (c >> 3)];
    }
    att::state_init(st);
    att::run_pass<2>(st, F.lds, Pb + C_KSEL + hkv * 64, Pb + C_VSEL + hkv * 64, NP, 0, ch, tq, 0, sel, tid, w, c, h);
#pragma unroll
    for (int qb = 0; qb < 2; ++qb) { const float lt = fmaxf(st.l[qb] + __shfl_xor(st.l[qb], 32), 1e-30f); f[qb] = GATE(qb, 1) / lt; }
    att::emit_out<true>(st, f, area, F.lds, w, Orow, c, h, lane);
    __syncthreads();
    att::state_init(st);
    att::run_pass<0>(st, F.lds, Pb + C_KWIN + hkv * 64, Pb + C_VWIN + hkv * 64, NP, ch >= 8 ? ch - 8 : 0, ch, tq, 512, sel, tid, w, c, h);
#pragma unroll
    for (int qb = 0; qb < 2; ++qb) { const float lt = fmaxf(st.l[qb] + __shfl_xor(st.l[qb], 32), 1e-30f); f[qb] = GATE(qb, 2) / lt; }
    att::emit_out<true>(st, f, area, F.lds, w, Orow, c, h, lane);
#undef GATE
    __syncthreads();
}

namespace scan {
constexpr int TC = 32;
constexpr int STEPB = 5 * 256 + 128;
constexpr int CHB = TC * STEPB;
constexpr int OFF_Y = 2 * CHB;
constexpr int YB = (TC + 1) * 32 * 4;
template <int CTRL> DI float dpp_f(float x) { return __builtin_bit_cast(float, __builtin_amdgcn_update_dpp(0, __builtin_bit_cast(int, x), CTRL, 0xf, 0xf, false)); }
DI void row_sum16x4(float& a, float& b, float& c, float& d) {
    asm volatile("s_nop 1\n\t"
        "v_add_f32_dpp %0, %0, %0 quad_perm:[1,0,3,2] row_mask:0xf bank_mask:0xf\n\tv_add_f32_dpp %1, %1, %1 quad_perm:[1,0,3,2] row_mask:0xf bank_mask:0xf\n\t"
        "v_add_f32_dpp %2, %2, %2 quad_perm:[1,0,3,2] row_mask:0xf bank_mask:0xf\n\tv_add_f32_dpp %3, %3, %3 quad_perm:[1,0,3,2] row_mask:0xf bank_mask:0xf\n\t"
        "v_add_f32_dpp %0, %0, %0 quad_perm:[2,3,0,1] row_mask:0xf bank_mask:0xf\n\tv_add_f32_dpp %1, %1, %1 quad_perm:[2,3,0,1] row_mask:0xf bank_mask:0xf\n\t"
        "v_add_f32_dpp %2, %2, %2 quad_perm:[2,3,0,1] row_mask:0xf bank_mask:0xf\n\tv_add_f32_dpp %3, %3, %3 quad_perm:[2,3,0,1] row_mask:0xf bank_mask:0xf\n\t"
        "v_add_f32_dpp %0, %0, %0 row_half_mirror row_mask:0xf bank_mask:0xf\n\tv_add_f32_dpp %1, %1, %1 row_half_mirror row_mask:0xf bank_mask:0xf\n\t"
        "v_add_f32_dpp %2, %2, %2 row_half_mirror row_mask:0xf bank_mask:0xf\n\tv_add_f32_dpp %3, %3, %3 row_half_mirror row_mask:0xf bank_mask:0xf\n\t"
        "v_add_f32_dpp %0, %0, %0 row_mirror row_mask:0xf bank_mask:0xf\n\tv_add_f32_dpp %1, %1, %1 row_mirror row_mask:0xf bank_mask:0xf\n\t"
        "v_add_f32_dpp %2, %2, %2 row_mirror row_mask:0xf bank_mask:0xf\n\tv_add_f32_dpp %3, %3, %3 row_mirror row_mask:0xf bank_mask:0xf"
        : "+v"(a), "+v"(b), "+v"(c), "+v"(d));
}
DI float wave_sum_dpp(float x) { x += dpp_f<0xB1>(x); x += dpp_f<0x4E>(x); x += dpp_f<0x141>(x); x += dpp_f<0x140>(x);
    const int xi = __builtin_bit_cast(int, x);
    return (__builtin_bit_cast(float, __builtin_amdgcn_readlane(xi, 0)) + __builtin_bit_cast(float, __builtin_amdgcn_readlane(xi, 16))) + (__builtin_bit_cast(float, __builtin_amdgcn_readlane(xi, 32)) + __builtin_bit_cast(float, __builtin_amdgcn_readlane(xi, 48))); }
DI float row_sum16(float x) { x += dpp_f<0xB1>(x); x += dpp_f<0x4E>(x); x += dpp_f<0x141>(x); x += dpp_f<0x140>(x); return x; }
}
struct ScanRegs { unsigned short r[8], k[8], v[8], a[8]; float dec[8]; };
DI void scan_issue(const Frame& F, ScanRegs& R, const bf16_t* RKV, const float* DEC, const bf16_t* AA, int b, int hd, int tch) {
    const int lw = F.wave - 4, lane = F.lane;
#pragma unroll
    for (int i = 0; i < 8; ++i) {
        const size_t tok = (size_t)b * SEQ + (size_t)tch * scan::TC + lw + 4 * i;
        const size_t o = tok * DM + hd * 64 + lane;
        R.r[i] = RKV[o]; R.k[i] = RKV[(size_t)M * DM + o]; R.v[i] = RKV[(size_t)2 * M * DM + o]; R.dec[i] = DEC[o]; R.a[i] = AA[o];
    }
}
DI void scan_fill(const Frame& F, const ScanRegs& R, LAS unsigned char* buf, float kkw, float kaw, int half) {
    const int lw = F.wave - 4, lane = F.lane;
#pragma unroll
    for (int i = 0; i < 8; ++i) {
        const int s = lw + 4 * i;
        const float r = bf2f(R.r[i]), k = bf2f(R.k[i]), v = bf2f(R.v[i]), dec = R.dec[i], a = bf2f(R.a[i]);
        const float kx = k * kkw;
        const float kk = kx * __builtin_amdgcn_rsqf(fmaxf(scan::wave_sum_dpp(kx * kx), 1e-24f));
        const float kp = k * (1.0f + (a - 1.0f) * kaw);
        LAS float* sp = (LAS float*)(buf + s * scan::STEPB);
        sp[lane] = dec; sp[64 + lane] = -kk; sp[128 + lane] = kk * a; sp[192 + lane] = kp; sp[256 + lane] = r;
        if ((lane >> 5) == half) sp[320 + (lane & 31)] = v;
    }
}
DI void scan_flush(const Frame& F, LAS unsigned char* ybuf, bf16_t* YRAW, int b, int hd, int half, int tch) {
    const int lw = F.wave - 4, lane = F.lane;
    for (int s = 2 * lw; s < scan::TC; s += 8) {
        const int ss = s + (lane >> 5);
        const size_t tok = (size_t)b * SEQ + (size_t)tch * scan::TC + ss;
        YRAW[tok * DM + hd * 64 + half * 32 + (lane & 31)] = (bf16_t)f2bf(((LAS float*)ybuf)[(ss + 1) * 32 + (lane & 31)]);
    }
}
struct CvItem { const float* W; unsigned char* WT; int Nsrc, Kd, k0, n0, s0; float mul; bool on; };
constexpr int CV_I13 = (DM / 64) * (2 * DFFE / 32), CV_I2 = (DFFE / 64) * (DM / 32), CV_TOTAL = NEXP * (CV_I13 + CV_I2);
DI CvItem cv_item(int gid, const float* w13, const float* w2, unsigned char* m13, unsigned char* m2) {
    CvItem it; it.on = gid < CV_TOTAL;
    if (gid < NEXP * CV_I13) { const int e = gid / CV_I13, r = gid % CV_I13, kb = r / (2 * DFFE / 32), nb = r % (2 * DFFE / 32);
        it.W = w13 + (size_t)e * DM * 2 * DFFE; it.WT = m13 + (size_t)e * 2 * DFFE * DM; it.Nsrc = 2 * DFFE; it.Kd = DM; it.k0 = 64 * kb; it.n0 = 32 * nb; it.mul = 64.0f;
        const int t = it.n0 >> 8, rr = it.n0 & 255; it.s0 = rr < 128 ? t * 128 + rr : DFFE + t * 128 + (rr - 128);
    } else { const int g2 = gid - NEXP * CV_I13; const int e = g2 / CV_I2, r = g2 % CV_I2, kb = r / (DM / 32), nb = r % (DM / 32);
        it.W = w2 + (size_t)e * DFFE * DM; it.WT = m2 + (size_t)e * DM * DFFE; it.Nsrc = DM; it.Kd = DFFE; it.k0 = 64 * kb; it.n0 = 32 * nb; it.mul = 128.0f; it.s0 = it.n0; }
    return it;
}
DI void cv_load(float (&v)[32], const CvItem& it, int lane) {
    if (!it.on) return;
    const char* rowbase = (const char*)(it.W + (size_t)it.k0 * it.Nsrc + it.s0);
    const unsigned loff = (unsigned)((lane >> 5) * it.Nsrc + (lane & 31)) * 4u;
    const size_t rstep = (size_t)it.Nsrc * 8;
#pragma unroll
    for (int i = 0; i < 32; ++i) v[i] = __builtin_nontemporal_load((const float*)(rowbase + (size_t)i * rstep + loff));
}
DI void cv_store(const float (&v)[32], const CvItem& it, LAS float* scr, int lane) {
    if (!it.on) return;
#pragma unroll
    for (int i = 0; i < 32; ++i) scr[(2 * i + (lane >> 5)) * 33 + (lane & 31)] = v[i];
    asm volatile("s_waitcnt lgkmcnt(0)" ::: "memory");
    const int c = lane & 7;
#pragma unroll
    for (int j = 0; j < 4; ++j) { const int n = (lane >> 3) + 8 * j; const LAS float* s = scr + (8 * c) * 33 + n;
        u32x2 o; o.x = pk4_fp8(s[0 * 33] * it.mul, s[1 * 33] * it.mul, s[2 * 33] * it.mul, s[3 * 33] * it.mul); o.y = pk4_fp8(s[4 * 33] * it.mul, s[5 * 33] * it.mul, s[6 * 33] * it.mul, s[7 * 33] * it.mul);
        *(u32x2*)(it.WT + (size_t)(it.n0 + n) * it.Kd + it.k0 + 8 * c) = o; }
    asm volatile("s_waitcnt lgkmcnt(0)" ::: "memory");
}
DI unsigned long long phase_scan(const Frame& F, const bf16_t* RKV, const float* DEC, const bf16_t* AA, const float* kk_w, const float* ka_w, bf16_t* YRAW,
                                  const float* w13, const float* w2, unsigned char* m13, unsigned char* m2) {
    unsigned long long pacc = 0ull;
    for (int vb = blockIdx.x; vb < 256; vb += F.G) {
        const int bh = vb >> 1, half = vb & 1, b = bh >> 5, hd = bh & 31;
        const int w = F.wave, lane = F.lane;
        const int rp = lane >> 4, cg = lane & 15;
        const int row0 = 8 * w + 2 * rp;
        f32x2 SS[4] = {(f32x2){0.f, 0.f}, (f32x2){0.f, 0.f}, (f32x2){0.f, 0.f}, (f32x2){0.f, 0.f}};
        constexpr int NCH = SEQ / scan::TC;
        volatile LAS unsigned* fl = (volatile LAS unsigned*)(F.lds + 138240);
#define SC_WAIT(idx, target) do { unsigned sp_ = 0; while (fl[idx] < (unsigned)(target) && ++sp_ < (1u << 24)) __builtin_amdgcn_s_sleep(1); asm volatile("" ::: "memory"); } while (0)
#define SC_SIGNAL(idx) do { asm volatile("s_waitcnt lgkmcnt(0)" ::: "memory"); if (lane == 0) (void)__hip_atomic_fetch_add((LAS unsigned*)&fl[idx], 1u, __ATOMIC_RELAXED, __HIP_MEMORY_SCOPE_WORKGROUP); } while (0)
        if (w < 4) {
            __builtin_amdgcn_s_setprio(3);
            for (int ch = 0; ch < NCH; ++ch) {
                LAS unsigned char* buf = F.lds + (ch & 1) * scan::CHB;
                LAS float* yb = (LAS float*)(F.lds + scan::OFF_Y + (ch & 1) * scan::YB);
                SC_WAIT(ch & 1, 4 * (ch / 2 + 1));
                if (ch >= 2) SC_WAIT(4 + (ch & 1), 4 * (ch / 2));
#ifdef PROBE_SCAN
                const unsigned long long pt0 = __builtin_amdgcn_s_memrealtime();
#endif
                f32x2 yp = (f32x2){0.f, 0.f};
                const LAS float* sp0 = (const LAS float*)buf;
                f32x4 w4 = *(const LAS f32x4*)(sp0 + 4 * cg), nk4 = *(const LAS f32x4*)(sp0 + 64 + 4 * cg), b4 = *(const LAS f32x4*)(sp0 + 128 + 4 * cg),
                      k4 = *(const LAS f32x4*)(sp0 + 192 + 4 * cg), r4 = *(const LAS f32x4*)(sp0 + 256 + 4 * cg);
                f32x2 v2 = *(const LAS f32x2*)(sp0 + 320 + row0);
#define SPL(x) ((f32x2){(x), (x)})
#pragma unroll 8
                for (int s = 0; s < scan::TC; ++s) {
                    const LAS float* sp = (const LAS float*)(buf + (s + 1) * scan::STEPB);
                    const f32x4 w4n = *(const LAS f32x4*)(sp + 4 * cg), nk4n = *(const LAS f32x4*)(sp + 64 + 4 * cg), b4n = *(const LAS f32x4*)(sp + 128 + 4 * cg),
                                k4n = *(const LAS f32x4*)(sp + 192 + 4 * cg), r4n = *(const LAS f32x4*)(sp + 256 + 4 * cg);
                    const f32x2 v2n = *(const LAS f32x2*)(sp + 320 + row0);
                    f32x2 sa = SS[0] * SPL(nk4[0]);
#pragma unroll
                    for (int i = 1; i < 4; ++i) sa = __builtin_elementwise_fma(SS[i], SPL(nk4[i]), sa);
                    float sa0 = sa.x, sa1 = sa.y, y0 = yp.x, y1 = yp.y;
                    scan::row_sum16x4(sa0, sa1, y0, y1);
                    if (cg == 0) { yb[s * 32 + row0] = y0; yb[s * 32 + row0 + 1] = y1; }
                    sa = (f32x2){sa0, sa1};
                    yp = (f32x2){0.f, 0.f};
#pragma unroll
                    for (int i = 0; i < 4; ++i) {
                        f32x2 t = v2 * SPL(k4[i]);
                        t = __builtin_elementwise_fma(sa, SPL(b4[i]), t);
                        SS[i] = __builtin_elementwise_fma(SS[i], SPL(w4[i]), t);
                        yp = __builtin_elementwise_fma(SS[i], SPL(r4[i]), yp);
                    }
                    w4 = w4n; nk4 = nk4n; b4 = b4n; k4 = k4n; r4 = r4n; v2 = v2n;
                }
#undef SPL
                float d0 = 0.f, d1 = 0.f, y0 = yp.x, y1 = yp.y;
                scan::row_sum16x4(y0, y1, d0, d1);
                if (cg == 0) { yb[scan::TC * 32 + row0] = y0; yb[scan::TC * 32 + row0 + 1] = y1; }
#ifdef PROBE_SCAN
                if (PROBE_SCAN == 1) pacc += __builtin_amdgcn_s_memrealtime() - pt0;
#endif
                SC_SIGNAL(2 + (ch & 1));
            }
            __builtin_amdgcn_s_setprio(0);
        } else {
            ScanRegs SR;
            const float kkw = kk_w[hd * 64 + lane], kaw = ka_w[hd * 64 + lane];
            scan_issue(F, SR, RKV, DEC, AA, b, hd, 0); scan_fill(F, SR, F.lds, kkw, kaw, half); SC_SIGNAL(0); scan_issue(F, SR, RKV, DEC, AA, b, hd, 1);
            LAS float* cscr = (LAS float*)(F.lds + 98816 + (w - 4) * 8448);
            for (int it = 0; it < NCH; ++it) {
#ifdef PROBE_SCAN
                const unsigned long long pt0 = __builtin_amdgcn_s_memrealtime();
#endif
                const int gid0 = ((it * 256 + vb) * 4 + (w - 4)) * 2;
                const CvItem ia = cv_item(gid0, w13, w2, m13, m2), ib = cv_item(gid0 + 1, w13, w2, m13, m2);
                float ca[32];
                cv_load(ca, ia, lane);
                if (it >= 1) SC_WAIT(2 + ((it - 1) & 1), 4 * ((it - 1) / 2 + 1));
                if (it + 1 < NCH) { scan_fill(F, SR, F.lds + ((it + 1) & 1) * scan::CHB, kkw, kaw, half); SC_SIGNAL((it + 1) & 1); }
                if (it + 2 < NCH) scan_issue(F, SR, RKV, DEC, AA, b, hd, it + 2);
                if (it >= 1) { scan_flush(F, F.lds + scan::OFF_Y + ((it - 1) & 1) * scan::YB, YRAW, b, hd, half, it - 1); SC_SIGNAL(4 + ((it - 1) & 1)); }
                cv_store(ca, ia, cscr, lane);
                cv_load(ca, ib, lane); cv_store(ca, ib, cscr, lane);
#ifdef PROBE_SCAN
                if (PROBE_SCAN == 2) pacc += __builtin_amdgcn_s_memrealtime() - pt0;
#endif
            }
            SC_WAIT(2 + ((NCH - 1) & 1), 4 * ((NCH - 1) / 2 + 1));
            scan_flush(F, F.lds + scan::OFF_Y + ((NCH - 1) & 1) * scan::YB, YRAW, b, hd, half, NCH - 1);
        }
#undef SC_WAIT
#undef SC_SIGNAL
        __syncthreads();
        if (F.tid < 6) fl[F.tid] = 0u;
        __syncthreads();
    }
    return pacc;
}

constexpr int NPHASE = 19;
__global__ void __launch_bounds__(NTHR, 2) mk_fwd(Args args) {
    extern __shared__ __attribute__((aligned(16))) unsigned char lds_raw[];
    Frame F;
    F.lds = (LAS unsigned char*)lds_raw;
    F.tid = threadIdx.x; F.lane = F.tid & 63; F.wave = __builtin_amdgcn_readfirstlane(F.tid >> 6);
    F.G = gridDim.x; F.gw = blockIdx.x * NWAVES + F.wave; F.NGW = F.G * NWAVES; F.ws = args.ws;
    unsigned char* ws = args.ws;
    unsigned* ctl = (unsigned*)(ws + WS_CTL);
    volatile LAS unsigned* MISC = (volatile LAS unsigned*)(F.lds + MISC_OFF);
    for (int u = F.tid; u < (LDS_BYTES - LDSCTL_OFF) / 4; u += NTHR) ((LAS unsigned*)(F.lds + LDSCTL_OFF))[u] = 0u;
    __syncthreads();
    XcdBarrier bar; bar.bar = ctl + CW_BAR; bar.x = 0; bar.st = nullptr;
    if (args.use_bar) bar = xcd_barrier_post(ctl + CW_BAR, MISC + 8);
    const int lo = args.ph_lo, hi = args.ph_hi;
#ifndef PH_MASK
#define PH_MASK 0xFFFFFFFFu
#endif
#define IN(k) (((PH_MASK >> (k)) & 1u) && lo <= (k) && (k) < hi)
#define SEAM(k) do { if (IN(k) && IN((k) + 1)) xcd_barrier(bar); if (PROBE_ON(k)) probe_acc += __builtin_amdgcn_s_memrealtime() - probe_t0; if (PROBE_ON((k) + 1)) probe_t0 = __builtin_amdgcn_s_memrealtime(); } while (0)
#ifndef REPEAT_MASK
#define REPEAT_MASK 0u
#endif
#define REPS(k) ((((REPEAT_MASK) >> (k)) & 1u) ? 2 : 1)
#ifndef PROBE_MASK
#define PROBE_MASK 0u
#endif
    unsigned long long probe_acc = 0ull, probe_t0 = 0ull;
#define PROBE_ON(k) (PROBE_MASK != 0u && (((PROBE_MASK) >> (k)) & 1u) && blockIdx.x == 0 && F.tid == 0)
#define PH(k) if (IN(k)) for (int rep_ = 0; rep_ < REPS(k); ++rep_, (rep_ < REPS(k) ? xcd_barrier(bar) : (void)0))

    bf16_t* W_IN = (bf16_t*)(ws + WS_W_IN); bf16_t* W_OUT = (bf16_t*)(ws + WS_W_OUT); bf16_t* CMPW1 = (bf16_t*)(ws + WS_CMPW1);
    bf16_t* FFN13 = (bf16_t*)(ws + WS_FFN13); bf16_t* FFN2 = (bf16_t*)(ws + WS_FFN2); bf16_t* WRKV = (bf16_t*)(ws + WS_WRKV);
    bf16_t* LORA1 = (bf16_t*)(ws + WS_LORA1); bf16_t* LORA2 = (bf16_t*)(ws + WS_LORA2); bf16_t* WO = (bf16_t*)(ws + WS_WO);
    bf16_t* MOE13 = (bf16_t*)(ws + WS_MOE13); bf16_t* MOE2 = (bf16_t*)(ws + WS_MOE2);
    bf16_t* XN = (bf16_t*)(ws + WS_XN); bf16_t* P = (bf16_t*)(ws + WS_P); float* ROPE = (float*)(ws + WS_ROPE); float* CMPB = (float*)(ws + WS_CMPB);
    bf16_t* HID = (bf16_t*)(ws + WS_HID); bf16_t* KVC = (bf16_t*)(ws + WS_KVC); bf16_t* O = (bf16_t*)(ws + WS_O); float* H = (float*)(ws + WS_H);
    bf16_t* ACT = (bf16_t*)(ws + WS_ACT); bf16_t* XS = (bf16_t*)(ws + WS_XS); bf16_t* RKV = (bf16_t*)(ws + WS_RKV); bf16_t* L1 = (bf16_t*)(ws + WS_L1);
    float* DEC = (float*)(ws + WS_DEC); bf16_t* AA = (bf16_t*)(ws + WS_AA); bf16_t* GG = (bf16_t*)(ws + WS_GG); bf16_t* YRAW = (bf16_t*)(ws + WS_YRAW); bf16_t* YG = (bf16_t*)(ws + WS_YG);
    int* ROWTOK = (int*)(ws + WS_ROWTOK); int* TOKSLOT = (int*)(ws + WS_TOKSLOT); float* Y2 = (float*)(ws + WS_Y2);
    LAS unsigned char* ring = F.lds;

    if (PROBE_ON(0)) probe_t0 = __builtin_amdgcn_s_memrealtime();
    PH(0) {
        LAS float* scr = (LAS float*)(F.lds + F.wave * 16640);
        transpose_matrix(F, args.in[I_W_IN], IN_COLS, DM, W_IN, DM, NP, ColInProj{}, scr, F.gw, F.NGW);
        for (int kv = 0; kv < 2; ++kv) transpose_matrix(F, args.in[I_CMP_W1] + (size_t)kv * 2048 * 256, 256, 2048, CMPW1 + (size_t)kv * 256 * 2048, 2048, 256, ColIdent{}, scr, F.gw, F.NGW);
        for (int m = F.gw; m < M; m += F.NGW) rms_row_to_bf16(args.in[I_X] + (size_t)m * DM, args.in[I_ATTN_NORM], XN + (size_t)m * DM, F.lane);
        { const int* pos = (const int*)args.in[I_POS];
          for (int i = blockIdx.x * NTHR + F.tid; i < M * 32; i += F.G * NTHR) { const int m = i >> 5, j = i & 31;
              const float inv = powf(150000.0f, -(float)j / 32.0f); const float ang = (float)pos[m] * inv; float sn, cs; sincosf(ang, &sn, &cs);
              ROPE[(size_t)m * 64 + j] = cs; ROPE[(size_t)m * 64 + 32 + j] = sn; } }
        if (F.gw < 512) { const int kv = F.gw >> 8, j = F.gw & 255; const float* pe = args.in[I_CMP_PE] + kv * 2048; const float* w1 = args.in[I_CMP_W1] + (size_t)kv * 2048 * 256;
            float s = 0.f; for (int i = F.lane; i < 2048; i += 64) s += pe[i] * w1[(size_t)i * 256 + j];
            s = wave_sum(s); if (F.lane == 0) CMPB[kv * 256 + j] = s + args.in[I_CMP_B1][kv * 256 + j]; }
    }
    SEAM(0);
    PH(1) {
        OrderSingle S{(const char*)XN, (const char*)W_IN, DM * 2, DM * 2, 64, 12, 64 * 12, F.G, (int)blockIdx.x};
        EpiInProj E{P, ROPE};
        pg8::gemm_phase<EpiInProj, OrderSingle, false>(ring, DM * 2, 128, DM * 2, DM / 64, S, E);
    }
    SEAM(1);
    PH(2) {
        OrderCmp S{(const char*)P, (const char*)CMPW1, (const char*)XN, (const char*)(W_IN + (size_t)C_GATE * DM), F.G, (int)blockIdx.x};
        EpiCmp1 E{HID, CMPB, P};
        pg8::gemm_phase<EpiCmp1, OrderCmp, true>(ring, 0, 0, 2048 * 2, 32, S, E);
        const bool conv = F.G > 80 ? (int)blockIdx.x >= 80 : true;
        if (conv) {
            const int nconv = F.G > 80 ? F.G - 80 : F.G; const int first = ((F.G > 80 ? (int)blockIdx.x - 80 : (int)blockIdx.x)) * NWAVES + F.wave, stride = nconv * NWAVES;
            LAS float* scr = (LAS float*)(F.lds + F.wave * 16640);
            transpose_matrix(F, args.in[I_W_OUT], DM, DM, W_OUT, DM, DM, ColIdent{}, scr, first, stride);
            transpose_matrix(F, args.in[I_FFN_W13], 2 * DFF, DM, FFN13, DM, 2 * DFF, ColSwiglu{DFF}, scr, first, stride);
            transpose_matrix(F, args.in[I_FFN_W2], DM, DFF, FFN2, DFF, DM, ColIdent{}, scr, first, stride);
            for (int i = 0; i < 3; ++i) transpose_matrix(F, args.in[I_W_RKV] + (size_t)i * DM * DM, DM, DM, WRKV + (size_t)i * DM * DM, DM, DM, ColIdent{}, scr, first, stride);
            transpose_matrix(F, args.in[I_DECAY_W1], 96, DM, LORA1, DM, 256, ColIdent{}, scr, first, stride);
            transpose_matrix(F, args.in[I_A1], 96, DM, LORA1 + (size_t)256 * DM, DM, 256, ColIdent{}, scr, first, stride);
            transpose_matrix(F, args.in[I_G1], 256, DM, LORA1 + (size_t)512 * DM, DM, 256, ColIdent{}, scr, first, stride);
            transpose_matrix(F, args.in[I_DECAY_W2], DM, 96, LORA2, 256, DM, ColIdent{}, scr, first, stride);
            transpose_matrix(F, args.in[I_A2], DM, 96, LORA2 + (size_t)DM * 256, 256, DM, ColIdent{}, scr, first, stride);
            transpose_matrix(F, args.in[I_G2], DM, 256, LORA2 + (size_t)2 * DM * 256, 256, DM, ColIdent{}, scr, first, stride);
            transpose_matrix(F, args.in[I_W_O], DM, DM, WO, DM, DM, ColIdent{}, scr, first, stride);
        }
    }
    SEAM(2);
    PH(3) {
        for (int it = blockIdx.x * NTHR + F.tid; it < 2 * 2048 * 16; it += F.G * NTHR) {
            const int dq = it & 15, row = (it >> 4) & 2047, kv = it >> 15;
            const bf16_t* hr = HID + ((size_t)kv * 2048 + row) * 256; const float* w2 = args.in[I_CMP_W2] + (size_t)kv * 256 * 64 + dq * 4;
            f32x4 a = (f32x4){0.f, 0.f, 0.f, 0.f};
            for (int j = 0; j < 256; j += 2) { const unsigned hw = *(const unsigned*)(hr + j); a += bflo(hw) * *(const f32x4*)(w2 + (size_t)j * 64); a += bfhi(hw) * *(const f32x4*)(w2 + (size_t)(j + 1) * 64); }
            u32x2 o; o.x = pk2(a.x, a.y); o.y = pk2(a.z, a.w); *(u32x2*)(KVC + ((size_t)kv * 2048 + row) * 64 + dq * 4) = o;
        }
    }
    SEAM(3);
    PH(4) {
        for (int vb = blockIdx.x; vb < 256; vb += F.G) {
            const int bh = vb >> 5, p = vb & 31;
#pragma unroll 1
            for (int k = 0; k < 2; ++k) attn_unit_B(F, P, KVC, O, nullptr, bh >> 1, bh & 1, k == 0 ? 63 - p : p);
#pragma unroll 1
            for (int k = 0; k < 2; ++k) { const int id = 2 * vb + k; attn_unit_A(F, P, O, args.in[I_SINKS], id >> 7, (id >> 6) & 1, id & 63); }
        }
    }
    SEAM(4);
    PH(5) {
        OrderSingle S{(const char*)O, (const char*)W_OUT, DM * 2, DM * 2, 64, 8, 512, F.G, (int)blockIdx.x};
        EpiResF32 E{args.in[I_X], H};
        pg8::gemm_phase<EpiResF32, OrderSingle, false>(ring, DM * 2, 128, DM * 2, DM / 64, S, E);
    }
    SEAM(5);
    PH(6) { for (int m = F.gw; m < M; m += F.NGW) rms_row_to_bf16(H + (size_t)m * DM, args.in[I_FFN_NORM], XN + (size_t)m * DM, F.lane); }
    SEAM(6);
    PH(7) {
        OrderSingle S{(const char*)XN, (const char*)FFN13, DM * 2, DM * 2, 64, 2 * DFF / 256, 64 * (2 * DFF / 256), F.G, (int)blockIdx.x};
        EpiSwiglu E{ACT, DFF};
        pg8::gemm_phase<EpiSwiglu, OrderSingle, false>(ring, DM * 2, 128, DM * 2, DM / 64, S, E);
    }
    SEAM(7);
    PH(8) {
        OrderSingle S{(const char*)ACT, (const char*)FFN2, DFF * 2, DFF * 2, 64, 8, 512, F.G, (int)blockIdx.x};
        EpiResF32 E{H, H};
        pg8::gemm_phase<EpiResF32, OrderSingle, false>(ring, DFF * 2, 128, DFF * 2, DFF / 64, S, E);
    }
    SEAM(8);
    PH(9) {
        const float* g = args.in[I_ATTN_NORM] + DM; const float* mu = args.in[I_MU];
        for (int m0 = F.gw * 8; m0 < M; m0 += F.NGW * 8) {
            f32x4 hp[8], vn[8];
            const bool has_prev0 = (m0 % SEQ) != 0;
            if (has_prev0) { float prs; rms_row_load(H + (size_t)(m0 - 1) * DM, F.lane, hp, prs);
#pragma unroll
                for (int j = 0; j < 8; ++j) hp[j] = hp[j] * prs * *(const f32x4*)(g + 4 * F.lane + 256 * j);
            } else {
#pragma unroll
                for (int j = 0; j < 8; ++j) hp[j] = (f32x4){0.f, 0.f, 0.f, 0.f};
            }
#pragma unroll
            for (int j = 0; j < 8; ++j) vn[j] = *(const f32x4*)(H + (size_t)m0 * DM + 4 * F.lane + 256 * j);
            for (int q = 0; q < 8; ++q) {
                const int m = m0 + q;
                f32x4 v[8]; float ss = 0.f;
#pragma unroll
                for (int j = 0; j < 8; ++j) { v[j] = vn[j]; ss += (v[j].x * v[j].x + v[j].y * v[j].y) + (v[j].z * v[j].z + v[j].w * v[j].w); }
                if (q < 7) {
#pragma unroll
                    for (int j = 0; j < 8; ++j) vn[j] = *(const f32x4*)(H + (size_t)(m + 1) * DM + 4 * F.lane + 256 * j);
                }
                const float rs = __builtin_amdgcn_rsqf(scan::wave_sum_dpp(ss) * (1.0f / DM) + RMS_EPS);
                const float* g_ = opqp(g); const float* mu_ = opqp(mu);
#pragma unroll
                for (int j = 0; j < 8; ++j) {
                    const int col = 4 * F.lane + 256 * j; const f32x4 gg = *(const f32x4*)(g_ + col);
                    const f32x4 hn = v[j] * rs * gg; const f32x4 xx = hp[j] - hn; hp[j] = hn;
#pragma unroll
                    for (int i = 0; i < 6; ++i) { const f32x4 mm = *(const f32x4*)(mu_ + (size_t)i * DM + col); const f32x4 y = hn + xx * mm;
                        u32x2 w; w.x = pk2(y.x, y.y); w.y = pk2(y.z, y.w); *(u32x2*)(XS + ((size_t)i * M + m) * DM + col) = w; }
                }
            }
        }
    }
    SEAM(9);
    PH(10) {
        OrderMulti S{};
        for (int g = 0; g < 6; ++g) { S.A[g] = (const char*)(XS + (size_t)g * M * DM); S.Bt[g] = g < 3 ? (const char*)(WRKV + (size_t)g * DM * DM) : (const char*)(LORA1 + (size_t)(g - 3) * 256 * DM); S.nN[g] = g < 3 ? 8 : 1; }
        S.start[0] = 0; for (int g = 0; g < 6; ++g) S.start[g + 1] = S.start[g] + 64 * S.nN[g];
        S.lda = DM * 2; S.ldb = DM * 2; S.ng = 6; S.nwg = S.start[6]; S.G = F.G; S.c = (int)blockIdx.x;
        EpiRkvLora1 E{RKV, L1};
        pg8::gemm_phase<EpiRkvLora1, OrderMulti, false>(ring, DM * 2, 128, DM * 2, DM / 64, S, E);
    }
    SEAM(10);
    PH(11) {
        OrderMulti S{};
        for (int g = 0; g < 3; ++g) { S.A[g] = (const char*)(L1 + (size_t)g * M * 256); S.Bt[g] = (const char*)(LORA2 + (size_t)g * DM * 256); S.nN[g] = 8; }
        for (int g = 3; g < 6; ++g) { S.A[g] = S.A[0]; S.Bt[g] = S.Bt[0]; S.nN[g] = 0; }
        S.start[0] = 0; for (int g = 0; g < 6; ++g) S.start[g + 1] = S.start[g] + 64 * S.nN[g];
        S.lda = 256 * 2; S.ldb = 256 * 2; S.ng = 3; S.nwg = S.start[3]; S.G = F.G; S.c = (int)blockIdx.x;
        EpiLora2 E{DEC, AA, GG, args.in[I_DECAY_W0], args.in[I_A0]};
        pg8::gemm_phase<EpiLora2, OrderMulti, false>(ring, 256 * 2, 128, 256 * 2, 4, S, E);
    }
    SEAM(11);
    PH(12) {
        const unsigned long long pa = phase_scan(F, RKV, DEC, AA, args.in[I_K_K], args.in[I_K_A], YRAW, args.in[I_MOE_W13], args.in[I_MOE_W2], (unsigned char*)MOE13, (unsigned char*)MOE2);
#ifdef PROBE_SCAN
        if (blockIdx.x == 0 && (F.tid == 0 || F.tid == 256)) { const unsigned long long t1 = __builtin_amdgcn_s_memrealtime(); if ((PROBE_SCAN == 1 && F.tid == 0) || (PROBE_SCAN == 2 && F.tid == 256)) while (__builtin_amdgcn_s_memrealtime() - t1 < 4ull * pa) __builtin_amdgcn_s_sleep(8); }
#else
        (void)pa;
#endif
    }
    SEAM(12);
    PH(13) {
        const float* lnw = args.in[I_LN_W]; const float* lnb = args.in[I_LN_B]; const float* rk = args.in[I_R_K]; const float* kaw = args.in[I_K_A];
        for (int m = F.gw; m < M; m += F.NGW) {
#pragma unroll
            for (int ps = 0; ps < 4; ++ps) {
                const int ch = ps * 512 + F.lane * 8; const size_t o = (size_t)m * DM + ch;
                const u32x4 yy = *(const u32x4*)(YRAW + o);
                const u32x4 aa = *(const u32x4*)(AA + o);
                const u32x4 rr = *(const u32x4*)(RKV + o), kk = *(const u32x4*)(RKV + (size_t)M * DM + o), vv = *(const u32x4*)(RKV + (size_t)2 * M * DM + o), gg = *(const u32x4*)(GG + o);
                float y[8] = {bflo(yy.x), bfhi(yy.x), bflo(yy.y), bfhi(yy.y), bflo(yy.z), bfhi(yy.z), bflo(yy.w), bfhi(yy.w)}, a[8] = {bflo(aa.x), bfhi(aa.x), bflo(aa.y), bfhi(aa.y), bflo(aa.z), bfhi(aa.z), bflo(aa.w), bfhi(aa.w)};
                const unsigned rw[4] = {rr.x, rr.y, rr.z, rr.w}, kw[4] = {kk.x, kk.y, kk.z, kk.w}, vw[4] = {vv.x, vv.y, vv.z, vv.w}, gw4[4] = {gg.x, gg.y, gg.z, gg.w};
                float r[8], k[8], v[8], g[8];
#pragma unroll
                for (int i = 0; i < 4; ++i) { r[2 * i] = bflo(rw[i]); r[2 * i + 1] = bfhi(rw[i]); k[2 * i] = bflo(kw[i]); k[2 * i + 1] = bfhi(kw[i]); v[2 * i] = bflo(vw[i]); v[2 * i + 1] = bfhi(vw[i]); g[2 * i] = bflo(gw4[i]); g[2 * i + 1] = bfhi(gw4[i]); }
                float s = 0.f, bs = 0.f;
#pragma unroll
                for (int i = 0; i < 8; ++i) { s += y[i]; bs += r[i] * (k[i] * (1.0f + (a[i] - 1.0f) * kaw[ch + i])) * rk[ch + i]; }
                s += scan::dpp_f<0xB1>(s); s += scan::dpp_f<0x4E>(s); s += scan::dpp_f<0x141>(s);
                bs += scan::dpp_f<0xB1>(bs); bs += scan::dpp_f<0x4E>(bs); bs += scan::dpp_f<0x141>(bs);
                const float mean = s * (1.0f / 64.0f); float q = 0.f;
#pragma unroll
                for (int i = 0; i < 8; ++i) { y[i] -= mean; q += y[i] * y[i]; }
                q += scan::dpp_f<0xB1>(q); q += scan::dpp_f<0x4E>(q); q += scan::dpp_f<0x141>(q);
                const float rstd = 1.0f / sqrtf(q * (1.0f / 64.0f) + GN_EPS);
                float out[8];
#pragma unroll
                for (int i = 0; i < 8; ++i) out[i] = ((y[i] * rstd) * lnw[ch + i] + lnb[ch + i] + bs * v[i]) * g[i];
                u32x4 w; w.x = pk2(out[0], out[1]); w.y = pk2(out[2], out[3]); w.z = pk2(out[4], out[5]); w.w = pk2(out[6], out[7]);
                *(u32x4*)(YG + o) = w;
            }
        }
    }
    SEAM(13);
    PH(14) {
        OrderSingle S{(const char*)YG, (const char*)WO, DM * 2, DM * 2, 64, 8, 512, F.G, (int)blockIdx.x};
        EpiResF32 E{H, H};
        pg8::gemm_phase<EpiResF32, OrderSingle, false>(ring, DM * 2, 128, DM * 2, DM / 64, S, E);
    }
    SEAM(14);
    PH(15) {
        LAS int* t_e = (LAS int*)(F.lds + 65536);
        LAS float* t_w = (LAS float*)(F.lds + 65536 + 512);
        LAS int* t_p = (LAS int*)(F.lds + 65536 + 1024);
        LAS unsigned char* rwl = F.lds;
        const float* g = args.in[I_FFN_NORM] + DM; const float* rw = args.in[I_ROUTER];
        for (int idx = F.tid; idx < 4096; idx += NTHR) {
            const int chn = idx >> 1, half = idx & 1; const int j = chn >> 8, l = (chn & 255) >> 2, e4 = chn & 3;
            *(LAS f32x4*)(rwl + ((2 * (4 * j + e4) + half) * 64 + l) * 16) = *(const f32x4*)(rw + (size_t)idx * 4);
        }
        __syncthreads();
        for (int base = blockIdx.x * 64; base < M; base += F.G * 64) {
            f32x4 vn[8];
#pragma unroll
            for (int j = 0; j < 8; ++j) vn[j] = *(const f32x4*)(H + (size_t)(base + F.wave * 8) * DM + 4 * F.lane + 256 * j);
            for (int qq = 0; qq < 8; ++qq) {
                const int lt = F.wave * 8 + qq, m = base + lt;
                f32x4 v[8]; float ss = 0.f;
#pragma unroll
                for (int j = 0; j < 8; ++j) { v[j] = vn[j]; ss += (v[j].x * v[j].x + v[j].y * v[j].y) + (v[j].z * v[j].z + v[j].w * v[j].w); }
                if (qq < 7) {
#pragma unroll
                    for (int j = 0; j < 8; ++j) vn[j] = *(const f32x4*)(H + (size_t)(m + 1) * DM + 4 * F.lane + 256 * j);
                }
                const float rs = __builtin_amdgcn_rsqf(scan::wave_sum_dpp(ss) * (1.0f / DM) + RMS_EPS);
                float lg[8] = {0.f, 0.f, 0.f, 0.f, 0.f, 0.f, 0.f, 0.f};
#pragma unroll
                for (int j = 0; j < 8; ++j) {
                    const int col = 4 * F.lane + 256 * j; const f32x4 gg = *(const f32x4*)(g + col); const f32x4 y = v[j] * rs * gg;
                    *(unsigned*)((unsigned char*)XN + (size_t)m * DM + col) = pk4_fp8(y.x, y.y, y.z, y.w);
#pragma unroll
                    for (int e4 = 0; e4 < 4; ++e4) { const f32x4 r0 = *(const LAS f32x4*)(rwl + ((2 * (4 * j + e4)) * 64 + F.lane) * 16), r1 = *(const LAS f32x4*)(rwl + ((2 * (4 * j + e4) + 1) * 64 + F.lane) * 16); const float yy = y[e4];
                        lg[0] += yy * r0.x; lg[1] += yy * r0.y; lg[2] += yy * r0.z; lg[3] += yy * r0.w; lg[4] += yy * r1.x; lg[5] += yy * r1.y; lg[6] += yy * r1.z; lg[7] += yy * r1.w; }
                }
#pragma unroll
                for (int e = 0; e < 8; ++e) lg[e] = scan::wave_sum_dpp(lg[e]);
                if (F.lane == 0) {
                    int i0 = 0; float v0 = lg[0];
#pragma unroll
                    for (int e = 1; e < 8; ++e) if (lg[e] > v0) { v0 = lg[e]; i0 = e; }
                    int i1 = -1; float v1 = -3.0e38f;
#pragma unroll
                    for (int e = 0; e < 8; ++e) if (e != i0 && (i1 < 0 || lg[e] > v1)) { v1 = lg[e]; i1 = e; }
                    const float w1 = 1.0f / (1.0f + expf(v0 - v1)), w0 = 1.0f - w1;
                    t_e[lt * 2] = i0; t_e[lt * 2 + 1] = i1; t_w[lt * 2] = w0; t_w[lt * 2 + 1] = w1;
                }
            }
            __syncthreads();
            if (F.wave == 0) {
                const int lane = F.lane; const int ea = t_e[lane], eb = t_e[64 + lane];
                const unsigned long long below = (1ull << lane) - 1ull;
                int pa = 0, pb = 0, mycnt = 0, ra = 0, rb = 0, na_sel = 0;
#pragma unroll
                for (int e = 0; e < 8; ++e) {
                    const unsigned long long ma = __ballot(ea == e), mb = __ballot(eb == e);
                    const int na = __popcll(ma), nb = __popcll(mb);
                    if (lane == e) mycnt = na + nb;
                    if (ea == e) ra = __popcll(ma & below);
                    if (eb == e) { rb = __popcll(mb & below); na_sel = na; }
                }
                int basep = 0;
                if (lane < 8 && mycnt) basep = (int)__hip_atomic_fetch_add(ctl + CW_MOECNT + 64 * lane, (unsigned)mycnt, RLX_AGENT);
#pragma unroll
                for (int e = 0; e < 8; ++e) { const int be = __builtin_amdgcn_readlane(basep, e); if (ea == e) pa = be + ra; if (eb == e) pb = be + na_sel + rb; }
                t_p[lane] = pa; t_p[64 + lane] = pb;
            }
            __syncthreads();
            if (F.tid < 128) { const int lt = F.tid >> 1, k = F.tid & 1, m = base + lt; const int e = t_e[F.tid], pos = t_p[F.tid];
                ROWTOK[e * M + pos] = m; TOKSLOT[m * 4 + k * 2] = e; TOKSLOT[m * 4 + k * 2 + 1] = pos; ((float*)TOKSLOT)[(size_t)M * 4 + m * 2 + k] = t_w[F.tid]; }
            __syncthreads();
        }
    }
    SEAM(15);
#define MOE_TABLE() do { if (F.tid == 0) { int ts_ = 0; for (int e = 0; e < 8; ++e) { const int ce = (int)__hip_atomic_load(ctl + CW_MOECNT + 64 * e, RLX_AGENT); moetab[16 + e] = ce; moetab[e] = ts_; ts_ += (ce + 255) >> 8; } moetab[8] = ts_; } __syncthreads(); } while (0)
    LAS int* moetab = (LAS int*)(F.lds + MISC_OFF + 256);
    PH(16) {
        MOE_TABLE();
        OrderMoe SM; SM.tab = moetab;
        SM.A = (const char*)XN; SM.Bt = (const char*)MOE13; SM.rowtok = ROWTOK; SM.lda = DM; SM.ldb = DM; SM.bstride = (size_t)2 * DFFE * DM; SM.nN = 2 * DFFE / 256;
        SM.nwg = moetab[8] * SM.nN; SM.G = F.G; SM.c = (int)blockIdx.x; SM.gather = true; SM.xcdrows = false;
        EpiSwiglu8 E{(unsigned char*)ACT, DFFE};
        pg8::gemm_phase<EpiSwiglu8, OrderMoe, true, true>(ring, DM, 128, DM, DM / 128, SM, E, 0x7f7f7f7f, 0x79797979);
    }
    SEAM(16);
    PH(17) {
        MOE_TABLE();
        OrderMoe SM; SM.tab = moetab;
        SM.A = (const char*)ACT; SM.Bt = (const char*)MOE2; SM.rowtok = ROWTOK; SM.lda = DFFE; SM.ldb = DFFE; SM.bstride = (size_t)DM * DFFE; SM.nN = 8;
        SM.nwg = moetab[8] * SM.nN; SM.G = F.G; SM.c = (int)blockIdx.x; SM.gather = false; SM.xcdrows = (F.G == 256);
        EpiBf16Out E{(bf16_t*)Y2};
        pg8::gemm_phase<EpiBf16Out, OrderMoe, false, true>(ring, DFFE, 128, DFFE, DFFE / 128, SM, E, 0x7f7f7f7f, 0x78787878);
    }
    SEAM(17);
    PH(18) {
        MOE_TABLE();
        const float* g = args.in[I_FINAL_NORM];
        for (int m = F.gw; m < M; m += F.NGW) {
            const int e0 = TOKSLOT[m * 4], p0 = TOKSLOT[m * 4 + 1], e1 = TOKSLOT[m * 4 + 2], p1 = TOKSLOT[m * 4 + 3];
            const float w0 = ((const float*)TOKSLOT)[(size_t)M * 4 + m * 2], w1 = ((const float*)TOKSLOT)[(size_t)M * 4 + m * 2 + 1];
            const int ts0 = moetab[e0], ts1 = moetab[e1];
            const bf16_t* y0 = (const bf16_t*)Y2 + ((size_t)ts0 * 256 + p0) * DM; const bf16_t* y1 = (const bf16_t*)Y2 + ((size_t)ts1 * 256 + p1) * DM; const float* hr = H + (size_t)m * DM;
            f32x4 v[8]; float s = 0.f;
#pragma unroll
            for (int j = 0; j < 8; ++j) { const int col = 4 * F.lane + 256 * j; const u32x2 q0 = *(const u32x2*)(y0 + col), q1 = *(const u32x2*)(y1 + col);
                const f32x4 f0 = (f32x4){bflo(q0.x), bfhi(q0.x), bflo(q0.y), bfhi(q0.y)}, f1 = (f32x4){bflo(q1.x), bfhi(q1.x), bflo(q1.y), bfhi(q1.y)};
                v[j] = *(const f32x4*)(hr + col) + (w0 * f0 + w1 * f1);
                s += (v[j].x * v[j].x + v[j].y * v[j].y) + (v[j].z * v[j].z + v[j].w * v[j].w); }
            const float rstd = 1.0f / sqrtf(wave_sum(s) * (1.0f / DM) + RMS_EPS);
#pragma unroll
            for (int j = 0; j < 8; ++j) { const int col = 4 * F.lane + 256 * j; *(f32x4*)(args.out + (size_t)m * DM + col) = v[j] * rstd * *(const f32x4*)(g + col); }
        }
    }
    if (PROBE_MASK != 0u && blockIdx.x == 0 && F.tid == 0) { if (PROBE_ON(18)) probe_acc += __builtin_amdgcn_s_memrealtime() - probe_t0; const unsigned long long t1 = __builtin_amdgcn_s_memrealtime(); while (__builtin_amdgcn_s_memrealtime() - t1 < 4ull * probe_acc) __builtin_amdgcn_s_sleep(8); }
#undef IN
#undef SEAM
}

extern "C" void kernel_launch(void* const* d_in, const int* in_sizes, int n_in, void* d_out, int out_size, void* d_ws, size_t ws_size, hipStream_t stream) {
    static int grid = 0;
    if (grid == 0) {
        if (n_in != 33 || out_size != M * DM || ws_size < WS_END) { fprintf(stderr, "kernel_launch: unexpected shapes (n_in %d, out %d, ws %zu < %zu)\n", n_in, out_size, ws_size, (size_t)WS_END); grid = -1; return; }
        int dev = 0, cus = 0, per_cu = 0;
        if (hipGetDevice(&dev) != hipSuccess || hipDeviceGetAttribute(&cus, hipDeviceAttributeMultiprocessorCount, dev) != hipSuccess) { grid = -1; return; }
        if (hipFuncSetAttribute((const void*)mk_fwd, hipFuncAttributeMaxDynamicSharedMemorySize, LDS_BYTES) != hipSuccess) { fprintf(stderr, "kernel_launch: hipFuncSetAttribute failed\n"); grid = -1; return; }
        if (hipOccupancyMaxActiveBlocksPerMultiprocessor(&per_cu, (const void*)mk_fwd, NTHR, LDS_BYTES) != hipSuccess || per_cu < 1) fprintf(stderr, "kernel_launch: occupancy query reports %d\n", per_cu);
        (void)hipGetLastError();
        grid = cus < 256 ? cus : 256;
    }
    if (grid < 0) return;
    if (hipMemsetAsync((char*)d_ws + WS_CTL, 0, CTL_ZERO_BYTES, stream) != hipSuccess) return;
    Args a{};
    for (int i = 0; i < 33; ++i) a.in[i] = (const float*)d_in[i];
    a.out = (float*)d_out; a.ws = (unsigned char*)d_ws; a.pad = 0;
    if (MK_N_LAUNCHES == 1) {
        a.ph_lo = 0; a.ph_hi = NPHASE; a.use_bar = 1;
        hipLaunchKernelGGL(mk_fwd, dim3(grid), dim3(NTHR), LDS_BYTES, stream, a);
    } else {
        for (int p = 0; p < NPHASE; ++p) { a.ph_lo = p; a.ph_hi = p + 1; a.use_bar = 0; hipLaunchKernelGGL(mk_fwd, dim3(grid), dim3(NTHR), LDS_BYTES, stream, a); }
    }
}
```

```cpp
#include <hip/hip_runtime.h>
#include <cstdio>
#include <cstdint>

#define GAS __attribute__((address_space(1)))
#define LAS __attribute__((address_space(3)))
typedef unsigned short bf16_t;
typedef short bf16x8 __attribute__((ext_vector_type(8)));
typedef short s16x4 __attribute__((ext_vector_type(4)));
typedef float f32x4 __attribute__((ext_vector_type(4)));
typedef float f32x2 __attribute__((ext_vector_type(2)));
typedef float f32x16 __attribute__((ext_vector_type(16)));
typedef unsigned u32x4 __attribute__((ext_vector_type(4)));
typedef unsigned u32x2 __attribute__((ext_vector_type(2)));
typedef __bf16 bf16x2_t __attribute__((ext_vector_type(2)));
typedef int i32x8 __attribute__((ext_vector_type(8)));
typedef int i32x4 __attribute__((ext_vector_type(4)));
#define DI __device__ __forceinline__

#ifndef MK_N_LAUNCHES
#define MK_N_LAUNCHES 1
#endif

constexpr int BATCH = 4, SEQ = 4096, DM = 2048, M = BATCH * SEQ;
constexpr int NP = 3328;
constexpr int IN_COLS = 3120;
constexpr int C_QA = 0, C_KA = 1024, C_VA = 1152, C_QB = 1280, C_KCMP = 2304, C_VCMP = 2432, C_KSEL = 2560, C_VSEL = 2688, C_KWIN = 2816, C_VWIN = 2944, C_GATE = 3072;
constexpr int DFF = 5632, DFFE = 7168, NEXP = 8;
constexpr float RMS_EPS = 1e-5f, GN_EPS = 64e-5f;
constexpr float LOG2E = 1.4426950408889634f;
constexpr float QSCALE = 0.125f * LOG2E;
constexpr int NWAVES = 8, NTHR = 512;
constexpr int MOE_ROWS = 2 * M + NEXP * 256;

constexpr size_t MiB = 1u << 20;
constexpr size_t al(size_t x) { return (x + 0xFFFFF) & ~(size_t)0xFFFFF; }
constexpr size_t WS_CTL = 0, CTL_ZERO_BYTES = 1 * MiB;
constexpr size_t WS_W_IN = 1 * MiB;
constexpr size_t WS_W_OUT = WS_W_IN + al((size_t)NP * DM * 2);
constexpr size_t WS_CMPW1 = WS_W_OUT + al((size_t)DM * DM * 2);
constexpr size_t WS_FFN13 = WS_CMPW1 + al((size_t)2 * 256 * 2048 * 2);
constexpr size_t WS_FFN2 = WS_FFN13 + al((size_t)2 * DFF * DM * 2);
constexpr size_t WS_WRKV = WS_FFN2 + al((size_t)DM * DFF * 2);
constexpr size_t WS_LORA1 = WS_WRKV + al((size_t)3 * DM * DM * 2);
constexpr size_t WS_LORA2 = WS_LORA1 + al((size_t)3 * 256 * DM * 2);
constexpr size_t WS_WO = WS_LORA2 + al((size_t)3 * DM * 256 * 2);
constexpr size_t WS_MOE13 = WS_WO + al((size_t)DM * DM * 2);
constexpr size_t WS_MOE2 = WS_MOE13 + al((size_t)NEXP * 2 * DFFE * DM * 2);
constexpr size_t WS_XN = WS_MOE2 + al((size_t)NEXP * DM * DFFE * 2);
constexpr size_t WS_P = WS_XN + al((size_t)M * DM * 2);
constexpr size_t WS_ROPE = WS_P + al((size_t)(M + 64) * NP * 2);
constexpr size_t WS_CMPB = WS_ROPE + al((size_t)M * 64 * 4);
constexpr size_t WS_HID = WS_CMPB + MiB;
constexpr size_t WS_KVC = WS_HID + al((size_t)2 * 2048 * 256 * 2);
constexpr size_t WS_O = WS_KVC + al((size_t)2 * 2048 * 64 * 2);
constexpr size_t WS_H = WS_O + al((size_t)M * DM * 2);
constexpr size_t WS_ACT = WS_H + al((size_t)M * DM * 4);
constexpr size_t WS_XS = WS_ACT + al((size_t)MOE_ROWS * DFFE * 2);
constexpr size_t WS_RKV = WS_XS + al((size_t)6 * M * DM * 2);
constexpr size_t WS_L1 = WS_RKV + al((size_t)3 * M * DM * 2);
constexpr size_t WS_DEC = WS_L1 + al((size_t)3 * M * 256 * 2);
constexpr size_t WS_AA = WS_DEC + al((size_t)M * DM * 4);
constexpr size_t WS_GG = WS_AA + al((size_t)M * DM * 4);
constexpr size_t WS_YRAW = WS_GG + al((size_t)M * DM * 2);
constexpr size_t WS_YG = WS_YRAW + al((size_t)M * DM * 4);
constexpr size_t WS_ROWTOK = WS_YG + al((size_t)M * DM * 2);
constexpr size_t WS_TOKSLOT = WS_ROWTOK + al((size_t)NEXP * M * 4);
constexpr size_t WS_Y2 = WS_TOKSLOT + al((size_t)M * 16);
constexpr size_t WS_END = WS_Y2 + al((size_t)MOE_ROWS * DM * 4);
constexpr int CW_BAR = 0;
constexpr int CW_MOECNT = 4096;

constexpr int RING_BYTES = 131072, LDSCTL_OFF = 135168, MISC_OFF = LDSCTL_OFF + 320, LDS_BYTES = 147456;

#define RLX_AGENT __ATOMIC_RELAXED, __HIP_MEMORY_SCOPE_AGENT
DI unsigned f2bf(float f) { unsigned u = __builtin_bit_cast(unsigned, f); return (u + 0x7fffu + ((u >> 16) & 1u)) >> 16; }
DI unsigned pk2(float lo, float hi) { f32x2 v = {lo, hi}; bf16x2_t b = __builtin_convertvector(v, bf16x2_t); return __builtin_bit_cast(unsigned, b); }
DI unsigned pk4_fp8(float a, float b, float c, float d) { int p = __builtin_amdgcn_cvt_pk_fp8_f32(a, b, 0, false); p = __builtin_amdgcn_cvt_pk_fp8_f32(c, d, p, true); return (unsigned)p; }
DI float bf2f(unsigned short b) { return __builtin_bit_cast(float, ((unsigned)b) << 16); }
DI float bflo(unsigned w) { return __builtin_bit_cast(float, w << 16); }
DI float bfhi(unsigned w) { return __builtin_bit_cast(float, w & 0xffff0000u); }
DI float wave_sum(float v) {
#pragma unroll
    for (int o = 1; o < 64; o <<= 1) v += __shfl_xor(v, o);
    return v;
}
DI int opq(int x) { asm volatile("" : "+v"(x)); return x; }
DI const float* opqp(const float* p) { asm volatile("" : "+s"(p)); return p; }
DI float ex2(float x) { return __builtin_amdgcn_exp2f(x); }
DI float sigmoidf_(float x) { return __builtin_amdgcn_rcpf(1.0f + __expf(-x)); }
DI float siluf_(float x) { return x * __builtin_amdgcn_rcpf(1.0f + __expf(-x)); }
DI float tanhf_(float x) { return 1.0f - 2.0f * __builtin_amdgcn_rcpf(__expf(2.0f * x) + 1.0f); }

#define XB_TMO      128
#define XB_XCNT(j)  (256  + 64 * (j))
#define XB_XSUB(j)  (1280 + 64 * (j))
#define XB_XGEN(j)  (2304 + 64 * (j))
#define XB_TOP      3328
#define XB_TOPGEN   3392
#define XCD_BAR_WORDS 3456
#define XB_SPIN_CAP (1u << 22)
DI unsigned xb_ld(unsigned* p)              { return __hip_atomic_load(p, __ATOMIC_RELAXED, __HIP_MEMORY_SCOPE_AGENT); }
DI unsigned xb_add(unsigned* p, unsigned v) { return __hip_atomic_fetch_add(p, v, __ATOMIC_RELAXED, __HIP_MEMORY_SCOPE_AGENT); }
DI unsigned xb_xcc_id() { return (unsigned)__builtin_amdgcn_s_getreg((3 << 11) | 20) & 0xFu; }
#define XB_SPIN(cond, bar) do { unsigned _sp = 0; while (cond) { __builtin_amdgcn_s_sleep(1); \
    if ((++_sp & 255u) == 0u) { if (xb_ld(&(bar)[XB_TMO])) break; if (_sp > XB_SPIN_CAP) { atomicAdd(&(bar)[XB_TMO], 1u); break; } } } } while (0)
struct XcdBarrier { unsigned* bar; unsigned x; volatile LAS unsigned* st; };
DI XcdBarrier xcd_barrier_post(unsigned* bar, volatile LAS unsigned* st) {
    XcdBarrier b; b.bar = bar; b.x = xb_xcc_id(); b.st = st;
    if (threadIdx.x == 0) (void)xb_add(&bar[XB_XCNT(b.x)], 1u);
    return b;
}
DI void xcd_barrier_complete(unsigned* bar, unsigned x, unsigned& nloc, unsigned& nx) {
    const unsigned G = gridDim.x * gridDim.y * gridDim.z;
    unsigned sum, cnt, mine, sp = 0u;
    for (;;) {
        sum = 0u; cnt = 0u; mine = 0u;
#pragma unroll
        for (unsigned j = 0; j < 16; ++j) { const unsigned c = xb_ld(&bar[XB_XCNT(j)]); sum += c; cnt += (c > 0u) ? 1u : 0u; mine = (j == x) ? c : mine; }
        if (sum == G) break;
        __builtin_amdgcn_s_sleep(1);
        if ((++sp & 255u) == 0u) { if (xb_ld(&bar[XB_TMO])) break; if (sp > XB_SPIN_CAP) { atomicAdd(&bar[XB_TMO], 1u); break; } }
    }
    nloc = mine > 0u ? mine : 1u; nx = cnt > 0u ? cnt : 1u;
}
DI void xcd_barrier(const XcdBarrier& b) {
    asm volatile("s_waitcnt vmcnt(0)" ::: "memory");
    __syncthreads();
    if (threadIdx.x == 0) {
        unsigned* bar = b.bar;
        __builtin_amdgcn_s_waitcnt(0);
        unsigned nloc = b.st[0], nx = b.st[1];
        if (nloc == 0u) { xcd_barrier_complete(bar, b.x, nloc, nx); b.st[0] = nloc; b.st[1] = nx; }
        const unsigned old = xb_add(&bar[XB_XSUB(b.x)], 1u);
        const unsigned gen = old / nloc;
        if (old + 1u == (gen + 1u) * nloc) {
            __builtin_amdgcn_fence(__ATOMIC_RELEASE, "agent");
            asm volatile("s_waitcnt vmcnt(0)" ::: "memory");
            const unsigned og = xb_add(&bar[XB_TOP], 1u);
            const unsigned tg = og / nx;
            if (og + 1u == (tg + 1u) * nx) xb_add(&bar[XB_TOPGEN], 1u);
            else XB_SPIN(xb_ld(&bar[XB_TOPGEN]) == tg, bar);
            __builtin_amdgcn_fence(__ATOMIC_ACQUIRE, "agent");
            xb_add(&bar[XB_XGEN(b.x)], 1u);
            asm volatile("s_waitcnt vmcnt(0)" ::: "memory");
        } else {
            XB_SPIN(xb_ld(&bar[XB_XGEN(b.x)]) == gen, bar);
            __builtin_amdgcn_fence(__ATOMIC_ACQUIRE, "agent");
            asm volatile("s_waitcnt vmcnt(0)" ::: "memory");
        }
    }
    __syncthreads();
}

namespace pg8 {
constexpr int BM = 256, BK = 64, HALF = 128, HTB = HALF * BK * 2, STAGE_BYTES = 8 * HTB, NXCD = 8, WGM = 4;
__host__ __device__ __forceinline__ int lds_byte(int r, int c) { const int st = (r >> 4) * 2 + (c >> 5), rr = r & 15, cc = c & 31, ob = rr * 64 + cc * 2; return st * 1024 + (ob ^ (((ob >> 9) & 1) << 5)); }
__host__ __device__ __forceinline__ void stage_rc(int b, int& R, int& C) { const int st = b / 1024, sb = b % 1024, swz = sb ^ (((sb >> 9) & 1) << 5); R = (st >> 1) * 16 + swz / 64; C = (st & 1) * 32 + (swz % 64) / 2; }
__host__ __device__ __forceinline__ int perm32(int rho) { const int n = rho >> 4, i = rho & 15; return 8 * (i >> 2) + 4 * n + (i & 3); }

struct Unit { const char* a; const char* b; int pm, pn, g; unsigned ka; };

DI int xcd_remap(int L, int nwg) { const int q = nwg / NXCD, r = nwg % NXCD, xcd = L % NXCD, off = L / NXCD; return (xcd < r ? xcd * (q + 1) : r * (q + 1) + (xcd - r) * q) + off; }
DI void tile_map(int idx, int nM, int nN, int& pm, int& pn) { const int nig = WGM * nN, gid = idx / nig, fm = gid * WGM, gsz = (nM - fm) < WGM ? (nM - fm) : WGM; pm = fm + ((idx % nig) % gsz); pn = (idx % nig) / gsz; }

template <class Epi, class Sched, bool GATHER, bool FP8 = false>
DI void gemm_phase(LAS unsigned char* lds, const unsigned lda, const unsigned ka, const unsigned ldb, const int nt, const Sched& S, const Epi& E, const int scaleA = 0x7f7f7f7f, const int scaleB = 0x7f7f7f7f) {
    const int tid = threadIdx.x, wid = __builtin_amdgcn_readfirstlane(tid >> 6), lane = tid & 63, wr = wid >> 2, wc = wid & 3, fr = lane & 15, fq = lane >> 4;
    int Rr[2], Cc[2];
    unsigned vB[2], vA[2][2], vN[2][2];
#pragma unroll
    for (int i = 0; i < 2; ++i) { stage_rc(tid * 16 + i * 8192, Rr[i], Cc[i]); const int Rb = (Rr[i] & ~31) + perm32(Rr[i] & 31); vB[i] = (unsigned)Rb * ldb + (unsigned)Cc[i] * 2u; }
    const size_t kb = (size_t)(BK * 2);
    const size_t hB = (size_t)HALF * ldb;
    const unsigned ldsw = (unsigned)wid * 1024u;
    const int aoff = lds_byte(wr * 64 + fr, fq * 8), boff = lds_byte(wc * 32 + fr, fq * 8);
#define PG8_SA(b, h) (((b) * 2 + (h)) * HTB)
#define PG8_SB(b, h) ((4 + (b) * 2 + (h)) * HTB)
#define PG8_STAGE(bufoff, gbase, v0, v1) do { \
        __builtin_amdgcn_global_load_lds((const unsigned*)((const char*)(gbase) + (v0)), (LAS unsigned*)(lds + (bufoff) + ldsw), 16, 0, 0); \
        __builtin_amdgcn_global_load_lds((const unsigned*)((const char*)(gbase) + (v1)), (LAS unsigned*)(lds + (bufoff) + ldsw + 8192), 16, 0, 0); } while (0)
#define PG8_LDA(dst, b, h) do { _Pragma("unroll") for (int m = 0; m < 4; ++m) { const i32x4 f0_ = *(const LAS i32x4*)(lds + PG8_SA(b, h) + aoff + m * 2048), f1_ = *(const LAS i32x4*)(lds + PG8_SA(b, h) + aoff + m * 2048 + 1024); \
        dst[m] = __builtin_shufflevector(f0_, f1_, 0, 1, 2, 3, 4, 5, 6, 7); } } while (0)
#define PG8_LDB(dst, b, h) do { _Pragma("unroll") for (int n = 0; n < 2; ++n) { const i32x4 f0_ = *(const LAS i32x4*)(lds + PG8_SB(b, h) + boff + n * 2048), f1_ = *(const LAS i32x4*)(lds + PG8_SB(b, h) + boff + n * 2048 + 1024); \
        dst[n] = __builtin_shufflevector(f0_, f1_, 0, 1, 2, 3, 4, 5, 6, 7); } } while (0)
#define PG8_MMA(ai, bj, At, Bt) do { __builtin_amdgcn_s_setprio(1); \
        if constexpr (FP8) { _Pragma("unroll") for (int m = 0; m < 4; ++m) _Pragma("unroll") for (int n = 0; n < 2; ++n) \
            asm volatile("v_mfma_scale_f32_16x16x128_f8f6f4 %0, %1, %2, %0, %3, %4 op_sel_hi:[0,0,0]" : "+v"(acc[ai][bj][m][n]) : "v"(Bt[n]), "v"(At[m]), "v"(scaleB), "v"(scaleA)); } \
        else { _Pragma("unroll") for (int m = 0; m < 4; ++m) _Pragma("unroll") for (int n = 0; n < 2; ++n) { \
            acc[ai][bj][m][n] = __builtin_amdgcn_mfma_f32_16x16x32_bf16(__builtin_bit_cast(bf16x8, __builtin_shufflevector(Bt[n], Bt[n], 0, 1, 2, 3)), __builtin_bit_cast(bf16x8, __builtin_shufflevector(At[m], At[m], 0, 1, 2, 3)), acc[ai][bj][m][n], 0, 0, 0); \
            acc[ai][bj][m][n] = __builtin_amdgcn_mfma_f32_16x16x32_bf16(__builtin_bit_cast(bf16x8, __builtin_shufflevector(Bt[n], Bt[n], 4, 5, 6, 7)), __builtin_bit_cast(bf16x8, __builtin_shufflevector(At[m], At[m], 4, 5, 6, 7)), acc[ai][bj][m][n], 0, 0, 0); } } __builtin_amdgcn_s_setprio(0); } while (0)
#define PG8_WAIT_V(n) asm volatile("s_waitcnt vmcnt(" #n ")" ::: "memory")
#define PG8_WAIT_L(n) asm volatile("s_waitcnt lgkmcnt(" #n ")" ::: "memory")
#define PG8_BAR __builtin_amdgcn_s_barrier()
#define PG8_SCHED __builtin_amdgcn_sched_barrier(0)
    Unit cur, nxt; int ui = 0;
    if (!S.next(0, cur)) return;
#pragma unroll
    for (int h = 0; h < 2; ++h)
#pragma unroll
        for (int i = 0; i < 2; ++i) {
            if constexpr (GATHER) vA[h][i] = S.rowoff(cur, h * HALF + Rr[i]) + (unsigned)Cc[i] * 2u;
            else vA[h][i] = (unsigned)(h * HALF + Rr[i]) * lda + (unsigned)Cc[i] * 2u;
            vN[h][i] = vA[h][i];
        }
    f32x4 acc[2][2][4][2];
#pragma unroll
    for (int a = 0; a < 2; ++a)
#pragma unroll
        for (int b = 0; b < 2; ++b)
#pragma unroll
            for (int m = 0; m < 4; ++m)
#pragma unroll
                for (int n = 0; n < 2; ++n) acc[a][b][m][n] = (f32x4){0.f, 0.f, 0.f, 0.f};
    i32x8 At[4], B0[2], B1[2];
    const char* cA = cur.a; const char* cB = cur.b;
    PG8_STAGE(PG8_SB(0, 0), cB, vB[0], vB[1]); PG8_STAGE(PG8_SB(0, 1), cB + hB, vB[0], vB[1]); PG8_STAGE(PG8_SA(0, 0), cA, vA[0][0], vA[0][1]); PG8_STAGE(PG8_SA(0, 1), cA, vA[1][0], vA[1][1]);
    if (wr == 1) PG8_BAR;
    PG8_WAIT_V(2); PG8_BAR;
    PG8_STAGE(PG8_SB(1, 0), cB + kb, vB[0], vB[1]); PG8_STAGE(PG8_SA(1, 0), cA + cur.ka, vA[0][0], vA[0][1]); PG8_STAGE(PG8_SB(1, 1), cB + hB + kb, vB[0], vB[1]);
    PG8_WAIT_V(6); PG8_BAR;
    for (;;) {
        const bool has_next = S.next(ui + 1, nxt);
        const char* nA = has_next ? nxt.a : cA; const char* nB = has_next ? nxt.b : cB; const unsigned nka = has_next ? nxt.ka : cur.ka;
        if constexpr (GATHER) {
            if (has_next) {
#pragma unroll
                for (int h = 0; h < 2; ++h)
#pragma unroll
                    for (int i = 0; i < 2; ++i) vN[h][i] = S.rowoff(nxt, h * HALF + Rr[i]) + (unsigned)Cc[i] * 2u;
            }
        }
        for (int t = 0; t < nt; t += 2) {
            const bool last = (t == nt - 2);
            const char* a1 = cA + (size_t)(t + 1) * cur.ka;
            const char* a2 = last ? nA : cA + (size_t)(t + 2) * cur.ka; const char* b2 = last ? nB : cB + (size_t)(t + 2) * kb;
            const char* a3 = a2 + (last ? nka : cur.ka); const char* b3 = b2 + kb;
            unsigned x00 = vA[0][0], x01 = vA[0][1], x10 = vA[1][0], x11 = vA[1][1];
            if constexpr (GATHER) { if (last) { x00 = vN[0][0]; x01 = vN[0][1]; x10 = vN[1][0]; x11 = vN[1][1]; } }
            PG8_LDB(B0, 0, 0); PG8_LDB(B1, 0, 1); PG8_SCHED; PG8_LDA(At, 0, 0); PG8_STAGE(PG8_SA(1, 1), a1, vA[1][0], vA[1][1]);
            PG8_WAIT_V(8); PG8_WAIT_L(0); PG8_BAR; PG8_MMA(0, 0, At, B0); PG8_MMA(0, 1, At, B1); PG8_BAR; PG8_SCHED;
            PG8_LDA(At, 0, 1); PG8_STAGE(PG8_SB(0, 0), b2, vB[0], vB[1]); PG8_STAGE(PG8_SB(0, 1), b2 + hB, vB[0], vB[1]); PG8_STAGE(PG8_SA(0, 0), a2, x00, x01);
            PG8_WAIT_V(8); PG8_WAIT_L(0); PG8_BAR; PG8_MMA(1, 0, At, B0); PG8_MMA(1, 1, At, B1); PG8_BAR; PG8_SCHED;
            PG8_LDB(B0, 1, 0); PG8_LDB(B1, 1, 1); PG8_SCHED; PG8_LDA(At, 1, 0); PG8_STAGE(PG8_SA(0, 1), a2, x10, x11);
            PG8_WAIT_V(8); PG8_WAIT_L(0); PG8_BAR; PG8_MMA(0, 0, At, B0); PG8_MMA(0, 1, At, B1); PG8_BAR; PG8_SCHED;
            PG8_LDA(At, 1, 1); PG8_STAGE(PG8_SB(1, 0), b3, vB[0], vB[1]); PG8_STAGE(PG8_SB(1, 1), b3 + hB, vB[0], vB[1]); PG8_STAGE(PG8_SA(1, 0), a3, x00, x01);
            PG8_WAIT_V(8); PG8_WAIT_L(0); PG8_BAR; PG8_MMA(1, 0, At, B0); PG8_MMA(1, 1, At, B1); PG8_BAR; PG8_SCHED;
        }
        if (wr == 0) PG8_BAR;
        if constexpr (FP8) asm volatile("s_nop 15\n\ts_nop 15" ::: "memory");
        E(acc, cur, wr, wc, fr, fq);
        if (!has_next) break;
#pragma unroll
        for (int a = 0; a < 2; ++a)
#pragma unroll
            for (int b = 0; b < 2; ++b)
#pragma unroll
                for (int m = 0; m < 4; ++m)
#pragma unroll
                    for (int n = 0; n < 2; ++n) acc[a][b][m][n] = (f32x4){0.f, 0.f, 0.f, 0.f};
        cur = nxt; cA = nA; cB = nB; ++ui;
        if constexpr (GATHER) {
#pragma unroll
            for (int h = 0; h < 2; ++h)
#pragma unroll
                for (int i = 0; i < 2; ++i) vA[h][i] = vN[h][i];
        }
        if (wr == 1) PG8_BAR;
    }
    PG8_WAIT_V(0);
    PG8_BAR;
#undef PG8_SA
#undef PG8_SB
#undef PG8_STAGE
#undef PG8_LDA
#undef PG8_LDB
#undef PG8_MMA
#undef PG8_WAIT_V
#undef PG8_WAIT_L
#undef PG8_BAR
#undef PG8_SCHED
}
}

typedef f32x4 AccT[2][2][4][2];
DI void st_bf16x8(bf16_t* p, f32x4 v0, f32x4 v1) { u32x4 w; w.x = pk2(v0[0], v0[1]); w.y = pk2(v0[2], v0[3]); w.z = pk2(v1[0], v1[1]); w.w = pk2(v1[2], v1[3]); *(u32x4*)p = w; }

struct OrderSingle {
    const char* A; const char* Bt; unsigned lda, ldb; int nM, nN, nwg, G, c;
    DI bool next(int i, pg8::Unit& u) const {
        const long L = (long)i * G + c; if (L >= nwg) return false;
        const int w = pg8::xcd_remap((int)L, nwg); int pm, pn; pg8::tile_map(w, nM, nN, pm, pn);
        u.pm = pm; u.pn = pn; u.g = 0; u.ka = 128u; u.a = A + (size_t)pm * 256 * lda; u.b = Bt + (size_t)pn * 256 * ldb; return true;
    }
    DI unsigned rowoff(const pg8::Unit&, int) const { return 0u; }
};
struct OrderMulti {
    const char* A[6]; const char* Bt[6]; int nN[6]; int start[7]; unsigned lda, ldb; int ng, nwg, G, c;
    DI bool next(int i, pg8::Unit& u) const {
        const long L = (long)i * G + c; if (L >= nwg) return false;
        const int w = pg8::xcd_remap((int)L, nwg);
        int g = 0; const char* a = A[0]; const char* b = Bt[0]; int nn = nN[0], st = start[0];
#pragma unroll
        for (int k = 1; k < 6; ++k) if (k < ng && w >= start[k]) { g = k; a = A[k]; b = Bt[k]; nn = nN[k]; st = start[k]; }
        int pm, pn; pg8::tile_map(w - st, 64, nn, pm, pn);
        u.pm = pm; u.pn = pn; u.g = g; u.ka = 128u; u.a = a + (size_t)pm * 256 * lda; u.b = b + (size_t)pn * 256 * ldb; return true;
    }
    DI unsigned rowoff(const pg8::Unit&, int) const { return 0u; }
};
struct OrderCmp {
    const char* P; const char* Bt; const char* XNp; const char* Wg; int G, c;
    DI bool next(int i, pg8::Unit& u) const {
        const int L = i * G + c; if (L >= 80) return false;
        if (L < 16) { const int kv = L >> 3, bh = L & 7, b = bh >> 1, h = bh & 1;
            u.pm = bh; u.pn = 0; u.g = kv; u.ka = (unsigned)(NP * 2);
            u.a = P + ((size_t)b * SEQ * NP + (size_t)(C_KCMP + kv * 128 + h * 64)) * 2;
            u.b = Bt + (size_t)kv * 256 * 2048 * 2; }
        else { const int pm = L - 16; u.pm = pm; u.pn = 12; u.g = 2; u.ka = 128u; u.a = XNp + (size_t)pm * 256 * DM * 2; u.b = Wg; }
        return true;
    }
    DI unsigned rowoff(const pg8::Unit& u, int row) const { return (unsigned)row * (u.g == 2 ? (unsigned)(DM * 2) : (unsigned)(16 * NP * 2)); }
};
struct OrderMoe {
    const char* A; const char* Bt; const int* rowtok; const LAS int* tab; unsigned lda, ldb; size_t bstride; int nN, nwg, G, c; bool gather;
    DI bool next(int i, pg8::Unit& u) const {
        const long L = (long)i * G + c; if (L >= nwg) return false;
        const int w = (int)L;
        const int tau = w / nN, pn = w % nN;
        int e = 0;
#pragma unroll
        for (int k = 1; k < 8; ++k) if (tau >= tab[k]) e = k;
        u.pm = tau; u.pn = pn; u.g = e; u.ka = 128u;
        u.a = gather ? A : A + (size_t)tau * 256 * lda;
        u.b = Bt + (size_t)e * bstride + (size_t)pn * 256 * ldb; return true;
    }
    DI unsigned rowoff(const pg8::Unit& u, int row) const {
        const int e = u.g; const int ce = tab[16 + e], ts = tab[e];
        const int pos = (u.pm - ts) * 256 + row;
        const int tok = pos < ce ? rowtok[e * M + pos] : 0;
        return (unsigned)tok * lda;
    }
};

struct EpiInProj {
    bf16_t* P; const float* rope;
    DI void operator()(const AccT& acc, const pg8::Unit& u, int wr, int wc, int fr, int fq) const {
        const int row0 = u.pm * 256 + wr * 64 + fr;
#pragma unroll
        for (int bj = 0; bj < 2; ++bj) {
            const int cb = u.pn * 256 + bj * 128;
            const int col0 = cb + wc * 32 + 8 * fq;
            const bool do_rope = cb < C_VA;
            const float sc = (cb < C_KA || (cb >= C_QB && cb < C_KCMP)) ? QSCALE : 1.0f;
            const int uidx = 4 * (wc & 1) + fq;
#pragma unroll
            for (int ai = 0; ai < 2; ++ai)
#pragma unroll
                for (int m = 0; m < 4; ++m) {
                    const int row = row0 + ai * 128 + m * 16;
                    f32x4 v0 = acc[ai][bj][m][0], v1 = acc[ai][bj][m][1];
                    if (do_rope) {
                        const f32x4 cs = *(const f32x4*)(rope + (size_t)row * 64 + 4 * uidx), sn = *(const f32x4*)(rope + (size_t)row * 64 + 32 + 4 * uidx);
                        const f32x4 o0 = v0 * cs - v1 * sn, o1 = v1 * cs + v0 * sn; v0 = o0; v1 = o1;
                    }
                    v0 = v0 * sc; v1 = v1 * sc;
                    st_bf16x8(P + (size_t)row * NP + col0, v0, v1);
                }
        }
    }
};
struct EpiCmp1 {
    bf16_t* HID; const float* bias; bf16_t* P;
    DI void operator()(const AccT& acc, const pg8::Unit& u, int wr, int wc, int fr, int fq) const {
        const int row0 = wr * 64 + fr;
        if (u.g == 2) {
#pragma unroll
            for (int bj = 0; bj < 2; ++bj)
#pragma unroll
                for (int ai = 0; ai < 2; ++ai)
#pragma unroll
                    for (int m = 0; m < 4; ++m) st_bf16x8(P + (size_t)(u.pm * 256 + row0 + ai * 128 + m * 16) * NP + C_GATE + bj * 128 + wc * 32 + 8 * fq, acc[ai][bj][m][0], acc[ai][bj][m][1]);
            return;
        }
#pragma unroll
        for (int bj = 0; bj < 2; ++bj) {
            const int col0 = bj * 128 + wc * 32 + 8 * fq;
            const f32x4 b0 = *(const f32x4*)(bias + u.g * 256 + col0), b1 = *(const f32x4*)(bias + u.g * 256 + col0 + 4);
#pragma unroll
            for (int ai = 0; ai < 2; ++ai)
#pragma unroll
                for (int m = 0; m < 4; ++m) {
                    const int row = row0 + ai * 128 + m * 16;
                    f32x4 v0 = acc[ai][bj][m][0] + b0, v1 = acc[ai][bj][m][1] + b1;
#pragma unroll
                    for (int j = 0; j < 4; ++j) { v0[j] = siluf_(v0[j]); v1[j] = siluf_(v1[j]); }
                    st_bf16x8(HID + ((size_t)(u.g * 2048 + u.pm * 256 + row)) * 256 + col0, v0, v1);
                }
        }
    }
};
template <bool RESF32>
struct EpiResH {
    const void* res; bf16_t* out;
    DI void operator()(const AccT& acc, const pg8::Unit& u, int wr, int wc, int fr_, int fq_) const {
        const int fr = opq(fr_), fq = opq(fq_);
        const int row0 = u.pm * 256 + wr * 64 + fr;
#pragma unroll
        for (int ai = 0; ai < 2; ++ai) {
            f32x4 r[4][2][2];
#pragma unroll
            for (int m = 0; m < 4; ++m) { const size_t ro = (size_t)(row0 + ai * 128 + m * 16) * DM;
#pragma unroll
                for (int bj = 0; bj < 2; ++bj) { const int col0 = u.pn * 256 + bj * 128 + wc * 32 + 8 * fq;
                    if (RESF32) { r[m][bj][0] = *(const f32x4*)((const float*)res + ro + col0); r[m][bj][1] = *(const f32x4*)((const float*)res + ro + col0 + 4); }
                    else { const u32x4 q = *(const u32x4*)((const bf16_t*)res + ro + col0); r[m][bj][0] = (f32x4){bflo(q.x), bfhi(q.x), bflo(q.y), bfhi(q.y)}; r[m][bj][1] = (f32x4){bflo(q.z), bfhi(q.z), bflo(q.w), bfhi(q.w)}; } } }
            asm volatile("s_waitcnt vmcnt(0)" ::: "memory");
#pragma unroll
            for (int m = 0; m < 4; ++m) { const size_t ro = (size_t)(row0 + ai * 128 + m * 16) * DM;
#pragma unroll
                for (int bj = 0; bj < 2; ++bj) { const int col0 = u.pn * 256 + bj * 128 + wc * 32 + 8 * fq;
                    st_bf16x8(out + ro + col0, r[m][bj][0] + acc[ai][bj][m][0], r[m][bj][1] + acc[ai][bj][m][1]); } }
        }
    }
};
struct EpiSwiglu {
    bf16_t* ACT; int ldc;
    DI void operator()(const AccT& acc, const pg8::Unit& u, int wr, int wc, int fr, int fq) const {
        const int row0 = u.pm * 256 + wr * 64 + fr; const int col0 = u.pn * 128 + wc * 32 + 8 * fq;
#pragma unroll
        for (int ai = 0; ai < 2; ++ai)
#pragma unroll
            for (int m = 0; m < 4; ++m) {
                f32x4 v0, v1;
#pragma unroll
                for (int j = 0; j < 4; ++j) { v0[j] = siluf_(acc[ai][0][m][0][j]) * acc[ai][1][m][0][j]; v1[j] = siluf_(acc[ai][0][m][1][j]) * acc[ai][1][m][1][j]; }
                st_bf16x8(ACT + (size_t)(row0 + ai * 128 + m * 16) * ldc + col0, v0, v1);
            }
    }
};
struct EpiSwiglu8 {
    unsigned char* ACT; int ldc;
    DI void operator()(const AccT& acc, const pg8::Unit& u, int wr, int wc, int fr, int fq) const {
        const int row0 = u.pm * 256 + wr * 64 + fr; const int col0 = u.pn * 128 + wc * 32 + 8 * fq;
#pragma unroll
        for (int ai = 0; ai < 2; ++ai)
#pragma unroll
            for (int m = 0; m < 4; ++m) {
                f32x4 v0, v1;
#pragma unroll
                for (int j = 0; j < 4; ++j) { v0[j] = siluf_(acc[ai][0][m][0][j]) * acc[ai][1][m][0][j]; v1[j] = siluf_(acc[ai][0][m][1][j]) * acc[ai][1][m][1][j]; }
                u32x2 o; o.x = pk4_fp8(v0[0], v0[1], v0[2], v0[3]); o.y = pk4_fp8(v1[0], v1[1], v1[2], v1[3]);
                *(u32x2*)(ACT + (size_t)(row0 + ai * 128 + m * 16) * ldc + col0) = o;
            }
    }
};
struct EpiRkvLora1 {
    bf16_t* RKV; bf16_t* L1;
    DI void operator()(const AccT& acc, const pg8::Unit& u, int wr, int wc, int fr, int fq) const {
        const int row0 = u.pm * 256 + wr * 64 + fr; const int g = u.g;
        bf16_t* base = g < 3 ? RKV + (size_t)g * M * DM : L1 + (size_t)(g - 3) * M * 256;
        const int ldc = g < 3 ? DM : 256;
#pragma unroll
        for (int ai = 0; ai < 2; ++ai)
#pragma unroll
            for (int m = 0; m < 4; ++m)
#pragma unroll
                for (int bj = 0; bj < 2; ++bj) {
                    const int col0 = u.pn * 256 + bj * 128 + wc * 32 + 8 * fq;
                    f32x4 v0 = acc[ai][bj][m][0], v1 = acc[ai][bj][m][1];
                    if (g == 3) {
#pragma unroll
                        for (int j = 0; j < 4; ++j) { v0[j] = tanhf_(v0[j]); v1[j] = tanhf_(v1[j]); }
                    } else if (g == 5) {
#pragma unroll
                        for (int j = 0; j < 4; ++j) { v0[j] = sigmoidf_(v0[j]); v1[j] = sigmoidf_(v1[j]); }
                    }
                    st_bf16x8(base + (size_t)(row0 + ai * 128 + m * 16) * ldc + col0, v0, v1);
                }
    }
};
struct EpiLora2 {
    float* DEC; bf16_t* AA; bf16_t* GG; const float* w0; const float* a0;
    DI void operator()(const AccT& acc, const pg8::Unit& u, int wr, int wc, int fr_, int fq_) const {
        const int fr = opq(fr_), fq = opq(fq_);
        const int row0 = u.pm * 256 + wr * 64 + fr; const int g = u.g;
        const float* cvec = g == 0 ? w0 : a0;
#pragma unroll
        for (int bj = 0; bj < 2; ++bj) {
            const int col0 = u.pn * 256 + bj * 128 + wc * 32 + 8 * fq;
            f32x4 c0 = (f32x4){0.f, 0.f, 0.f, 0.f}, c1 = c0;
            if (g < 2) { c0 = *(const f32x4*)(cvec + col0); c1 = *(const f32x4*)(cvec + col0 + 4); }
#pragma unroll
            for (int ai = 0; ai < 2; ++ai)
#pragma unroll
                for (int m = 0; m < 4; ++m) {
                    const size_t ro = (size_t)(row0 + ai * 128 + m * 16) * DM + col0;
                    f32x4 v0 = acc[ai][bj][m][0] + c0, v1 = acc[ai][bj][m][1] + c1;
                    if (g < 2) {
#pragma unroll
                        for (int j = 0; j < 4; ++j) { v0[j] = sigmoidf_(v0[j]); v1[j] = sigmoidf_(v1[j]); }
                        if (g == 0) {
#pragma unroll
                            for (int j = 0; j < 4; ++j) { v0[j] = __expf(-0.60653065971f * v0[j]); v1[j] = __expf(-0.60653065971f * v1[j]); }
                            *(f32x4*)(DEC + ro) = v0; *(f32x4*)(DEC + ro + 4) = v1;
                        } else st_bf16x8(AA + ro, v0, v1);
                    } else st_bf16x8(GG + ro, v0, v1);
                    asm volatile("" ::: "memory");
                }
        }
    }
};
struct EpiBf16Out {
    bf16_t* out;
    DI void operator()(const AccT& acc, const pg8::Unit& u, int wr, int wc, int fr, int fq) const {
        const int row0 = u.pm * 256 + wr * 64 + fr;
#pragma unroll
        for (int ai = 0; ai < 2; ++ai)
#pragma unroll
            for (int m = 0; m < 4; ++m) {
                const size_t ro = (size_t)(row0 + ai * 128 + m * 16) * DM;
#pragma unroll
                for (int bj = 0; bj < 2; ++bj) { const int col0 = u.pn * 256 + bj * 128 + wc * 32 + 8 * fq; st_bf16x8(out + ro + col0, acc[ai][bj][m][0], acc[ai][bj][m][1]); }
            }
    }
};

struct Args { const float* in[33]; float* out; unsigned char* ws; int ph_lo, ph_hi, use_bar, pad; };
enum { I_X = 0, I_POS, I_ATTN_NORM, I_FFN_NORM, I_FINAL_NORM, I_W_IN, I_W_OUT, I_SINKS, I_CMP_PE, I_CMP_W1, I_CMP_B1, I_CMP_W2, I_FFN_W13, I_FFN_W2, I_MU, I_W_RKV, I_DECAY_W0, I_DECAY_W1,
       I_DECAY_W2, I_A0, I_A1, I_A2, I_G1, I_G2, I_K_K, I_K_A, I_R_K, I_LN_W, I_LN_B, I_W_O, I_ROUTER, I_MOE_W13, I_MOE_W2 };

struct Frame {
    LAS unsigned char* lds;
    int tid, lane, wave, G, gw, NGW;
    unsigned char* ws;
};

template <class F>
DI void transpose_item(const float* W, int Nsrc, int kvalid, bf16_t* WT, int Kd, const F& map, int k0, int n0, LAS float* scr, int lane) {
    const int s0 = map.src0(n0);
    const int rsub = lane >> 4, col = s0 + 4 * (lane & 15);
    f32x4 v[16];
#pragma unroll
    for (int i = 0; i < 16; ++i) { const int k = k0 + 4 * i + rsub; v[i] = (f32x4){0.f, 0.f, 0.f, 0.f}; if (k < kvalid && col < Nsrc) v[i] = *(const f32x4*)(W + (size_t)k * Nsrc + col); }
#pragma unroll
    for (int i = 0; i < 16; ++i) { LAS float* d = scr + (4 * i + rsub) * 65 + 4 * (lane & 15); d[0] = v[i].x; d[1] = v[i].y; d[2] = v[i].z; d[3] = v[i].w; }
    asm volatile("s_waitcnt lgkmcnt(0)" ::: "memory");
    const int c = lane & 7;
#pragma unroll
    for (int j = 0; j < 8; ++j) { const int nl = (lane >> 3) + 8 * j; const LAS float* s = scr + (8 * c) * 65 + map.perm(n0, nl);
        u32x4 o; o.x = pk2(s[0 * 65], s[1 * 65]); o.y = pk2(s[2 * 65], s[3 * 65]); o.z = pk2(s[4 * 65], s[5 * 65]); o.w = pk2(s[6 * 65], s[7 * 65]);
        *(u32x4*)(WT + (size_t)(n0 + nl) * Kd + k0 + 8 * c) = o; }
    asm volatile("s_waitcnt lgkmcnt(0)" ::: "memory");
}
template <class F>
DI void t8_load(f32x4 (&v)[16], const float* W, int Nsrc, int kvalid, const F& map, int k0, int n0, int lane) {
    const int s0 = map.src0(n0); const int rsub = lane >> 4, col = s0 + 4 * (lane & 15);
#pragma unroll
    for (int i = 0; i < 16; ++i) { const int k = k0 + 4 * i + rsub; v[i] = (f32x4){0.f, 0.f, 0.f, 0.f}; if (k < kvalid && col < Nsrc) v[i] = __builtin_nontemporal_load((const f32x4*)(W + (size_t)k * Nsrc + col)); }
}
template <class F>
DI void t8_store(const f32x4 (&v)[16], unsigned char* WT, int Kd, const F& map, int k0, int n0, LAS float* scr, int lane, float mul) {
    const int rsub = lane >> 4;
#pragma unroll
    for (int i = 0; i < 16; ++i) { LAS float* d = scr + (4 * i + rsub) * 65 + 4 * (lane & 15); d[0] = v[i].x; d[1] = v[i].y; d[2] = v[i].z; d[3] = v[i].w; }
    asm volatile("s_waitcnt lgkmcnt(0)" ::: "memory");
    const int c = lane & 7;
#pragma unroll
    for (int j = 0; j < 8; ++j) { const int nl = (lane >> 3) + 8 * j; const LAS float* s = scr + (8 * c) * 65 + map.perm(n0, nl);
        u32x2 o; o.x = pk4_fp8(s[0 * 65] * mul, s[1 * 65] * mul, s[2 * 65] * mul, s[3 * 65] * mul); o.y = pk4_fp8(s[4 * 65] * mul, s[5 * 65] * mul, s[6 * 65] * mul, s[7 * 65] * mul);
        *(u32x2*)(WT + (size_t)(n0 + nl) * Kd + k0 + 8 * c) = o; }
    asm volatile("s_waitcnt lgkmcnt(0)" ::: "memory");
}
template <class F>
DI void transpose_matrix8(const Frame& F_, const float* W, int Nsrc, int kvalid, unsigned char* WT, int Kd, int Nd, const F& map, LAS float* scr, float mul) {
    const int nkb = Kd / 64, nnb = Nd / 64, nitems = nkb * nnb;
    for (int it = F_.gw; it < nitems; it += 2 * F_.NGW) {
        const int it2 = it + F_.NGW; const bool two = it2 < nitems;
        const int k0a = 64 * (it / nnb), n0a = 64 * (it % nnb), k0b = two ? 64 * (it2 / nnb) : k0a, n0b = two ? 64 * (it2 % nnb) : n0a;
        f32x4 va[16], vb[16];
        t8_load(va, W, Nsrc, kvalid, map, k0a, n0a, F_.lane);
        if (two) t8_load(vb, W, Nsrc, kvalid, map, k0b, n0b, F_.lane);
        t8_store(va, WT, Kd, map, k0a, n0a, scr, F_.lane, mul);
        if (two) t8_store(vb, WT, Kd, map, k0b, n0b, scr, F_.lane, mul);
    }
}
template <class F>
DI void transpose_matrix(const Frame& F_, const float* W, int Nsrc, int kvalid, bf16_t* WT, int Kd, int Nd, const F& map, LAS float* scr, int first, int stride) {
    const int nkb = Kd / 64, nnb = Nd / 64, nitems = nkb * nnb;
    for (int it = first; it < nitems; it += stride) { const int kbi = it / nnb, nb = it % nnb; transpose_item(W, Nsrc, kvalid, WT, Kd, map, 64 * kbi, 64 * nb, scr, F_.lane); }
}
struct ColIdent { DI int src0(int n0) const { return n0; } DI int perm(int, int nl) const { return nl; } };
struct ColInProj { DI int src0(int n0) const { return n0; }
    DI int perm(int n0, int l) const { return n0 < C_VA ? ((l & 7) < 4 ? 4 * (l >> 3) + (l & 3) : 32 + 4 * (l >> 3) + (l & 3)) : l; } };
struct ColSwiglu { int F; DI int src0(int n0) const { const int t = n0 >> 8, r = n0 & 255; return r < 128 ? t * 128 + r : F + t * 128 + (r - 128); } DI int perm(int, int nl) const { return nl; } };

DI f32x4 ld4bf(const bf16_t* p) { const u32x2 q = *(const u32x2*)p; return (f32x4){bflo(q.x), bfhi(q.x), bflo(q.y), bfhi(q.y)}; }
DI void rms_row_load(const float* xrow, int lane, f32x4 (&v)[8], float& rstd) {
    float s = 0.f;
#pragma unroll
    for (int j = 0; j < 8; ++j) { v[j] = *(const f32x4*)(xrow + 4 * lane + 256 * j); s += (v[j].x * v[j].x + v[j].y * v[j].y) + (v[j].z * v[j].z + v[j].w * v[j].w); }
    rstd = 1.0f / sqrtf(wave_sum(s) * (1.0f / DM) + RMS_EPS);
}
DI void rms_row_to_bf16(const float* xrow, const float* g, bf16_t* orow, int lane) {
    f32x4 v[8]; float rstd; rms_row_load(xrow, lane, v, rstd);
#pragma unroll
    for (int j = 0; j < 8; ++j) { const f32x4 gg = *(const f32x4*)(g + 4 * lane + 256 * j); const f32x4 y = v[j] * rstd * gg;
        u32x2 w; w.x = pk2(y.x, y.y); w.y = pk2(y.z, y.w); *(u32x2*)(orow + 4 * lane + 256 * j) = w; }
}

DI void rms_row_load_h(const bf16_t* xrow, int lane, f32x4 (&v)[8], float& rstd) {
    float s = 0.f;
#pragma unroll
    for (int j = 0; j < 8; ++j) { v[j] = ld4bf(xrow + 4 * lane + 256 * j); s += (v[j].x * v[j].x + v[j].y * v[j].y) + (v[j].z * v[j].z + v[j].w * v[j].w); }
    rstd = 1.0f / sqrtf(wave_sum(s) * (1.0f / DM) + RMS_EPS);
}
DI void rms_row_to_bf16_h(const bf16_t* xrow, const float* g, bf16_t* orow, int lane) {
    f32x4 v[8]; float rstd; rms_row_load_h(xrow, lane, v, rstd);
#pragma unroll
    for (int j = 0; j < 8; ++j) { const f32x4 gg = *(const f32x4*)(g + 4 * lane + 256 * j); const f32x4 y = v[j] * rstd * gg;
        u32x2 w; w.x = pk2(y.x, y.y); w.y = pk2(y.z, y.w); *(u32x2*)(orow + 4 * lane + 256 * j) = w; }
}
namespace att {
constexpr int KPADB = 144;
constexpr int VPADB = 144;
constexpr int BUFB = 64 * KPADB + 64 * VPADB;
constexpr int OFF_ALPHA = 2 * BUFB;
constexpr int OFF_IMP = OFF_ALPHA + 8 * 256;
constexpr int OFF_SEL = OFF_IMP + 16384;
constexpr int OFF_RANK = OFF_SEL + 512;
constexpr int OFF_Q = 65536;
constexpr float NEGBIG = -1e30f;
DI int crow(int r, int h) { return (r & 3) + 8 * (r >> 2) + 4 * h; }
#define MFMA32(a, b, c) __builtin_amdgcn_mfma_f32_32x32x16_bf16((a), (b), (c), 0, 0, 0)

struct KVRegs { u32x4 k, v; };
DI void kv_load(KVRegs& r, const bf16_t* Kg, const bf16_t* Vg, size_t pitch, int tid) {
    const int key = tid >> 3, dc = tid & 7;
    r.k = *(const u32x4*)(Kg + (size_t)key * pitch + dc * 8); r.v = *(const u32x4*)(Vg + (size_t)key * pitch + dc * 8);
}
DI void kv_store(const KVRegs& r, LAS unsigned char* buf, int tid) {
    const int key = tid >> 3, dc = tid & 7;
    *(LAS u32x4*)(buf + key * KPADB + dc * 16) = r.k;
    LAS unsigned short* vt = (LAS unsigned short*)(buf + 64 * KPADB);
    const unsigned w[4] = {r.v.x, r.v.y, r.v.z, r.v.w};
#pragma unroll
    for (int i = 0; i < 4; ++i) { vt[(dc * 8 + 2 * i) * (VPADB / 2) + key] = (unsigned short)(w[i] & 0xffffu); vt[(dc * 8 + 2 * i + 1) * (VPADB / 2) + key] = (unsigned short)(w[i] >> 16); }
}

struct State { f32x16 O[2][2]; float m[2], l[2]; };
DI void state_init(State& s) {
#pragma unroll
    for (int a = 0; a < 2; ++a) { s.m[a] = NEGBIG; s.l[a] = 0.f;
#pragma unroll
        for (int b = 0; b < 2; ++b)
#pragma unroll
            for (int r = 0; r < 16; ++r) s.O[a][b][r] = 0.f; }
}
DI void row_scale(f32x16 (&O)[2], float f, LAS float* area, int c_, int h_) {
    const int c = opq(c_), h = opq(h_);
    area[c] = f;
    asm volatile("s_waitcnt lgkmcnt(0)" ::: "memory");
#pragma unroll
    for (int g4 = 0; g4 < 4; ++g4) { const f32x4 a = *(LAS f32x4*)(area + 8 * g4 + 4 * h);
#pragma unroll
        for (int j = 0; j < 4; ++j) { O[0][4 * g4 + j] *= a[j]; O[1][4 * g4 + j] *= a[j]; } }
    asm volatile("s_waitcnt lgkmcnt(0)" ::: "memory");
}
template <int MODE, bool MASKED>
DI void softmax_block(State& st, f32x16& S, int qb, int kpos0, const int (&tq)[2], int W, bool bit, LAS float* area, int c, int h) {
    if constexpr (MASKED) {
        float mx = NEGBIG;
        const int dd = tq[qb] - kpos0;
#pragma unroll
        for (int r = 0; r < 16; ++r) { const int cr0 = (r & 3) + 8 * (r >> 2); bool valid;
            if (MODE == 0) valid = (cr0 <= dd) && (cr0 > dd - W);
            else if (MODE == 1) valid = (cr0 <= dd);
            else valid = (cr0 <= dd) && bit;
            S[r] = valid ? S[r] : NEGBIG; mx = fmaxf(mx, S[r]); }
        mx = fmaxf(mx, __shfl_xor(mx, 32));
        if (__any(mx > st.m[qb] + 8.0f)) {
            const float mnew = fmaxf(st.m[qb], mx); const float alpha = ex2(st.m[qb] - mnew);
            st.l[qb] *= alpha; st.m[qb] = mnew;
            row_scale(st.O[qb], alpha, area + qb * 32, c, h);
        }
        float ls = 0.f;
#pragma unroll
        for (int r = 0; r < 16; ++r) { S[r] = (S[r] > -1e29f) ? ex2(S[r] - st.m[qb]) : 0.f; ls += S[r]; }
        st.l[qb] += ls;
    } else {
        float mx = fmaxf(fmaxf(fmaxf(S[0], S[1]), fmaxf(S[2], S[3])), fmaxf(fmaxf(S[4], S[5]), fmaxf(S[6], S[7])));
        mx = fmaxf(mx, fmaxf(fmaxf(fmaxf(S[8], S[9]), fmaxf(S[10], S[11])), fmaxf(fmaxf(S[12], S[13]), fmaxf(S[14], S[15]))));
        if (MODE == 2) mx = bit ? mx : NEGBIG;
        mx = fmaxf(mx, __shfl_xor(mx, 32));
        if (__any(mx > st.m[qb] + 8.0f)) {
            const float mnew = fmaxf(st.m[qb], mx); const float alpha = ex2(st.m[qb] - mnew);
            st.l[qb] *= alpha; st.m[qb] = mnew;
            row_scale(st.O[qb], alpha, area + qb * 32, c, h);
        }
        const float mref = (MODE == 2 && !bit) ? 3.0e38f : st.m[qb];
        float ls = 0.f;
#pragma unroll
        for (int r = 0; r < 16; ++r) { S[r] = ex2(S[r] - mref); ls += S[r]; }
        st.l[qb] += ls;
    }
}
DI void pack_p(bf16x8 (&Pf)[2], const f32x16& S) {
#pragma unroll
    for (int ks = 0; ks < 2; ++ks) { u32x4 w; w.x = pk2(S[8 * ks], S[8 * ks + 1]); w.y = pk2(S[8 * ks + 2], S[8 * ks + 3]); w.z = pk2(S[8 * ks + 4], S[8 * ks + 5]); w.w = pk2(S[8 * ks + 6], S[8 * ks + 7]);
        Pf[ks] = __builtin_bit_cast(bf16x8, w); }
}
template <int MODE, bool MASKED>
DI void tile_compute(State& st, const LAS unsigned char* qf, LAS unsigned char* buf, int kbase, const int (&tq)[2], int W, const unsigned long long (&sel)[2], int tile, LAS float* area, int c_, int h_) {
    const int c = opq(c_), h = opq(h_);
    LAS unsigned char* Kl = buf; LAS unsigned char* Vl = buf + 64 * KPADB;
    const bool bit0 = MODE == 2 ? (((sel[0] >> tile) & 1ull) != 0ull) : true, bit1 = MODE == 2 ? (((sel[1] >> tile) & 1ull) != 0ull) : true;
#pragma unroll 1
    for (int kbk = 0; kbk < 2; ++kbk) {
        bf16x8 kf[4];
#pragma unroll
        for (int s = 0; s < 4; ++s) kf[s] = *(LAS bf16x8*)(Kl + (32 * kbk + c) * KPADB + (16 * s + 8 * h) * 2);
        f32x16 S0, S1;
#pragma unroll
        for (int r = 0; r < 16; ++r) { S0[r] = 0.f; S1[r] = 0.f; }
#pragma unroll
        for (int s = 0; s < 4; ++s) { const bf16x8 q = *(const LAS bf16x8*)(qf + s * 1024); S0 = MFMA32(kf[s], q, S0); }
#pragma unroll
        for (int s = 0; s < 4; ++s) { const bf16x8 q = *(const LAS bf16x8*)(qf + (4 + s) * 1024); S1 = MFMA32(kf[s], q, S1); }
        const LAS unsigned char* vbase = Vl + opq(c * VPADB + h * 8) + kbk * 64;
        bf16x8 vf[2][2];
#pragma unroll
        for (int ks = 0; ks < 2; ++ks)
#pragma unroll
            for (int db = 0; db < 2; ++db) {
                const s16x4 lo = *(const LAS s16x4*)(vbase + 32 * db * VPADB + 32 * ks);
                const s16x4 hi = *(const LAS s16x4*)(vbase + 32 * db * VPADB + 32 * ks + 16);
                vf[ks][db] = __builtin_shufflevector(lo, hi, 0, 1, 2, 3, 4, 5, 6, 7);
            }
        __builtin_amdgcn_sched_barrier(0);
        const int kpos0 = kbase + 32 * kbk + 4 * h;
        bf16x8 Pf[2];
        softmax_block<MODE, MASKED>(st, S0, 0, kpos0, tq, W, bit0, area, c, h);
        pack_p(Pf, S0);
        __builtin_amdgcn_sched_barrier(0);
#pragma unroll
        for (int ks = 0; ks < 2; ++ks)
#pragma unroll
            for (int db = 0; db < 2; ++db) st.O[0][db] = MFMA32(Pf[ks], vf[ks][db], st.O[0][db]);
        softmax_block<MODE, MASKED>(st, S1, 1, kpos0, tq, W, bit1, area, c, h);
        pack_p(Pf, S1);
        __builtin_amdgcn_sched_barrier(0);
#pragma unroll
        for (int ks = 0; ks < 2; ++ks)
#pragma unroll
            for (int db = 0; db < 2; ++db) st.O[1][db] = MFMA32(Pf[ks], vf[ks][db], st.O[1][db]);
    }
}
template <int MODE>
DI void run_pass(State& st, LAS unsigned char* lds, const bf16_t* Kg, const bf16_t* Vg, size_t pitch, int tlo, int thi, const int (&tq)[2], int W,
                 const unsigned long long (&sel)[2], int tid, int wave, int c, int h) {
    LAS float* area = (LAS float*)(lds + OFF_ALPHA) + wave * 64;
    const LAS unsigned char* qf = lds + OFF_Q + wave * 8192 + (c + 32 * h) * 16;
    KVRegs kr; kv_load(kr, Kg + (size_t)tlo * 64 * pitch, Vg + (size_t)tlo * 64 * pitch, pitch, tid);
    int bi = 0;
    for (int t = tlo; t <= thi; ++t) {
        LAS unsigned char* buf = lds + bi * BUFB;
        const int tid2 = opq(tid);
        kv_store(kr, buf, tid2);
        if (t < thi) kv_load(kr, Kg + (size_t)(t + 1) * 64 * pitch, Vg + (size_t)(t + 1) * 64 * pitch, pitch, tid2);
        __syncthreads();
        const bool masked = (MODE == 1) || (t == thi) || (MODE == 0 && t == thi - W / 64);
        if (masked) tile_compute<MODE, true>(st, qf, buf, t * 64, tq, W, sel, t, area, c, h);
        else tile_compute<MODE, false>(st, qf, buf, t * 64, tq, W, sel, t, area, c, h);
        bi ^= 1;
    }
    __syncthreads();
}
DI void load_q(LAS unsigned char* lds, int wave, const bf16_t* Pbase  , int colbase, int c_, int h_) {
    const int c = opq(c_), h = opq(h_);
    LAS unsigned char* q = lds + OFF_Q + wave * 8192 + (c + 32 * h) * 16;
#pragma unroll
    for (int qb = 0; qb < 2; ++qb) { const bf16_t* p = Pbase + (size_t)(4 * qb + (c >> 3)) * NP + colbase + (c & 7) * 64 + 8 * h;
#pragma unroll
        for (int s = 0; s < 4; ++s) *(LAS bf16x8*)(q + (qb * 4 + s) * 1024) = *(const bf16x8*)(p + 16 * s); }
}
template <bool ACC>
DI void emit_out(State& st, const float (&f)[2], LAS float* area, LAS unsigned char* lds, int wave, bf16_t* Orow, int c_, int h_, int lane_) {
    const int c = opq(c_), h = opq(h_), lane = opq(lane_);
    LAS unsigned char* slice = lds + wave * 4608;
#pragma unroll
    for (int qb = 0; qb < 2; ++qb) {
        area[qb * 32 + c] = f[qb];
        asm volatile("s_waitcnt lgkmcnt(0)" ::: "memory");
#pragma unroll
        for (int g4 = 0; g4 < 4; ++g4) { const f32x4 a = *(LAS f32x4*)(area + qb * 32 + 8 * g4 + 4 * h);
#pragma unroll
            for (int j = 0; j < 4; ++j)
#pragma unroll
                for (int db = 0; db < 2; ++db)
                    *(LAS unsigned short*)(slice + (8 * g4 + 4 * h + j) * KPADB + (32 * db + c) * 2) = (unsigned short)f2bf(st.O[qb][db][4 * g4 + j] * a[j]); }
        asm volatile("s_waitcnt lgkmcnt(0)" ::: "memory");
        u32x4 v[4], o[4];
#pragma unroll
        for (int i = 0; i < 4; ++i) v[i] = *(LAS u32x4*)(slice + ((lane >> 3) + 8 * i) * KPADB + (lane & 7) * 16);
        if (ACC) {
#pragma unroll
            for (int i = 0; i < 4; ++i) { const int row = (lane >> 3) + 8 * i; o[i] = *(const u32x4*)(Orow + (size_t)(4 * qb + (row >> 3)) * DM + (row & 7) * 64 + (lane & 7) * 8); }
#pragma unroll
            for (int i = 0; i < 4; ++i) { const unsigned a[4] = {v[i].x, v[i].y, v[i].z, v[i].w}, bb[4] = {o[i].x, o[i].y, o[i].z, o[i].w}; unsigned r[4];
#pragma unroll
                for (int k = 0; k < 4; ++k) r[k] = pk2(bflo(a[k]) + bflo(bb[k]), bfhi(a[k]) + bfhi(bb[k]));
                v[i] = (u32x4){r[0], r[1], r[2], r[3]}; }
        }
#pragma unroll
        for (int i = 0; i < 4; ++i) { const int row = (lane >> 3) + 8 * i; *(u32x4*)(Orow + (size_t)(4 * qb + (row >> 3)) * DM + (row & 7) * 64 + (lane & 7) * 8) = v[i]; }
        asm volatile("s_waitcnt lgkmcnt(0)" ::: "memory");
    }
}
}

DI void attn_unit_A(const Frame& F, const bf16_t* P, bf16_t* O, const float* sinks, int b, int kvh, int ch) {
    const int lane = opq(F.lane), tid = F.wave * 64 + lane;
    const int c = lane & 31, h = lane >> 5, w = F.wave;
    const int t0 = ch * 64;
    const bf16_t* Pb = P + (size_t)b * SEQ * NP;
    att::load_q(F.lds, w, Pb + (size_t)(t0 + 8 * w) * NP, C_QA + kvh * 512, c, h);
    int tq[2] = {t0 + 8 * w + (c >> 3), t0 + 8 * w + 4 + (c >> 3)};
    unsigned long long sel[2] = {0ull, 0ull};
    att::State st; att::state_init(st);
    const int tlo = ch >= 2 ? ch - 2 : 0;
    att::run_pass<0>(st, F.lds, Pb + C_KA + kvh * 64, Pb + C_VA + kvh * 64, NP, tlo, ch, tq, 128, sel, tid, w, c, h);
    const float sink2 = sinks[kvh * 8 + (c & 7)] * LOG2E;
    float f[2];
#pragma unroll
    for (int qb = 0; qb < 2; ++qb) { const float lt = st.l[qb] + __shfl_xor(st.l[qb], 32) + ex2(sink2 - st.m[qb]); f[qb] = 1.0f / lt; }
    LAS float* area = (LAS float*)(F.lds + att::OFF_ALPHA) + w * 64;
    att::emit_out<false>(st, f, area, F.lds, w, O + ((size_t)b * SEQ + t0 + 8 * w) * DM + kvh * 512, c, h, lane);
    __syncthreads();
}

DI void attn_unit_B(const Frame& F, const bf16_t* P, const bf16_t* KVC, bf16_t* O, float* OB, int b, int hkv, int ch) {
    const int lane = opq(F.lane), tid = F.wave * 64 + lane;
    const int c = lane & 31, h = lane >> 5, w = F.wave;
    const int t0 = ch * 64;
    const bf16_t* Pb = P + (size_t)b * SEQ * NP;
    LAS float* area = (LAS float*)(F.lds + att::OFF_ALPHA) + w * 64;
    LAS float* imp = (LAS float*)(F.lds + att::OFF_IMP);
    LAS unsigned long long* selbuf = (LAS unsigned long long*)(F.lds + att::OFF_SEL);
    LAS float* rank = (LAS float*)(F.lds + att::OFF_RANK) + w * 64;
    att::load_q(F.lds, w, Pb + (size_t)(t0 + 8 * w) * NP, C_QB + hkv * 512, c, h);
    const LAS unsigned char* qf = F.lds + att::OFF_Q + w * 8192 + (c + 32 * h) * 16;
    int tq[2] = {t0 + 8 * w + (c >> 3), t0 + 8 * w + 4 + (c >> 3)};
    unsigned long long sel[2] = {0ull, 0ull};
#define GATE(qb, j) sigmoidf_(bf2f(Pb[(size_t)tq[qb] * NP + C_GATE + hkv * 24 + (c & 7) * 3 + (j)]))
    for (int i = tid; i < 4096; i += NTHR) imp[i] = 0.f;
    bf16_t* Orow = O + ((size_t)b * SEQ + t0 + 8 * w) * DM + 1024 + hkv * 512;
    const bf16_t* Kc = KVC + (size_t)(0 * 2048 + (b * 2 + hkv) * 256) * 64;
    const bf16_t* Vc = KVC + (size_t)(1 * 2048 + (b * 2 + hkv) * 256) * 64;
    const int ntc = (4 * ch + 2) / 64;
    att::State st; att::state_init(st);
    int tqc[2] = {(tq[0] - 31) >> 4, (tq[1] - 31) >> 4};
    att::run_pass<1>(st, F.lds, Kc, Vc, 64, 0, ntc, tqc, 0, sel, tid, w, c, h);
    float ltot[2], f[2];
#pragma unroll
    for (int qb = 0; qb < 2; ++qb) { ltot[qb] = fmaxf(st.l[qb] + __shfl_xor(st.l[qb], 32), 1e-30f); f[qb] = GATE(qb, 0) / ltot[qb]; }
    att::emit_out<false>(st, f, area, F.lds, w, Orow, c, h, lane);
    __syncthreads();
    {
        att::KVRegs kr; att::kv_load(kr, Kc, Vc, 64, tid);
        int bi = 0;
        for (int t = 0; t <= ntc; ++t) {
            LAS unsigned char* buf = F.lds + bi * att::BUFB;
            att::kv_store(kr, buf, tid);
            if (t < ntc) att::kv_load(kr, Kc + (size_t)(t + 1) * 64 * 64, Vc + (size_t)(t + 1) * 64 * 64, 64, tid);
            __syncthreads();
#pragma unroll
            for (int kbk = 0; kbk < 2; ++kbk) {
#pragma unroll
                for (int qb = 0; qb < 2; ++qb) {
                    f32x16 S;
#pragma unroll
                    for (int r = 0; r < 16; ++r) S[r] = 0.f;
#pragma unroll
                    for (int s = 0; s < 4; ++s) { const bf16x8 kf = *(LAS bf16x8*)(buf + (32 * kbk + c) * att::KPADB + (16 * s + 8 * h) * 2); const bf16x8 q = *(const LAS bf16x8*)(qf + (qb * 4 + s) * 1024); S = MFMA32(kf, q, S); }
                    const float inv = 1.0f / ltot[qb];
                    const int q = 8 * w + 4 * qb + (c >> 3);
                    const int ddq = tqc[qb] - (t * 64 + 32 * kbk + 4 * h);
#pragma unroll
                    for (int g4 = 0; g4 < 4; ++g4) {
                        float s4 = 0.f, p3 = 0.f;
#pragma unroll
                        for (int j = 0; j < 4; ++j) { const float pv = (8 * g4 + j <= ddq) ? ex2(S[4 * g4 + j] - st.m[qb]) * inv : 0.f; s4 += pv; if (j == 3) p3 = pv; }
                        s4 += __shfl_xor(s4, 1); s4 += __shfl_xor(s4, 2); s4 += __shfl_xor(s4, 4);
                        p3 += __shfl_xor(p3, 1); p3 += __shfl_xor(p3, 2); p3 += __shfl_xor(p3, 4);
                        const int n0 = t * 16 + 8 * kbk + 2 * g4 + h;
                        if ((c & 7) == 0) { (void)__hip_atomic_fetch_add(&imp[q * 64 + n0], s4, __ATOMIC_RELAXED, __HIP_MEMORY_SCOPE_WORKGROUP); if (n0 + 1 < 64) (void)__hip_atomic_fetch_add(&imp[q * 64 + n0 + 1], p3, __ATOMIC_RELAXED, __HIP_MEMORY_SCOPE_WORKGROUP); }
                    }
                    __builtin_amdgcn_sched_barrier(0);
                }
            }
            bi ^= 1;
        }
        __syncthreads();
    }
    {
        const int cur = ch;
        for (int qq = 0; qq < 8; ++qq) {
            const int q = 8 * w + qq;
            float v = imp[q * 64 + lane];
            if (lane > cur) v = -1e9f; else if (lane == 0 || lane > cur - 2) v = 1e9f;
            rank[lane] = v;
            asm volatile("s_waitcnt lgkmcnt(0)" ::: "memory");
            int rk = 0;
#pragma unroll 8
            for (int mth = 0; mth < 64; ++mth) { const float o = rank[mth]; rk += (o > v || (o == v && mth < lane)) ? 1 : 0; }
            const unsigned long long msk = __ballot(rk < 16);
            if (lane == 0) selbuf[q] = msk;
            asm volatile("s_waitcnt lgkmcnt(0)" ::: "memory");
        }
        __syncthreads();
        sel[0] = selbuf[8 * w + (c >> 3)]; sel[1] = selbuf[8 * w + 4 + (c >> 3)];
    }
    att::state_init(st);
    att::run_pass<2>(st, F.lds, Pb + C_KSEL + hkv * 64, Pb + C_VSEL + hkv * 64, NP, 0, ch, tq, 0, sel, tid, w, c, h);
#pragma unroll
    for (int qb = 0; qb < 2; ++qb) { const float lt = fmaxf(st.l[qb] + __shfl_xor(st.l[qb], 32), 1e-30f); f[qb] = GATE(qb, 1) / lt; }
    att::emit_out<true>(st, f, area, F.lds, w, Orow, c, h, lane);
    __syncthreads();
    att::state_init(st);
    att::run_pass<0>(st, F.lds, Pb + C_KWIN + hkv * 64, Pb + C_VWIN + hkv * 64, NP, ch >= 8 ? ch - 8 : 0, ch, tq, 512, sel, tid, w, c, h);
#pragma unroll
    for (int qb = 0; qb < 2; ++qb) { const float lt = fmaxf(st.l[qb] + __shfl_xor(st.l[qb], 32), 1e-30f); f[qb] = GATE(qb, 2) / lt; }
    att::emit_out<true>(st, f, area, F.lds, w, Orow, c, h, lane);
#undef GATE
    __syncthreads();
}

namespace scan {
constexpr int TC = 32;
constexpr int STEPB = 5 * 256 + 128;
constexpr int CHB = TC * STEPB;
constexpr int OFF_Y = 2 * CHB;
constexpr int YB = (TC + 1) * 32 * 4;
template <int CTRL> DI float dpp_f(float x) { return __builtin_bit_cast(float, __builtin_amdgcn_update_dpp(0, __builtin_bit_cast(int, x), CTRL, 0xf, 0xf, false)); }
DI void row_sum16x4(float& a, float& b, float& c, float& d) {
    asm volatile("s_nop 1\n\t"
        "v_add_f32_dpp %0, %0, %0 quad_perm:[1,0,3,2] row_mask:0xf bank_mask:0xf\n\tv_add_f32_dpp %1, %1, %1 quad_perm:[1,0,3,2] row_mask:0xf bank_mask:0xf\n\t"
        "v_add_f32_dpp %2, %2, %2 quad_perm:[1,0,3,2] row_mask:0xf bank_mask:0xf\n\tv_add_f32_dpp %3, %3, %3 quad_perm:[1,0,3,2] row_mask:0xf bank_mask:0xf\n\t"
        "v_add_f32_dpp %0, %0, %0 quad_perm:[2,3,0,1] row_mask:0xf bank_mask:0xf\n\tv_add_f32_dpp %1, %1, %1 quad_perm:[2,3,0,1] row_mask:0xf bank_mask:0xf\n\t"
        "v_add_f32_dpp %2, %2, %2 quad_perm:[2,3,0,1] row_mask:0xf bank_mask:0xf\n\tv_add_f32_dpp %3, %3, %3 quad_perm:[2,3,0,1] row_mask:0xf bank_mask:0xf\n\t"
        "v_add_f32_dpp %0, %0, %0 row_half_mirror row_mask:0xf bank_mask:0xf\n\tv_add_f32_dpp %1, %1, %1 row_half_mirror row_mask:0xf bank_mask:0xf\n\t"
        "v_add_f32_dpp %2, %2, %2 row_half_mirror row_mask:0xf bank_mask:0xf\n\tv_add_f32_dpp %3, %3, %3 row_half_mirror row_mask:0xf bank_mask:0xf\n\t"
        "v_add_f32_dpp %0, %0, %0 row_mirror row_mask:0xf bank_mask:0xf\n\tv_add_f32_dpp %1, %1, %1 row_mirror row_mask:0xf bank_mask:0xf\n\t"
        "v_add_f32_dpp %2, %2, %2 row_mirror row_mask:0xf bank_mask:0xf\n\tv_add_f32_dpp %3, %3, %3 row_mirror row_mask:0xf bank_mask:0xf"
        : "+v"(a), "+v"(b), "+v"(c), "+v"(d));
}
DI float wave_sum_dpp(float x) { x += dpp_f<0xB1>(x); x += dpp_f<0x4E>(x); x += dpp_f<0x141>(x); x += dpp_f<0x140>(x);
    const int xi = __builtin_bit_cast(int, x);
    return (__builtin_bit_cast(float, __builtin_amdgcn_readlane(xi, 0)) + __builtin_bit_cast(float, __builtin_amdgcn_readlane(xi, 16))) + (__builtin_bit_cast(float, __builtin_amdgcn_readlane(xi, 32)) + __builtin_bit_cast(float, __builtin_amdgcn_readlane(xi, 48))); }
DI float row_sum16(float x) { x += dpp_f<0xB1>(x); x += dpp_f<0x4E>(x); x += dpp_f<0x141>(x); x += dpp_f<0x140>(x); return x; }
}
struct ScanRegs { unsigned short r[8], k[8], v[8], a[8]; float dec[8]; };
DI void scan_issue(const Frame& F, ScanRegs& R, const bf16_t* RKV, const float* DEC, const bf16_t* AA, int b, int hd, int tch) {
    const int lw = F.wave - 4, lane = F.lane;
#pragma unroll
    for (int i = 0; i < 8; ++i) {
        const size_t tok = (size_t)b * SEQ + (size_t)tch * scan::TC + lw + 4 * i;
        const size_t o = tok * DM + hd * 64 + lane;
        R.r[i] = RKV[o]; R.k[i] = RKV[(size_t)M * DM + o]; R.v[i] = RKV[(size_t)2 * M * DM + o]; R.dec[i] = DEC[o]; R.a[i] = AA[o];
    }
}
DI void scan_fill(const Frame& F, const ScanRegs& R, LAS unsigned char* buf, float kkw, float kaw, int half) {
    const int lw = F.wave - 4, lane = F.lane;
#pragma unroll
    for (int i = 0; i < 8; ++i) {
        const int s = lw + 4 * i;
        const float r = bf2f(R.r[i]), k = bf2f(R.k[i]), v = bf2f(R.v[i]), dec = R.dec[i], a = bf2f(R.a[i]);
        const float kx = k * kkw;
        const float kk = kx * __builtin_amdgcn_rsqf(fmaxf(scan::wave_sum_dpp(kx * kx), 1e-24f));
        const float kp = k * (1.0f + (a - 1.0f) * kaw);
        LAS float* sp = (LAS float*)(buf + s * scan::STEPB);
        sp[lane] = dec; sp[64 + lane] = -kk; sp[128 + lane] = kk * a; sp[192 + lane] = kp; sp[256 + lane] = r;
        if ((lane >> 5) == half) sp[320 + (lane & 31)] = v;
    }
}
DI void scan_flush(const Frame& F, LAS unsigned char* ybuf, bf16_t* YRAW, int b, int hd, int half, int tch) {
    const int lw = F.wave - 4, lane = F.lane;
    for (int s = 2 * lw; s < scan::TC; s += 8) {
        const int ss = s + (lane >> 5);
        const size_t tok = (size_t)b * SEQ + (size_t)tch * scan::TC + ss;
        YRAW[tok * DM + hd * 64 + half * 32 + (lane & 31)] = (bf16_t)f2bf(((LAS float*)ybuf)[(ss + 1) * 32 + (lane & 31)]);
    }
}
struct CvItem { const float* W; unsigned char* WT; int Nsrc, Kd, k0, n0, s0; float mul; bool on; };
constexpr int CV_I13 = (DM / 64) * (2 * DFFE / 32), CV_I2 = (DFFE / 64) * (DM / 32), CV_TOTAL = NEXP * (CV_I13 + CV_I2);
DI CvItem cv_item(int gid, const float* w13, const float* w2, unsigned char* m13, unsigned char* m2) {
    CvItem it; it.on = gid < CV_TOTAL;
    if (gid < NEXP * CV_I13) { const int e = gid / CV_I13, r = gid % CV_I13, kb = r / (2 * DFFE / 32), nb = r % (2 * DFFE / 32);
        it.W = w13 + (size_t)e * DM * 2 * DFFE; it.WT = m13 + (size_t)e * 2 * DFFE * DM; it.Nsrc = 2 * DFFE; it.Kd = DM; it.k0 = 64 * kb; it.n0 = 32 * nb; it.mul = 64.0f;
        const int t = it.n0 >> 8, rr = it.n0 & 255; it.s0 = rr < 128 ? t * 128 + rr : DFFE + t * 128 + (rr - 128);
    } else { const int g2 = gid - NEXP * CV_I13; const int e = g2 / CV_I2, r = g2 % CV_I2, kb = r / (DM / 32), nb = r % (DM / 32);
        it.W = w2 + (size_t)e * DFFE * DM; it.WT = m2 + (size_t)e * DM * DFFE; it.Nsrc = DM; it.Kd = DFFE; it.k0 = 64 * kb; it.n0 = 32 * nb; it.mul = 128.0f; it.s0 = it.n0; }
    return it;
}
DI void cv_load(float (&v)[32], const CvItem& it, int lane) {
    if (!it.on) return;
    const char* rowbase = (const char*)(it.W + (size_t)it.k0 * it.Nsrc + it.s0);
    const unsigned loff = (unsigned)((lane >> 5) * it.Nsrc + (lane & 31)) * 4u;
    const size_t rstep = (size_t)it.Nsrc * 8;
#pragma unroll
    for (int i = 0; i < 32; ++i) v[i] = __builtin_nontemporal_load((const float*)(rowbase + (size_t)i * rstep + loff));
}
DI void cv_store(const float (&v)[32], const CvItem& it, LAS float* scr, int lane) {
    if (!it.on) return;
#pragma unroll
    for (int i = 0; i < 32; ++i) scr[(2 * i + (lane >> 5)) * 33 + (lane & 31)] = v[i];
    asm volatile("s_waitcnt lgkmcnt(0)" ::: "memory");
    const int c = lane & 7;
#pragma unroll
    for (int j = 0; j < 4; ++j) { const int n = (lane >> 3) + 8 * j; const LAS float* s = scr + (8 * c) * 33 + n;
        u32x2 o; o.x = pk4_fp8(s[0 * 33] * it.mul, s[1 * 33] * it.mul, s[2 * 33] * it.mul, s[3 * 33] * it.mul); o.y = pk4_fp8(s[4 * 33] * it.mul, s[5 * 33] * it.mul, s[6 * 33] * it.mul, s[7 * 33] * it.mul);
        *(u32x2*)(it.WT + (size_t)(it.n0 + n) * it.Kd + it.k0 + 8 * c) = o; }
    asm volatile("s_waitcnt lgkmcnt(0)" ::: "memory");
}
DI unsigned long long phase_scan(const Frame& F, const bf16_t* RKV, const float* DEC, const bf16_t* AA, const float* kk_w, const float* ka_w, bf16_t* YRAW,
                                  const float* w13, const float* w2, unsigned char* m13, unsigned char* m2) {
    unsigned long long pacc = 0ull;
    for (int vb = blockIdx.x; vb < 256; vb += F.G) {
        const int bh = vb >> 1, half = vb & 1, b = bh >> 5, hd = bh & 31;
        const int w = F.wave, lane = F.lane;
        const int rp = lane >> 4, cg = lane & 15;
        const int row0 = 8 * w + 2 * rp;
        f32x2 SS[4] = {(f32x2){0.f, 0.f}, (f32x2){0.f, 0.f}, (f32x2){0.f, 0.f}, (f32x2){0.f, 0.f}};
        constexpr int NCH = SEQ / scan::TC;
        volatile LAS unsigned* fl = (volatile LAS unsigned*)(F.lds + 138240);
#define SC_WAIT(idx, target) do { unsigned sp_ = 0; while (fl[idx] < (unsigned)(target) && ++sp_ < (1u << 24)) __builtin_amdgcn_s_sleep(1); asm volatile("" ::: "memory"); } while (0)
#define SC_SIGNAL(idx) do { asm volatile("s_waitcnt lgkmcnt(0)" ::: "memory"); if (lane == 0) (void)__hip_atomic_fetch_add((LAS unsigned*)&fl[idx], 1u, __ATOMIC_RELAXED, __HIP_MEMORY_SCOPE_WORKGROUP); } while (0)
        if (w < 4) {
            __builtin_amdgcn_s_setprio(3);
            for (int ch = 0; ch < NCH; ++ch) {
                LAS unsigned char* buf = F.lds + (ch & 1) * scan::CHB;
                LAS float* yb = (LAS float*)(F.lds + scan::OFF_Y + (ch & 1) * scan::YB);
                SC_WAIT(ch & 1, 4 * (ch / 2 + 1));
                if (ch >= 2) SC_WAIT(4 + (ch & 1), 4 * (ch / 2));
#ifdef PROBE_SCAN
                const unsigned long long pt0 = __builtin_amdgcn_s_memrealtime();
#endif
                f32x2 yp = (f32x2){0.f, 0.f};
                const LAS float* sp0 = (const LAS float*)buf;
                f32x4 w4 = *(const LAS f32x4*)(sp0 + 4 * cg), nk4 = *(const LAS f32x4*)(sp0 + 64 + 4 * cg), b4 = *(const LAS f32x4*)(sp0 + 128 + 4 * cg),
                      k4 = *(const LAS f32x4*)(sp0 + 192 + 4 * cg), r4 = *(const LAS f32x4*)(sp0 + 256 + 4 * cg);
                f32x2 v2 = *(const LAS f32x2*)(sp0 + 320 + row0);
#define SPL(x) ((f32x2){(x), (x)})
#pragma unroll 8
                for (int s = 0; s < scan::TC; ++s) {
                    const LAS float* sp = (const LAS float*)(buf + (s + 1) * scan::STEPB);
                    const f32x4 w4n = *(const LAS f32x4*)(sp + 4 * cg), nk4n = *(const LAS f32x4*)(sp + 64 + 4 * cg), b4n = *(const LAS f32x4*)(sp + 128 + 4 * cg),
                                k4n = *(const LAS f32x4*)(sp + 192 + 4 * cg), r4n = *(const LAS f32x4*)(sp + 256 + 4 * cg);
                    const f32x2 v2n = *(const LAS f32x2*)(sp + 320 + row0);
                    f32x2 sa = SS[0] * SPL(nk4[0]);
#pragma unroll
                    for (int i = 1; i < 4; ++i) sa = __builtin_elementwise_fma(SS[i], SPL(nk4[i]), sa);
                    float sa0 = sa.x, sa1 = sa.y, y0 = yp.x, y1 = yp.y;
                    scan::row_sum16x4(sa0, sa1, y0, y1);
                    if (cg == 0) { yb[s * 32 + row0] = y0; yb[s * 32 + row0 + 1] = y1; }
                    sa = (f32x2){sa0, sa1};
                    yp = (f32x2){0.f, 0.f};
#pragma unroll
                    for (int i = 0; i < 4; ++i) {
                        f32x2 t = v2 * SPL(k4[i]);
                        t = __builtin_elementwise_fma(sa, SPL(b4[i]), t);
                        SS[i] = __builtin_elementwise_fma(SS[i], SPL(w4[i]), t);
                        yp = __builtin_elementwise_fma(SS[i], SPL(r4[i]), yp);
                    }
                    w4 = w4n; nk4 = nk4n; b4 = b4n; k4 = k4n; r4 = r4n; v2 = v2n;
                }
#undef SPL
                float d0 = 0.f, d1 = 0.f, y0 = yp.x, y1 = yp.y;
                scan::row_sum16x4(y0, y1, d0, d1);
                if (cg == 0) { yb[scan::TC * 32 + row0] = y0; yb[scan::TC * 32 + row0 + 1] = y1; }
#ifdef PROBE_SCAN
                if (PROBE_SCAN == 1) pacc += __builtin_amdgcn_s_memrealtime() - pt0;
#endif
                SC_SIGNAL(2 + (ch & 1));
            }
            __builtin_amdgcn_s_setprio(0);
        } else {
            ScanRegs SR;
            const float kkw = kk_w[hd * 64 + lane], kaw = ka_w[hd * 64 + lane];
            scan_issue(F, SR, RKV, DEC, AA, b, hd, 0); scan_fill(F, SR, F.lds, kkw, kaw, half); SC_SIGNAL(0); scan_issue(F, SR, RKV, DEC, AA, b, hd, 1);
            LAS float* cscr = (LAS float*)(F.lds + 98816 + (w - 4) * 8448);
            for (int it = 0; it < NCH; ++it) {
#ifdef PROBE_SCAN
                const unsigned long long pt0 = __builtin_amdgcn_s_memrealtime();
#endif
                const int gid0 = ((it * 256 + vb) * 4 + (w - 4)) * 2;
                const CvItem ia = cv_item(gid0, w13, w2, m13, m2), ib = cv_item(gid0 + 1, w13, w2, m13, m2);
                float ca[32];
                cv_load(ca, ia, lane);
                if (it >= 1) SC_WAIT(2 + ((it - 1) & 1), 4 * ((it - 1) / 2 + 1));
                if (it + 1 < NCH) { scan_fill(F, SR, F.lds + ((it + 1) & 1) * scan::CHB, kkw, kaw, half); SC_SIGNAL((it + 1) & 1); }
                if (it + 2 < NCH) scan_issue(F, SR, RKV, DEC, AA, b, hd, it + 2);
                if (it >= 1) { scan_flush(F, F.lds + scan::OFF_Y + ((it - 1) & 1) * scan::YB, YRAW, b, hd, half, it - 1); SC_SIGNAL(4 + ((it - 1) & 1)); }
                cv_store(ca, ia, cscr, lane);
                cv_load(ca, ib, lane); cv_store(ca, ib, cscr, lane);
#ifdef PROBE_SCAN
                if (PROBE_SCAN == 2) pacc += __builtin_amdgcn_s_memrealtime() - pt0;
#endif
            }
            SC_WAIT(2 + ((NCH - 1) & 1), 4 * ((NCH - 1) / 2 + 1));
            scan_flush(F, F.lds + scan::OFF_Y + ((NCH - 1) & 1) * scan::YB, YRAW, b, hd, half, NCH - 1);
        }
#undef SC_WAIT
#undef SC_SIGNAL
        __syncthreads();
        if (F.tid < 6) fl[F.tid] = 0u;
        __syncthreads();
    }
    return pacc;
}

constexpr int NPHASE = 19;
__global__ void __launch_bounds__(NTHR, 2) mk_fwd(Args args) {
    extern __shared__ __attribute__((aligned(16))) unsigned char lds_raw[];
    Frame F;
    F.lds = (LAS unsigned char*)lds_raw;
    F.tid = threadIdx.x; F.lane = F.tid & 63; F.wave = __builtin_amdgcn_readfirstlane(F.tid >> 6);
    F.G = gridDim.x; F.gw = blockIdx.x * NWAVES + F.wave; F.NGW = F.G * NWAVES; F.ws = args.ws;
    unsigned char* ws = args.ws;
    unsigned* ctl = (unsigned*)(ws + WS_CTL);
    volatile LAS unsigned* MISC = (volatile LAS unsigned*)(F.lds + MISC_OFF);
    for (int u = F.tid; u < (LDS_BYTES - LDSCTL_OFF) / 4; u += NTHR) ((LAS unsigned*)(F.lds + LDSCTL_OFF))[u] = 0u;
    __syncthreads();
    XcdBarrier bar; bar.bar = ctl + CW_BAR; bar.x = 0; bar.st = nullptr;
    if (args.use_bar) bar = xcd_barrier_post(ctl + CW_BAR, MISC + 8);
    const int lo = args.ph_lo, hi = args.ph_hi;
#ifndef PH_MASK
#define PH_MASK 0xFFFFFFFFu
#endif
#define IN(k) (((PH_MASK >> (k)) & 1u) && lo <= (k) && (k) < hi)
#define SEAM(k) do { if (IN(k) && IN((k) + 1)) xcd_barrier(bar); if (PROBE_ON(k)) probe_acc += __builtin_amdgcn_s_memrealtime() - probe_t0; if (PROBE_ON((k) + 1)) probe_t0 = __builtin_amdgcn_s_memrealtime(); } while (0)
#ifndef REPEAT_MASK
#define REPEAT_MASK 0u
#endif
#define REPS(k) ((((REPEAT_MASK) >> (k)) & 1u) ? 2 : 1)
#ifndef PROBE_MASK
#define PROBE_MASK 0u
#endif
    unsigned long long probe_acc = 0ull, probe_t0 = 0ull;
#define PROBE_ON(k) (PROBE_MASK != 0u && (((PROBE_MASK) >> (k)) & 1u) && blockIdx.x == 0 && F.tid == 0)
#define PH(k) if (IN(k)) for (int rep_ = 0; rep_ < REPS(k); ++rep_, (rep_ < REPS(k) ? xcd_barrier(bar) : (void)0))

    bf16_t* W_IN = (bf16_t*)(ws + WS_W_IN); bf16_t* W_OUT = (bf16_t*)(ws + WS_W_OUT); bf16_t* CMPW1 = (bf16_t*)(ws + WS_CMPW1);
    bf16_t* FFN13 = (bf16_t*)(ws + WS_FFN13); bf16_t* FFN2 = (bf16_t*)(ws + WS_FFN2); bf16_t* WRKV = (bf16_t*)(ws + WS_WRKV);
    bf16_t* LORA1 = (bf16_t*)(ws + WS_LORA1); bf16_t* LORA2 = (bf16_t*)(ws + WS_LORA2); bf16_t* WO = (bf16_t*)(ws + WS_WO);
    bf16_t* MOE13 = (bf16_t*)(ws + WS_MOE13); bf16_t* MOE2 = (bf16_t*)(ws + WS_MOE2);
    bf16_t* XN = (bf16_t*)(ws + WS_XN); bf16_t* P = (bf16_t*)(ws + WS_P); float* ROPE = (float*)(ws + WS_ROPE); float* CMPB = (float*)(ws + WS_CMPB);
    bf16_t* HID = (bf16_t*)(ws + WS_HID); bf16_t* KVC = (bf16_t*)(ws + WS_KVC); bf16_t* O = (bf16_t*)(ws + WS_O); bf16_t* H = (bf16_t*)(ws + WS_H);
    bf16_t* ACT = (bf16_t*)(ws + WS_ACT); bf16_t* XS = (bf16_t*)(ws + WS_XS); bf16_t* RKV = (bf16_t*)(ws + WS_RKV); bf16_t* L1 = (bf16_t*)(ws + WS_L1);
    float* DEC = (float*)(ws + WS_DEC); bf16_t* AA = (bf16_t*)(ws + WS_AA); bf16_t* GG = (bf16_t*)(ws + WS_GG); bf16_t* YRAW = (bf16_t*)(ws + WS_YRAW); bf16_t* YG = (bf16_t*)(ws + WS_YG);
    int* ROWTOK = (int*)(ws + WS_ROWTOK); int* TOKSLOT = (int*)(ws + WS_TOKSLOT); float* Y2 = (float*)(ws + WS_Y2);
    LAS unsigned char* ring = F.lds;

    if (PROBE_ON(0)) probe_t0 = __builtin_amdgcn_s_memrealtime();
    PH(0) {
        LAS float* scr = (LAS float*)(F.lds + F.wave * 16640);
        transpose_matrix(F, args.in[I_W_IN], IN_COLS, DM, W_IN, DM, NP, ColInProj{}, scr, F.gw, F.NGW);
        for (int kv = 0; kv < 2; ++kv) transpose_matrix(F, args.in[I_CMP_W1] + (size_t)kv * 2048 * 256, 256, 2048, CMPW1 + (size_t)kv * 256 * 2048, 2048, 256, ColIdent{}, scr, F.gw, F.NGW);
        for (int m = F.gw; m < M; m += F.NGW) rms_row_to_bf16(args.in[I_X] + (size_t)m * DM, args.in[I_ATTN_NORM], XN + (size_t)m * DM, F.lane);
        { const int* pos = (const int*)args.in[I_POS];
          for (int i = blockIdx.x * NTHR + F.tid; i < M * 32; i += F.G * NTHR) { const int m = i >> 5, j = i & 31;
              const float inv = powf(150000.0f, -(float)j / 32.0f); const float ang = (float)pos[m] * inv; float sn, cs; sincosf(ang, &sn, &cs);
              ROPE[(size_t)m * 64 + j] = cs; ROPE[(size_t)m * 64 + 32 + j] = sn; } }
        if (F.gw < 512) { const int kv = F.gw >> 8, j = F.gw & 255; const float* pe = args.in[I_CMP_PE] + kv * 2048; const float* w1 = args.in[I_CMP_W1] + (size_t)kv * 2048 * 256;
            float s = 0.f; for (int i = F.lane; i < 2048; i += 64) s += pe[i] * w1[(size_t)i * 256 + j];
            s = wave_sum(s); if (F.lane == 0) CMPB[kv * 256 + j] = s + args.in[I_CMP_B1][kv * 256 + j]; }
    }
    SEAM(0);
    PH(1) {
        OrderSingle S{(const char*)XN, (const char*)W_IN, DM * 2, DM * 2, 64, 12, 64 * 12, F.G, (int)blockIdx.x};
        EpiInProj E{P, ROPE};
        pg8::gemm_phase<EpiInProj, OrderSingle, false>(ring, DM * 2, 128, DM * 2, DM / 64, S, E);
    }
    SEAM(1);
    PH(2) {
        OrderCmp S{(const char*)P, (const char*)CMPW1, (const char*)XN, (const char*)(W_IN + (size_t)C_GATE * DM), F.G, (int)blockIdx.x};
        EpiCmp1 E{HID, CMPB, P};
        pg8::gemm_phase<EpiCmp1, OrderCmp, true>(ring, 0, 0, 2048 * 2, 32, S, E);
        const bool conv = F.G > 80 ? (int)blockIdx.x >= 80 : true;
        if (conv) {
            const int nconv = F.G > 80 ? F.G - 80 : F.G; const int first = ((F.G > 80 ? (int)blockIdx.x - 80 : (int)blockIdx.x)) * NWAVES + F.wave, stride = nconv * NWAVES;
            LAS float* scr = (LAS float*)(F.lds + F.wave * 16640);
            transpose_matrix(F, args.in[I_W_OUT], DM, DM, W_OUT, DM, DM, ColIdent{}, scr, first, stride);
            transpose_matrix(F, args.in[I_FFN_W13], 2 * DFF, DM, FFN13, DM, 2 * DFF, ColSwiglu{DFF}, scr, first, stride);
            transpose_matrix(F, args.in[I_FFN_W2], DM, DFF, FFN2, DFF, DM, ColIdent{}, scr, first, stride);
            for (int i = 0; i < 3; ++i) transpose_matrix(F, args.in[I_W_RKV] + (size_t)i * DM * DM, DM, DM, WRKV + (size_t)i * DM * DM, DM, DM, ColIdent{}, scr, first, stride);
            transpose_matrix(F, args.in[I_DECAY_W1], 96, DM, LORA1, DM, 256, ColIdent{}, scr, first, stride);
            transpose_matrix(F, args.in[I_A1], 96, DM, LORA1 + (size_t)256 * DM, DM, 256, ColIdent{}, scr, first, stride);
            transpose_matrix(F, args.in[I_G1], 256, DM, LORA1 + (size_t)512 * DM, DM, 256, ColIdent{}, scr, first, stride);
            transpose_matrix(F, args.in[I_DECAY_W2], DM, 96, LORA2, 256, DM, ColIdent{}, scr, first, stride);
            transpose_matrix(F, args.in[I_A2], DM, 96, LORA2 + (size_t)DM * 256, 256, DM, ColIdent{}, scr, first, stride);
            transpose_matrix(F, args.in[I_G2], DM, 256, LORA2 + (size_t)2 * DM * 256, 256, DM, ColIdent{}, scr, first, stride);
            transpose_matrix(F, args.in[I_W_O], DM, DM, WO, DM, DM, ColIdent{}, scr, first, stride);
        }
    }
    SEAM(2);
    PH(3) {
        for (int it = blockIdx.x * NTHR + F.tid; it < 2 * 2048 * 16; it += F.G * NTHR) {
            const int dq = it & 15, row = (it >> 4) & 2047, kv = it >> 15;
            const bf16_t* hr = HID + ((size_t)kv * 2048 + row) * 256; const float* w2 = args.in[I_CMP_W2] + (size_t)kv * 256 * 64 + dq * 4;
            f32x4 a = (f32x4){0.f, 0.f, 0.f, 0.f};
            for (int j = 0; j < 256; j += 2) { const unsigned hw = *(const unsigned*)(hr + j); a += bflo(hw) * *(const f32x4*)(w2 + (size_t)j * 64); a += bfhi(hw) * *(const f32x4*)(w2 + (size_t)(j + 1) * 64); }
            u32x2 o; o.x = pk2(a.x, a.y); o.y = pk2(a.z, a.w); *(u32x2*)(KVC + ((size_t)kv * 2048 + row) * 64 + dq * 4) = o;
        }
    }
    SEAM(3);
    PH(4) {
        for (int vb = blockIdx.x; vb < 256; vb += F.G) {
            const int bh = vb >> 5, p = vb & 31;
#pragma unroll 1
            for (int k = 0; k < 2; ++k) attn_unit_B(F, P, KVC, O, nullptr, bh >> 1, bh & 1, k == 0 ? 63 - p : p);
#pragma unroll 1
            for (int k = 0; k < 2; ++k) { const int id = 2 * vb + k; attn_unit_A(F, P, O, args.in[I_SINKS], id >> 7, (id >> 6) & 1, id & 63); }
        }
    }
    SEAM(4);
    PH(5) {
        OrderSingle S{(const char*)O, (const char*)W_OUT, DM * 2, DM * 2, 64, 8, 512, F.G, (int)blockIdx.x};
        EpiResH<true> E{args.in[I_X], H};
        pg8::gemm_phase<EpiResH<true>, OrderSingle, false>(ring, DM * 2, 128, DM * 2, DM / 64, S, E);
    }
    SEAM(5);
    PH(6) { for (int m = F.gw; m < M; m += F.NGW) rms_row_to_bf16_h(H + (size_t)m * DM, args.in[I_FFN_NORM], XN + (size_t)m * DM, F.lane); }
    SEAM(6);
    PH(7) {
        OrderSingle S{(const char*)XN, (const char*)FFN13, DM * 2, DM * 2, 64, 2 * DFF / 256, 64 * (2 * DFF / 256), F.G, (int)blockIdx.x};
        EpiSwiglu E{ACT, DFF};
        pg8::gemm_phase<EpiSwiglu, OrderSingle, false>(ring, DM * 2, 128, DM * 2, DM / 64, S, E);
    }
    SEAM(7);
    PH(8) {
        OrderSingle S{(const char*)ACT, (const char*)FFN2, DFF * 2, DFF * 2, 64, 8, 512, F.G, (int)blockIdx.x};
        EpiResH<false> E{H, H};
        pg8::gemm_phase<EpiResH<false>, OrderSingle, false>(ring, DFF * 2, 128, DFF * 2, DFF / 64, S, E);
    }
    SEAM(8);
    PH(9) {
        const float* g = args.in[I_ATTN_NORM] + DM; const float* mu = args.in[I_MU];
        for (int m0 = F.gw * 8; m0 < M; m0 += F.NGW * 8) {
            f32x4 hp[8], vn[8];
            const bool has_prev0 = (m0 % SEQ) != 0;
            if (has_prev0) { float prs; rms_row_load_h(H + (size_t)(m0 - 1) * DM, F.lane, hp, prs);
#pragma unroll
                for (int j = 0; j < 8; ++j) hp[j] = hp[j] * prs * *(const f32x4*)(g + 4 * F.lane + 256 * j);
            } else {
#pragma unroll
                for (int j = 0; j < 8; ++j) hp[j] = (f32x4){0.f, 0.f, 0.f, 0.f};
            }
#pragma unroll
            for (int j = 0; j < 8; ++j) vn[j] = ld4bf(H + (size_t)m0 * DM + 4 * F.lane + 256 * j);
            for (int q = 0; q < 8; ++q) {
                const int m = m0 + q;
                f32x4 v[8]; float ss = 0.f;
#pragma unroll
                for (int j = 0; j < 8; ++j) { v[j] = vn[j]; ss += (v[j].x * v[j].x + v[j].y * v[j].y) + (v[j].z * v[j].z + v[j].w * v[j].w); }
                if (q < 7) {
#pragma unroll
                    for (int j = 0; j < 8; ++j) vn[j] = ld4bf(H + (size_t)(m + 1) * DM + 4 * F.lane + 256 * j);
                }
                const float rs = __builtin_amdgcn_rsqf(scan::wave_sum_dpp(ss) * (1.0f / DM) + RMS_EPS);
                const float* g_ = opqp(g); const float* mu_ = opqp(mu);
#pragma unroll
                for (int j = 0; j < 8; ++j) {
                    const int col = 4 * F.lane + 256 * j; const f32x4 gg = *(const f32x4*)(g_ + col);
                    const f32x4 hn = v[j] * rs * gg; const f32x4 xx = hp[j] - hn; hp[j] = hn;
#pragma unroll
                    for (int i = 0; i < 6; ++i) { const f32x4 mm = *(const f32x4*)(mu_ + (size_t)i * DM + col); const f32x4 y = hn + xx * mm;
                        u32x2 w; w.x = pk2(y.x, y.y); w.y = pk2(y.z, y.w); *(u32x2*)(XS + ((size_t)i * M + m) * DM + col) = w; }
                }
            }
        }
    }
    SEAM(9);
    PH(10) {
        OrderMulti S{};
        for (int g = 0; g < 6; ++g) { S.A[g] = (const char*)(XS + (size_t)g * M * DM); S.Bt[g] = g < 3 ? (const char*)(WRKV + (size_t)g * DM * DM) : (const char*)(LORA1 + (size_t)(g - 3) * 256 * DM); S.nN[g] = g < 3 ? 8 : 1; }
        S.start[0] = 0; for (int g = 0; g < 6; ++g) S.start[g + 1] = S.start[g] + 64 * S.nN[g];
        S.lda = DM * 2; S.ldb = DM * 2; S.ng = 6; S.nwg = S.start[6]; S.G = F.G; S.c = (int)blockIdx.x;
        EpiRkvLora1 E{RKV, L1};
        pg8::gemm_phase<EpiRkvLora1, OrderMulti, false>(ring, DM * 2, 128, DM * 2, DM / 64, S, E);
    }
    SEAM(10);
    PH(11) {
        OrderMulti S{};
        for (int g = 0; g < 3; ++g) { S.A[g] = (const char*)(L1 + (size_t)g * M * 256); S.Bt[g] = (const char*)(LORA2 + (size_t)g * DM * 256); S.nN[g] = 8; }
        for (int g = 3; g < 6; ++g) { S.A[g] = S.A[0]; S.Bt[g] = S.Bt[0]; S.nN[g] = 0; }
        S.start[0] = 0; for (int g = 0; g < 6; ++g) S.start[g + 1] = S.start[g] + 64 * S.nN[g];
        S.lda = 256 * 2; S.ldb = 256 * 2; S.ng = 3; S.nwg = S.start[3]; S.G = F.G; S.c = (int)blockIdx.x;
        EpiLora2 E{DEC, AA, GG, args.in[I_DECAY_W0], args.in[I_A0]};
        pg8::gemm_phase<EpiLora2, OrderMulti, false>(ring, 256 * 2, 128, 256 * 2, 4, S, E);
    }
    SEAM(11);
    PH(12) {
        const unsigned long long pa = phase_scan(F, RKV, DEC, AA, args.in[I_K_K], args.in[I_K_A], YRAW, args.in[I_MOE_W13], args.in[I_MOE_W2], (unsigned char*)MOE13, (unsigned char*)MOE2);
#ifdef PROBE_SCAN
        if (blockIdx.x == 0 && (F.tid == 0 || F.tid == 256)) { const unsigned long long t1 = __builtin_amdgcn_s_memrealtime(); if ((PROBE_SCAN == 1 && F.tid == 0) || (PROBE_SCAN == 2 && F.tid == 256)) while (__builtin_amdgcn_s_memrealtime() - t1 < 4ull * pa) __builtin_amdgcn_s_sleep(8); }
#else
        (void)pa;
#endif
    }
    SEAM(12);
    PH(13) {
        const float* lnw = args.in[I_LN_W]; const float* lnb = args.in[I_LN_B]; const float* rk = args.in[I_R_K]; const float* kaw = args.in[I_K_A];
        for (int m = F.gw; m < M; m += F.NGW) {
#pragma unroll
            for (int ps = 0; ps < 4; ++ps) {
                const int ch = ps * 512 + F.lane * 8; const size_t o = (size_t)m * DM + ch;
                const u32x4 yy = *(const u32x4*)(YRAW + o);
                const u32x4 aa = *(const u32x4*)(AA + o);
                const u32x4 rr = *(const u32x4*)(RKV + o), kk = *(const u32x4*)(RKV + (size_t)M * DM + o), vv = *(const u32x4*)(RKV + (size_t)2 * M * DM + o), gg = *(const u32x4*)(GG + o);
                float y[8] = {bflo(yy.x), bfhi(yy.x), bflo(yy.y), bfhi(yy.y), bflo(yy.z), bfhi(yy.z), bflo(yy.w), bfhi(yy.w)}, a[8] = {bflo(aa.x), bfhi(aa.x), bflo(aa.y), bfhi(aa.y), bflo(aa.z), bfhi(aa.z), bflo(aa.w), bfhi(aa.w)};
                const unsigned rw[4] = {rr.x, rr.y, rr.z, rr.w}, kw[4] = {kk.x, kk.y, kk.z, kk.w}, vw[4] = {vv.x, vv.y, vv.z, vv.w}, gw4[4] = {gg.x, gg.y, gg.z, gg.w};
                float r[8], k[8], v[8], g[8];
#pragma unroll
                for (int i = 0; i < 4; ++i) { r[2 * i] = bflo(rw[i]); r[2 * i + 1] = bfhi(rw[i]); k[2 * i] = bflo(kw[i]); k[2 * i + 1] = bfhi(kw[i]); v[2 * i] = bflo(vw[i]); v[2 * i + 1] = bfhi(vw[i]); g[2 * i] = bflo(gw4[i]); g[2 * i + 1] = bfhi(gw4[i]); }
                float s = 0.f, bs = 0.f;
#pragma unroll
                for (int i = 0; i < 8; ++i) { s += y[i]; bs += r[i] * (k[i] * (1.0f + (a[i] - 1.0f) * kaw[ch + i])) * rk[ch + i]; }
                s += scan::dpp_f<0xB1>(s); s += scan::dpp_f<0x4E>(s); s += scan::dpp_f<0x141>(s);
                bs += scan::dpp_f<0xB1>(bs); bs += scan::dpp_f<0x4E>(bs); bs += scan::dpp_f<0x141>(bs);
                const float mean = s * (1.0f / 64.0f); float q = 0.f;
#pragma unroll
                for (int i = 0; i < 8; ++i) { y[i] -= mean; q += y[i] * y[i]; }
                q += scan::dpp_f<0xB1>(q); q += scan::dpp_f<0x4E>(q); q += scan::dpp_f<0x141>(q);
                const float rstd = 1.0f / sqrtf(q * (1.0f / 64.0f) + GN_EPS);
                float out[8];
#pragma unroll
                for (int i = 0; i < 8; ++i) out[i] = ((y[i] * rstd) * lnw[ch + i] + lnb[ch + i] + bs * v[i]) * g[i];
                u32x4 w; w.x = pk2(out[0], out[1]); w.y = pk2(out[2], out[3]); w.z = pk2(out[4], out[5]); w.w = pk2(out[6], out[7]);
                *(u32x4*)(YG + o) = w;
            }
        }
    }
    SEAM(13);
    PH(14) {
        OrderSingle S{(const char*)YG, (const char*)WO, DM * 2, DM * 2, 64, 8, 512, F.G, (int)blockIdx.x};
        EpiResH<false> E{H, H};
        pg8::gemm_phase<EpiResH<false>, OrderSingle, false>(ring, DM * 2, 128, DM * 2, DM / 64, S, E);
    }
    SEAM(14);
    PH(15) {
        LAS int* t_e = (LAS int*)(F.lds + 65536);
        LAS float* t_w = (LAS float*)(F.lds + 65536 + 512);
        LAS int* t_p = (LAS int*)(F.lds + 65536 + 1024);
        LAS unsigned char* rwl = F.lds;
        const float* g = args.in[I_FFN_NORM] + DM; const float* rw = args.in[I_ROUTER];
        for (int idx = F.tid; idx < 4096; idx += NTHR) {
            const int chn = idx >> 1, half = idx & 1; const int j = chn >> 8, l = (chn & 255) >> 2, e4 = chn & 3;
            *(LAS f32x4*)(rwl + ((2 * (4 * j + e4) + half) * 64 + l) * 16) = *(const f32x4*)(rw + (size_t)idx * 4);
        }
        __syncthreads();
        for (int base = blockIdx.x * 64; base < M; base += F.G * 64) {
            f32x4 vn[8];
#pragma unroll
            for (int j = 0; j < 8; ++j) vn[j] = ld4bf(H + (size_t)(base + F.wave * 8) * DM + 4 * F.lane + 256 * j);
            for (int qq = 0; qq < 8; ++qq) {
                const int lt = F.wave * 8 + qq, m = base + lt;
                f32x4 v[8]; float ss = 0.f;
#pragma unroll
                for (int j = 0; j < 8; ++j) { v[j] = vn[j]; ss += (v[j].x * v[j].x + v[j].y * v[j].y) + (v[j].z * v[j].z + v[j].w * v[j].w); }
                if (qq < 7) {
#pragma unroll
                    for (int j = 0; j < 8; ++j) vn[j] = ld4bf(H + (size_t)(m + 1) * DM + 4 * F.lane + 256 * j);
                }
                const float rs = __builtin_amdgcn_rsqf(scan::wave_sum_dpp(ss) * (1.0f / DM) + RMS_EPS);
                float lg[8] = {0.f, 0.f, 0.f, 0.f, 0.f, 0.f, 0.f, 0.f};
#pragma unroll
                for (int j = 0; j < 8; ++j) {
                    const int col = 4 * F.lane + 256 * j; const f32x4 gg = *(const f32x4*)(g + col); const f32x4 y = v[j] * rs * gg;
                    *(unsigned*)((unsigned char*)XN + (size_t)m * DM + col) = pk4_fp8(y.x, y.y, y.z, y.w);
#pragma unroll
                    for (int e4 = 0; e4 < 4; ++e4) { const f32x4 r0 = *(const LAS f32x4*)(rwl + ((2 * (4 * j + e4)) * 64 + F.lane) * 16), r1 = *(const LAS f32x4*)(rwl + ((2 * (4 * j + e4) + 1) * 64 + F.lane) * 16); const float yy = y[e4];
                        lg[0] += yy * r0.x; lg[1] += yy * r0.y; lg[2] += yy * r0.z; lg[3] += yy * r0.w; lg[4] += yy * r1.x; lg[5] += yy * r1.y; lg[6] += yy * r1.z; lg[7] += yy * r1.w; }
                }
#pragma unroll
                for (int e = 0; e < 8; ++e) lg[e] = scan::wave_sum_dpp(lg[e]);
                if (F.lane == 0) {
                    int i0 = 0; float v0 = lg[0];
#pragma unroll
                    for (int e = 1; e < 8; ++e) if (lg[e] > v0) { v0 = lg[e]; i0 = e; }
                    int i1 = -1; float v1 = -3.0e38f;
#pragma unroll
                    for (int e = 0; e < 8; ++e) if (e != i0 && (i1 < 0 || lg[e] > v1)) { v1 = lg[e]; i1 = e; }
                    const float w1 = 1.0f / (1.0f + expf(v0 - v1)), w0 = 1.0f - w1;
                    t_e[lt * 2] = i0; t_e[lt * 2 + 1] = i1; t_w[lt * 2] = w0; t_w[lt * 2 + 1] = w1;
                }
            }
            __syncthreads();
            if (F.wave == 0) {
                const int lane = F.lane; const int ea = t_e[lane], eb = t_e[64 + lane];
                const unsigned long long below = (1ull << lane) - 1ull;
                int pa = 0, pb = 0, mycnt = 0, ra = 0, rb = 0, na_sel = 0;
#pragma unroll
                for (int e = 0; e < 8; ++e) {
                    const unsigned long long ma = __ballot(ea == e), mb = __ballot(eb == e);
                    const int na = __popcll(ma), nb = __popcll(mb);
                    if (lane == e) mycnt = na + nb;
                    if (ea == e) ra = __popcll(ma & below);
                    if (eb == e) { rb = __popcll(mb & below); na_sel = na; }
                }
                int basep = 0;
                if (lane < 8 && mycnt) basep = (int)__hip_atomic_fetch_add(ctl + CW_MOECNT + 64 * lane, (unsigned)mycnt, RLX_AGENT);
#pragma unroll
                for (int e = 0; e < 8; ++e) { const int be = __builtin_amdgcn_readlane(basep, e); if (ea == e) pa = be + ra; if (eb == e) pb = be + na_sel + rb; }
                t_p[lane] = pa; t_p[64 + lane] = pb;
            }
            __syncthreads();
            if (F.tid < 128) { const int lt = F.tid >> 1, k = F.tid & 1, m = base + lt; const int e = t_e[F.tid], pos = t_p[F.tid];
                ROWTOK[e * M + pos] = m; TOKSLOT[m * 4 + k * 2] = e; TOKSLOT[m * 4 + k * 2 + 1] = pos; ((float*)TOKSLOT)[(size_t)M * 4 + m * 2 + k] = t_w[F.tid]; }
            __syncthreads();
        }
    }
    SEAM(15);
#define MOE_TABLE() do { if (F.tid == 0) { int ts_ = 0; for (int e = 0; e < 8; ++e) { const int ce = (int)__hip_atomic_load(ctl + CW_MOECNT + 64 * e, RLX_AGENT); moetab[16 + e] = ce; moetab[e] = ts_; ts_ += (ce + 255) >> 8; } moetab[8] = ts_; } __syncthreads(); } while (0)
    LAS int* moetab = (LAS int*)(F.lds + MISC_OFF + 256);
    PH(16) {
        MOE_TABLE();
        OrderMoe SM; SM.tab = moetab;
        SM.A = (const char*)XN; SM.Bt = (const char*)MOE13; SM.rowtok = ROWTOK; SM.lda = DM; SM.ldb = DM; SM.bstride = (size_t)2 * DFFE * DM; SM.nN = 2 * DFFE / 256;
        SM.nwg = moetab[8] * SM.nN; SM.G = F.G; SM.c = (int)blockIdx.x; SM.gather = true;
        EpiSwiglu8 E{(unsigned char*)ACT, DFFE};
        pg8::gemm_phase<EpiSwiglu8, OrderMoe, true, true>(ring, DM, 128, DM, DM / 128, SM, E, 0x7f7f7f7f, 0x79797979);
    }
    SEAM(16);
    PH(17) {
        MOE_TABLE();
        OrderMoe SM; SM.tab = moetab;
        SM.A = (const char*)ACT; SM.Bt = (const char*)MOE2; SM.rowtok = ROWTOK; SM.lda = DFFE; SM.ldb = DFFE; SM.bstride = (size_t)DM * DFFE; SM.nN = 8;
        SM.nwg = moetab[8] * SM.nN; SM.G = F.G; SM.c = (int)blockIdx.x; SM.gather = false;
        EpiBf16Out E{(bf16_t*)Y2};
        pg8::gemm_phase<EpiBf16Out, OrderMoe, false, true>(ring, DFFE, 128, DFFE, DFFE / 128, SM, E, 0x7f7f7f7f, 0x78787878);
    }
    SEAM(17);
    PH(18) {
        MOE_TABLE();
        const float* g = args.in[I_FINAL_NORM];
        for (int m = F.gw; m < M; m += F.NGW) {
            const int e0 = TOKSLOT[m * 4], p0 = TOKSLOT[m * 4 + 1], e1 = TOKSLOT[m * 4 + 2], p1 = TOKSLOT[m * 4 + 3];
            const float w0 = ((const float*)TOKSLOT)[(size_t)M * 4 + m * 2], w1 = ((const float*)TOKSLOT)[(size_t)M * 4 + m * 2 + 1];
            const int ts0 = moetab[e0], ts1 = moetab[e1];
            const bf16_t* y0 = (const bf16_t*)Y2 + ((size_t)ts0 * 256 + p0) * DM; const bf16_t* y1 = (const bf16_t*)Y2 + ((size_t)ts1 * 256 + p1) * DM; const bf16_t* hr = H + (size_t)m * DM;
            f32x4 v[8]; float s = 0.f;
#pragma unroll
            for (int j = 0; j < 8; ++j) { const int col = 4 * F.lane + 256 * j; const u32x2 q0 = *(const u32x2*)(y0 + col), q1 = *(const u32x2*)(y1 + col);
                const f32x4 f0 = (f32x4){bflo(q0.x), bfhi(q0.x), bflo(q0.y), bfhi(q0.y)}, f1 = (f32x4){bflo(q1.x), bfhi(q1.x), bflo(q1.y), bfhi(q1.y)};
                v[j] = ld4bf(hr + col) + (w0 * f0 + w1 * f1);
                s += (v[j].x * v[j].x + v[j].y * v[j].y) + (v[j].z * v[j].z + v[j].w * v[j].w); }
            const float rstd = 1.0f / sqrtf(wave_sum(s) * (1.0f / DM) + RMS_EPS);
#pragma unroll
            for (int j = 0; j < 8; ++j) { const int col = 4 * F.lane + 256 * j; *(f32x4*)(args.out + (size_t)m * DM + col) = v[j] * rstd * *(const f32x4*)(g + col); }
        }
    }
    if (PROBE_MASK != 0u && blockIdx.x == 0 && F.tid == 0) { if (PROBE_ON(18)) probe_acc += __builtin_amdgcn_s_memrealtime() - probe_t0; const unsigned long long t1 = __builtin_amdgcn_s_memrealtime(); while (__builtin_amdgcn_s_memrealtime() - t1 < 4ull * probe_acc) __builtin_amdgcn_s_sleep(8); }
#undef IN
#undef SEAM
}

extern "C" void kernel_launch(void* const* d_in, const int* in_sizes, int n_in, void* d_out, int out_size, void* d_ws, size_t ws_size, hipStream_t stream) {
    static int grid = 0;
    if (grid == 0) {
        if (n_in != 33 || out_size != M * DM || ws_size < WS_END) { fprintf(stderr, "kernel_launch: unexpected shapes (n_in %d, out %d, ws %zu < %zu)\n", n_in, out_size, ws_size, (size_t)WS_END); grid = -1; return; }
        int dev = 0, cus = 0, per_cu = 0;
        if (hipGetDevice(&dev) != hipSuccess || hipDeviceGetAttribute(&cus, hipDeviceAttributeMultiprocessorCount, dev) != hipSuccess) { grid = -1; return; }
        if (hipFuncSetAttribute((const void*)mk_fwd, hipFuncAttributeMaxDynamicSharedMemorySize, LDS_BYTES) != hipSuccess) { fprintf(stderr, "kernel_launch: hipFuncSetAttribute failed\n"); grid = -1; return; }
        if (hipOccupancyMaxActiveBlocksPerMultiprocessor(&per_cu, (const void*)mk_fwd, NTHR, LDS_BYTES) != hipSuccess || per_cu < 1) fprintf(stderr, "kernel_launch: occupancy query reports %d\n", per_cu);
        (void)hipGetLastError();
        grid = cus < 256 ? cus : 256;
    }
    if (grid < 0) return;
    if (hipMemsetAsync((char*)d_ws + WS_CTL, 0, CTL_ZERO_BYTES, stream) != hipSuccess) return;
    Args a{};
    for (int i = 0; i < 33; ++i) a.in[i] = (const float*)d_in[i];
    a.out = (float*)d_out; a.ws = (unsigned char*)d_ws; a.pad = 0;
    if (MK_N_LAUNCHES == 1) {
        a.ph_lo = 0; a.ph_hi = NPHASE; a.use_bar = 1;
        hipLaunchKernelGGL(mk_fwd, dim3(grid), dim3(NTHR), LDS_BYTES, stream, a);
    } else {
        for (int p = 0; p < NPHASE; ++p) { a.ph_lo = p; a.ph_hi = p + 1; a.use_bar = 0; hipLaunchKernelGGL(mk_fwd, dim3(grid), dim3(NTHR), LDS_BYTES, stream, a); }
    }
}
```

```cpp
#include <hip/hip_runtime.h>
#include <cstdio>
#include <cstdint>

#define GAS __attribute__((address_space(1)))
#define LAS __attribute__((address_space(3)))
typedef unsigned short bf16_t;
typedef short bf16x8 __attribute__((ext_vector_type(8)));
typedef short s16x4 __attribute__((ext_vector_type(4)));
typedef float f32x4 __attribute__((ext_vector_type(4)));
typedef float f32x2 __attribute__((ext_vector_type(2)));
typedef float f32x16 __attribute__((ext_vector_type(16)));
typedef unsigned u32x4 __attribute__((ext_vector_type(4)));
typedef unsigned u32x2 __attribute__((ext_vector_type(2)));
typedef __bf16 bf16x2_t __attribute__((ext_vector_type(2)));
typedef int i32x8 __attribute__((ext_vector_type(8)));
typedef int i32x4 __attribute__((ext_vector_type(4)));
#define DI __device__ __forceinline__

#ifndef MK_N_LAUNCHES
#define MK_N_LAUNCHES 1
#endif

constexpr int BATCH = 4, SEQ = 4096, DM = 2048, M = BATCH * SEQ;
constexpr int NP = 3328;
constexpr int IN_COLS = 3120;
constexpr int C_QA = 0, C_KA = 1024, C_VA = 1152, C_QB = 1280, C_KCMP = 2304, C_VCMP = 2432, C_KSEL = 2560, C_VSEL = 2688, C_KWIN = 2816, C_VWIN = 2944, C_GATE = 3072;
constexpr int DFF = 5632, DFFE = 7168, NEXP = 8;
constexpr float RMS_EPS = 1e-5f, GN_EPS = 64e-5f;
constexpr float LOG2E = 1.4426950408889634f;
constexpr float QSCALE = 0.125f * LOG2E;
constexpr int NWAVES = 8, NTHR = 512;
constexpr int MOE_ROWS = 2 * M + NEXP * 256;

constexpr size_t MiB = 1u << 20;
constexpr size_t al(size_t x) { return (x + 0xFFFFF) & ~(size_t)0xFFFFF; }
constexpr size_t WS_CTL = 0, CTL_ZERO_BYTES = 1 * MiB;
constexpr size_t WS_W_IN = 1 * MiB;
constexpr size_t WS_W_OUT = WS_W_IN + al((size_t)NP * DM * 2);
constexpr size_t WS_CMPW1 = WS_W_OUT + al((size_t)DM * DM * 2);
constexpr size_t WS_FFN13 = WS_CMPW1 + al((size_t)2 * 256 * 2048 * 2);
constexpr size_t WS_FFN2 = WS_FFN13 + al((size_t)2 * DFF * DM * 2);
constexpr size_t WS_WRKV = WS_FFN2 + al((size_t)DM * DFF * 2);
constexpr size_t WS_LORA1 = WS_WRKV + al((size_t)3 * DM * DM * 2);
constexpr size_t WS_LORA2 = WS_LORA1 + al((size_t)3 * 256 * DM * 2);
constexpr size_t WS_WO = WS_LORA2 + al((size_t)3 * DM * 256 * 2);
constexpr size_t WS_MOE13 = WS_WO + al((size_t)DM * DM * 2);
constexpr size_t WS_MOE2 = WS_MOE13 + al((size_t)NEXP * 2 * DFFE * DM * 2);
constexpr size_t WS_XN = WS_MOE2 + al((size_t)NEXP * DM * DFFE * 2);
constexpr size_t WS_P = WS_XN + al((size_t)M * DM * 2);
constexpr size_t WS_ROPE = WS_P + al((size_t)(M + 64) * NP * 2);
constexpr size_t WS_CMPB = WS_ROPE + al((size_t)M * 64 * 4);
constexpr size_t WS_HID = WS_CMPB + MiB;
constexpr size_t WS_KVC = WS_HID + al((size_t)2 * 2048 * 256 * 2);
constexpr size_t WS_O = WS_KVC + al((size_t)2 * 2048 * 64 * 2);
constexpr size_t WS_H = WS_O + al((size_t)M * DM * 2);
constexpr size_t WS_ACT = WS_H + al((size_t)M * DM * 4);
constexpr size_t WS_XS = WS_ACT + al((size_t)MOE_ROWS * DFFE * 2);
constexpr size_t WS_RKV = WS_XS + al((size_t)6 * M * DM * 2);
constexpr size_t WS_L1 = WS_RKV + al((size_t)3 * M * DM * 2);
constexpr size_t WS_DEC = WS_L1 + al((size_t)3 * M * 256 * 2);
constexpr size_t WS_AA = WS_DEC + al((size_t)M * DM * 4);
constexpr size_t WS_GG = WS_AA + al((size_t)M * DM * 4);
constexpr size_t WS_YRAW = WS_GG + al((size_t)M * DM * 2);
constexpr size_t WS_YG = WS_YRAW + al((size_t)M * DM * 4);
constexpr size_t WS_ROWTOK = WS_YG + al((size_t)M * DM * 2);
constexpr size_t WS_TOKSLOT = WS_ROWTOK + al((size_t)NEXP * M * 4);
constexpr size_t WS_Y2 = WS_TOKSLOT + al((size_t)M * 16);
constexpr size_t WS_END = WS_Y2 + al((size_t)MOE_ROWS * DM * 4);
constexpr int CW_BAR = 0;
constexpr int CW_MOECNT = 4096;

constexpr int RING_BYTES = 131072, LDSCTL_OFF = 135168, MISC_OFF = LDSCTL_OFF + 320, LDS_BYTES = 147456;

#define RLX_AGENT __ATOMIC_RELAXED, __HIP_MEMORY_SCOPE_AGENT
DI unsigned f2bf(float f) { unsigned u = __builtin_bit_cast(unsigned, f); return (u + 0x7fffu + ((u >> 16) & 1u)) >> 16; }
DI unsigned pk2(float lo, float hi) { f32x2 v = {lo, hi}; bf16x2_t b = __builtin_convertvector(v, bf16x2_t); return __builtin_bit_cast(unsigned, b); }
DI unsigned pk4_fp8(float a, float b, float c, float d) { int p = __builtin_amdgcn_cvt_pk_fp8_f32(a, b, 0, false); p = __builtin_amdgcn_cvt_pk_fp8_f32(c, d, p, true); return (unsigned)p; }
DI float bf2f(unsigned short b) { return __builtin_bit_cast(float, ((unsigned)b) << 16); }
DI float bflo(unsigned w) { return __builtin_bit_cast(float, w << 16); }
DI float bfhi(unsigned w) { return __builtin_bit_cast(float, w & 0xffff0000u); }
DI float wave_sum(float v) {
#pragma unroll
    for (int o = 1; o < 64; o <<= 1) v += __shfl_xor(v, o);
    return v;
}
DI int opq(int x) { asm volatile("" : "+v"(x)); return x; }
DI const float* opqp(const float* p) { asm volatile("" : "+s"(p)); return p; }
DI float ex2(float x) { return __builtin_amdgcn_exp2f(x); }
DI float sigmoidf_(float x) { return __builtin_amdgcn_rcpf(1.0f + __expf(-x)); }
DI float siluf_(float x) { return x * __builtin_amdgcn_rcpf(1.0f + __expf(-x)); }
DI float tanhf_(float x) { return 1.0f - 2.0f * __builtin_amdgcn_rcpf(__expf(2.0f * x) + 1.0f); }

#define XB_TMO      128
#define XB_XCNT(j)  (256  + 64 * (j))
#define XB_XSUB(j)  (1280 + 64 * (j))
#define XB_XGEN(j)  (2304 + 64 * (j))
#define XB_TOP      3328
#define XB_TOPGEN   3392
#define XCD_BAR_WORDS 3456
#define XB_SPIN_CAP (1u << 22)
DI unsigned xb_ld(unsigned* p)              { return __hip_atomic_load(p, __ATOMIC_RELAXED, __HIP_MEMORY_SCOPE_AGENT); }
DI unsigned xb_add(unsigned* p, unsigned v) { return __hip_atomic_fetch_add(p, v, __ATOMIC_RELAXED, __HIP_MEMORY_SCOPE_AGENT); }
DI unsigned xb_xcc_id() { return (unsigned)__builtin_amdgcn_s_getreg((3 << 11) | 20) & 0xFu; }
#define XB_SPIN(cond, bar) do { unsigned _sp = 0; while (cond) { __builtin_amdgcn_s_sleep(1); \
    if ((++_sp & 255u) == 0u) { if (xb_ld(&(bar)[XB_TMO])) break; if (_sp > XB_SPIN_CAP) { atomicAdd(&(bar)[XB_TMO], 1u); break; } } } } while (0)
struct XcdBarrier { unsigned* bar; unsigned x; volatile LAS unsigned* st; };
DI XcdBarrier xcd_barrier_post(unsigned* bar, volatile LAS unsigned* st) {
    XcdBarrier b; b.bar = bar; b.x = xb_xcc_id(); b.st = st;
    if (threadIdx.x == 0) (void)xb_add(&bar[XB_XCNT(b.x)], 1u);
    return b;
}
DI void xcd_barrier_complete(unsigned* bar, unsigned x, unsigned& nloc, unsigned& nx) {
    const unsigned G = gridDim.x * gridDim.y * gridDim.z;
    unsigned sum, cnt, mine, sp = 0u;
    for (;;) {
        sum = 0u; cnt = 0u; mine = 0u;
#pragma unroll
        for (unsigned j = 0; j < 16; ++j) { const unsigned c = xb_ld(&bar[XB_XCNT(j)]); sum += c; cnt += (c > 0u) ? 1u : 0u; mine = (j == x) ? c : mine; }
        if (sum == G) break;
        __builtin_amdgcn_s_sleep(1);
        if ((++sp & 255u) == 0u) { if (xb_ld(&bar[XB_TMO])) break; if (sp > XB_SPIN_CAP) { atomicAdd(&bar[XB_TMO], 1u); break; } }
    }
    nloc = mine > 0u ? mine : 1u; nx = cnt > 0u ? cnt : 1u;
}
DI void xcd_barrier(const XcdBarrier& b) {
    asm volatile("s_waitcnt vmcnt(0)" ::: "memory");
    __syncthreads();
    if (threadIdx.x == 0) {
        unsigned* bar = b.bar;
        __builtin_amdgcn_s_waitcnt(0);
        unsigned nloc = b.st[0], nx = b.st[1];
        if (nloc == 0u) { xcd_barrier_complete(bar, b.x, nloc, nx); b.st[0] = nloc; b.st[1] = nx; }
        const unsigned old = xb_add(&bar[XB_XSUB(b.x)], 1u);
        const unsigned gen = old / nloc;
        if (old + 1u == (gen + 1u) * nloc) {
            __builtin_amdgcn_fence(__ATOMIC_RELEASE, "agent");
            asm volatile("s_waitcnt vmcnt(0)" ::: "memory");
            const unsigned og = xb_add(&bar[XB_TOP], 1u);
            const unsigned tg = og / nx;
            if (og + 1u == (tg + 1u) * nx) xb_add(&bar[XB_TOPGEN], 1u);
            else XB_SPIN(xb_ld(&bar[XB_TOPGEN]) == tg, bar);
            __builtin_amdgcn_fence(__ATOMIC_ACQUIRE, "agent");
            xb_add(&bar[XB_XGEN(b.x)], 1u);
            asm volatile("s_waitcnt vmcnt(0)" ::: "memory");
        } else {
            XB_SPIN(xb_ld(&bar[XB_XGEN(b.x)]) == gen, bar);
            __builtin_amdgcn_fence(__ATOMIC_ACQUIRE, "agent");
            asm volatile("s_waitcnt vmcnt(0)" ::: "memory");
        }
    }
    __syncthreads();
}

namespace pg8 {
constexpr int BM = 256, BK = 64, HALF = 128, HTB = HALF * BK * 2, STAGE_BYTES = 8 * HTB, NXCD = 8, WGM = 4;
__host__ __device__ __forceinline__ int lds_byte(int r, int c) { const int st = (r >> 4) * 2 + (c >> 5), rr = r & 15, cc = c & 31, ob = rr * 64 + cc * 2; return st * 1024 + (ob ^ (((ob >> 9) & 1) << 5)); }
__host__ __device__ __forceinline__ void stage_rc(int b, int& R, int& C) { const int st = b / 1024, sb = b % 1024, swz = sb ^ (((sb >> 9) & 1) << 5); R = (st >> 1) * 16 + swz / 64; C = (st & 1) * 32 + (swz % 64) / 2; }
__host__ __device__ __forceinline__ int perm32(int rho) { const int n = rho >> 4, i = rho & 15; return 8 * (i >> 2) + 4 * n + (i & 3); }

struct Unit { const char* a; const char* b; int pm, pn, g; unsigned ka; };

DI int xcd_remap(int L, int nwg) { const int q = nwg / NXCD, r = nwg % NXCD, xcd = L % NXCD, off = L / NXCD; return (xcd < r ? xcd * (q + 1) : r * (q + 1) + (xcd - r) * q) + off; }
DI void tile_map(int idx, int nM, int nN, int& pm, int& pn) { const int nig = WGM * nN, gid = idx / nig, fm = gid * WGM, gsz = (nM - fm) < WGM ? (nM - fm) : WGM; pm = fm + ((idx % nig) % gsz); pn = (idx % nig) / gsz; }

template <class Epi, class Sched, bool GATHER, bool FP8 = false>
DI void gemm_phase(LAS unsigned char* lds, const unsigned lda, const unsigned ka, const unsigned ldb, const int nt, const Sched& S, const Epi& E, const int scaleA = 0x7f7f7f7f, const int scaleB = 0x7f7f7f7f) {
    const int tid = threadIdx.x, wid = __builtin_amdgcn_readfirstlane(tid >> 6), lane = tid & 63, wr = wid >> 2, wc = wid & 3, fr = lane & 15, fq = lane >> 4;
    int Rr[2], Cc[2];
    unsigned vB[2], vA[2][2], vN[2][2];
#pragma unroll
    for (int i = 0; i < 2; ++i) { stage_rc(tid * 16 + i * 8192, Rr[i], Cc[i]); const int Rb = (Rr[i] & ~31) + perm32(Rr[i] & 31); vB[i] = (unsigned)Rb * ldb + (unsigned)Cc[i] * 2u; }
    const size_t kb = (size_t)(BK * 2);
    const size_t hB = (size_t)HALF * ldb;
    const unsigned ldsw = (unsigned)wid * 1024u;
    const int aoff = lds_byte(wr * 64 + fr, fq * 8), boff = lds_byte(wc * 32 + fr, fq * 8);
#define PG8_SA(b, h) (((b) * 2 + (h)) * HTB)
#define PG8_SB(b, h) ((4 + (b) * 2 + (h)) * HTB)
#define PG8_STAGE(bufoff, gbase, v0, v1) do { \
        __builtin_amdgcn_global_load_lds((const unsigned*)((const char*)(gbase) + (v0)), (LAS unsigned*)(lds + (bufoff) + ldsw), 16, 0, 0); \
        __builtin_amdgcn_global_load_lds((const unsigned*)((const char*)(gbase) + (v1)), (LAS unsigned*)(lds + (bufoff) + ldsw + 8192), 16, 0, 0); } while (0)
#define PG8_LDA(dst, b, h) do { _Pragma("unroll") for (int m = 0; m < 4; ++m) { const i32x4 f0_ = *(const LAS i32x4*)(lds + PG8_SA(b, h) + aoff + m * 2048), f1_ = *(const LAS i32x4*)(lds + PG8_SA(b, h) + aoff + m * 2048 + 1024); \
        dst[m] = __builtin_shufflevector(f0_, f1_, 0, 1, 2, 3, 4, 5, 6, 7); } } while (0)
#define PG8_LDB(dst, b, h) do { _Pragma("unroll") for (int n = 0; n < 2; ++n) { const i32x4 f0_ = *(const LAS i32x4*)(lds + PG8_SB(b, h) + boff + n * 2048), f1_ = *(const LAS i32x4*)(lds + PG8_SB(b, h) + boff + n * 2048 + 1024); \
        dst[n] = __builtin_shufflevector(f0_, f1_, 0, 1, 2, 3, 4, 5, 6, 7); } } while (0)
#define PG8_MMA(ai, bj, At, Bt) do { __builtin_amdgcn_s_setprio(1); \
        if constexpr (FP8) { _Pragma("unroll") for (int m = 0; m < 4; ++m) _Pragma("unroll") for (int n = 0; n < 2; ++n) \
            asm volatile("v_mfma_scale_f32_16x16x128_f8f6f4 %0, %1, %2, %0, %3, %4 op_sel_hi:[0,0,0]" : "+v"(acc[ai][bj][m][n]) : "v"(Bt[n]), "v"(At[m]), "v"(scaleB), "v"(scaleA)); } \
        else { _Pragma("unroll") for (int m = 0; m < 4; ++m) _Pragma("unroll") for (int n = 0; n < 2; ++n) { \
            acc[ai][bj][m][n] = __builtin_amdgcn_mfma_f32_16x16x32_bf16(__builtin_bit_cast(bf16x8, __builtin_shufflevector(Bt[n], Bt[n], 0, 1, 2, 3)), __builtin_bit_cast(bf16x8, __builtin_shufflevector(At[m], At[m], 0, 1, 2, 3)), acc[ai][bj][m][n], 0, 0, 0); \
            acc[ai][bj][m][n] = __builtin_amdgcn_mfma_f32_16x16x32_bf16(__builtin_bit_cast(bf16x8, __builtin_shufflevector(Bt[n], Bt[n], 4, 5, 6, 7)), __builtin_bit_cast(bf16x8, __builtin_shufflevector(At[m], At[m], 4, 5, 6, 7)), acc[ai][bj][m][n], 0, 0, 0); } } __builtin_amdgcn_s_setprio(0); } while (0)
#define PG8_WAIT_V(n) asm volatile("s_waitcnt vmcnt(" #n ")" ::: "memory")
#define PG8_WAIT_L(n) asm volatile("s_waitcnt lgkmcnt(" #n ")" ::: "memory")
#define PG8_BAR __builtin_amdgcn_s_barrier()
#define PG8_SCHED __builtin_amdgcn_sched_barrier(0)
    Unit cur, nxt; int ui = 0;
    if (!S.next(0, cur)) return;
#pragma unroll
    for (int h = 0; h < 2; ++h)
#pragma unroll
        for (int i = 0; i < 2; ++i) {
            if constexpr (GATHER) vA[h][i] = S.rowoff(cur, h * HALF + Rr[i]) + (unsigned)Cc[i] * 2u;
            else vA[h][i] = (unsigned)(h * HALF + Rr[i]) * lda + (unsigned)Cc[i] * 2u;
            vN[h][i] = vA[h][i];
        }
    f32x4 acc[2][2][4][2];
#pragma unroll
    for (int a = 0; a < 2; ++a)
#pragma unroll
        for (int b = 0; b < 2; ++b)
#pragma unroll
            for (int m = 0; m < 4; ++m)
#pragma unroll
                for (int n = 0; n < 2; ++n) acc[a][b][m][n] = (f32x4){0.f, 0.f, 0.f, 0.f};
    i32x8 At[4], B0[2], B1[2];
    const char* cA = cur.a; const char* cB = cur.b;
    PG8_STAGE(PG8_SB(0, 0), cB, vB[0], vB[1]); PG8_STAGE(PG8_SB(0, 1), cB + hB, vB[0], vB[1]); PG8_STAGE(PG8_SA(0, 0), cA, vA[0][0], vA[0][1]); PG8_STAGE(PG8_SA(0, 1), cA, vA[1][0], vA[1][1]);
    if (wr == 1) PG8_BAR;
    PG8_WAIT_V(2); PG8_BAR;
    PG8_STAGE(PG8_SB(1, 0), cB + kb, vB[0], vB[1]); PG8_STAGE(PG8_SA(1, 0), cA + cur.ka, vA[0][0], vA[0][1]); PG8_STAGE(PG8_SB(1, 1), cB + hB + kb, vB[0], vB[1]);
    PG8_WAIT_V(6); PG8_BAR;
    for (;;) {
        const bool has_next = S.next(ui + 1, nxt);
        const char* nA = has_next ? nxt.a : cA; const char* nB = has_next ? nxt.b : cB; const unsigned nka = has_next ? nxt.ka : cur.ka;
        if constexpr (GATHER) {
            if (has_next) {
#pragma unroll
                for (int h = 0; h < 2; ++h)
#pragma unroll
                    for (int i = 0; i < 2; ++i) vN[h][i] = S.rowoff(nxt, h * HALF + Rr[i]) + (unsigned)Cc[i] * 2u;
            }
        }
        for (int t = 0; t < nt; t += 2) {
            const bool last = (t == nt - 2);
            const char* a1 = cA + (size_t)(t + 1) * cur.ka;
            const char* a2 = last ? nA : cA + (size_t)(t + 2) * cur.ka; const char* b2 = last ? nB : cB + (size_t)(t + 2) * kb;
            const char* a3 = a2 + (last ? nka : cur.ka); const char* b3 = b2 + kb;
            unsigned x00 = vA[0][0], x01 = vA[0][1], x10 = vA[1][0], x11 = vA[1][1];
            if constexpr (GATHER) { if (last) { x00 = vN[0][0]; x01 = vN[0][1]; x10 = vN[1][0]; x11 = vN[1][1]; } }
            PG8_LDB(B0, 0, 0); PG8_LDB(B1, 0, 1); PG8_SCHED; PG8_LDA(At, 0, 0); PG8_STAGE(PG8_SA(1, 1), a1, vA[1][0], vA[1][1]);
            PG8_WAIT_V(8); PG8_WAIT_L(0); PG8_BAR; PG8_MMA(0, 0, At, B0); PG8_MMA(0, 1, At, B1); PG8_BAR; PG8_SCHED;
            PG8_LDA(At, 0, 1); PG8_STAGE(PG8_SB(0, 0), b2, vB[0], vB[1]); PG8_STAGE(PG8_SB(0, 1), b2 + hB, vB[0], vB[1]); PG8_STAGE(PG8_SA(0, 0), a2, x00, x01);
            PG8_WAIT_V(8); PG8_WAIT_L(0); PG8_BAR; PG8_MMA(1, 0, At, B0); PG8_MMA(1, 1, At, B1); PG8_BAR; PG8_SCHED;
            PG8_LDB(B0, 1, 0); PG8_LDB(B1, 1, 1); PG8_SCHED; PG8_LDA(At, 1, 0); PG8_STAGE(PG8_SA(0, 1), a2, x10, x11);
            PG8_WAIT_V(8); PG8_WAIT_L(0); PG8_BAR; PG8_MMA(0, 0, At, B0); PG8_MMA(0, 1, At, B1); PG8_BAR; PG8_SCHED;
            PG8_LDA(At, 1, 1); PG8_STAGE(PG8_SB(1, 0), b3, vB[0], vB[1]); PG8_STAGE(PG8_SB(1, 1), b3 + hB, vB[0], vB[1]); PG8_STAGE(PG8_SA(1, 0), a3, x00, x01);
            PG8_WAIT_V(8); PG8_WAIT_L(0); PG8_BAR; PG8_MMA(1, 0, At, B0); PG8_MMA(1, 1, At, B1); PG8_BAR; PG8_SCHED;
        }
        if (wr == 0) PG8_BAR;
        if constexpr (FP8) asm volatile("s_nop 15\n\ts_nop 15" ::: "memory");
        E(acc, cur, wr, wc, fr, fq);
        if (!has_next) break;
#pragma unroll
        for (int a = 0; a < 2; ++a)
#pragma unroll
            for (int b = 0; b < 2; ++b)
#pragma unroll
                for (int m = 0; m < 4; ++m)
#pragma unroll
                    for (int n = 0; n < 2; ++n) acc[a][b][m][n] = (f32x4){0.f, 0.f, 0.f, 0.f};
        cur = nxt; cA = nA; cB = nB; ++ui;
        if constexpr (GATHER) {
#pragma unroll
            for (int h = 0; h < 2; ++h)
#pragma unroll
                for (int i = 0; i < 2; ++i) vA[h][i] = vN[h][i];
        }
        if (wr == 1) PG8_BAR;
    }
    PG8_WAIT_V(0);
    PG8_BAR;
#undef PG8_SA
#undef PG8_SB
#undef PG8_STAGE
#undef PG8_LDA
#undef PG8_LDB
#undef PG8_MMA
#undef PG8_WAIT_V
#undef PG8_WAIT_L
#undef PG8_BAR
#undef PG8_SCHED
}
}

typedef f32x4 AccT[2][2][4][2];
DI void st_bf16x8(bf16_t* p, f32x4 v0, f32x4 v1) { u32x4 w; w.x = pk2(v0[0], v0[1]); w.y = pk2(v0[2], v0[3]); w.z = pk2(v1[0], v1[1]); w.w = pk2(v1[2], v1[3]); *(u32x4*)p = w; }

struct OrderSingle {
    const char* A; const char* Bt; unsigned lda, ldb; int nM, nN, nwg, G, c;
    DI bool next(int i, pg8::Unit& u) const {
        const long L = (long)i * G + c; if (L >= nwg) return false;
        const int w = pg8::xcd_remap((int)L, nwg); int pm, pn; pg8::tile_map(w, nM, nN, pm, pn);
        u.pm = pm; u.pn = pn; u.g = 0; u.ka = 128u; u.a = A + (size_t)pm * 256 * lda; u.b = Bt + (size_t)pn * 256 * ldb; return true;
    }
    DI unsigned rowoff(const pg8::Unit&, int) const { return 0u; }
};
struct OrderMulti {
    const char* A[6]; const char* Bt[6]; int nN[6]; int start[7]; unsigned lda, ldb; int ng, nwg, G, c;
    DI bool next(int i, pg8::Unit& u) const {
        const long L = (long)i * G + c; if (L >= nwg) return false;
        const int w = pg8::xcd_remap((int)L, nwg);
        int g = 0; const char* a = A[0]; const char* b = Bt[0]; int nn = nN[0], st = start[0];
#pragma unroll
        for (int k = 1; k < 6; ++k) if (k < ng && w >= start[k]) { g = k; a = A[k]; b = Bt[k]; nn = nN[k]; st = start[k]; }
        int pm, pn; pg8::tile_map(w - st, 64, nn, pm, pn);
        u.pm = pm; u.pn = pn; u.g = g; u.ka = 128u; u.a = a + (size_t)pm * 256 * lda; u.b = b + (size_t)pn * 256 * ldb; return true;
    }
    DI unsigned rowoff(const pg8::Unit&, int) const { return 0u; }
};
struct OrderCmp {
    const char* P; const char* Bt; const char* XNp; const char* Wg; int G, c;
    DI bool next(int i, pg8::Unit& u) const {
        const int L = i * G + c; if (L >= 80) return false;
        if (L < 16) { const int kv = L >> 3, bh = L & 7, b = bh >> 1, h = bh & 1;
            u.pm = bh; u.pn = 0; u.g = kv; u.ka = (unsigned)(NP * 2);
            u.a = P + ((size_t)b * SEQ * NP + (size_t)(C_KCMP + kv * 128 + h * 64)) * 2;
            u.b = Bt + (size_t)kv * 256 * 2048 * 2; }
        else { const int pm = L - 16; u.pm = pm; u.pn = 12; u.g = 2; u.ka = 128u; u.a = XNp + (size_t)pm * 256 * DM * 2; u.b = Wg; }
        return true;
    }
    DI unsigned rowoff(const pg8::Unit& u, int row) const { return (unsigned)row * (u.g == 2 ? (unsigned)(DM * 2) : (unsigned)(16 * NP * 2)); }
};
struct OrderMoe {
    const char* A; const char* Bt; const int* rowtok; const LAS int* tab; unsigned lda, ldb; size_t bstride; int nN, nwg, G, c; bool gather;
    DI bool next(int i, pg8::Unit& u) const {
        const long L = (long)i * G + c; if (L >= nwg) return false;
        const int w = (int)L;
        const int tau = w / nN, pn = w % nN;
        int e = 0;
#pragma unroll
        for (int k = 1; k < 8; ++k) if (tau >= tab[k]) e = k;
        u.pm = tau; u.pn = pn; u.g = e; u.ka = 128u;
        u.a = gather ? A : A + (size_t)tau * 256 * lda;
        u.b = Bt + (size_t)e * bstride + (size_t)pn * 256 * ldb; return true;
    }
    DI unsigned rowoff(const pg8::Unit& u, int row) const {
        const int e = u.g; const int ce = tab[16 + e], ts = tab[e];
        const int pos = (u.pm - ts) * 256 + row;
        const int tok = pos < ce ? rowtok[e * M + pos] : 0;
        return (unsigned)tok * lda;
    }
};

struct EpiInProj {
    bf16_t* P; const float* rope;
    DI void operator()(const AccT& acc, const pg8::Unit& u, int wr, int wc, int fr, int fq) const {
        const int row0 = u.pm * 256 + wr * 64 + fr;
#pragma unroll
        for (int bj = 0; bj < 2; ++bj) {
            const int cb = u.pn * 256 + bj * 128;
            const int col0 = cb + wc * 32 + 8 * fq;
            const bool do_rope = cb < C_VA;
            const float sc = (cb < C_KA || (cb >= C_QB && cb < C_KCMP)) ? QSCALE : 1.0f;
            const int uidx = 4 * (wc & 1) + fq;
#pragma unroll
            for (int ai = 0; ai < 2; ++ai)
#pragma unroll
                for (int m = 0; m < 4; ++m) {
                    const int row = row0 + ai * 128 + m * 16;
                    f32x4 v0 = acc[ai][bj][m][0], v1 = acc[ai][bj][m][1];
                    if (do_rope) {
                        const f32x4 cs = *(const f32x4*)(rope + (size_t)row * 64 + 4 * uidx), sn = *(const f32x4*)(rope + (size_t)row * 64 + 32 + 4 * uidx);
                        const f32x4 o0 = v0 * cs - v1 * sn, o1 = v1 * cs + v0 * sn; v0 = o0; v1 = o1;
                    }
                    v0 = v0 * sc; v1 = v1 * sc;
                    st_bf16x8(P + (size_t)row * NP + col0, v0, v1);
                }
        }
    }
};
struct EpiCmp1 {
    bf16_t* HID; const float* bias; bf16_t* P;
    DI void operator()(const AccT& acc, const pg8::Unit& u, int wr, int wc, int fr, int fq) const {
        const int row0 = wr * 64 + fr;
        if (u.g == 2) {
#pragma unroll
            for (int bj = 0; bj < 2; ++bj)
#pragma unroll
                for (int ai = 0; ai < 2; ++ai)
#pragma unroll
                    for (int m = 0; m < 4; ++m) st_bf16x8(P + (size_t)(u.pm * 256 + row0 + ai * 128 + m * 16) * NP + C_GATE + bj * 128 + wc * 32 + 8 * fq, acc[ai][bj][m][0], acc[ai][bj][m][1]);
            return;
        }
#pragma unroll
        for (int bj = 0; bj < 2; ++bj) {
            const int col0 = bj * 128 + wc * 32 + 8 * fq;
            const f32x4 b0 = *(const f32x4*)(bias + u.g * 256 + col0), b1 = *(const f32x4*)(bias + u.g * 256 + col0 + 4);
#pragma unroll
            for (int ai = 0; ai < 2; ++ai)
#pragma unroll
                for (int m = 0; m < 4; ++m) {
                    const int row = row0 + ai * 128 + m * 16;
                    f32x4 v0 = acc[ai][bj][m][0] + b0, v1 = acc[ai][bj][m][1] + b1;
#pragma unroll
                    for (int j = 0; j < 4; ++j) { v0[j] = siluf_(v0[j]); v1[j] = siluf_(v1[j]); }
                    st_bf16x8(HID + ((size_t)(u.g * 2048 + u.pm * 256 + row)) * 256 + col0, v0, v1);
                }
        }
    }
};
template <bool RESF32>
struct EpiResH {
    const void* res; bf16_t* out;
    DI void operator()(const AccT& acc, const pg8::Unit& u, int wr, int wc, int fr_, int fq_) const {
        const int fr = opq(fr_), fq = opq(fq_);
        const int row0 = u.pm * 256 + wr * 64 + fr;
#pragma unroll
        for (int ai = 0; ai < 2; ++ai) {
            f32x4 r[4][2][2];
#pragma unroll
            for (int m = 0; m < 4; ++m) { const size_t ro = (size_t)(row0 + ai * 128 + m * 16) * DM;
#pragma unroll
                for (int bj = 0; bj < 2; ++bj) { const int col0 = u.pn * 256 + bj * 128 + wc * 32 + 8 * fq;
                    if (RESF32) { r[m][bj][0] = *(const f32x4*)((const float*)res + ro + col0); r[m][bj][1] = *(const f32x4*)((const float*)res + ro + col0 + 4); }
                    else { const u32x4 q = *(const u32x4*)((const bf16_t*)res + ro + col0); r[m][bj][0] = (f32x4){bflo(q.x), bfhi(q.x), bflo(q.y), bfhi(q.y)}; r[m][bj][1] = (f32x4){bflo(q.z), bfhi(q.z), bflo(q.w), bfhi(q.w)}; } } }
            asm volatile("s_waitcnt vmcnt(0)" ::: "memory");
#pragma unroll
            for (int m = 0; m < 4; ++m) { const size_t ro = (size_t)(row0 + ai * 128 + m * 16) * DM;
#pragma unroll
                for (int bj = 0; bj < 2; ++bj) { const int col0 = u.pn * 256 + bj * 128 + wc * 32 + 8 * fq;
                    st_bf16x8(out + ro + col0, r[m][bj][0] + acc[ai][bj][m][0], r[m][bj][1] + acc[ai][bj][m][1]); } }
        }
    }
};
struct EpiSwiglu {
    bf16_t* ACT; int ldc;
    DI void operator()(const AccT& acc, const pg8::Unit& u, int wr, int wc, int fr, int fq) const {
        const int row0 = u.pm * 256 + wr * 64 + fr; const int col0 = u.pn * 128 + wc * 32 + 8 * fq;
#pragma unroll
        for (int ai = 0; ai < 2; ++ai)
#pragma unroll
            for (int m = 0; m < 4; ++m) {
                f32x4 v0, v1;
#pragma unroll
                for (int j = 0; j < 4; ++j) { v0[j] = siluf_(acc[ai][0][m][0][j]) * acc[ai][1][m][0][j]; v1[j] = siluf_(acc[ai][0][m][1][j]) * acc[ai][1][m][1][j]; }
                st_bf16x8(ACT + (size_t)(row0 + ai * 128 + m * 16) * ldc + col0, v0, v1);
            }
    }
};
struct EpiSwiglu8 {
    unsigned char* ACT; int ldc;
    DI void operator()(const AccT& acc, const pg8::Unit& u, int wr, int wc, int fr, int fq) const {
        const int row0 = u.pm * 256 + wr * 64 + fr; const int col0 = u.pn * 128 + wc * 32 + 8 * fq;
#pragma unroll
        for (int ai = 0; ai < 2; ++ai)
#pragma unroll
            for (int m = 0; m < 4; ++m) {
                f32x4 v0, v1;
#pragma unroll
                for (int j = 0; j < 4; ++j) { v0[j] = siluf_(acc[ai][0][m][0][j]) * acc[ai][1][m][0][j]; v1[j] = siluf_(acc[ai][0][m][1][j]) * acc[ai][1][m][1][j]; }
                u32x2 o; o.x = pk4_fp8(v0[0], v0[1], v0[2], v0[3]); o.y = pk4_fp8(v1[0], v1[1], v1[2], v1[3]);
                *(u32x2*)(ACT + (size_t)(row0 + ai * 128 + m * 16) * ldc + col0) = o;
            }
    }
};
struct EpiRkvLora1 {
    bf16_t* RKV; bf16_t* L1;
    DI void operator()(const AccT& acc, const pg8::Unit& u, int wr, int wc, int fr, int fq) const {
        const int row0 = u.pm * 256 + wr * 64 + fr; const int g = u.g;
        bf16_t* base = g < 3 ? RKV + (size_t)g * M * DM : L1 + (size_t)(g - 3) * M * 256;
        const int ldc = g < 3 ? DM : 256;
#pragma unroll
        for (int ai = 0; ai < 2; ++ai)
#pragma unroll
            for (int m = 0; m < 4; ++m)
#pragma unroll
                for (int bj = 0; bj < 2; ++bj) {
                    const int col0 = u.pn * 256 + bj * 128 + wc * 32 + 8 * fq;
                    f32x4 v0 = acc[ai][bj][m][0], v1 = acc[ai][bj][m][1];
                    if (g == 3) {
#pragma unroll
                        for (int j = 0; j < 4; ++j) { v0[j] = tanhf_(v0[j]); v1[j] = tanhf_(v1[j]); }
                    } else if (g == 5) {
#pragma unroll
                        for (int j = 0; j < 4; ++j) { v0[j] = sigmoidf_(v0[j]); v1[j] = sigmoidf_(v1[j]); }
                    }
                    st_bf16x8(base + (size_t)(row0 + ai * 128 + m * 16) * ldc + col0, v0, v1);
                }
    }
};
struct EpiLora2 {
    float* DEC; bf16_t* AA; bf16_t* GG; const float* w0; const float* a0;
    DI void operator()(const AccT& acc, const pg8::Unit& u, int wr, int wc, int fr_, int fq_) const {
        const int fr = opq(fr_), fq = opq(fq_);
        const int row0 = u.pm * 256 + wr * 64 + fr; const int g = u.g;
        const float* cvec = g == 0 ? w0 : a0;
#pragma unroll
        for (int bj = 0; bj < 2; ++bj) {
            const int col0 = u.pn * 256 + bj * 128 + wc * 32 + 8 * fq;
            f32x4 c0 = (f32x4){0.f, 0.f, 0.f, 0.f}, c1 = c0;
            if (g < 2) { c0 = *(const f32x4*)(cvec + col0); c1 = *(const f32x4*)(cvec + col0 + 4); }
#pragma unroll
            for (int ai = 0; ai < 2; ++ai)
#pragma unroll
                for (int m = 0; m < 4; ++m) {
                    const size_t ro = (size_t)(row0 + ai * 128 + m * 16) * DM + col0;
                    f32x4 v0 = acc[ai][bj][m][0] + c0, v1 = acc[ai][bj][m][1] + c1;
                    if (g < 2) {
#pragma unroll
                        for (int j = 0; j < 4; ++j) { v0[j] = sigmoidf_(v0[j]); v1[j] = sigmoidf_(v1[j]); }
                        if (g == 0) {
#pragma unroll
                            for (int j = 0; j < 4; ++j) { v0[j] = __expf(-0.60653065971f * v0[j]); v1[j] = __expf(-0.60653065971f * v1[j]); }
                            *(f32x4*)(DEC + ro) = v0; *(f32x4*)(DEC + ro + 4) = v1;
                        } else st_bf16x8(AA + ro, v0, v1);
                    } else st_bf16x8(GG + ro, v0, v1);
                    asm volatile("" ::: "memory");
                }
        }
    }
};
struct EpiBf16Out {
    bf16_t* out;
    DI void operator()(const AccT& acc, const pg8::Unit& u, int wr, int wc, int fr, int fq) const {
        const int row0 = u.pm * 256 + wr * 64 + fr;
#pragma unroll
        for (int ai = 0; ai < 2; ++ai)
#pragma unroll
            for (int m = 0; m < 4; ++m) {
                const size_t ro = (size_t)(row0 + ai * 128 + m * 16) * DM;
#pragma unroll
                for (int bj = 0; bj < 2; ++bj) { const int col0 = u.pn * 256 + bj * 128 + wc * 32 + 8 * fq; st_bf16x8(out + ro + col0, acc[ai][bj][m][0], acc[ai][bj][m][1]); }
            }
    }
};

struct Args { const float* in[33]; float* out; unsigned char* ws; int ph_lo, ph_hi, use_bar, pad; };
enum { I_X = 0, I_POS, I_ATTN_NORM, I_FFN_NORM, I_FINAL_NORM, I_W_IN, I_W_OUT, I_SINKS, I_CMP_PE, I_CMP_W1, I_CMP_B1, I_CMP_W2, I_FFN_W13, I_FFN_W2, I_MU, I_W_RKV, I_DECAY_W0, I_DECAY_W1,
       I_DECAY_W2, I_A0, I_A1, I_A2, I_G1, I_G2, I_K_K, I_K_A, I_R_K, I_LN_W, I_LN_B, I_W_O, I_ROUTER, I_MOE_W13, I_MOE_W2 };

struct Frame {
    LAS unsigned char* lds;
    int tid, lane, wave, G, gw, NGW;
    unsigned char* ws;
};

template <class F>
DI void transpose_item(const float* W, int Nsrc, int kvalid, bf16_t* WT, int Kd, const F& map, int k0, int n0, LAS float* scr, int lane) {
    const int s0 = map.src0(n0);
    const int rsub = lane >> 4, col = s0 + 4 * (lane & 15);
    f32x4 v[16];
#pragma unroll
    for (int i = 0; i < 16; ++i) { const int k = k0 + 4 * i + rsub; v[i] = (f32x4){0.f, 0.f, 0.f, 0.f}; if (k < kvalid && col < Nsrc) v[i] = *(const f32x4*)(W + (size_t)k * Nsrc + col); }
#pragma unroll
    for (int i = 0; i < 16; ++i) { LAS float* d = scr + (4 * i + rsub) * 65 + 4 * (lane & 15); d[0] = v[i].x; d[1] = v[i].y; d[2] = v[i].z; d[3] = v[i].w; }
    asm volatile("s_waitcnt lgkmcnt(0)" ::: "memory");
    const int c = lane & 7;
#pragma unroll
    for (int j = 0; j < 8; ++j) { const int nl = (lane >> 3) + 8 * j; const LAS float* s = scr + (8 * c) * 65 + map.perm(n0, nl);
        u32x4 o; o.x = pk2(s[0 * 65], s[1 * 65]); o.y = pk2(s[2 * 65], s[3 * 65]); o.z = pk2(s[4 * 65], s[5 * 65]); o.w = pk2(s[6 * 65], s[7 * 65]);
        *(u32x4*)(WT + (size_t)(n0 + nl) * Kd + k0 + 8 * c) = o; }
    asm volatile("s_waitcnt lgkmcnt(0)" ::: "memory");
}
template <class F>
DI void t8_load(f32x4 (&v)[16], const float* W, int Nsrc, int kvalid, const F& map, int k0, int n0, int lane) {
    const int s0 = map.src0(n0); const int rsub = lane >> 4, col = s0 + 4 * (lane & 15);
#pragma unroll
    for (int i = 0; i < 16; ++i) { const int k = k0 + 4 * i + rsub; v[i] = (f32x4){0.f, 0.f, 0.f, 0.f}; if (k < kvalid && col < Nsrc) v[i] = __builtin_nontemporal_load((const f32x4*)(W + (size_t)k * Nsrc + col)); }
}
template <class F>
DI void t8_store(const f32x4 (&v)[16], unsigned char* WT, int Kd, const F& map, int k0, int n0, LAS float* scr, int lane, float mul) {
    const int rsub = lane >> 4;
#pragma unroll
    for (int i = 0; i < 16; ++i) { LAS float* d = scr + (4 * i + rsub) * 65 + 4 * (lane & 15); d[0] = v[i].x; d[1] = v[i].y; d[2] = v[i].z; d[3] = v[i].w; }
    asm volatile("s_waitcnt lgkmcnt(0)" ::: "memory");
    const int c = lane & 7;
#pragma unroll
    for (int j = 0; j < 8; ++j) { const int nl = (lane >> 3) + 8 * j; const LAS float* s = scr + (8 * c) * 65 + map.perm(n0, nl);
        u32x2 o; o.x = pk4_fp8(s[0 * 65] * mul, s[1 * 65] * mul, s[2 * 65] * mul, s[3 * 65] * mul); o.y = pk4_fp8(s[4 * 65] * mul, s[5 * 65] * mul, s[6 * 65] * mul, s[7 * 65] * mul);
        *(u32x2*)(WT + (size_t)(n0 + nl) * Kd + k0 + 8 * c) = o; }
    asm volatile("s_waitcnt lgkmcnt(0)" ::: "memory");
}
template <class F>
DI void transpose_matrix8(const Frame& F_, const float* W, int Nsrc, int kvalid, unsigned char* WT, int Kd, int Nd, const F& map, LAS float* scr, float mul) {
    const int nkb = Kd / 64, nnb = Nd / 64, nitems = nkb * nnb;
    for (int it = F_.gw; it < nitems; it += 2 * F_.NGW) {
        const int it2 = it + F_.NGW; const bool two = it2 < nitems;
        const int k0a = 64 * (it / nnb), n0a = 64 * (it % nnb), k0b = two ? 64 * (it2 / nnb) : k0a, n0b = two ? 64 * (it2 % nnb) : n0a;
        f32x4 va[16], vb[16];
        t8_load(va, W, Nsrc, kvalid, map, k0a, n0a, F_.lane);
        if (two) t8_load(vb, W, Nsrc, kvalid, map, k0b, n0b, F_.lane);
        t8_store(va, WT, Kd, map, k0a, n0a, scr, F_.lane, mul);
        if (two) t8_store(vb, WT, Kd, map, k0b, n0b, scr, F_.lane, mul);
    }
}
template <class F>
DI void transpose_matrix(const Frame& F_, const float* W, int Nsrc, int kvalid, bf16_t* WT, int Kd, int Nd, const F& map, LAS float* scr, int first, int stride) {
    const int nkb = Kd / 64, nnb = Nd / 64, nitems = nkb * nnb;
    for (int it = first; it < nitems; it += stride) { const int kbi = it / nnb, nb = it % nnb; transpose_item(W, Nsrc, kvalid, WT, Kd, map, 64 * kbi, 64 * nb, scr, F_.lane); }
}
struct ColIdent { DI int src0(int n0) const { return n0; } DI int perm(int, int nl) const { return nl; } };
struct ColInProj { DI int src0(int n0) const { return n0; }
    DI int perm(int n0, int l) const { return n0 < C_VA ? ((l & 7) < 4 ? 4 * (l >> 3) + (l & 3) : 32 + 4 * (l >> 3) + (l & 3)) : l; } };
struct ColSwiglu { int F; DI int src0(int n0) const { const int t = n0 >> 8, r = n0 & 255; return r < 128 ? t * 128 + r : F + t * 128 + (r - 128); } DI int perm(int, int nl) const { return nl; } };

DI f32x4 ld4bf(const bf16_t* p) { const u32x2 q = *(const u32x2*)p; return (f32x4){bflo(q.x), bfhi(q.x), bflo(q.y), bfhi(q.y)}; }
DI void rms_row_load(const float* xrow, int lane, f32x4 (&v)[8], float& rstd) {
    float s = 0.f;
#pragma unroll
    for (int j = 0; j < 8; ++j) { v[j] = *(const f32x4*)(xrow + 4 * lane + 256 * j); s += (v[j].x * v[j].x + v[j].y * v[j].y) + (v[j].z * v[j].z + v[j].w * v[j].w); }
    rstd = 1.0f / sqrtf(wave_sum(s) * (1.0f / DM) + RMS_EPS);
}
DI void rms_row_to_bf16(const float* xrow, const float* g, bf16_t* orow, int lane) {
    f32x4 v[8]; float rstd; rms_row_load(xrow, lane, v, rstd);
#pragma unroll
    for (int j = 0; j < 8; ++j) { const f32x4 gg = *(const f32x4*)(g + 4 * lane + 256 * j); const f32x4 y = v[j] * rstd * gg;
        u32x2 w; w.x = pk2(y.x, y.y); w.y = pk2(y.z, y.w); *(u32x2*)(orow + 4 * lane + 256 * j) = w; }
}

DI void rms_row_load_h(const bf16_t* xrow, int lane, f32x4 (&v)[8], float& rstd) {
    float s = 0.f;
#pragma unroll
    for (int j = 0; j < 8; ++j) { v[j] = ld4bf(xrow + 4 * lane + 256 * j); s += (v[j].x * v[j].x + v[j].y * v[j].y) + (v[j].z * v[j].z + v[j].w * v[j].w); }
    rstd = 1.0f / sqrtf(wave_sum(s) * (1.0f / DM) + RMS_EPS);
}
DI void rms_row_to_bf16_h(const bf16_t* xrow, const float* g, bf16_t* orow, int lane) {
    f32x4 v[8]; float rstd; rms_row_load_h(xrow, lane, v, rstd);
#pragma unroll
    for (int j = 0; j < 8; ++j) { const f32x4 gg = *(const f32x4*)(g + 4 * lane + 256 * j); const f32x4 y = v[j] * rstd * gg;
        u32x2 w; w.x = pk2(y.x, y.y); w.y = pk2(y.z, y.w); *(u32x2*)(orow + 4 * lane + 256 * j) = w; }
}
namespace att {
constexpr int KPADB = 144;
constexpr int VPADB = 144;
constexpr int BUFB = 64 * KPADB + 64 * VPADB;
constexpr int OFF_ALPHA = 2 * BUFB;
constexpr int OFF_IMP = OFF_ALPHA + 8 * 256;
constexpr int OFF_SEL = OFF_IMP + 16384;
constexpr int OFF_RANK = OFF_SEL + 512;
constexpr int OFF_Q = 65536;
constexpr float NEGBIG = -1e30f;
DI int crow(int r, int h) { return (r & 3) + 8 * (r >> 2) + 4 * h; }
#define MFMA32(a, b, c) __builtin_amdgcn_mfma_f32_32x32x16_bf16((a), (b), (c), 0, 0, 0)

struct KVRegs { u32x4 k, v; };
DI void kv_load(KVRegs& r, const bf16_t* Kg, const bf16_t* Vg, size_t pitch, int tid) {
    const int key = tid >> 3, dc = tid & 7;
    r.k = *(const u32x4*)(Kg + (size_t)key * pitch + dc * 8); r.v = *(const u32x4*)(Vg + (size_t)key * pitch + dc * 8);
}
DI void kv_store(const KVRegs& r, LAS unsigned char* buf, int tid) {
    const int key = tid >> 3, dc = tid & 7;
    *(LAS u32x4*)(buf + key * KPADB + dc * 16) = r.k;
    LAS unsigned short* vt = (LAS unsigned short*)(buf + 64 * KPADB);
    const unsigned w[4] = {r.v.x, r.v.y, r.v.z, r.v.w};
#pragma unroll
    for (int i = 0; i < 4; ++i) { vt[(dc * 8 + 2 * i) * (VPADB / 2) + key] = (unsigned short)(w[i] & 0xffffu); vt[(dc * 8 + 2 * i + 1) * (VPADB / 2) + key] = (unsigned short)(w[i] >> 16); }
}

struct State { f32x16 O[2][2]; float m[2], l[2]; };
DI void state_init(State& s) {
#pragma unroll
    for (int a = 0; a < 2; ++a) { s.m[a] = NEGBIG; s.l[a] = 0.f;
#pragma unroll
        for (int b = 0; b < 2; ++b)
#pragma unroll
            for (int r = 0; r < 16; ++r) s.O[a][b][r] = 0.f; }
}
DI void row_scale(f32x16 (&O)[2], float f, LAS float* area, int c_, int h_) {
    const int c = opq(c_), h = opq(h_);
    area[c] = f;
    asm volatile("s_waitcnt lgkmcnt(0)" ::: "memory");
#pragma unroll
    for (int g4 = 0; g4 < 4; ++g4) { const f32x4 a = *(LAS f32x4*)(area + 8 * g4 + 4 * h);
#pragma unroll
        for (int j = 0; j < 4; ++j) { O[0][4 * g4 + j] *= a[j]; O[1][4 * g4 + j] *= a[j]; } }
    asm volatile("s_waitcnt lgkmcnt(0)" ::: "memory");
}
template <int MODE, bool MASKED>
DI void softmax_block(State& st, f32x16& S, int qb, int kpos0, const int (&tq)[2], int W, bool bit, LAS float* area, int c, int h) {
    if constexpr (MASKED) {
        float mx = NEGBIG;
        const int dd = tq[qb] - kpos0;
#pragma unroll
        for (int r = 0; r < 16; ++r) { const int cr0 = (r & 3) + 8 * (r >> 2); bool valid;
            if (MODE == 0) valid = (cr0 <= dd) && (cr0 > dd - W);
            else if (MODE == 1) valid = (cr0 <= dd);
            else valid = (cr0 <= dd) && bit;
            S[r] = valid ? S[r] : NEGBIG; mx = fmaxf(mx, S[r]); }
        mx = fmaxf(mx, __shfl_xor(mx, 32));
        if (__any(mx > st.m[qb] + 8.0f)) {
            const float mnew = fmaxf(st.m[qb], mx); const float alpha = ex2(st.m[qb] - mnew);
            st.l[qb] *= alpha; st.m[qb] = mnew;
            row_scale(st.O[qb], alpha, area + qb * 32, c, h);
        }
        float ls = 0.f;
#pragma unroll
        for (int r = 0; r < 16; ++r) { S[r] = (S[r] > -1e29f) ? ex2(S[r] - st.m[qb]) : 0.f; ls += S[r]; }
        st.l[qb] += ls;
    } else {
        float mx = fmaxf(fmaxf(fmaxf(S[0], S[1]), fmaxf(S[2], S[3])), fmaxf(fmaxf(S[4], S[5]), fmaxf(S[6], S[7])));
        mx = fmaxf(mx, fmaxf(fmaxf(fmaxf(S[8], S[9]), fmaxf(S[10], S[11])), fmaxf(fmaxf(S[12], S[13]), fmaxf(S[14], S[15]))));
        if (MODE == 2) mx = bit ? mx : NEGBIG;
        mx = fmaxf(mx, __shfl_xor(mx, 32));
        if (__any(mx > st.m[qb] + 8.0f)) {
            const float mnew = fmaxf(st.m[qb], mx); const float alpha = ex2(st.m[qb] - mnew);
            st.l[qb] *= alpha; st.m[qb] = mnew;
            row_scale(st.O[qb], alpha, area + qb * 32, c, h);
        }
        const float mref = (MODE == 2 && !bit) ? 3.0e38f : st.m[qb];
        float ls = 0.f;
#pragma unroll
        for (int r = 0; r < 16; ++r) { S[r] = ex2(S[r] - mref); ls += S[r]; }
        st.l[qb] += ls;
    }
}
DI void pack_p(bf16x8 (&Pf)[2], const f32x16& S) {
#pragma unroll
    for (int ks = 0; ks < 2; ++ks) { u32x4 w; w.x = pk2(S[8 * ks], S[8 * ks + 1]); w.y = pk2(S[8 * ks + 2], S[8 * ks + 3]); w.z = pk2(S[8 * ks + 4], S[8 * ks + 5]); w.w = pk2(S[8 * ks + 6], S[8 * ks + 7]);
        Pf[ks] = __builtin_bit_cast(bf16x8, w); }
}
template <int MODE, bool MASKED>
DI void tile_compute(State& st, const LAS unsigned char* qf, LAS unsigned char* buf, int kbase, const int (&tq)[2], int W, const unsigned long long (&sel)[2], int tile, LAS float* area, int c_, int h_) {
    const int c = opq(c_), h = opq(h_);
    LAS unsigned char* Kl = buf; LAS unsigned char* Vl = buf + 64 * KPADB;
    const bool bit0 = MODE == 2 ? (((sel[0] >> tile) & 1ull) != 0ull) : true, bit1 = MODE == 2 ? (((sel[1] >> tile) & 1ull) != 0ull) : true;
#pragma unroll 1
    for (int kbk = 0; kbk < 2; ++kbk) {
        bf16x8 kf[4];
#pragma unroll
        for (int s = 0; s < 4; ++s) kf[s] = *(LAS bf16x8*)(Kl + (32 * kbk + c) * KPADB + (16 * s + 8 * h) * 2);
        f32x16 S0, S1;
#pragma unroll
        for (int r = 0; r < 16; ++r) { S0[r] = 0.f; S1[r] = 0.f; }
#pragma unroll
        for (int s = 0; s < 4; ++s) { const bf16x8 q = *(const LAS bf16x8*)(qf + s * 1024); S0 = MFMA32(kf[s], q, S0); }
#pragma unroll
        for (int s = 0; s < 4; ++s) { const bf16x8 q = *(const LAS bf16x8*)(qf + (4 + s) * 1024); S1 = MFMA32(kf[s], q, S1); }
        const LAS unsigned char* vbase = Vl + opq(c * VPADB + h * 8) + kbk * 64;
        bf16x8 vf[2][2];
#pragma unroll
        for (int ks = 0; ks < 2; ++ks)
#pragma unroll
            for (int db = 0; db < 2; ++db) {
                const s16x4 lo = *(const LAS s16x4*)(vbase + 32 * db * VPADB + 32 * ks);
                const s16x4 hi = *(const LAS s16x4*)(vbase + 32 * db * VPADB + 32 * ks + 16);
                vf[ks][db] = __builtin_shufflevector(lo, hi, 0, 1, 2, 3, 4, 5, 6, 7);
            }
        __builtin_amdgcn_sched_barrier(0);
        const int kpos0 = kbase + 32 * kbk + 4 * h;
        bf16x8 Pf[2];
        softmax_block<MODE, MASKED>(st, S0, 0, kpos0, tq, W, bit0, area, c, h);
        pack_p(Pf, S0);
        __builtin_amdgcn_sched_barrier(0);
#pragma unroll
        for (int ks = 0; ks < 2; ++ks)
#pragma unroll
            for (int db = 0; db < 2; ++db) st.O[0][db] = MFMA32(Pf[ks], vf[ks][db], st.O[0][db]);
        softmax_block<MODE, MASKED>(st, S1, 1, kpos0, tq, W, bit1, area, c, h);
        pack_p(Pf, S1);
        __builtin_amdgcn_sched_barrier(0);
#pragma unroll
        for (int ks = 0; ks < 2; ++ks)
#pragma unroll
            for (int db = 0; db < 2; ++db) st.O[1][db] = MFMA32(Pf[ks], vf[ks][db], st.O[1][db]);
    }
}
template <int MODE>
DI void run_pass(State& st, LAS unsigned char* lds, const bf16_t* Kg, const bf16_t* Vg, size_t pitch, int tlo, int thi, const int (&tq)[2], int W,
                 const unsigned long long (&sel)[2], int tid, int wave, int c, int h) {
    LAS float* area = (LAS float*)(lds + OFF_ALPHA) + wave * 64;
    const LAS unsigned char* qf = lds + OFF_Q + wave * 8192 + (c + 32 * h) * 16;
    KVRegs kr; kv_load(kr, Kg + (size_t)tlo * 64 * pitch, Vg + (size_t)tlo * 64 * pitch, pitch, tid);
    int bi = 0;
    for (int t = tlo; t <= thi; ++t) {
        LAS unsigned char* buf = lds + bi * BUFB;
        const int tid2 = opq(tid);
        kv_store(kr, buf, tid2);
        if (t < thi) kv_load(kr, Kg + (size_t)(t + 1) * 64 * pitch, Vg + (size_t)(t + 1) * 64 * pitch, pitch, tid2);
        __syncthreads();
        const bool masked = (MODE == 1) || (t == thi) || (MODE == 0 && t == thi - W / 64);
        if (masked) tile_compute<MODE, true>(st, qf, buf, t * 64, tq, W, sel, t, area, c, h);
        else tile_compute<MODE, false>(st, qf, buf, t * 64, tq, W, sel, t, area, c, h);
        bi ^= 1;
    }
    __syncthreads();
}
DI void load_q(LAS unsigned char* lds, int wave, const bf16_t* Pbase  , int colbase, int c_, int h_) {
    const int c = opq(c_), h = opq(h_);
    LAS unsigned char* q = lds + OFF_Q + wave * 8192 + (c + 32 * h) * 16;
#pragma unroll
    for (int qb = 0; qb < 2; ++qb) { const bf16_t* p = Pbase + (size_t)(4 * qb + (c >> 3)) * NP + colbase + (c & 7) * 64 + 8 * h;
#pragma unroll
        for (int s = 0; s < 4; ++s) *(LAS bf16x8*)(q + (qb * 4 + s) * 1024) = *(const bf16x8*)(p + 16 * s); }
}
template <bool ACC>
DI void emit_out(State& st, const float (&f)[2], LAS float* area, LAS unsigned char* lds, int wave, bf16_t* Orow, int c_, int h_, int lane_) {
    const int c = opq(c_), h = opq(h_), lane = opq(lane_);
    LAS unsigned char* slice = lds + wave * 4608;
#pragma unroll
    for (int qb = 0; qb < 2; ++qb) {
        area[qb * 32 + c] = f[qb];
        asm volatile("s_waitcnt lgkmcnt(0)" ::: "memory");
#pragma unroll
        for (int g4 = 0; g4 < 4; ++g4) { const f32x4 a = *(LAS f32x4*)(area + qb * 32 + 8 * g4 + 4 * h);
#pragma unroll
            for (int j = 0; j < 4; ++j)
#pragma unroll
                for (int db = 0; db < 2; ++db)
                    *(LAS unsigned short*)(slice + (8 * g4 + 4 * h + j) * KPADB + (32 * db + c) * 2) = (unsigned short)f2bf(st.O[qb][db][4 * g4 + j] * a[j]); }
        asm volatile("s_waitcnt lgkmcnt(0)" ::: "memory");
        u32x4 v[4], o[4];
#pragma unroll
        for (int i = 0; i < 4; ++i) v[i] = *(LAS u32x4*)(slice + ((lane >> 3) + 8 * i) * KPADB + (lane & 7) * 16);
        if (ACC) {
#pragma unroll
            for (int i = 0; i < 4; ++i) { const int row = (lane >> 3) + 8 * i; o[i] = *(const u32x4*)(Orow + (size_t)(4 * qb + (row >> 3)) * DM + (row & 7) * 64 + (lane & 7) * 8); }
#pragma unroll
            for (int i = 0; i < 4; ++i) { const unsigned a[4] = {v[i].x, v[i].y, v[i].z, v[i].w}, bb[4] = {o[i].x, o[i].y, o[i].z, o[i].w}; unsigned r[4];
#pragma unroll
                for (int k = 0; k < 4; ++k) r[k] = pk2(bflo(a[k]) + bflo(bb[k]), bfhi(a[k]) + bfhi(bb[k]));
                v[i] = (u32x4){r[0], r[1], r[2], r[3]}; }
        }
#pragma unroll
        for (int i = 0; i < 4; ++i) { const int row = (lane >> 3) + 8 * i; *(u32x4*)(Orow + (size_t)(4 * qb + (row >> 3)) * DM + (row & 7) * 64 + (lane & 7) * 8) = v[i]; }
        asm volatile("s_waitcnt lgkmcnt(0)" ::: "memory");
    }
}
}

DI void attn_unit_A(const Frame& F, const bf16_t* P, bf16_t* O, const float* sinks, int b, int kvh, int ch) {
    const int lane = opq(F.lane), tid = F.wave * 64 + lane;
    const int c = lane & 31, h = lane >> 5, w = F.wave;
    const int t0 = ch * 64;
    const bf16_t* Pb = P + (size_t)b * SEQ * NP;
    att::load_q(F.lds, w, Pb + (size_t)(t0 + 8 * w) * NP, C_QA + kvh * 512, c, h);
    int tq[2] = {t0 + 8 * w + (c >> 3), t0 + 8 * w + 4 + (c >> 3)};
    unsigned long long sel[2] = {0ull, 0ull};
    att::State st; att::state_init(st);
    const int tlo = ch >= 2 ? ch - 2 : 0;
    att::run_pass<0>(st, F.lds, Pb + C_KA + kvh * 64, Pb + C_VA + kvh * 64, NP, tlo, ch, tq, 128, sel, tid, w, c, h);
    const float sink2 = sinks[kvh * 8 + (c & 7)] * LOG2E;
    float f[2];
#pragma unroll
    for (int qb = 0; qb < 2; ++qb) { const float lt = st.l[qb] + __shfl_xor(st.l[qb], 32) + ex2(sink2 - st.m[qb]); f[qb] = 1.0f / lt; }
    LAS float* area = (LAS float*)(F.lds + att::OFF_ALPHA) + w * 64;
    att::emit_out<false>(st, f, area, F.lds, w, O + ((size_t)b * SEQ + t0 + 8 * w) * DM + kvh * 512, c, h, lane);
    __syncthreads();
}

DI void attn_unit_B(const Frame& F, const bf16_t* P, const bf16_t* KVC, bf16_t* O, float* OB, int b, int hkv, int ch) {
    const int lane = opq(F.lane), tid = F.wave * 64 + lane;
    const int c = lane & 31, h = lane >> 5, w = F.wave;
    const int t0 = ch * 64;
    const bf16_t* Pb = P + (size_t)b * SEQ * NP;
    LAS float* area = (LAS float*)(F.lds + att::OFF_ALPHA) + w * 64;
    LAS float* imp = (LAS float*)(F.lds + att::OFF_IMP);
    LAS unsigned long long* selbuf = (LAS unsigned long long*)(F.lds + att::OFF_SEL);
    LAS float* rank = (LAS float*)(F.lds + att::OFF_RANK) + w * 64;
    att::load_q(F.lds, w, Pb + (size_t)(t0 + 8 * w) * NP, C_QB + hkv * 512, c, h);
    const LAS unsigned char* qf = F.lds + att::OFF_Q + w * 8192 + (c + 32 * h) * 16;
    int tq[2] = {t0 + 8 * w + (c >> 3), t0 + 8 * w + 4 + (c >> 3)};
    unsigned long long sel[2] = {0ull, 0ull};
#define GATE(qb, j) sigmoidf_(bf2f(Pb[(size_t)tq[qb] * NP + C_GATE + hkv * 24 + (c & 7) * 3 + (j)]))
    for (int i = tid; i < 4096; i += NTHR) imp[i] = 0.f;
    bf16_t* Orow = O + ((size_t)b * SEQ + t0 + 8 * w) * DM + 1024 + hkv * 512;
    const bf16_t* Kc = KVC + (size_t)(0 * 2048 + (b * 2 + hkv) * 256) * 64;
    const bf16_t* Vc = KVC + (size_t)(1 * 2048 + (b * 2 + hkv) * 256) * 64;
    const int ntc = (4 * ch + 2) / 64;
    att::State st; att::state_init(st);
    int tqc[2] = {(tq[0] - 31) >> 4, (tq[1] - 31) >> 4};
    att::run_pass<1>(st, F.lds, Kc, Vc, 64, 0, ntc, tqc, 0, sel, tid, w, c, h);
    float ltot[2], f[2];
#pragma unroll
    for (int qb = 0; qb < 2; ++qb) { ltot[qb] = fmaxf(st.l[qb] + __shfl_xor(st.l[qb], 32), 1e-30f); f[qb] = GATE(qb, 0) / ltot[qb]; }
    att::emit_out<false>(st, f, area, F.lds, w, Orow, c, h, lane);
    __syncthreads();
    {
        att::KVRegs kr; att::kv_load(kr, Kc, Vc, 64, tid);
        int bi = 0;
        for (int t = 0; t <= ntc; ++t) {
            LAS unsigned char* buf = F.lds + bi * att::BUFB;
            att::kv_store(kr, buf, tid);
            if (t < ntc) att::kv_load(kr, Kc + (size_t)(t + 1) * 64 * 64, Vc + (size_t)(t + 1) * 64 * 64, 64, tid);
            __syncthreads();
#pragma unroll
            for (int kbk = 0; kbk < 2; ++kbk) {
#pragma unroll
                for (int qb = 0; qb < 2; ++qb) {
                    f32x16 S;
#pragma unroll
                    for (int r = 0; r < 16; ++r) S[r] = 0.f;
#pragma unroll
                    for (int s = 0; s < 4; ++s) { const bf16x8 kf = *(LAS bf16x8*)(buf + (32 * kbk + c) * att::KPADB + (16 * s + 8 * h) * 2); const bf16x8 q = *(const LAS bf16x8*)(qf + (qb * 4 + s) * 1024); S = MFMA32(kf, q, S); }
                    const float inv = 1.0f / ltot[qb];
                    const int q = 8 * w + 4 * qb + (c >> 3);
                    const int ddq = tqc[qb] - (t * 64 + 32 * kbk + 4 * h);
#pragma unroll
                    for (int g4 = 0; g4 < 4; ++g4) {
                        float s4 = 0.f, p3 = 0.f;
#pragma unroll
                        for (int j = 0; j < 4; ++j) { const float pv = (8 * g4 + j <= ddq) ? ex2(S[4 * g4 + j] - st.m[qb]) * inv : 0.f; s4 += pv; if (j == 3) p3 = pv; }
                        s4 += __shfl_xor(s4, 1); s4 += __shfl_xor(s4, 2); s4 += __shfl_xor(s4, 4);
                        p3 += __shfl_xor(p3, 1); p3 += __shfl_xor(p3, 2); p3 += __shfl_xor(p3, 4);
                        const int n0 = t * 16 + 8 * kbk + 2 * g4 + h;
                        if ((c & 7) == 0) { (void)__hip_atomic_fetch_add(&imp[q * 64 + n0], s4, __ATOMIC_RELAXED, __HIP_MEMORY_SCOPE_WORKGROUP); if (n0 + 1 < 64) (void)__hip_atomic_fetch_add(&imp[q * 64 + n0 + 1], p3, __ATOMIC_RELAXED, __HIP_MEMORY_SCOPE_WORKGROUP); }
                    }
                    __builtin_amdgcn_sched_barrier(0);
                }
            }
            bi ^= 1;
        }
        __syncthreads();
    }
    {
        const int cur = ch;
        for (int qq = 0; qq < 8; ++qq) {
            const int q = 8 * w + qq;
            float v = imp[q * 64 + lane];
            if (lane > cur) v = -1e9f; else if (lane == 0 || lane > cur - 2) v = 1e9f;
            rank[lane] = v;
            asm volatile("s_waitcnt lgkmcnt(0)" ::: "memory");
            int rk = 0;
#pragma unroll 8
            for (int mth = 0; mth < 64; ++mth) { const float o = rank[mth]; rk += (o > v || (o == v && mth < lane)) ? 1 : 0; }
            const unsigned long long msk = __ballot(rk < 16);
            if (lane == 0) selbuf[q] = msk;
            asm volatile("s_waitcnt lgkmcnt(0)" ::: "memory");
        }
        __syncthreads();
        sel[0] = selbuf[8 * w + (c >> 3)]; sel[1] = selbuf[8 * w + 4 + (c >> 3)];
    }
    att::state_init(st);
    att::run_pass<2>(st, F.lds, Pb + C_KSEL + hkv * 64, Pb + C_VSEL + hkv * 64, NP, 0, ch, tq, 0, sel, tid, w, c, h);
#pragma unroll
    for (int qb = 0; qb < 2; ++qb) { const float lt = fmaxf(st.l[qb] + __shfl_xor(st.l[qb], 32), 1e-30f); f[qb] = GATE(qb, 1) / lt; }
    att::emit_out<true>(st, f, area, F.lds, w, Orow, c, h, lane);
    __syncthreads();
    att::state_init(st);
    att::run_pass<0>(st, F.lds, Pb + C_KWIN + hkv * 64, Pb + C_VWIN + hkv * 64, NP, ch >= 8 ? ch - 8 : 0, ch, tq, 512, sel, tid, w, c, h);
#pragma unroll
    for (int qb = 0; qb < 2; ++qb) { const float lt = fmaxf(st.l[qb] + __shfl_xor(st.l[qb], 32), 1e-30f); f[qb] = GATE(qb, 2) / lt; }
    att::emit_out<true>(st, f, area, F.lds, w, Orow, c, h, lane);
#undef GATE
    __syncthreads();
}

namespace scan {
constexpr int TC = 32;
constexpr int STEPB = 5 * 256 + 128;
constexpr int CHB = TC * STEPB;
constexpr int OFF_Y = 2 * CHB;
constexpr int YB = (TC + 1) * 32 * 4;
template <int CTRL> DI float dpp_f(float x) { return __builtin_bit_cast(float, __builtin_amdgcn_update_dpp(0, __builtin_bit_cast(int, x), CTRL, 0xf, 0xf, false)); }
DI void row_sum16x4(float& a, float& b, float& c, float& d) {
    asm volatile("s_nop 1\n\t"
        "v_add_f32_dpp %0, %0, %0 quad_perm:[1,0,3,2] row_mask:0xf bank_mask:0xf\n\tv_add_f32_dpp %1, %1, %1 quad_perm:[1,0,3,2] row_mask:0xf bank_mask:0xf\n\t"
        "v_add_f32_dpp %2, %2, %2 quad_perm:[1,0,3,2] row_mask:0xf bank_mask:0xf\n\tv_add_f32_dpp %3, %3, %3 quad_perm:[1,0,3,2] row_mask:0xf bank_mask:0xf\n\t"
        "v_add_f32_dpp %0, %0, %0 quad_perm:[2,3,0,1] row_mask:0xf bank_mask:0xf\n\tv_add_f32_dpp %1, %1, %1 quad_perm:[2,3,0,1] row_mask:0xf bank_mask:0xf\n\t"
        "v_add_f32_dpp %2, %2, %2 quad_perm:[2,3,0,1] row_mask:0xf bank_mask:0xf\n\tv_add_f32_dpp %3, %3, %3 quad_perm:[2,3,0,1] row_mask:0xf bank_mask:0xf\n\t"
        "v_add_f32_dpp %0, %0, %0 row_half_mirror row_mask:0xf bank_mask:0xf\n\tv_add_f32_dpp %1, %1, %1 row_half_mirror row_mask:0xf bank_mask:0xf\n\t"
        "v_add_f32_dpp %2, %2, %2 row_half_mirror row_mask:0xf bank_mask:0xf\n\tv_add_f32_dpp %3, %3, %3 row_half_mirror row_mask:0xf bank_mask:0xf\n\t"
        "v_add_f32_dpp %0, %0, %0 row_mirror row_mask:0xf bank_mask:0xf\n\tv_add_f32_dpp %1, %1, %1 row_mirror row_mask:0xf bank_mask:0xf\n\t"
        "v_add_f32_dpp %2, %2, %2 row_mirror row_mask:0xf bank_mask:0xf\n\tv_add_f32_dpp %3, %3, %3 row_mirror row_mask:0xf bank_mask:0xf"
        : "+v"(a), "+v"(b), "+v"(c), "+v"(d));
}
DI float wave_sum_dpp(float x) { x += dpp_f<0xB1>(x); x += dpp_f<0x4E>(x); x += dpp_f<0x141>(x); x += dpp_f<0x140>(x);
    const int xi = __builtin_bit_cast(int, x);
    return (__builtin_bit_cast(float, __builtin_amdgcn_readlane(xi, 0)) + __builtin_bit_cast(float, __builtin_amdgcn_readlane(xi, 16))) + (__builtin_bit_cast(float, __builtin_amdgcn_readlane(xi, 32)) + __builtin_bit_cast(float, __builtin_amdgcn_readlane(xi, 48))); }
DI float row_sum16(float x) { x += dpp_f<0xB1>(x); x += dpp_f<0x4E>(x); x += dpp_f<0x141>(x); x += dpp_f<0x140>(x); return x; }
}
struct ScanRegs { unsigned short r[8], k[8], v[8], a[8]; float dec[8]; };
DI void scan_issue(const Frame& F, ScanRegs& R, const bf16_t* RKV, const float* DEC, const bf16_t* AA, int b, int hd, int tch) {
    const int lw = F.wave - 4, lane = F.lane;
#pragma unroll
    for (int i = 0; i < 8; ++i) {
        const size_t tok = (size_t)b * SEQ + (size_t)tch * scan::TC + lw + 4 * i;
        const size_t o = tok * DM + hd * 64 + lane;
        R.r[i] = RKV[o]; R.k[i] = RKV[(size_t)M * DM + o]; R.v[i] = RKV[(size_t)2 * M * DM + o]; R.dec[i] = DEC[o]; R.a[i] = AA[o];
    }
}
DI void scan_fill(const Frame& F, const ScanRegs& R, LAS unsigned char* buf, float kkw, float kaw, int half) {
    const int lw = F.wave - 4, lane = F.lane;
#pragma unroll
    for (int i = 0; i < 8; ++i) {
        const int s = lw + 4 * i;
        const float r = bf2f(R.r[i]), k = bf2f(R.k[i]), v = bf2f(R.v[i]), dec = R.dec[i], a = bf2f(R.a[i]);
        const float kx = k * kkw;
        const float kk = kx * __builtin_amdgcn_rsqf(fmaxf(scan::wave_sum_dpp(kx * kx), 1e-24f));
        const float kp = k * (1.0f + (a - 1.0f) * kaw);
        LAS float* sp = (LAS float*)(buf + s * scan::STEPB);
        sp[lane] = dec; sp[64 + lane] = -kk; sp[128 + lane] = kk * a; sp[192 + lane] = kp; sp[256 + lane] = r;
        if ((lane >> 5) == half) sp[320 + (lane & 31)] = v;
    }
}
DI void scan_flush(const Frame& F, LAS unsigned char* ybuf, bf16_t* YRAW, int b, int hd, int half, int tch) {
    const int lw = F.wave - 4, lane = F.lane;
    for (int s = 2 * lw; s < scan::TC; s += 8) {
        const int ss = s + (lane >> 5);
        const size_t tok = (size_t)b * SEQ + (size_t)tch * scan::TC + ss;
        YRAW[tok * DM + hd * 64 + half * 32 + (lane & 31)] = (bf16_t)f2bf(((LAS float*)ybuf)[(ss + 1) * 32 + (lane & 31)]);
    }
}
struct CvItem { const float* W; unsigned char* WT; int Nsrc, Kd, k0, n0, s0; float mul; bool on; };
constexpr int CV_I13 = (DM / 64) * (2 * DFFE / 32), CV_I2 = (DFFE / 64) * (DM / 32), CV_TOTAL = NEXP * (CV_I13 + CV_I2);
DI CvItem cv_item(int gid, const float* w13, const float* w2, unsigned char* m13, unsigned char* m2) {
    CvItem it; it.on = gid < CV_TOTAL;
    if (gid < NEXP * CV_I13) { const int e = gid / CV_I13, r = gid % CV_I13, kb = r / (2 * DFFE / 32), nb = r % (2 * DFFE / 32);
        it.W = w13 + (size_t)e * DM * 2 * DFFE; it.WT = m13 + (size_t)e * 2 * DFFE * DM; it.Nsrc = 2 * DFFE; it.Kd = DM; it.k0 = 64 * kb; it.n0 = 32 * nb; it.mul = 64.0f;
        const int t = it.n0 >> 8, rr = it.n0 & 255; it.s0 = rr < 128 ? t * 128 + rr : DFFE + t * 128 + (rr - 128);
    } else { const int g2 = gid - NEXP * CV_I13; const int e = g2 / CV_I2, r = g2 % CV_I2, kb = r / (DM / 32), nb = r % (DM / 32);
        it.W = w2 + (size_t)e * DFFE * DM; it.WT = m2 + (size_t)e * DM * DFFE; it.Nsrc = DM; it.Kd = DFFE; it.k0 = 64 * kb; it.n0 = 32 * nb; it.mul = 128.0f; it.s0 = it.n0; }
    return it;
}
DI void cv_load(float (&v)[32], const CvItem& it, int lane) {
    if (!it.on) return;
    const char* rowbase = (const char*)(it.W + (size_t)it.k0 * it.Nsrc + it.s0);
    const unsigned loff = (unsigned)((lane >> 5) * it.Nsrc + (lane & 31)) * 4u;
    const size_t rstep = (size_t)it.Nsrc * 8;
#pragma unroll
    for (int i = 0; i < 32; ++i) v[i] = __builtin_nontemporal_load((const float*)(rowbase + (size_t)i * rstep + loff));
}
DI void cv_store(const float (&v)[32], const CvItem& it, LAS float* scr, int lane) {
    if (!it.on) return;
#pragma unroll
    for (int i = 0; i < 32; ++i) scr[(2 * i + (lane >> 5)) * 33 + (lane & 31)] = v[i];
    asm volatile("s_waitcnt lgkmcnt(0)" ::: "memory");
    const int c = lane & 7;
#pragma unroll
    for (int j = 0; j < 4; ++j) { const int n = (lane >> 3) + 8 * j; const LAS float* s = scr + (8 * c) * 33 + n;
        u32x2 o; o.x = pk4_fp8(s[0 * 33] * it.mul, s[1 * 33] * it.mul, s[2 * 33] * it.mul, s[3 * 33] * it.mul); o.y = pk4_fp8(s[4 * 33] * it.mul, s[5 * 33] * it.mul, s[6 * 33] * it.mul, s[7 * 33] * it.mul);
        *(u32x2*)(it.WT + (size_t)(it.n0 + n) * it.Kd + it.k0 + 8 * c) = o; }
    asm volatile("s_waitcnt lgkmcnt(0)" ::: "memory");
}
DI unsigned long long phase_scan(const Frame& F, const bf16_t* RKV, const float* DEC, const bf16_t* AA, const float* kk_w, const float* ka_w, bf16_t* YRAW,
                                  const float* w13, const float* w2, unsigned char* m13, unsigned char* m2) {
    unsigned long long pacc = 0ull;
    for (int vb = blockIdx.x; vb < 256; vb += F.G) {
        const int bh = vb >> 1, half = vb & 1, b = bh >> 5, hd = bh & 31;
        const int w = F.wave, lane = F.lane;
        const int rp = lane >> 4, cg = lane & 15;
        const int row0 = 8 * w + 2 * rp;
        f32x2 SS[4] = {(f32x2){0.f, 0.f}, (f32x2){0.f, 0.f}, (f32x2){0.f, 0.f}, (f32x2){0.f, 0.f}};
        constexpr int NCH = SEQ / scan::TC;
        volatile LAS unsigned* fl = (volatile LAS unsigned*)(F.lds + 138240);
#define SC_WAIT(idx, target) do { unsigned sp_ = 0; while (fl[idx] < (unsigned)(target) && ++sp_ < (1u << 24)) __builtin_amdgcn_s_sleep(1); asm volatile("" ::: "memory"); } while (0)
#define SC_SIGNAL(idx) do { asm volatile("s_waitcnt lgkmcnt(0)" ::: "memory"); if (lane == 0) (void)__hip_atomic_fetch_add((LAS unsigned*)&fl[idx], 1u, __ATOMIC_RELAXED, __HIP_MEMORY_SCOPE_WORKGROUP); } while (0)
        if (w < 4) {
            __builtin_amdgcn_s_setprio(3);
            for (int ch = 0; ch < NCH; ++ch) {
                LAS unsigned char* buf = F.lds + (ch & 1) * scan::CHB;
                LAS float* yb = (LAS float*)(F.lds + scan::OFF_Y + (ch & 1) * scan::YB);
                SC_WAIT(ch & 1, 4 * (ch / 2 + 1));
                if (ch >= 2) SC_WAIT(4 + (ch & 1), 4 * (ch / 2));
#ifdef PROBE_SCAN
                const unsigned long long pt0 = __builtin_amdgcn_s_memrealtime();
#endif
                f32x2 yp = (f32x2){0.f, 0.f};
                const LAS float* sp0 = (const LAS float*)buf;
                f32x4 w4 = *(const LAS f32x4*)(sp0 + 4 * cg), nk4 = *(const LAS f32x4*)(sp0 + 64 + 4 * cg), b4 = *(const LAS f32x4*)(sp0 + 128 + 4 * cg),
                      k4 = *(const LAS f32x4*)(sp0 + 192 + 4 * cg), r4 = *(const LAS f32x4*)(sp0 + 256 + 4 * cg);
                f32x2 v2 = *(const LAS f32x2*)(sp0 + 320 + row0);
#define SPL(x) ((f32x2){(x), (x)})
#pragma unroll 8
                for (int s = 0; s < scan::TC; ++s) {
                    const LAS float* sp = (const LAS float*)(buf + (s + 1) * scan::STEPB);
                    const f32x4 w4n = *(const LAS f32x4*)(sp + 4 * cg), nk4n = *(const LAS f32x4*)(sp + 64 + 4 * cg), b4n = *(const LAS f32x4*)(sp + 128 + 4 * cg),
                                k4n = *(const LAS f32x4*)(sp + 192 + 4 * cg), r4n = *(const LAS f32x4*)(sp + 256 + 4 * cg);
                    const f32x2 v2n = *(const LAS f32x2*)(sp + 320 + row0);
                    f32x2 sa = SS[0] * SPL(nk4[0]);
#pragma unroll
                    for (int i = 1; i < 4; ++i) sa = __builtin_elementwise_fma(SS[i], SPL(nk4[i]), sa);
                    float sa0 = sa.x, sa1 = sa.y, y0 = yp.x, y1 = yp.y;
                    scan::row_sum16x4(sa0, sa1, y0, y1);
                    if (cg == 0) { yb[s * 32 + row0] = y0; yb[s * 32 + row0 + 1] = y1; }
                    sa = (f32x2){sa0, sa1};
                    yp = (f32x2){0.f, 0.f};
#pragma unroll
                    for (int i = 0; i < 4; ++i) {
                        f32x2 t = v2 * SPL(k4[i]);
                        t = __builtin_elementwise_fma(sa, SPL(b4[i]), t);
                        SS[i] = __builtin_elementwise_fma(SS[i], SPL(w4[i]), t);
                        yp = __builtin_elementwise_fma(SS[i], SPL(r4[i]), yp);
                    }
                    w4 = w4n; nk4 = nk4n; b4 = b4n; k4 = k4n; r4 = r4n; v2 = v2n;
                }
#undef SPL
                float d0 = 0.f, d1 = 0.f, y0 = yp.x, y1 = yp.y;
                scan::row_sum16x4(y0, y1, d0, d1);
                if (cg == 0) { yb[scan::TC * 32 + row0] = y0; yb[scan::TC * 32 + row0 + 1] = y1; }
#ifdef PROBE_SCAN
                if (PROBE_SCAN == 1) pacc += __builtin_amdgcn_s_memrealtime() - pt0;
#endif
                SC_SIGNAL(2 + (ch & 1));
            }
            __builtin_amdgcn_s_setprio(0);
        } else {
            ScanRegs SR;
            const float kkw = kk_w[hd * 64 + lane], kaw = ka_w[hd * 64 + lane];
            scan_issue(F, SR, RKV, DEC, AA, b, hd, 0); scan_fill(F, SR, F.lds, kkw, kaw, half); SC_SIGNAL(0); scan_issue(F, SR, RKV, DEC, AA, b, hd, 1);
            LAS float* cscr = (LAS float*)(F.lds + 98816 + (w - 4) * 8448);
            for (int it = 0; it < NCH; ++it) {
#ifdef PROBE_SCAN
                const unsigned long long pt0 = __builtin_amdgcn_s_memrealtime();
#endif
                const int gid0 = ((it * 256 + vb) * 4 + (w - 4)) * 2;
                const CvItem ia = cv_item(gid0, w13, w2, m13, m2), ib = cv_item(gid0 + 1, w13, w2, m13, m2);
                float ca[32];
                cv_load(ca, ia, lane);
                if (it >= 1) SC_WAIT(2 + ((it - 1) & 1), 4 * ((it - 1) / 2 + 1));
                if (it + 1 < NCH) { scan_fill(F, SR, F.lds + ((it + 1) & 1) * scan::CHB, kkw, kaw, half); SC_SIGNAL((it + 1) & 1); }
                if (it + 2 < NCH) scan_issue(F, SR, RKV, DEC, AA, b, hd, it + 2);
                if (it >= 1) { scan_flush(F, F.lds + scan::OFF_Y + ((it - 1) & 1) * scan::YB, YRAW, b, hd, half, it - 1); SC_SIGNAL(4 + ((it - 1) & 1)); }
                cv_store(ca, ia, cscr, lane);
                cv_load(ca, ib, lane); cv_store(ca, ib, cscr, lane);
#ifdef PROBE_SCAN
                if (PROBE_SCAN == 2) pacc += __builtin_amdgcn_s_memrealtime() - pt0;
#endif
            }
            SC_WAIT(2 + ((NCH - 1) & 1), 4 * ((NCH - 1) / 2 + 1));
            scan_flush(F, F.lds + scan::OFF_Y + ((NCH - 1) & 1) * scan::YB, YRAW, b, hd, half, NCH - 1);
        }
#undef SC_WAIT
#undef SC_SIGNAL
        __syncthreads();
        if (F.tid < 6) fl[F.tid] = 0u;
        __syncthreads();
    }
    return pacc;
}

namespace sc2 {
constexpr int C = 16, NCHK = SEQ / C, NSLOT = 6;
constexpr int OFF_XT = 0, OFF_ZS = 4096, OFF_B2T = 8192, OFF_VT = 10240, OFF_GC = 11264, SLOTB = 11520;
constexpr int OFF_SCR = NSLOT * SLOTB, SCRB = 8448;
constexpr int FL = 138240;
constexpr int NITEM = CV_TOTAL / 256;
DI bf16x8 pack8(float a0, float a1, float a2, float a3, float a4, float a5, float a6, float a7) { const u32x4 u = {pk2(a0, a1), pk2(a2, a3), pk2(a4, a5), pk2(a6, a7)}; return __builtin_bit_cast(bf16x8, u); }
struct Raw { unsigned short r[16], k[16], v[16], a[16]; float dec[16]; };
DI void issue(Raw& R, const bf16_t* RKV, const float* DEC, const bf16_t* AA, int b, int hd, int c, int lane) {
#pragma unroll
    for (int t = 0; t < 16; ++t) {
        const size_t o = ((size_t)b * SEQ + (size_t)c * C + t) * DM + hd * 64 + lane;
        R.r[t] = RKV[o]; R.k[t] = RKV[(size_t)M * DM + o]; R.v[t] = RKV[(size_t)2 * M * DM + o]; R.dec[t] = DEC[o]; R.a[t] = AA[o];
    }
}
}
DI void phase_scan2(const Frame& F, const bf16_t* RKV, const float* DEC, const bf16_t* AA, const float* kk_w, const float* ka_w, bf16_t* YRAW,
                    const float* w13, const float* w2, unsigned char* m13, unsigned char* m2) {
    using namespace sc2;
    for (int vb = blockIdx.x; vb < 256; vb += F.G) {
        const int xq_ = vb & 7, yq_ = vb >> 3; const int half = yq_ & 1, bh = (yq_ >> 1) * 8 + xq_, b = bh >> 5, hd = bh & 31;
        const int w = F.wave, lane = opq(F.lane);
        const int n = lane & 31, h = lane >> 5;
        volatile LAS unsigned* fl = (volatile LAS unsigned*)(F.lds + FL);
#define SC_WAIT(idx, target) do { unsigned sp_ = 0; while (fl[idx] < (unsigned)(target) && ++sp_ < (1u << 24)) __builtin_amdgcn_s_sleep(1); asm volatile("" ::: "memory"); } while (0)
#define SC_GRAB(dst) do { unsigned g_ = 0; if (lane == 0) g_ = __hip_atomic_fetch_add((LAS unsigned*)&fl[7], 1u, __ATOMIC_RELAXED, __HIP_MEMORY_SCOPE_WORKGROUP); dst = __builtin_amdgcn_readfirstlane((int)g_); } while (0)
#define SC_GID(nn) (((nn) >> 3) * 2048 + vb * 8 + ((nn) & 7))
        if (w == 0) {
            __builtin_amdgcn_s_setprio(3);
            f32x16 ST0, ST1;
#pragma unroll
            for (int r = 0; r < 16; ++r) { ST0[r] = 0.f; ST1[r] = 0.f; }
            bf16x8 Sb0 = pack8(0.f, 0.f, 0.f, 0.f, 0.f, 0.f, 0.f, 0.f), Sb1 = Sb0, Sb2 = Sb0, Sb3 = Sb0;
            bf16_t* yout = YRAW + (size_t)b * SEQ * DM + hd * 64 + half * 32 + n;
#pragma unroll 1
            for (int c = 0; c < NCHK; ++c) {
                const int slot = c % NSLOT;
                const LAS unsigned char* sl = F.lds + slot * SLOTB;
                SC_WAIT(slot, c + 1);
                const int sw8 = n & 7, sw4 = (n >> 1) & 3;
                const bf16x8 A10 = *(const LAS bf16x8*)(sl + OFF_XT + n * 128 + (((0 + h) ^ sw8) << 4)), A11 = *(const LAS bf16x8*)(sl + OFF_XT + n * 128 + (((2 + h) ^ sw8) << 4)),
                             A12 = *(const LAS bf16x8*)(sl + OFF_XT + n * 128 + (((4 + h) ^ sw8) << 4)), A13 = *(const LAS bf16x8*)(sl + OFF_XT + n * 128 + (((6 + h) ^ sw8) << 4));
                const bf16x8 A20 = *(const LAS bf16x8*)(sl + OFF_B2T + n * 64 + (((0 + h) ^ sw4) << 4)), A21 = *(const LAS bf16x8*)(sl + OFF_B2T + n * 64 + (((2 + h) ^ sw4) << 4));
                const bf16x8 Vb = *(const LAS bf16x8*)(sl + OFF_VT + n * 32 + ((h ^ ((n >> 2) & 1)) << 4));
                const bf16x8 A300 = *(const LAS bf16x8*)(sl + OFF_ZS + n * 64 + (((0 + h) ^ sw4) << 4)), A301 = *(const LAS bf16x8*)(sl + OFF_ZS + n * 64 + (((2 + h) ^ sw4) << 4)),
                             A310 = *(const LAS bf16x8*)(sl + OFF_ZS + (32 + n) * 64 + (((0 + h) ^ sw4) << 4)), A311 = *(const LAS bf16x8*)(sl + OFF_ZS + (32 + n) * 64 + (((2 + h) ^ sw4) << 4));
                f32x4 gc0[4], gc1[4];
#pragma unroll
                for (int g = 0; g < 4; ++g) { gc0[g] = *(const LAS f32x4*)(sl + OFF_GC + (8 * g + 4 * h) * 4); gc1[g] = *(const LAS f32x4*)(sl + OFF_GC + (32 + 8 * g + 4 * h) * 4); }
                asm volatile("s_waitcnt lgkmcnt(0)" ::: "memory");
                if (lane == 0) fl[6] = (unsigned)(c + 1);
                f32x16 P;
#pragma unroll
                for (int r = 0; r < 16; ++r) P[r] = 0.f;
                P = MFMA32(A10, Sb0, P); P = MFMA32(A11, Sb1, P); P = MFMA32(A12, Sb2, P); P = MFMA32(A13, Sb3, P);
                const bf16x8 Bp = pack8(P[0], P[1], P[2], P[3], P[4], P[5], P[6], P[7]);
                f32x16 D2 = P;
#pragma unroll
                for (int r = 0; r < 8; ++r) D2[r] = 0.f;
                D2 = MFMA32(A20, Bp, D2); D2 = MFMA32(A21, Vb, D2);
                const bf16x8 Bu = pack8(D2[0], D2[1], D2[2], D2[3], D2[4], D2[5], D2[6], D2[7]);
#pragma unroll
                for (int r = 0; r < 16; ++r) { ST0[r] *= gc0[r >> 2][r & 3]; ST1[r] *= gc1[r >> 2][r & 3]; }
                ST0 = MFMA32(A300, Bu, ST0); ST0 = MFMA32(A301, Vb, ST0);
                ST1 = MFMA32(A310, Bu, ST1); ST1 = MFMA32(A311, Vb, ST1);
#pragma unroll
                for (int q = 0; q < 8; ++q) yout[((size_t)c * C + 8 * (q >> 2) + 4 * h + (q & 3)) * DM] = (bf16_t)f2bf(D2[8 + q]);
                Sb0 = pack8(ST0[0], ST0[1], ST0[2], ST0[3], ST0[4], ST0[5], ST0[6], ST0[7]); Sb1 = pack8(ST0[8], ST0[9], ST0[10], ST0[11], ST0[12], ST0[13], ST0[14], ST0[15]);
                Sb2 = pack8(ST1[0], ST1[1], ST1[2], ST1[3], ST1[4], ST1[5], ST1[6], ST1[7]); Sb3 = pack8(ST1[8], ST1[9], ST1[10], ST1[11], ST1[12], ST1[13], ST1[14], ST1[15]);
            }
            __builtin_amdgcn_s_setprio(0);
        } else {
            LAS unsigned char* scr = F.lds + OFF_SCR + (w - 1) * SCRB;
            if (w <= 3) {
                const float kkw = kk_w[hd * 64 + lane], kaw = ka_w[hd * 64 + lane];
                const int xslot = (lane >> 4) * 2 + ((lane >> 2) & 1), xq = (4 * ((lane >> 3) & 1) + (lane & 3)) * 2;
                LAS unsigned char* ZT = scr; LAS float* GS = (LAS float*)(scr + 4096);
#pragma unroll 1
                for (int c = w - 1; c < NCHK; c += 3) {
                    Raw R; issue(R, RKV, DEC, AA, b, hd, c, lane);
                    { int nn; SC_GRAB(nn); if (nn < NITEM) { const CvItem it = cv_item(SC_GID(nn), w13, w2, m13, m2); float ca[32]; cv_load(ca, it, lane); cv_store(ca, it, (LAS float*)scr, lane); } }
                    const int slot = c % NSLOT;
                    LAS unsigned char* sl = F.lds + slot * SLOTB;
                    if (c >= NSLOT) SC_WAIT(6, c - NSLOT + 1);
                    float gam = 1.0f; float bt[16], kt[16];
#pragma unroll
                    for (int t = 0; t < 16; ++t) {
                        const float r = bf2f(R.r[t]), k = bf2f(R.k[t]), a = bf2f(R.a[t]), dec = R.dec[t];
                        const float kx = k * kkw;
                        const float kk = kx * __builtin_amdgcn_rsqf(fmaxf(scan::wave_sum_dpp(kx * kx), 1e-24f));
                        const float kp = k * (1.0f + (a - 1.0f) * kaw);
                        const float at = -kk * gam;
                        gam *= dec;
                        const float ig = __builtin_amdgcn_rcpf(gam);
                        const float rt = r * gam;
                        bt[t] = kk * a * ig; kt[t] = kp * ig;
                        *(LAS unsigned short*)(sl + OFF_XT + t * 128 + ((xslot ^ (t & 7)) << 4) + xq) = (unsigned short)f2bf(at);
                        *(LAS unsigned short*)(sl + OFF_XT + (16 + t) * 128 + ((xslot ^ (t & 7)) << 4) + xq) = (unsigned short)f2bf(rt);
                        *(LAS unsigned short*)(ZT + t * 128 + ((xslot ^ (t & 7)) << 4) + xq) = (unsigned short)f2bf(bt[t]);
                        *(LAS unsigned short*)(ZT + (16 + t) * 128 + ((xslot ^ (t & 7)) << 4) + xq) = (unsigned short)f2bf(kt[t]);
                    }
                    {
                        const int sw4 = (lane >> 1) & 3;
                        LAS unsigned char* zr = sl + OFF_ZS + lane * 64;
#define ZB(s) (bt[s] * gam)
#define ZK(s) (kt[s] * gam)
                        *(LAS bf16x8*)(zr + ((0 ^ sw4) << 4)) = pack8(ZB(0), ZB(1), ZB(2), ZB(3), ZB(8), ZB(9), ZB(10), ZB(11));
                        *(LAS bf16x8*)(zr + ((1 ^ sw4) << 4)) = pack8(ZB(4), ZB(5), ZB(6), ZB(7), ZB(12), ZB(13), ZB(14), ZB(15));
                        *(LAS bf16x8*)(zr + ((2 ^ sw4) << 4)) = pack8(ZK(0), ZK(1), ZK(2), ZK(3), ZK(4), ZK(5), ZK(6), ZK(7));
                        *(LAS bf16x8*)(zr + ((3 ^ sw4) << 4)) = pack8(ZK(8), ZK(9), ZK(10), ZK(11), ZK(12), ZK(13), ZK(14), ZK(15));
#undef ZB
#undef ZK
                        *(LAS float*)(sl + OFF_GC + lane * 4) = gam;
                        if (h == half) {
                            const u32x4 v0 = {(unsigned)R.v[0] | ((unsigned)R.v[1] << 16), (unsigned)R.v[2] | ((unsigned)R.v[3] << 16), (unsigned)R.v[4] | ((unsigned)R.v[5] << 16), (unsigned)R.v[6] | ((unsigned)R.v[7] << 16)};
                            const u32x4 v1 = {(unsigned)R.v[8] | ((unsigned)R.v[9] << 16), (unsigned)R.v[10] | ((unsigned)R.v[11] << 16), (unsigned)R.v[12] | ((unsigned)R.v[13] << 16), (unsigned)R.v[14] | ((unsigned)R.v[15] << 16)};
                            const int vs = (n >> 2) & 1;
                            *(LAS u32x4*)(sl + OFF_VT + n * 32 + ((0 ^ vs) << 4)) = v0; *(LAS u32x4*)(sl + OFF_VT + n * 32 + ((1 ^ vs) << 4)) = v1;
                        }
                    }
                    asm volatile("s_waitcnt lgkmcnt(0)" ::: "memory");
                    f32x16 Gm;
#pragma unroll
                    for (int r = 0; r < 16; ++r) Gm[r] = 0.f;
#pragma unroll
                    for (int kq = 0; kq < 4; ++kq) {
                        const int so = ((2 * kq + h) ^ (n & 7)) << 4;
                        const bf16x8 za = *(const LAS bf16x8*)(ZT + n * 128 + so), xb = *(const LAS bf16x8*)(sl + OFF_XT + n * 128 + so);
                        Gm = MFMA32(za, xb, Gm);
                    }
#pragma unroll
                    for (int r = 0; r < 16; ++r) GS[(8 * (r >> 2) + 4 * h + (r & 3)) * 32 + n] = Gm[r];
                    asm volatile("s_waitcnt lgkmcnt(0)" ::: "memory");
                    float Xs[16], Wl[16];
                    const int tq = n - 16;
#pragma unroll
                    for (int s = 0; s < 16; ++s) {
                        const float gq = GS[s * 32 + n], gk = GS[(16 + s) * 32 + n];
                        Xs[s] = n < 16 ? (n == s ? 1.0f : 0.0f) : (s <= tq ? gq : 0.0f);
                        Wl[s] = (n >= 16 && s <= tq) ? gk : 0.0f;
                    }
#pragma unroll
                    for (int s = 14; s >= 0; --s) {
#pragma unroll
                        for (int qd = (s + 1) >> 2; qd < 4; ++qd) {
                            const f32x4 l4 = *(const LAS f32x4*)(GS + s * 32 + 4 * qd);
#pragma unroll
                            for (int e = 0; e < 4; ++e) if (4 * qd + e > s) Xs[s] = fmaf(l4[e], Xs[4 * qd + e], Xs[s]);
                        }
                    }
#pragma unroll
                    for (int s = 0; s < 15; ++s) {
#pragma unroll
                        for (int qd = (s + 1) >> 2; qd < 4; ++qd) {
                            const f32x4 l4 = *(const LAS f32x4*)(GS + (16 + s) * 32 + 4 * qd);
#pragma unroll
                            for (int e = 0; e < 4; ++e) if (4 * qd + e > s) Wl[s] = fmaf(l4[e], Xs[4 * qd + e], Wl[s]);
                        }
                    }
                    if (lane < 32) {
                        const int sw4 = (n >> 1) & 3;
                        LAS unsigned char* br = sl + OFF_B2T + n * 64;
                        *(LAS bf16x8*)(br + ((0 ^ sw4) << 4)) = pack8(Xs[0], Xs[1], Xs[2], Xs[3], Xs[8], Xs[9], Xs[10], Xs[11]);
                        *(LAS bf16x8*)(br + ((1 ^ sw4) << 4)) = pack8(Xs[4], Xs[5], Xs[6], Xs[7], Xs[12], Xs[13], Xs[14], Xs[15]);
                        *(LAS bf16x8*)(br + ((2 ^ sw4) << 4)) = pack8(Wl[0], Wl[1], Wl[2], Wl[3], Wl[4], Wl[5], Wl[6], Wl[7]);
                        *(LAS bf16x8*)(br + ((3 ^ sw4) << 4)) = pack8(Wl[8], Wl[9], Wl[10], Wl[11], Wl[12], Wl[13], Wl[14], Wl[15]);
                    }
                    asm volatile("s_waitcnt lgkmcnt(0)" ::: "memory");
                    if (lane == 0) fl[slot] = (unsigned)(c + 1);
                }
            }
#pragma unroll 1
            for (;;) {
                int nn; SC_GRAB(nn);
                if (nn >= NITEM) break;
                const CvItem it = cv_item(SC_GID(nn), w13, w2, m13, m2);
                float ca[32]; cv_load(ca, it, lane); cv_store(ca, it, (LAS float*)scr, lane);
            }
        }
#undef SC_WAIT
#undef SC_GRAB
#undef SC_GID
        __syncthreads();
        if (F.tid < 8) fl[F.tid] = 0u;
        __syncthreads();
    }
}

constexpr int NPHASE = 19;
__global__ void __launch_bounds__(NTHR, 2) mk_fwd(Args args) {
    extern __shared__ __attribute__((aligned(16))) unsigned char lds_raw[];
    Frame F;
    F.lds = (LAS unsigned char*)lds_raw;
    F.tid = threadIdx.x; F.lane = F.tid & 63; F.wave = __builtin_amdgcn_readfirstlane(F.tid >> 6);
    F.G = gridDim.x; F.gw = blockIdx.x * NWAVES + F.wave; F.NGW = F.G * NWAVES; F.ws = args.ws;
    unsigned char* ws = args.ws;
    unsigned* ctl = (unsigned*)(ws + WS_CTL);
    volatile LAS unsigned* MISC = (volatile LAS unsigned*)(F.lds + MISC_OFF);
    for (int u = F.tid; u < (LDS_BYTES - LDSCTL_OFF) / 4; u += NTHR) ((LAS unsigned*)(F.lds + LDSCTL_OFF))[u] = 0u;
    __syncthreads();
    XcdBarrier bar; bar.bar = ctl + CW_BAR; bar.x = 0; bar.st = nullptr;
    if (args.use_bar) bar = xcd_barrier_post(ctl + CW_BAR, MISC + 8);
    const int lo = args.ph_lo, hi = args.ph_hi;
#ifndef PH_MASK
#define PH_MASK 0xFFFFFFFFu
#endif
#define IN(k) (((PH_MASK >> (k)) & 1u) && lo <= (k) && (k) < hi)
#define SEAM(k) do { if (IN(k) && IN((k) + 1)) xcd_barrier(bar); if (PROBE_ON(k)) probe_acc += __builtin_amdgcn_s_memrealtime() - probe_t0; if (PROBE_ON((k) + 1)) probe_t0 = __builtin_amdgcn_s_memrealtime(); } while (0)
#ifndef REPEAT_MASK
#define REPEAT_MASK 0u
#endif
#define REPS(k) ((((REPEAT_MASK) >> (k)) & 1u) ? 2 : 1)
#ifndef PROBE_MASK
#define PROBE_MASK 0u
#endif
    unsigned long long probe_acc = 0ull, probe_t0 = 0ull;
#define PROBE_ON(k) (PROBE_MASK != 0u && (((PROBE_MASK) >> (k)) & 1u) && blockIdx.x == 0 && F.tid == 0)
#define PH(k) if (IN(k)) for (int rep_ = 0; rep_ < REPS(k); ++rep_, (rep_ < REPS(k) ? xcd_barrier(bar) : (void)0))

    bf16_t* W_IN = (bf16_t*)(ws + WS_W_IN); bf16_t* W_OUT = (bf16_t*)(ws + WS_W_OUT); bf16_t* CMPW1 = (bf16_t*)(ws + WS_CMPW1);
    bf16_t* FFN13 = (bf16_t*)(ws + WS_FFN13); bf16_t* FFN2 = (bf16_t*)(ws + WS_FFN2); bf16_t* WRKV = (bf16_t*)(ws + WS_WRKV);
    bf16_t* LORA1 = (bf16_t*)(ws + WS_LORA1); bf16_t* LORA2 = (bf16_t*)(ws + WS_LORA2); bf16_t* WO = (bf16_t*)(ws + WS_WO);
    bf16_t* MOE13 = (bf16_t*)(ws + WS_MOE13); bf16_t* MOE2 = (bf16_t*)(ws + WS_MOE2);
    bf16_t* XN = (bf16_t*)(ws + WS_XN); bf16_t* P = (bf16_t*)(ws + WS_P); float* ROPE = (float*)(ws + WS_ROPE); float* CMPB = (float*)(ws + WS_CMPB);
    bf16_t* HID = (bf16_t*)(ws + WS_HID); bf16_t* KVC = (bf16_t*)(ws + WS_KVC); bf16_t* O = (bf16_t*)(ws + WS_O); bf16_t* H = (bf16_t*)(ws + WS_H);
    bf16_t* ACT = (bf16_t*)(ws + WS_ACT); bf16_t* XS = (bf16_t*)(ws + WS_XS); bf16_t* RKV = (bf16_t*)(ws + WS_RKV); bf16_t* L1 = (bf16_t*)(ws + WS_L1);
    float* DEC = (float*)(ws + WS_DEC); bf16_t* AA = (bf16_t*)(ws + WS_AA); bf16_t* GG = (bf16_t*)(ws + WS_GG); bf16_t* YRAW = (bf16_t*)(ws + WS_YRAW); bf16_t* YG = (bf16_t*)(ws + WS_YG);
    int* ROWTOK = (int*)(ws + WS_ROWTOK); int* TOKSLOT = (int*)(ws + WS_TOKSLOT); float* Y2 = (float*)(ws + WS_Y2);
    LAS unsigned char* ring = F.lds;

    if (PROBE_ON(0)) probe_t0 = __builtin_amdgcn_s_memrealtime();
    PH(0) {
        LAS float* scr = (LAS float*)(F.lds + F.wave * 16640);
        transpose_matrix(F, args.in[I_W_IN], IN_COLS, DM, W_IN, DM, NP, ColInProj{}, scr, F.gw, F.NGW);
        for (int kv = 0; kv < 2; ++kv) transpose_matrix(F, args.in[I_CMP_W1] + (size_t)kv * 2048 * 256, 256, 2048, CMPW1 + (size_t)kv * 256 * 2048, 2048, 256, ColIdent{}, scr, F.gw, F.NGW);
        for (int m = F.gw; m < M; m += F.NGW) rms_row_to_bf16(args.in[I_X] + (size_t)m * DM, args.in[I_ATTN_NORM], XN + (size_t)m * DM, F.lane);
        { const int* pos = (const int*)args.in[I_POS];
          for (int i = blockIdx.x * NTHR + F.tid; i < M * 32; i += F.G * NTHR) { const int m = i >> 5, j = i & 31;
              const float inv = powf(150000.0f, -(float)j / 32.0f); const float ang = (float)pos[m] * inv; float sn, cs; sincosf(ang, &sn, &cs);
              ROPE[(size_t)m * 64 + j] = cs; ROPE[(size_t)m * 64 + 32 + j] = sn; } }
        if (F.gw < 512) { const int kv = F.gw >> 8, j = F.gw & 255; const float* pe = args.in[I_CMP_PE] + kv * 2048; const float* w1 = args.in[I_CMP_W1] + (size_t)kv * 2048 * 256;
            float s = 0.f; for (int i = F.lane; i < 2048; i += 64) s += pe[i] * w1[(size_t)i * 256 + j];
            s = wave_sum(s); if (F.lane == 0) CMPB[kv * 256 + j] = s + args.in[I_CMP_B1][kv * 256 + j]; }
    }
    SEAM(0);
    PH(1) {
        OrderSingle S{(const char*)XN, (const char*)W_IN, DM * 2, DM * 2, 64, 12, 64 * 12, F.G, (int)blockIdx.x};
        EpiInProj E{P, ROPE};
        pg8::gemm_phase<EpiInProj, OrderSingle, false>(ring, DM * 2, 128, DM * 2, DM / 64, S, E);
    }
    SEAM(1);
    PH(2) {
        OrderCmp S{(const char*)P, (const char*)CMPW1, (const char*)XN, (const char*)(W_IN + (size_t)C_GATE * DM), F.G, (int)blockIdx.x};
        EpiCmp1 E{HID, CMPB, P};
        pg8::gemm_phase<EpiCmp1, OrderCmp, true>(ring, 0, 0, 2048 * 2, 32, S, E);
        const bool conv = F.G > 80 ? (int)blockIdx.x >= 80 : true;
        if (conv) {
            const int nconv = F.G > 80 ? F.G - 80 : F.G; const int first = ((F.G > 80 ? (int)blockIdx.x - 80 : (int)blockIdx.x)) * NWAVES + F.wave, stride = nconv * NWAVES;
            LAS float* scr = (LAS float*)(F.lds + F.wave * 16640);
            transpose_matrix(F, args.in[I_W_OUT], DM, DM, W_OUT, DM, DM, ColIdent{}, scr, first, stride);
            transpose_matrix(F, args.in[I_FFN_W13], 2 * DFF, DM, FFN13, DM, 2 * DFF, ColSwiglu{DFF}, scr, first, stride);
            transpose_matrix(F, args.in[I_FFN_W2], DM, DFF, FFN2, DFF, DM, ColIdent{}, scr, first, stride);
            for (int i = 0; i < 3; ++i) transpose_matrix(F, args.in[I_W_RKV] + (size_t)i * DM * DM, DM, DM, WRKV + (size_t)i * DM * DM, DM, DM, ColIdent{}, scr, first, stride);
            transpose_matrix(F, args.in[I_DECAY_W1], 96, DM, LORA1, DM, 256, ColIdent{}, scr, first, stride);
            transpose_matrix(F, args.in[I_A1], 96, DM, LORA1 + (size_t)256 * DM, DM, 256, ColIdent{}, scr, first, stride);
            transpose_matrix(F, args.in[I_G1], 256, DM, LORA1 + (size_t)512 * DM, DM, 256, ColIdent{}, scr, first, stride);
            transpose_matrix(F, args.in[I_DECAY_W2], DM, 96, LORA2, 256, DM, ColIdent{}, scr, first, stride);
            transpose_matrix(F, args.in[I_A2], DM, 96, LORA2 + (size_t)DM * 256, 256, DM, ColIdent{}, scr, first, stride);
            transpose_matrix(F, args.in[I_G2], DM, 256, LORA2 + (size_t)2 * DM * 256, 256, DM, ColIdent{}, scr, first, stride);
            transpose_matrix(F, args.in[I_W_O], DM, DM, WO, DM, DM, ColIdent{}, scr, first, stride);
        }
    }
    SEAM(2);
    PH(3) {
        for (int it = blockIdx.x * NTHR + F.tid; it < 2 * 2048 * 16; it += F.G * NTHR) {
            const int dq = it & 15, row = (it >> 4) & 2047, kv = it >> 15;
            const bf16_t* hr = HID + ((size_t)kv * 2048 + row) * 256; const float* w2 = args.in[I_CMP_W2] + (size_t)kv * 256 * 64 + dq * 4;
            f32x4 a = (f32x4){0.f, 0.f, 0.f, 0.f};
            for (int j = 0; j < 256; j += 2) { const unsigned hw = *(const unsigned*)(hr + j); a += bflo(hw) * *(const f32x4*)(w2 + (size_t)j * 64); a += bfhi(hw) * *(const f32x4*)(w2 + (size_t)(j + 1) * 64); }
            u32x2 o; o.x = pk2(a.x, a.y); o.y = pk2(a.z, a.w); *(u32x2*)(KVC + ((size_t)kv * 2048 + row) * 64 + dq * 4) = o;
        }
    }
    SEAM(3);
    PH(4) {
        for (int vb = blockIdx.x; vb < 256; vb += F.G) {
            const int bh = vb >> 5, p = vb & 31;
#pragma unroll 1
            for (int k = 0; k < 2; ++k) attn_unit_B(F, P, KVC, O, nullptr, bh >> 1, bh & 1, k == 0 ? 63 - p : p);
#pragma unroll 1
            for (int k = 0; k < 2; ++k) { const int id = 2 * vb + k; attn_unit_A(F, P, O, args.in[I_SINKS], id >> 7, (id >> 6) & 1, id & 63); }
        }
    }
    SEAM(4);
    PH(5) {
        OrderSingle S{(const char*)O, (const char*)W_OUT, DM * 2, DM * 2, 64, 8, 512, F.G, (int)blockIdx.x};
        EpiResH<true> E{args.in[I_X], H};
        pg8::gemm_phase<EpiResH<true>, OrderSingle, false>(ring, DM * 2, 128, DM * 2, DM / 64, S, E);
    }
    SEAM(5);
    PH(6) { for (int m = F.gw; m < M; m += F.NGW) rms_row_to_bf16_h(H + (size_t)m * DM, args.in[I_FFN_NORM], XN + (size_t)m * DM, F.lane); }
    SEAM(6);
    PH(7) {
        OrderSingle S{(const char*)XN, (const char*)FFN13, DM * 2, DM * 2, 64, 2 * DFF / 256, 64 * (2 * DFF / 256), F.G, (int)blockIdx.x};
        EpiSwiglu E{ACT, DFF};
        pg8::gemm_phase<EpiSwiglu, OrderSingle, false>(ring, DM * 2, 128, DM * 2, DM / 64, S, E);
    }
    SEAM(7);
    PH(8) {
        OrderSingle S{(const char*)ACT, (const char*)FFN2, DFF * 2, DFF * 2, 64, 8, 512, F.G, (int)blockIdx.x};
        EpiResH<false> E{H, H};
        pg8::gemm_phase<EpiResH<false>, OrderSingle, false>(ring, DFF * 2, 128, DFF * 2, DFF / 64, S, E);
    }
    SEAM(8);
    PH(9) {
        const float* g = args.in[I_ATTN_NORM] + DM; const float* mu = args.in[I_MU];
        for (int m0 = F.gw * 8; m0 < M; m0 += F.NGW * 8) {
            f32x4 hp[8], vn[8];
            const bool has_prev0 = (m0 % SEQ) != 0;
            if (has_prev0) { float prs; rms_row_load_h(H + (size_t)(m0 - 1) * DM, F.lane, hp, prs);
#pragma unroll
                for (int j = 0; j < 8; ++j) hp[j] = hp[j] * prs * *(const f32x4*)(g + 4 * F.lane + 256 * j);
            } else {
#pragma unroll
                for (int j = 0; j < 8; ++j) hp[j] = (f32x4){0.f, 0.f, 0.f, 0.f};
            }
#pragma unroll
            for (int j = 0; j < 8; ++j) vn[j] = ld4bf(H + (size_t)m0 * DM + 4 * F.lane + 256 * j);
            for (int q = 0; q < 8; ++q) {
                const int m = m0 + q;
                f32x4 v[8]; float ss = 0.f;
#pragma unroll
                for (int j = 0; j < 8; ++j) { v[j] = vn[j]; ss += (v[j].x * v[j].x + v[j].y * v[j].y) + (v[j].z * v[j].z + v[j].w * v[j].w); }
                if (q < 7) {
#pragma unroll
                    for (int j = 0; j < 8; ++j) vn[j] = ld4bf(H + (size_t)(m + 1) * DM + 4 * F.lane + 256 * j);
                }
                const float rs = __builtin_amdgcn_rsqf(scan::wave_sum_dpp(ss) * (1.0f / DM) + RMS_EPS);
                const float* g_ = opqp(g); const float* mu_ = opqp(mu);
#pragma unroll
                for (int j = 0; j < 8; ++j) {
                    const int col = 4 * F.lane + 256 * j; const f32x4 gg = *(const f32x4*)(g_ + col);
                    const f32x4 hn = v[j] * rs * gg; const f32x4 xx = hp[j] - hn; hp[j] = hn;
#pragma unroll
                    for (int i = 0; i < 6; ++i) { const f32x4 mm = *(const f32x4*)(mu_ + (size_t)i * DM + col); const f32x4 y = hn + xx * mm;
                        u32x2 w; w.x = pk2(y.x, y.y); w.y = pk2(y.z, y.w); *(u32x2*)(XS + ((size_t)i * M + m) * DM + col) = w; }
                }
            }
        }
    }
    SEAM(9);
    PH(10) {
        OrderMulti S{};
        for (int g = 0; g < 6; ++g) { S.A[g] = (const char*)(XS + (size_t)g * M * DM); S.Bt[g] = g < 3 ? (const char*)(WRKV + (size_t)g * DM * DM) : (const char*)(LORA1 + (size_t)(g - 3) * 256 * DM); S.nN[g] = g < 3 ? 8 : 1; }
        S.start[0] = 0; for (int g = 0; g < 6; ++g) S.start[g + 1] = S.start[g] + 64 * S.nN[g];
        S.lda = DM * 2; S.ldb = DM * 2; S.ng = 6; S.nwg = S.start[6]; S.G = F.G; S.c = (int)blockIdx.x;
        EpiRkvLora1 E{RKV, L1};
        pg8::gemm_phase<EpiRkvLora1, OrderMulti, false>(ring, DM * 2, 128, DM * 2, DM / 64, S, E);
    }
    SEAM(10);
    PH(11) {
        OrderMulti S{};
        for (int g = 0; g < 3; ++g) { S.A[g] = (const char*)(L1 + (size_t)g * M * 256); S.Bt[g] = (const char*)(LORA2 + (size_t)g * DM * 256); S.nN[g] = 8; }
        for (int g = 3; g < 6; ++g) { S.A[g] = S.A[0]; S.Bt[g] = S.Bt[0]; S.nN[g] = 0; }
        S.start[0] = 0; for (int g = 0; g < 6; ++g) S.start[g + 1] = S.start[g] + 64 * S.nN[g];
        S.lda = 256 * 2; S.ldb = 256 * 2; S.ng = 3; S.nwg = S.start[3]; S.G = F.G; S.c = (int)blockIdx.x;
        EpiLora2 E{DEC, AA, GG, args.in[I_DECAY_W0], args.in[I_A0]};
        pg8::gemm_phase<EpiLora2, OrderMulti, false>(ring, 256 * 2, 128, 256 * 2, 4, S, E);
    }
    SEAM(11);
    PH(12) {
        phase_scan2(F, RKV, DEC, AA, args.in[I_K_K], args.in[I_K_A], YRAW, args.in[I_MOE_W13], args.in[I_MOE_W2], (unsigned char*)MOE13, (unsigned char*)MOE2);
    }
    SEAM(12);
    PH(13) {
        const float* lnw = args.in[I_LN_W]; const float* lnb = args.in[I_LN_B]; const float* rk = args.in[I_R_K]; const float* kaw = args.in[I_K_A];
        for (int m = F.gw; m < M; m += F.NGW) {
#pragma unroll
            for (int ps = 0; ps < 4; ++ps) {
                const int ch = ps * 512 + F.lane * 8; const size_t o = (size_t)m * DM + ch;
                const u32x4 yy = *(const u32x4*)(YRAW + o);
                const u32x4 aa = *(const u32x4*)(AA + o);
                const u32x4 rr = *(const u32x4*)(RKV + o), kk = *(const u32x4*)(RKV + (size_t)M * DM + o), vv = *(const u32x4*)(RKV + (size_t)2 * M * DM + o), gg = *(const u32x4*)(GG + o);
                float y[8] = {bflo(yy.x), bfhi(yy.x), bflo(yy.y), bfhi(yy.y), bflo(yy.z), bfhi(yy.z), bflo(yy.w), bfhi(yy.w)}, a[8] = {bflo(aa.x), bfhi(aa.x), bflo(aa.y), bfhi(aa.y), bflo(aa.z), bfhi(aa.z), bflo(aa.w), bfhi(aa.w)};
                const unsigned rw[4] = {rr.x, rr.y, rr.z, rr.w}, kw[4] = {kk.x, kk.y, kk.z, kk.w}, vw[4] = {vv.x, vv.y, vv.z, vv.w}, gw4[4] = {gg.x, gg.y, gg.z, gg.w};
                float r[8], k[8], v[8], g[8];
#pragma unroll
                for (int i = 0; i < 4; ++i) { r[2 * i] = bflo(rw[i]); r[2 * i + 1] = bfhi(rw[i]); k[2 * i] = bflo(kw[i]); k[2 * i + 1] = bfhi(kw[i]); v[2 * i] = bflo(vw[i]); v[2 * i + 1] = bfhi(vw[i]); g[2 * i] = bflo(gw4[i]); g[2 * i + 1] = bfhi(gw4[i]); }
                float s = 0.f, bs = 0.f;
#pragma unroll
                for (int i = 0; i < 8; ++i) { s += y[i]; bs += r[i] * (k[i] * (1.0f + (a[i] - 1.0f) * kaw[ch + i])) * rk[ch + i]; }
                s += scan::dpp_f<0xB1>(s); s += scan::dpp_f<0x4E>(s); s += scan::dpp_f<0x141>(s);
                bs += scan::dpp_f<0xB1>(bs); bs += scan::dpp_f<0x4E>(bs); bs += scan::dpp_f<0x141>(bs);
                const float mean = s * (1.0f / 64.0f); float q = 0.f;
#pragma unroll
                for (int i = 0; i < 8; ++i) { y[i] -= mean; q += y[i] * y[i]; }
                q += scan::dpp_f<0xB1>(q); q += scan::dpp_f<0x4E>(q); q += scan::dpp_f<0x141>(q);
                const float rstd = 1.0f / sqrtf(q * (1.0f / 64.0f) + GN_EPS);
                float out[8];
#pragma unroll
                for (int i = 0; i < 8; ++i) out[i] = ((y[i] * rstd) * lnw[ch + i] + lnb[ch + i] + bs * v[i]) * g[i];
                u32x4 w; w.x = pk2(out[0], out[1]); w.y = pk2(out[2], out[3]); w.z = pk2(out[4], out[5]); w.w = pk2(out[6], out[7]);
                *(u32x4*)(YG + o) = w;
            }
        }
    }
    SEAM(13);
    PH(14) {
        OrderSingle S{(const char*)YG, (const char*)WO, DM * 2, DM * 2, 64, 8, 512, F.G, (int)blockIdx.x};
        EpiResH<false> E{H, H};
        pg8::gemm_phase<EpiResH<false>, OrderSingle, false>(ring, DM * 2, 128, DM * 2, DM / 64, S, E);
    }
    SEAM(14);
    PH(15) {
        LAS int* t_e = (LAS int*)(F.lds + 65536);
        LAS float* t_w = (LAS float*)(F.lds + 65536 + 512);
        LAS int* t_p = (LAS int*)(F.lds + 65536 + 1024);
        LAS unsigned char* rwl = F.lds;
        const float* g = args.in[I_FFN_NORM] + DM; const float* rw = args.in[I_ROUTER];
        for (int idx = F.tid; idx < 4096; idx += NTHR) {
            const int chn = idx >> 1, half = idx & 1; const int j = chn >> 8, l = (chn & 255) >> 2, e4 = chn & 3;
            *(LAS f32x4*)(rwl + ((2 * (4 * j + e4) + half) * 64 + l) * 16) = *(const f32x4*)(rw + (size_t)idx * 4);
        }
        __syncthreads();
        for (int base = blockIdx.x * 64; base < M; base += F.G * 64) {
            f32x4 vn[8];
#pragma unroll
            for (int j = 0; j < 8; ++j) vn[j] = ld4bf(H + (size_t)(base + F.wave * 8) * DM + 4 * F.lane + 256 * j);
            for (int qq = 0; qq < 8; ++qq) {
                const int lt = F.wave * 8 + qq, m = base + lt;
                f32x4 v[8]; float ss = 0.f;
#pragma unroll
                for (int j = 0; j < 8; ++j) { v[j] = vn[j]; ss += (v[j].x * v[j].x + v[j].y * v[j].y) + (v[j].z * v[j].z + v[j].w * v[j].w); }
                if (qq < 7) {
#pragma unroll
                    for (int j = 0; j < 8; ++j) vn[j] = ld4bf(H + (size_t)(m + 1) * DM + 4 * F.lane + 256 * j);
                }
                const float rs = __builtin_amdgcn_rsqf(scan::wave_sum_dpp(ss) * (1.0f / DM) + RMS_EPS);
                float lg[8] = {0.f, 0.f, 0.f, 0.f, 0.f, 0.f, 0.f, 0.f};
#pragma unroll
                for (int j = 0; j < 8; ++j) {
                    const int col = 4 * F.lane + 256 * j; const f32x4 gg = *(const f32x4*)(g + col); const f32x4 y = v[j] * rs * gg;
                    *(unsigned*)((unsigned char*)XN + (size_t)m * DM + col) = pk4_fp8(y.x, y.y, y.z, y.w);
#pragma unroll
                    for (int e4 = 0; e4 < 4; ++e4) { const f32x4 r0 = *(const LAS f32x4*)(rwl + ((2 * (4 * j + e4)) * 64 + F.lane) * 16), r1 = *(const LAS f32x4*)(rwl + ((2 * (4 * j + e4) + 1) * 64 + F.lane) * 16); const float yy = y[e4];
                        lg[0] += yy * r0.x; lg[1] += yy * r0.y; lg[2] += yy * r0.z; lg[3] += yy * r0.w; lg[4] += yy * r1.x; lg[5] += yy * r1.y; lg[6] += yy * r1.z; lg[7] += yy * r1.w; }
                }
#pragma unroll
                for (int e = 0; e < 8; ++e) lg[e] = scan::wave_sum_dpp(lg[e]);
                if (F.lane == 0) {
                    int i0 = 0; float v0 = lg[0];
#pragma unroll
                    for (int e = 1; e < 8; ++e) if (lg[e] > v0) { v0 = lg[e]; i0 = e; }
                    int i1 = -1; float v1 = -3.0e38f;
#pragma unroll
                    for (int e = 0; e < 8; ++e) if (e != i0 && (i1 < 0 || lg[e] > v1)) { v1 = lg[e]; i1 = e; }
                    const float w1 = 1.0f / (1.0f + expf(v0 - v1)), w0 = 1.0f - w1;
                    t_e[lt * 2] = i0; t_e[lt * 2 + 1] = i1; t_w[lt * 2] = w0; t_w[lt * 2 + 1] = w1;
                }
            }
            __syncthreads();
            if (F.wave == 0) {
                const int lane = F.lane; const int ea = t_e[lane], eb = t_e[64 + lane];
                const unsigned long long below = (1ull << lane) - 1ull;
                int pa = 0, pb = 0, mycnt = 0, ra = 0, rb = 0, na_sel = 0;
#pragma unroll
                for (int e = 0; e < 8; ++e) {
                    const unsigned long long ma = __ballot(ea == e), mb = __ballot(eb == e);
                    const int na = __popcll(ma), nb = __popcll(mb);
                    if (lane == e) mycnt = na + nb;
                    if (ea == e) ra = __popcll(ma & below);
                    if (eb == e) { rb = __popcll(mb & below); na_sel = na; }
                }
                int basep = 0;
                if (lane < 8 && mycnt) basep = (int)__hip_atomic_fetch_add(ctl + CW_MOECNT + 64 * lane, (unsigned)mycnt, RLX_AGENT);
#pragma unroll
                for (int e = 0; e < 8; ++e) { const int be = __builtin_amdgcn_readlane(basep, e); if (ea == e) pa = be + ra; if (eb == e) pb = be + na_sel + rb; }
                t_p[lane] = pa; t_p[64 + lane] = pb;
            }
            __syncthreads();
            if (F.tid < 128) { const int lt = F.tid >> 1, k = F.tid & 1, m = base + lt; const int e = t_e[F.tid], pos = t_p[F.tid];
                ROWTOK[e * M + pos] = m; TOKSLOT[m * 4 + k * 2] = e; TOKSLOT[m * 4 + k * 2 + 1] = pos; ((float*)TOKSLOT)[(size_t)M * 4 + m * 2 + k] = t_w[F.tid]; }
            __syncthreads();
        }
    }
    SEAM(15);
#define MOE_TABLE() do { if (F.tid == 0) { int ts_ = 0; for (int e = 0; e < 8; ++e) { const int ce = (int)__hip_atomic_load(ctl + CW_MOECNT + 64 * e, RLX_AGENT); moetab[16 + e] = ce; moetab[e] = ts_; ts_ += (ce + 255) >> 8; } moetab[8] = ts_; } __syncthreads(); } while (0)
    LAS int* moetab = (LAS int*)(F.lds + MISC_OFF + 256);
    PH(16) {
        MOE_TABLE();
        OrderMoe SM; SM.tab = moetab;
        SM.A = (const char*)XN; SM.Bt = (const char*)MOE13; SM.rowtok = ROWTOK; SM.lda = DM; SM.ldb = DM; SM.bstride = (size_t)2 * DFFE * DM; SM.nN = 2 * DFFE / 256;
        SM.nwg = moetab[8] * SM.nN; SM.G = F.G; SM.c = (int)blockIdx.x; SM.gather = true;
        EpiSwiglu8 E{(unsigned char*)ACT, DFFE};
        pg8::gemm_phase<EpiSwiglu8, OrderMoe, true, true>(ring, DM, 128, DM, DM / 128, SM, E, 0x7f7f7f7f, 0x79797979);
    }
    SEAM(16);
    PH(17) {
        MOE_TABLE();
        OrderMoe SM; SM.tab = moetab;
        SM.A = (const char*)ACT; SM.Bt = (const char*)MOE2; SM.rowtok = ROWTOK; SM.lda = DFFE; SM.ldb = DFFE; SM.bstride = (size_t)DM * DFFE; SM.nN = 8;
        SM.nwg = moetab[8] * SM.nN; SM.G = F.G; SM.c = (int)blockIdx.x; SM.gather = false;
        EpiBf16Out E{(bf16_t*)Y2};
        pg8::gemm_phase<EpiBf16Out, OrderMoe, false, true>(ring, DFFE, 128, DFFE, DFFE / 128, SM, E, 0x7f7f7f7f, 0x78787878);
    }
    SEAM(17);
    PH(18) {
        MOE_TABLE();
        const float* g = args.in[I_FINAL_NORM];
        for (int m = F.gw; m < M; m += F.NGW) {
            const int e0 = TOKSLOT[m * 4], p0 = TOKSLOT[m * 4 + 1], e1 = TOKSLOT[m * 4 + 2], p1 = TOKSLOT[m * 4 + 3];
            const float w0 = ((const float*)TOKSLOT)[(size_t)M * 4 + m * 2], w1 = ((const float*)TOKSLOT)[(size_t)M * 4 + m * 2 + 1];
            const int ts0 = moetab[e0], ts1 = moetab[e1];
            const bf16_t* y0 = (const bf16_t*)Y2 + ((size_t)ts0 * 256 + p0) * DM; const bf16_t* y1 = (const bf16_t*)Y2 + ((size_t)ts1 * 256 + p1) * DM; const bf16_t* hr = H + (size_t)m * DM;
            f32x4 v[8]; float s = 0.f;
#pragma unroll
            for (int j = 0; j < 8; ++j) { const int col = 4 * F.lane + 256 * j; const u32x2 q0 = *(const u32x2*)(y0 + col), q1 = *(const u32x2*)(y1 + col);
                const f32x4 f0 = (f32x4){bflo(q0.x), bfhi(q0.x), bflo(q0.y), bfhi(q0.y)}, f1 = (f32x4){bflo(q1.x), bfhi(q1.x), bflo(q1.y), bfhi(q1.y)};
                v[j] = ld4bf(hr + col) + (w0 * f0 + w1 * f1);
                s += (v[j].x * v[j].x + v[j].y * v[j].y) + (v[j].z * v[j].z + v[j].w * v[j].w); }
            const float rstd = 1.0f / sqrtf(wave_sum(s) * (1.0f / DM) + RMS_EPS);
#pragma unroll
            for (int j = 0; j < 8; ++j) { const int col = 4 * F.lane + 256 * j; *(f32x4*)(args.out + (size_t)m * DM + col) = v[j] * rstd * *(const f32x4*)(g + col); }
        }
    }
    if (PROBE_MASK != 0u && blockIdx.x == 0 && F.tid == 0) { if (PROBE_ON(18)) probe_acc += __builtin_amdgcn_s_memrealtime() - probe_t0; const unsigned long long t1 = __builtin_amdgcn_s_memrealtime(); while (__builtin_amdgcn_s_memrealtime() - t1 < 4ull * probe_acc) __builtin_amdgcn_s_sleep(8); }
#undef IN
#undef SEAM
}

extern "C" void kernel_launch(void* const* d_in, const int* in_sizes, int n_in, void* d_out, int out_size, void* d_ws, size_t ws_size, hipStream_t stream) {
    static int grid = 0;
    if (grid == 0) {
        if (n_in != 33 || out_size != M * DM || ws_size < WS_END) { fprintf(stderr, "kernel_launch: unexpected shapes (n_in %d, out %d, ws %zu < %zu)\n", n_in, out_size, ws_size, (size_t)WS_END); grid = -1; return; }
        int dev = 0, cus = 0, per_cu = 0;
        if (hipGetDevice(&dev) != hipSuccess || hipDeviceGetAttribute(&cus, hipDeviceAttributeMultiprocessorCount, dev) != hipSuccess) { grid = -1; return; }
        if (hipFuncSetAttribute((const void*)mk_fwd, hipFuncAttributeMaxDynamicSharedMemorySize, LDS_BYTES) != hipSuccess) { fprintf(stderr, "kernel_launch: hipFuncSetAttribute failed\n"); grid = -1; return; }
        if (hipOccupancyMaxActiveBlocksPerMultiprocessor(&per_cu, (const void*)mk_fwd, NTHR, LDS_BYTES) != hipSuccess || per_cu < 1) fprintf(stderr, "kernel_launch: occupancy query reports %d\n", per_cu);
        (void)hipGetLastError();
        grid = cus < 256 ? cus : 256;
    }
    if (grid < 0) return;
    if (hipMemsetAsync((char*)d_ws + WS_CTL, 0, CTL_ZERO_BYTES, stream) != hipSuccess) return;
    Args a{};
    for (int i = 0; i < 33; ++i) a.in[i] = (const float*)d_in[i];
    a.out = (float*)d_out; a.ws = (unsigned char*)d_ws; a.pad = 0;
    if (MK_N_LAUNCHES == 1) {
        a.ph_lo = 0; a.ph_hi = NPHASE; a.use_bar = 1;
        hipLaunchKernelGGL(mk_fwd, dim3(grid), dim3(NTHR), LDS_BYTES, stream, a);
    } else {
        for (int p = 0; p < NPHASE; ++p) { a.ph_lo = p; a.ph_hi = p + 1; a.use_bar = 0; hipLaunchKernelGGL(mk_fwd, dim3(grid), dim3(NTHR), LDS_BYTES, stream, a); }
    }
}
```

```cpp
#include <hip/hip_runtime.h>
#include <cstdio>
#include <cstdint>

#define GAS __attribute__((address_space(1)))
#define LAS __attribute__((address_space(3)))
typedef unsigned short bf16_t;
typedef short bf16x8 __attribute__((ext_vector_type(8)));
typedef short s16x4 __attribute__((ext_vector_type(4)));
typedef float f32x4 __attribute__((ext_vector_type(4)));
typedef float f32x2 __attribute__((ext_vector_type(2)));
typedef float f32x16 __attribute__((ext_vector_type(16)));
typedef unsigned u32x4 __attribute__((ext_vector_type(4)));
typedef unsigned u32x2 __attribute__((ext_vector_type(2)));
typedef __bf16 bf16x2_t __attribute__((ext_vector_type(2)));
typedef int i32x8 __attribute__((ext_vector_type(8)));
typedef int i32x4 __attribute__((ext_vector_type(4)));
#define DI __device__ __forceinline__

#ifndef MK_N_LAUNCHES
#define MK_N_LAUNCHES 1
#endif

constexpr int BATCH = 4, SEQ = 4096, DM = 2048, M = BATCH * SEQ;
constexpr int NP = 3328;
constexpr int IN_COLS = 3120;
constexpr int C_QA = 0, C_KA = 1024, C_VA = 1152, C_QB = 1280, C_KCMP = 2304, C_VCMP = 2432, C_KSEL = 2560, C_VSEL = 2688, C_KWIN = 2816, C_VWIN = 2944, C_GATE = 3072;
constexpr int DFF = 5632, DFFE = 7168, NEXP = 8;
constexpr float RMS_EPS = 1e-5f, GN_EPS = 64e-5f;
constexpr float LOG2E = 1.4426950408889634f;
constexpr float QSCALE = 0.125f * LOG2E;
constexpr int NWAVES = 8, NTHR = 512;
constexpr int MOE_ROWS = 2 * M + NEXP * 256;

constexpr size_t MiB = 1u << 20;
constexpr size_t al(size_t x) { return (x + 0xFFFFF) & ~(size_t)0xFFFFF; }
constexpr size_t WS_CTL = 0, CTL_ZERO_BYTES = 1 * MiB;
constexpr size_t WS_W_IN = 1 * MiB;
constexpr size_t WS_W_OUT = WS_W_IN + al((size_t)NP * DM * 2);
constexpr size_t WS_CMPW1 = WS_W_OUT + al((size_t)DM * DM * 2);
constexpr size_t WS_FFN13 = WS_CMPW1 + al((size_t)2 * 256 * 2048 * 2);
constexpr size_t WS_FFN2 = WS_FFN13 + al((size_t)2 * DFF * DM * 2);
constexpr size_t WS_WRKV = WS_FFN2 + al((size_t)DM * DFF * 2);
constexpr size_t WS_LORA1 = WS_WRKV + al((size_t)3 * DM * DM * 2);
constexpr size_t WS_LORA2 = WS_LORA1 + al((size_t)3 * 256 * DM * 2);
constexpr size_t WS_WO = WS_LORA2 + al((size_t)3 * DM * 256 * 2);
constexpr size_t WS_MOE13 = WS_WO + al((size_t)DM * DM * 2);
constexpr size_t WS_MOE2 = WS_MOE13 + al((size_t)NEXP * 2 * DFFE * DM * 2);
constexpr size_t WS_XN = WS_MOE2 + al((size_t)NEXP * DM * DFFE * 2);
constexpr size_t WS_P = WS_XN + al((size_t)M * DM * 2);
constexpr size_t WS_ROPE = WS_P + al((size_t)(M + 64) * NP * 2);
constexpr size_t WS_CMPB = WS_ROPE + al((size_t)M * 64 * 4);
constexpr size_t WS_HID = WS_CMPB + MiB;
constexpr size_t WS_KVC = WS_HID + al((size_t)2 * 2048 * 256 * 2);
constexpr size_t WS_O = WS_KVC + al((size_t)2 * 2048 * 64 * 2);
constexpr size_t WS_H = WS_O + al((size_t)M * DM * 2);
constexpr size_t WS_ACT = WS_H + al((size_t)M * DM * 4);
constexpr size_t WS_XS = WS_ACT + al((size_t)MOE_ROWS * DFFE * 2);
constexpr size_t WS_RKV = WS_XS + al((size_t)6 * M * DM * 2);
constexpr size_t WS_L1 = WS_RKV + al((size_t)3 * M * DM * 2);
constexpr size_t WS_DEC = WS_L1 + al((size_t)3 * M * 256 * 2);
constexpr size_t WS_AA = WS_DEC + al((size_t)M * DM * 4);
constexpr size_t WS_GG = WS_AA + al((size_t)M * DM * 4);
constexpr size_t WS_YRAW = WS_GG + al((size_t)M * DM * 2);
constexpr size_t WS_YG = WS_YRAW + al((size_t)M * DM * 4);
constexpr size_t WS_ROWTOK = WS_YG + al((size_t)M * DM * 2);
constexpr size_t WS_TOKSLOT = WS_ROWTOK + al((size_t)NEXP * M * 4);
constexpr size_t WS_Y2 = WS_TOKSLOT + al((size_t)M * 16);
constexpr size_t WS_END = WS_Y2 + al((size_t)MOE_ROWS * DM * 4);
constexpr int CW_BAR = 0;
constexpr int CW_MOECNT = 4096;

constexpr int RING_BYTES = 131072, LDSCTL_OFF = 135168, MISC_OFF = LDSCTL_OFF + 320, LDS_BYTES = 147456;

#define RLX_AGENT __ATOMIC_RELAXED, __HIP_MEMORY_SCOPE_AGENT
DI unsigned f2bf(float f) { unsigned u = __builtin_bit_cast(unsigned, f); return (u + 0x7fffu + ((u >> 16) & 1u)) >> 16; }
DI unsigned pk2(float lo, float hi) { f32x2 v = {lo, hi}; bf16x2_t b = __builtin_convertvector(v, bf16x2_t); return __builtin_bit_cast(unsigned, b); }
DI unsigned pk4_fp8(float a, float b, float c, float d) { int p = __builtin_amdgcn_cvt_pk_fp8_f32(a, b, 0, false); p = __builtin_amdgcn_cvt_pk_fp8_f32(c, d, p, true); return (unsigned)p; }
DI float bf2f(unsigned short b) { return __builtin_bit_cast(float, ((unsigned)b) << 16); }
DI float bflo(unsigned w) { return __builtin_bit_cast(float, w << 16); }
DI float bfhi(unsigned w) { return __builtin_bit_cast(float, w & 0xffff0000u); }
DI float wave_sum(float v) {
#pragma unroll
    for (int o = 1; o < 64; o <<= 1) v += __shfl_xor(v, o);
    return v;
}
DI int opq(int x) { asm volatile("" : "+v"(x)); return x; }
DI const float* opqp(const float* p) { asm volatile("" : "+s"(p)); return p; }
DI float ex2(float x) { return __builtin_amdgcn_exp2f(x); }
DI float sigmoidf_(float x) { return __builtin_amdgcn_rcpf(1.0f + __expf(-x)); }
DI float siluf_(float x) { return x * __builtin_amdgcn_rcpf(1.0f + __expf(-x)); }
DI float tanhf_(float x) { return 1.0f - 2.0f * __builtin_amdgcn_rcpf(__expf(2.0f * x) + 1.0f); }

#define XB_TMO      128
#define XB_XCNT(j)  (256  + 64 * (j))
#define XB_XSUB(j)  (1280 + 64 * (j))
#define XB_XGEN(j)  (2304 + 64 * (j))
#define XB_TOP      3328
#define XB_TOPGEN   3392
#define XCD_BAR_WORDS 3456
#define XB_SPIN_CAP (1u << 22)
DI unsigned xb_ld(unsigned* p)              { return __hip_atomic_load(p, __ATOMIC_RELAXED, __HIP_MEMORY_SCOPE_AGENT); }
DI unsigned xb_add(unsigned* p, unsigned v) { return __hip_atomic_fetch_add(p, v, __ATOMIC_RELAXED, __HIP_MEMORY_SCOPE_AGENT); }
DI unsigned xb_xcc_id() { return (unsigned)__builtin_amdgcn_s_getreg((3 << 11) | 20) & 0xFu; }
#define XB_SPIN(cond, bar) do { unsigned _sp = 0; while (cond) { __builtin_amdgcn_s_sleep(1); \
    if ((++_sp & 255u) == 0u) { if (xb_ld(&(bar)[XB_TMO])) break; if (_sp > XB_SPIN_CAP) { atomicAdd(&(bar)[XB_TMO], 1u); break; } } } } while (0)
struct XcdBarrier { unsigned* bar; unsigned x; volatile LAS unsigned* st; };
DI XcdBarrier xcd_barrier_post(unsigned* bar, volatile LAS unsigned* st) {
    XcdBarrier b; b.bar = bar; b.x = xb_xcc_id(); b.st = st;
    if (threadIdx.x == 0) (void)xb_add(&bar[XB_XCNT(b.x)], 1u);
    return b;
}
DI void xcd_barrier_complete(unsigned* bar, unsigned x, unsigned& nloc, unsigned& nx) {
    const unsigned G = gridDim.x * gridDim.y * gridDim.z;
    unsigned sum, cnt, mine, sp = 0u;
    for (;;) {
        sum = 0u; cnt = 0u; mine = 0u;
#pragma unroll
        for (unsigned j = 0; j < 16; ++j) { const unsigned c = xb_ld(&bar[XB_XCNT(j)]); sum += c; cnt += (c > 0u) ? 1u : 0u; mine = (j == x) ? c : mine; }
        if (sum == G) break;
        __builtin_amdgcn_s_sleep(1);
        if ((++sp & 255u) == 0u) { if (xb_ld(&bar[XB_TMO])) break; if (sp > XB_SPIN_CAP) { atomicAdd(&bar[XB_TMO], 1u); break; } }
    }
    nloc = mine > 0u ? mine : 1u; nx = cnt > 0u ? cnt : 1u;
}
DI void xcd_barrier(const XcdBarrier& b) {
    asm volatile("s_waitcnt vmcnt(0)" ::: "memory");
    __syncthreads();
    if (threadIdx.x == 0) {
        unsigned* bar = b.bar;
        __builtin_amdgcn_s_waitcnt(0);
        unsigned nloc = b.st[0], nx = b.st[1];
        if (nloc == 0u) { xcd_barrier_complete(bar, b.x, nloc, nx); b.st[0] = nloc; b.st[1] = nx; }
        const unsigned old = xb_add(&bar[XB_XSUB(b.x)], 1u);
        const unsigned gen = old / nloc;
        if (old + 1u == (gen + 1u) * nloc) {
            __builtin_amdgcn_fence(__ATOMIC_RELEASE, "agent");
            asm volatile("s_waitcnt vmcnt(0)" ::: "memory");
            const unsigned og = xb_add(&bar[XB_TOP], 1u);
            const unsigned tg = og / nx;
            if (og + 1u == (tg + 1u) * nx) xb_add(&bar[XB_TOPGEN], 1u);
            else XB_SPIN(xb_ld(&bar[XB_TOPGEN]) == tg, bar);
            __builtin_amdgcn_fence(__ATOMIC_ACQUIRE, "agent");
            xb_add(&bar[XB_XGEN(b.x)], 1u);
            asm volatile("s_waitcnt vmcnt(0)" ::: "memory");
        } else {
            XB_SPIN(xb_ld(&bar[XB_XGEN(b.x)]) == gen, bar);
            __builtin_amdgcn_fence(__ATOMIC_ACQUIRE, "agent");
            asm volatile("s_waitcnt vmcnt(0)" ::: "memory");
        }
    }
    __syncthreads();
}

namespace pg8 {
constexpr int BM = 256, BK = 64, HALF = 128, HTB = HALF * BK * 2, STAGE_BYTES = 8 * HTB, NXCD = 8, WGM = 4;
__host__ __device__ __forceinline__ int lds_byte(int r, int c) { const int st = (r >> 4) * 2 + (c >> 5), rr = r & 15, cc = c & 31, ob = rr * 64 + cc * 2; return st * 1024 + (ob ^ (((ob >> 9) & 1) << 5)); }
__host__ __device__ __forceinline__ void stage_rc(int b, int& R, int& C) { const int st = b / 1024, sb = b % 1024, swz = sb ^ (((sb >> 9) & 1) << 5); R = (st >> 1) * 16 + swz / 64; C = (st & 1) * 32 + (swz % 64) / 2; }
__host__ __device__ __forceinline__ int perm32(int rho) { const int n = rho >> 4, i = rho & 15; return 8 * (i >> 2) + 4 * n + (i & 3); }

struct Unit { const char* a; const char* b; int pm, pn, g; unsigned ka; };

DI int xcd_remap(int L, int nwg) { const int q = nwg / NXCD, r = nwg % NXCD, xcd = L % NXCD, off = L / NXCD; return (xcd < r ? xcd * (q + 1) : r * (q + 1) + (xcd - r) * q) + off; }
DI void tile_map(int idx, int nM, int nN, int& pm, int& pn) { const int nig = WGM * nN, gid = idx / nig, fm = gid * WGM, gsz = (nM - fm) < WGM ? (nM - fm) : WGM; pm = fm + ((idx % nig) % gsz); pn = (idx % nig) / gsz; }

template <class Epi, class Sched, bool GATHER, bool FP8 = false>
DI void gemm_phase(LAS unsigned char* lds, const unsigned lda, const unsigned ka, const unsigned ldb, const int nt, const Sched& S, const Epi& E, const int scaleA = 0x7f7f7f7f, const int scaleB = 0x7f7f7f7f) {
    const int tid = threadIdx.x, wid = __builtin_amdgcn_readfirstlane(tid >> 6), lane = tid & 63, wr = wid >> 2, wc = wid & 3, fr = lane & 15, fq = lane >> 4;
    int Rr[2], Cc[2];
    unsigned vB[2], vA[2][2], vN[2][2];
#pragma unroll
    for (int i = 0; i < 2; ++i) { stage_rc(tid * 16 + i * 8192, Rr[i], Cc[i]); const int Rb = (Rr[i] & ~31) + perm32(Rr[i] & 31); vB[i] = (unsigned)Rb * ldb + (unsigned)Cc[i] * 2u; }
    const size_t kb = (size_t)(BK * 2);
    const size_t hB = (size_t)HALF * ldb;
    const unsigned ldsw = (unsigned)wid * 1024u;
    const int aoff = lds_byte(wr * 64 + fr, fq * 8), boff = lds_byte(wc * 32 + fr, fq * 8);
#define PG8_SA(b, h) (((b) * 2 + (h)) * HTB)
#define PG8_SB(b, h) ((4 + (b) * 2 + (h)) * HTB)
#define PG8_STAGE(bufoff, gbase, v0, v1) do { \
        __builtin_amdgcn_global_load_lds((const unsigned*)((const char*)(gbase) + (v0)), (LAS unsigned*)(lds + (bufoff) + ldsw), 16, 0, 0); \
        __builtin_amdgcn_global_load_lds((const unsigned*)((const char*)(gbase) + (v1)), (LAS unsigned*)(lds + (bufoff) + ldsw + 8192), 16, 0, 0); } while (0)
#define PG8_LDA(dst, b, h) do { _Pragma("unroll") for (int m = 0; m < 4; ++m) { const i32x4 f0_ = *(const LAS i32x4*)(lds + PG8_SA(b, h) + aoff + m * 2048), f1_ = *(const LAS i32x4*)(lds + PG8_SA(b, h) + aoff + m * 2048 + 1024); \
        dst[m] = __builtin_shufflevector(f0_, f1_, 0, 1, 2, 3, 4, 5, 6, 7); } } while (0)
#define PG8_LDB(dst, b, h) do { _Pragma("unroll") for (int n = 0; n < 2; ++n) { const i32x4 f0_ = *(const LAS i32x4*)(lds + PG8_SB(b, h) + boff + n * 2048), f1_ = *(const LAS i32x4*)(lds + PG8_SB(b, h) + boff + n * 2048 + 1024); \
        dst[n] = __builtin_shufflevector(f0_, f1_, 0, 1, 2, 3, 4, 5, 6, 7); } } while (0)
#define PG8_MMA(ai, bj, At, Bt) do { __builtin_amdgcn_s_setprio(1); \
        if constexpr (FP8) { _Pragma("unroll") for (int m = 0; m < 4; ++m) _Pragma("unroll") for (int n = 0; n < 2; ++n) \
            asm volatile("v_mfma_scale_f32_16x16x128_f8f6f4 %0, %1, %2, %0, %3, %4 op_sel_hi:[0,0,0]" : "+v"(acc[ai][bj][m][n]) : "v"(Bt[n]), "v"(At[m]), "v"(scaleB), "v"(scaleA)); } \
        else { _Pragma("unroll") for (int m = 0; m < 4; ++m) _Pragma("unroll") for (int n = 0; n < 2; ++n) { \
            acc[ai][bj][m][n] = __builtin_amdgcn_mfma_f32_16x16x32_bf16(__builtin_bit_cast(bf16x8, __builtin_shufflevector(Bt[n], Bt[n], 0, 1, 2, 3)), __builtin_bit_cast(bf16x8, __builtin_shufflevector(At[m], At[m], 0, 1, 2, 3)), acc[ai][bj][m][n], 0, 0, 0); \
            acc[ai][bj][m][n] = __builtin_amdgcn_mfma_f32_16x16x32_bf16(__builtin_bit_cast(bf16x8, __builtin_shufflevector(Bt[n], Bt[n], 4, 5, 6, 7)), __builtin_bit_cast(bf16x8, __builtin_shufflevector(At[m], At[m], 4, 5, 6, 7)), acc[ai][bj][m][n], 0, 0, 0); } } __builtin_amdgcn_s_setprio(0); } while (0)
#define PG8_WAIT_V(n) asm volatile("s_waitcnt vmcnt(" #n ")" ::: "memory")
#define PG8_WAIT_L(n) asm volatile("s_waitcnt lgkmcnt(" #n ")" ::: "memory")
#define PG8_BAR __builtin_amdgcn_s_barrier()
#define PG8_SCHED __builtin_amdgcn_sched_barrier(0)
    Unit cur, nxt; int ui = 0;
    if (!S.next(0, cur)) return;
#pragma unroll
    for (int h = 0; h < 2; ++h)
#pragma unroll
        for (int i = 0; i < 2; ++i) {
            if constexpr (GATHER) vA[h][i] = S.rowoff(cur, h * HALF + Rr[i]) + (unsigned)Cc[i] * 2u;
            else vA[h][i] = (unsigned)(h * HALF + Rr[i]) * lda + (unsigned)Cc[i] * 2u;
            vN[h][i] = vA[h][i];
        }
    f32x4 acc[2][2][4][2];
#pragma unroll
    for (int a = 0; a < 2; ++a)
#pragma unroll
        for (int b = 0; b < 2; ++b)
#pragma unroll
            for (int m = 0; m < 4; ++m)
#pragma unroll
                for (int n = 0; n < 2; ++n) acc[a][b][m][n] = (f32x4){0.f, 0.f, 0.f, 0.f};
    i32x8 At[4], B0[2], B1[2];
    const char* cA = cur.a; const char* cB = cur.b;
    PG8_STAGE(PG8_SB(0, 0), cB, vB[0], vB[1]); PG8_STAGE(PG8_SB(0, 1), cB + hB, vB[0], vB[1]); PG8_STAGE(PG8_SA(0, 0), cA, vA[0][0], vA[0][1]); PG8_STAGE(PG8_SA(0, 1), cA, vA[1][0], vA[1][1]);
    if (wr == 1) PG8_BAR;
    PG8_WAIT_V(2); PG8_BAR;
    PG8_STAGE(PG8_SB(1, 0), cB + kb, vB[0], vB[1]); PG8_STAGE(PG8_SA(1, 0), cA + cur.ka, vA[0][0], vA[0][1]); PG8_STAGE(PG8_SB(1, 1), cB + hB + kb, vB[0], vB[1]);
    PG8_WAIT_V(6); PG8_BAR;
    for (;;) {
        const bool has_next = S.next(ui + 1, nxt);
        const char* nA = has_next ? nxt.a : cA; const char* nB = has_next ? nxt.b : cB; const unsigned nka = has_next ? nxt.ka : cur.ka;
        if constexpr (GATHER) {
            if (has_next) {
#pragma unroll
                for (int h = 0; h < 2; ++h)
#pragma unroll
                    for (int i = 0; i < 2; ++i) vN[h][i] = S.rowoff(nxt, h * HALF + Rr[i]) + (unsigned)Cc[i] * 2u;
            }
        }
        for (int t = 0; t < nt; t += 2) {
            const bool last = (t == nt - 2);
            const char* a1 = cA + (size_t)(t + 1) * cur.ka;
            const char* a2 = last ? nA : cA + (size_t)(t + 2) * cur.ka; const char* b2 = last ? nB : cB + (size_t)(t + 2) * kb;
            const char* a3 = a2 + (last ? nka : cur.ka); const char* b3 = b2 + kb;
            unsigned x00 = vA[0][0], x01 = vA[0][1], x10 = vA[1][0], x11 = vA[1][1];
            if constexpr (GATHER) { if (last) { x00 = vN[0][0]; x01 = vN[0][1]; x10 = vN[1][0]; x11 = vN[1][1]; } }
            PG8_LDB(B0, 0, 0); PG8_LDB(B1, 0, 1); PG8_SCHED; PG8_LDA(At, 0, 0); PG8_STAGE(PG8_SA(1, 1), a1, vA[1][0], vA[1][1]);
            PG8_WAIT_V(8); PG8_WAIT_L(0); PG8_BAR; PG8_MMA(0, 0, At, B0); PG8_MMA(0, 1, At, B1); PG8_BAR; PG8_SCHED;
            PG8_LDA(At, 0, 1); PG8_STAGE(PG8_SB(0, 0), b2, vB[0], vB[1]); PG8_STAGE(PG8_SB(0, 1), b2 + hB, vB[0], vB[1]); PG8_STAGE(PG8_SA(0, 0), a2, x00, x01);
            PG8_WAIT_V(8); PG8_WAIT_L(0); PG8_BAR; PG8_MMA(1, 0, At, B0); PG8_MMA(1, 1, At, B1); PG8_BAR; PG8_SCHED;
            PG8_LDB(B0, 1, 0); PG8_LDB(B1, 1, 1); PG8_SCHED; PG8_LDA(At, 1, 0); PG8_STAGE(PG8_SA(0, 1), a2, x10, x11);
            PG8_WAIT_V(8); PG8_WAIT_L(0); PG8_BAR; PG8_MMA(0, 0, At, B0); PG8_MMA(0, 1, At, B1); PG8_BAR; PG8_SCHED;
            PG8_LDA(At, 1, 1); PG8_STAGE(PG8_SB(1, 0), b3, vB[0], vB[1]); PG8_STAGE(PG8_SB(1, 1), b3 + hB, vB[0], vB[1]); PG8_STAGE(PG8_SA(1, 0), a3, x00, x01);
            PG8_WAIT_V(8); PG8_WAIT_L(0); PG8_BAR; PG8_MMA(1, 0, At, B0); PG8_MMA(1, 1, At, B1); PG8_BAR; PG8_SCHED;
        }
        if (wr == 0) PG8_BAR;
        if constexpr (FP8) asm volatile("s_nop 15\n\ts_nop 15" ::: "memory");
        E(acc, cur, wr, wc, fr, fq);
        if (!has_next) break;
#pragma unroll
        for (int a = 0; a < 2; ++a)
#pragma unroll
            for (int b = 0; b < 2; ++b)
#pragma unroll
                for (int m = 0; m < 4; ++m)
#pragma unroll
                    for (int n = 0; n < 2; ++n) acc[a][b][m][n] = (f32x4){0.f, 0.f, 0.f, 0.f};
        cur = nxt; cA = nA; cB = nB; ++ui;
        if constexpr (GATHER) {
#pragma unroll
            for (int h = 0; h < 2; ++h)
#pragma unroll
                for (int i = 0; i < 2; ++i) vA[h][i] = vN[h][i];
        }
        if (wr == 1) PG8_BAR;
    }
    PG8_WAIT_V(0);
    PG8_BAR;
#undef PG8_SA
#undef PG8_SB
#undef PG8_STAGE
#undef PG8_LDA
#undef PG8_LDB
#undef PG8_MMA
#undef PG8_WAIT_V
#undef PG8_WAIT_L
#undef PG8_BAR
#undef PG8_SCHED
}
}

typedef f32x4 AccT[2][2][4][2];
DI void st_bf16x8(bf16_t* p, f32x4 v0, f32x4 v1) { u32x4 w; w.x = pk2(v0[0], v0[1]); w.y = pk2(v0[2], v0[3]); w.z = pk2(v1[0], v1[1]); w.w = pk2(v1[2], v1[3]); *(u32x4*)p = w; }

struct OrderSingle {
    const char* A; const char* Bt; unsigned lda, ldb; int nM, nN, nwg, G, c;
    DI bool next(int i, pg8::Unit& u) const {
        const long L = (long)i * G + c; if (L >= nwg) return false;
        const int w = pg8::xcd_remap((int)L, nwg); int pm, pn; pg8::tile_map(w, nM, nN, pm, pn);
        u.pm = pm; u.pn = pn; u.g = 0; u.ka = 128u; u.a = A + (size_t)pm * 256 * lda; u.b = Bt + (size_t)pn * 256 * ldb; return true;
    }
    DI unsigned rowoff(const pg8::Unit&, int) const { return 0u; }
};
struct OrderMulti {
    const char* A[6]; const char* Bt[6]; int nN[6]; int start[7]; unsigned lda, ldb; int ng, nwg, G, c;
    DI bool next(int i, pg8::Unit& u) const {
        const long L = (long)i * G + c; if (L >= nwg) return false;
        const int w = pg8::xcd_remap((int)L, nwg);
        int g = 0; const char* a = A[0]; const char* b = Bt[0]; int nn = nN[0], st = start[0];
#pragma unroll
        for (int k = 1; k < 6; ++k) if (k < ng && w >= start[k]) { g = k; a = A[k]; b = Bt[k]; nn = nN[k]; st = start[k]; }
        int pm, pn; pg8::tile_map(w - st, 64, nn, pm, pn);
        u.pm = pm; u.pn = pn; u.g = g; u.ka = 128u; u.a = a + (size_t)pm * 256 * lda; u.b = b + (size_t)pn * 256 * ldb; return true;
    }
    DI unsigned rowoff(const pg8::Unit&, int) const { return 0u; }
};
struct OrderCmp {
    const char* P; const char* Bt; const char* XNp; const char* Wg; int G, c;
    DI bool next(int i, pg8::Unit& u) const {
        const int L = i * G + c; if (L >= 80) return false;
        if (L < 16) { const int kv = L >> 3, bh = L & 7, b = bh >> 1, h = bh & 1;
            u.pm = bh; u.pn = 0; u.g = kv; u.ka = (unsigned)(NP * 2);
            u.a = P + ((size_t)b * SEQ * NP + (size_t)(C_KCMP + kv * 128 + h * 64)) * 2;
            u.b = Bt + (size_t)kv * 256 * 2048 * 2; }
        else { const int pm = L - 16; u.pm = pm; u.pn = 12; u.g = 2; u.ka = 128u; u.a = XNp + (size_t)pm * 256 * DM * 2; u.b = Wg; }
        return true;
    }
    DI unsigned rowoff(const pg8::Unit& u, int row) const { return (unsigned)row * (u.g == 2 ? (unsigned)(DM * 2) : (unsigned)(16 * NP * 2)); }
};
struct OrderMoe {
    const char* A; const char* Bt; const int* rowtok; const LAS int* tab; unsigned lda, ldb; size_t bstride; int nN, nwg, G, c; bool gather;
    DI bool next(int i, pg8::Unit& u) const {
        const long L = (long)i * G + c; if (L >= nwg) return false;
        const int w = (int)L;
        const int tau = w / nN, pn = w % nN;
        int e = 0;
#pragma unroll
        for (int k = 1; k < 8; ++k) if (tau >= tab[k]) e = k;
        u.pm = tau; u.pn = pn; u.g = e; u.ka = 128u;
        u.a = gather ? A : A + (size_t)tau * 256 * lda;
        u.b = Bt + (size_t)e * bstride + (size_t)pn * 256 * ldb; return true;
    }
    DI unsigned rowoff(const pg8::Unit& u, int row) const {
        const int e = u.g; const int ce = tab[16 + e], ts = tab[e];
        const int pos = (u.pm - ts) * 256 + row;
        const int tok = pos < ce ? rowtok[e * M + pos] : 0;
        return (unsigned)tok * lda;
    }
};

struct EpiInProj {
    bf16_t* P; const float* rope;
    DI void operator()(const AccT& acc, const pg8::Unit& u, int wr, int wc, int fr, int fq) const {
        const int row0 = u.pm * 256 + wr * 64 + fr;
#pragma unroll
        for (int bj = 0; bj < 2; ++bj) {
            const int cb = u.pn * 256 + bj * 128;
            const int col0 = cb + wc * 32 + 8 * fq;
            const bool do_rope = cb < C_VA;
            const float sc = (cb < C_KA || (cb >= C_QB && cb < C_KCMP)) ? QSCALE : 1.0f;
            const int uidx = 4 * (wc & 1) + fq;
#pragma unroll
            for (int ai = 0; ai < 2; ++ai)
#pragma unroll
                for (int m = 0; m < 4; ++m) {
                    const int row = row0 + ai * 128 + m * 16;
                    f32x4 v0 = acc[ai][bj][m][0], v1 = acc[ai][bj][m][1];
                    if (do_rope) {
                        const f32x4 cs = *(const f32x4*)(rope + (size_t)row * 64 + 4 * uidx), sn = *(const f32x4*)(rope + (size_t)row * 64 + 32 + 4 * uidx);
                        const f32x4 o0 = v0 * cs - v1 * sn, o1 = v1 * cs + v0 * sn; v0 = o0; v1 = o1;
                    }
                    v0 = v0 * sc; v1 = v1 * sc;
                    st_bf16x8(P + (size_t)row * NP + col0, v0, v1);
                }
        }
    }
};
struct EpiCmp1 {
    bf16_t* HID; const float* bias; bf16_t* P;
    DI void operator()(const AccT& acc, const pg8::Unit& u, int wr, int wc, int fr, int fq) const {
        const int row0 = wr * 64 + fr;
        if (u.g == 2) {
#pragma unroll
            for (int bj = 0; bj < 2; ++bj)
#pragma unroll
                for (int ai = 0; ai < 2; ++ai)
#pragma unroll
                    for (int m = 0; m < 4; ++m) st_bf16x8(P + (size_t)(u.pm * 256 + row0 + ai * 128 + m * 16) * NP + C_GATE + bj * 128 + wc * 32 + 8 * fq, acc[ai][bj][m][0], acc[ai][bj][m][1]);
            return;
        }
#pragma unroll
        for (int bj = 0; bj < 2; ++bj) {
            const int col0 = bj * 128 + wc * 32 + 8 * fq;
            const f32x4 b0 = *(const f32x4*)(bias + u.g * 256 + col0), b1 = *(const f32x4*)(bias + u.g * 256 + col0 + 4);
#pragma unroll
            for (int ai = 0; ai < 2; ++ai)
#pragma unroll
                for (int m = 0; m < 4; ++m) {
                    const int row = row0 + ai * 128 + m * 16;
                    f32x4 v0 = acc[ai][bj][m][0] + b0, v1 = acc[ai][bj][m][1] + b1;
#pragma unroll
                    for (int j = 0; j < 4; ++j) { v0[j] = siluf_(v0[j]); v1[j] = siluf_(v1[j]); }
                    st_bf16x8(HID + ((size_t)(u.g * 2048 + u.pm * 256 + row)) * 256 + col0, v0, v1);
                }
        }
    }
};
template <bool RESF32>
struct EpiResH {
    const void* res; bf16_t* out;
    DI void operator()(const AccT& acc, const pg8::Unit& u, int wr, int wc, int fr_, int fq_) const {
        const int fr = opq(fr_), fq = opq(fq_);
        const int row0 = u.pm * 256 + wr * 64 + fr;
#pragma unroll
        for (int ai = 0; ai < 2; ++ai) {
            f32x4 r[4][2][2];
#pragma unroll
            for (int m = 0; m < 4; ++m) { const size_t ro = (size_t)(row0 + ai * 128 + m * 16) * DM;
#pragma unroll
                for (int bj = 0; bj < 2; ++bj) { const int col0 = u.pn * 256 + bj * 128 + wc * 32 + 8 * fq;
                    if (RESF32) { r[m][bj][0] = *(const f32x4*)((const float*)res + ro + col0); r[m][bj][1] = *(const f32x4*)((const float*)res + ro + col0 + 4); }
                    else { const u32x4 q = *(const u32x4*)((const bf16_t*)res + ro + col0); r[m][bj][0] = (f32x4){bflo(q.x), bfhi(q.x), bflo(q.y), bfhi(q.y)}; r[m][bj][1] = (f32x4){bflo(q.z), bfhi(q.z), bflo(q.w), bfhi(q.w)}; } } }
            asm volatile("s_waitcnt vmcnt(0)" ::: "memory");
#pragma unroll
            for (int m = 0; m < 4; ++m) { const size_t ro = (size_t)(row0 + ai * 128 + m * 16) * DM;
#pragma unroll
                for (int bj = 0; bj < 2; ++bj) { const int col0 = u.pn * 256 + bj * 128 + wc * 32 + 8 * fq;
                    st_bf16x8(out + ro + col0, r[m][bj][0] + acc[ai][bj][m][0], r[m][bj][1] + acc[ai][bj][m][1]); } }
        }
    }
};
struct EpiSwiglu {
    bf16_t* ACT; int ldc;
    DI void operator()(const AccT& acc, const pg8::Unit& u, int wr, int wc, int fr, int fq) const {
        const int row0 = u.pm * 256 + wr * 64 + fr; const int col0 = u.pn * 128 + wc * 32 + 8 * fq;
#pragma unroll
        for (int ai = 0; ai < 2; ++ai)
#pragma unroll
            for (int m = 0; m < 4; ++m) {
                f32x4 v0, v1;
#pragma unroll
                for (int j = 0; j < 4; ++j) { v0[j] = siluf_(acc[ai][0][m][0][j]) * acc[ai][1][m][0][j]; v1[j] = siluf_(acc[ai][0][m][1][j]) * acc[ai][1][m][1][j]; }
                st_bf16x8(ACT + (size_t)(row0 + ai * 128 + m * 16) * ldc + col0, v0, v1);
            }
    }
};
struct EpiSwiglu8 {
    unsigned char* ACT; int ldc;
    DI void operator()(const AccT& acc, const pg8::Unit& u, int wr, int wc, int fr, int fq) const {
        const int row0 = u.pm * 256 + wr * 64 + fr; const int col0 = u.pn * 128 + wc * 32 + 8 * fq;
#pragma unroll
        for (int ai = 0; ai < 2; ++ai)
#pragma unroll
            for (int m = 0; m < 4; ++m) {
                f32x4 v0, v1;
#pragma unroll
                for (int j = 0; j < 4; ++j) { v0[j] = siluf_(acc[ai][0][m][0][j]) * acc[ai][1][m][0][j]; v1[j] = siluf_(acc[ai][0][m][1][j]) * acc[ai][1][m][1][j]; }
                u32x2 o; o.x = pk4_fp8(v0[0], v0[1], v0[2], v0[3]); o.y = pk4_fp8(v1[0], v1[1], v1[2], v1[3]);
                *(u32x2*)(ACT + (size_t)(row0 + ai * 128 + m * 16) * ldc + col0) = o;
            }
    }
};
struct EpiRkvLora1 {
    bf16_t* RKV; bf16_t* L1;
    DI void operator()(const AccT& acc, const pg8::Unit& u, int wr, int wc, int fr, int fq) const {
        const int row0 = u.pm * 256 + wr * 64 + fr; const int g = u.g;
        bf16_t* base = g < 3 ? RKV + (size_t)g * M * DM : L1 + (size_t)(g - 3) * M * 256;
        const int ldc = g < 3 ? DM : 256;
#pragma unroll
        for (int ai = 0; ai < 2; ++ai)
#pragma unroll
            for (int m = 0; m < 4; ++m)
#pragma unroll
                for (int bj = 0; bj < 2; ++bj) {
                    const int col0 = u.pn * 256 + bj * 128 + wc * 32 + 8 * fq;
                    f32x4 v0 = acc[ai][bj][m][0], v1 = acc[ai][bj][m][1];
                    if (g == 3) {
#pragma unroll
                        for (int j = 0; j < 4; ++j) { v0[j] = tanhf_(v0[j]); v1[j] = tanhf_(v1[j]); }
                    } else if (g == 5) {
#pragma unroll
                        for (int j = 0; j < 4; ++j) { v0[j] = sigmoidf_(v0[j]); v1[j] = sigmoidf_(v1[j]); }
                    }
                    st_bf16x8(base + (size_t)(row0 + ai * 128 + m * 16) * ldc + col0, v0, v1);
                }
    }
};
struct EpiLora2 {
    float* DEC; bf16_t* AA; bf16_t* GG; const float* w0; const float* a0;
    DI void operator()(const AccT& acc, const pg8::Unit& u, int wr, int wc, int fr_, int fq_) const {
        const int fr = opq(fr_), fq = opq(fq_);
        const int row0 = u.pm * 256 + wr * 64 + fr; const int g = u.g;
        const float* cvec = g == 0 ? w0 : a0;
#pragma unroll
        for (int bj = 0; bj < 2; ++bj) {
            const int col0 = u.pn * 256 + bj * 128 + wc * 32 + 8 * fq;
            f32x4 c0 = (f32x4){0.f, 0.f, 0.f, 0.f}, c1 = c0;
            if (g < 2) { c0 = *(const f32x4*)(cvec + col0); c1 = *(const f32x4*)(cvec + col0 + 4); }
#pragma unroll
            for (int ai = 0; ai < 2; ++ai)
#pragma unroll
                for (int m = 0; m < 4; ++m) {
                    const size_t ro = (size_t)(row0 + ai * 128 + m * 16) * DM + col0;
                    f32x4 v0 = acc[ai][bj][m][0] + c0, v1 = acc[ai][bj][m][1] + c1;
                    if (g < 2) {
#pragma unroll
                        for (int j = 0; j < 4; ++j) { v0[j] = sigmoidf_(v0[j]); v1[j] = sigmoidf_(v1[j]); }
                        if (g == 0) {
#pragma unroll
                            for (int j = 0; j < 4; ++j) { v0[j] = __expf(-0.60653065971f * v0[j]); v1[j] = __expf(-0.60653065971f * v1[j]); }
                            *(f32x4*)(DEC + ro) = v0; *(f32x4*)(DEC + ro + 4) = v1;
                        } else st_bf16x8(AA + ro, v0, v1);
                    } else st_bf16x8(GG + ro, v0, v1);
                    asm volatile("" ::: "memory");
                }
        }
    }
};
struct EpiBf16Out {
    bf16_t* out;
    DI void operator()(const AccT& acc, const pg8::Unit& u, int wr, int wc, int fr, int fq) const {
        const int row0 = u.pm * 256 + wr * 64 + fr;
#pragma unroll
        for (int ai = 0; ai < 2; ++ai)
#pragma unroll
            for (int m = 0; m < 4; ++m) {
                const size_t ro = (size_t)(row0 + ai * 128 + m * 16) * DM;
#pragma unroll
                for (int bj = 0; bj < 2; ++bj) { const int col0 = u.pn * 256 + bj * 128 + wc * 32 + 8 * fq; st_bf16x8(out + ro + col0, acc[ai][bj][m][0], acc[ai][bj][m][1]); }
            }
    }
};

struct Args { const float* in[33]; float* out; unsigned char* ws; int ph_lo, ph_hi, use_bar, pad; };
enum { I_X = 0, I_POS, I_ATTN_NORM, I_FFN_NORM, I_FINAL_NORM, I_W_IN, I_W_OUT, I_SINKS, I_CMP_PE, I_CMP_W1, I_CMP_B1, I_CMP_W2, I_FFN_W13, I_FFN_W2, I_MU, I_W_RKV, I_DECAY_W0, I_DECAY_W1,
       I_DECAY_W2, I_A0, I_A1, I_A2, I_G1, I_G2, I_K_K, I_K_A, I_R_K, I_LN_W, I_LN_B, I_W_O, I_ROUTER, I_MOE_W13, I_MOE_W2 };

struct Frame {
    LAS unsigned char* lds;
    int tid, lane, wave, G, gw, NGW;
    unsigned char* ws;
};

template <class F>
DI void transpose_item(const float* W, int Nsrc, int kvalid, bf16_t* WT, int Kd, const F& map, int k0, int n0, LAS float* scr, int lane) {
    const int s0 = map.src0(n0);
    const int rsub = lane >> 4, col = s0 + 4 * (lane & 15);
    f32x4 v[16];
#pragma unroll
    for (int i = 0; i < 16; ++i) { const int k = k0 + 4 * i + rsub; v[i] = (f32x4){0.f, 0.f, 0.f, 0.f}; if (k < kvalid && col < Nsrc) v[i] = *(const f32x4*)(W + (size_t)k * Nsrc + col); }
#pragma unroll
    for (int i = 0; i < 16; ++i) { LAS float* d = scr + (4 * i + rsub) * 65 + 4 * (lane & 15); d[0] = v[i].x; d[1] = v[i].y; d[2] = v[i].z; d[3] = v[i].w; }
    asm volatile("s_waitcnt lgkmcnt(0)" ::: "memory");
    const int c = lane & 7;
#pragma unroll
    for (int j = 0; j < 8; ++j) { const int nl = (lane >> 3) + 8 * j; const LAS float* s = scr + (8 * c) * 65 + map.perm(n0, nl);
        u32x4 o; o.x = pk2(s[0 * 65], s[1 * 65]); o.y = pk2(s[2 * 65], s[3 * 65]); o.z = pk2(s[4 * 65], s[5 * 65]); o.w = pk2(s[6 * 65], s[7 * 65]);
        *(u32x4*)(WT + (size_t)(n0 + nl) * Kd + k0 + 8 * c) = o; }
    asm volatile("s_waitcnt lgkmcnt(0)" ::: "memory");
}
template <class F>
DI void t8_load(f32x4 (&v)[16], const float* W, int Nsrc, int kvalid, const F& map, int k0, int n0, int lane) {
    const int s0 = map.src0(n0); const int rsub = lane >> 4, col = s0 + 4 * (lane & 15);
#pragma unroll
    for (int i = 0; i < 16; ++i) { const int k = k0 + 4 * i + rsub; v[i] = (f32x4){0.f, 0.f, 0.f, 0.f}; if (k < kvalid && col < Nsrc) v[i] = __builtin_nontemporal_load((const f32x4*)(W + (size_t)k * Nsrc + col)); }
}
template <class F>
DI void t8_store(const f32x4 (&v)[16], unsigned char* WT, int Kd, const F& map, int k0, int n0, LAS float* scr, int lane, float mul) {
    const int rsub = lane >> 4;
#pragma unroll
    for (int i = 0; i < 16; ++i) { LAS float* d = scr + (4 * i + rsub) * 65 + 4 * (lane & 15); d[0] = v[i].x; d[1] = v[i].y; d[2] = v[i].z; d[3] = v[i].w; }
    asm volatile("s_waitcnt lgkmcnt(0)" ::: "memory");
    const int c = lane & 7;
#pragma unroll
    for (int j = 0; j < 8; ++j) { const int nl = (lane >> 3) + 8 * j; const LAS float* s = scr + (8 * c) * 65 + map.perm(n0, nl);
        u32x2 o; o.x = pk4_fp8(s[0 * 65] * mul, s[1 * 65] * mul, s[2 * 65] * mul, s[3 * 65] * mul); o.y = pk4_fp8(s[4 * 65] * mul, s[5 * 65] * mul, s[6 * 65] * mul, s[7 * 65] * mul);
        *(u32x2*)(WT + (size_t)(n0 + nl) * Kd + k0 + 8 * c) = o; }
    asm volatile("s_waitcnt lgkmcnt(0)" ::: "memory");
}
template <class F>
DI void transpose_matrix8(const Frame& F_, const float* W, int Nsrc, int kvalid, unsigned char* WT, int Kd, int Nd, const F& map, LAS float* scr, float mul) {
    const int nkb = Kd / 64, nnb = Nd / 64, nitems = nkb * nnb;
    for (int it = F_.gw; it < nitems; it += 2 * F_.NGW) {
        const int it2 = it + F_.NGW; const bool two = it2 < nitems;
        const int k0a = 64 * (it / nnb), n0a = 64 * (it % nnb), k0b = two ? 64 * (it2 / nnb) : k0a, n0b = two ? 64 * (it2 % nnb) : n0a;
        f32x4 va[16], vb[16];
        t8_load(va, W, Nsrc, kvalid, map, k0a, n0a, F_.lane);
        if (two) t8_load(vb, W, Nsrc, kvalid, map, k0b, n0b, F_.lane);
        t8_store(va, WT, Kd, map, k0a, n0a, scr, F_.lane, mul);
        if (two) t8_store(vb, WT, Kd, map, k0b, n0b, scr, F_.lane, mul);
    }
}
template <class F>
DI void transpose_matrix(const Frame& F_, const float* W, int Nsrc, int kvalid, bf16_t* WT, int Kd, int Nd, const F& map, LAS float* scr, int first, int stride) {
    const int nkb = Kd / 64, nnb = Nd / 64, nitems = nkb * nnb;
    for (int it = first; it < nitems; it += stride) { const int kbi = it / nnb, nb = it % nnb; transpose_item(W, Nsrc, kvalid, WT, Kd, map, 64 * kbi, 64 * nb, scr, F_.lane); }
}
struct ColIdent { DI int src0(int n0) const { return n0; } DI int perm(int, int nl) const { return nl; } };
struct ColInProj { DI int src0(int n0) const { return n0; }
    DI int perm(int n0, int l) const { return n0 < C_VA ? ((l & 7) < 4 ? 4 * (l >> 3) + (l & 3) : 32 + 4 * (l >> 3) + (l & 3)) : l; } };
struct ColSwiglu { int F; DI int src0(int n0) const { const int t = n0 >> 8, r = n0 & 255; return r < 128 ? t * 128 + r : F + t * 128 + (r - 128); } DI int perm(int, int nl) const { return nl; } };

DI f32x4 ld4bf(const bf16_t* p) { const u32x2 q = *(const u32x2*)p; return (f32x4){bflo(q.x), bfhi(q.x), bflo(q.y), bfhi(q.y)}; }
DI void rms_row_load(const float* xrow, int lane, f32x4 (&v)[8], float& rstd) {
    float s = 0.f;
#pragma unroll
    for (int j = 0; j < 8; ++j) { v[j] = *(const f32x4*)(xrow + 4 * lane + 256 * j); s += (v[j].x * v[j].x + v[j].y * v[j].y) + (v[j].z * v[j].z + v[j].w * v[j].w); }
    rstd = 1.0f / sqrtf(wave_sum(s) * (1.0f / DM) + RMS_EPS);
}
DI void rms_row_to_bf16(const float* xrow, const float* g, bf16_t* orow, int lane) {
    f32x4 v[8]; float rstd; rms_row_load(xrow, lane, v, rstd);
#pragma unroll
    for (int j = 0; j < 8; ++j) { const f32x4 gg = *(const f32x4*)(g + 4 * lane + 256 * j); const f32x4 y = v[j] * rstd * gg;
        u32x2 w; w.x = pk2(y.x, y.y); w.y = pk2(y.z, y.w); *(u32x2*)(orow + 4 * lane + 256 * j) = w; }
}

DI void rms_row_load_h(const bf16_t* xrow, int lane, f32x4 (&v)[8], float& rstd) {
    float s = 0.f;
#pragma unroll
    for (int j = 0; j < 8; ++j) { v[j] = ld4bf(xrow + 4 * lane + 256 * j); s += (v[j].x * v[j].x + v[j].y * v[j].y) + (v[j].z * v[j].z + v[j].w * v[j].w); }
    rstd = 1.0f / sqrtf(wave_sum(s) * (1.0f / DM) + RMS_EPS);
}
DI void rms_row_to_bf16_h(const bf16_t* xrow, const float* g, bf16_t* orow, int lane) {
    f32x4 v[8]; float rstd; rms_row_load_h(xrow, lane, v, rstd);
#pragma unroll
    for (int j = 0; j < 8; ++j) { const f32x4 gg = *(const f32x4*)(g + 4 * lane + 256 * j); const f32x4 y = v[j] * rstd * gg;
        u32x2 w; w.x = pk2(y.x, y.y); w.y = pk2(y.z, y.w); *(u32x2*)(orow + 4 * lane + 256 * j) = w; }
}
namespace att {
constexpr int KPADB = 144;
constexpr int VPADB = 144;
constexpr int BUFB = 64 * KPADB + 64 * VPADB;
constexpr int OFF_ALPHA = 2 * BUFB;
constexpr int OFF_IMP = OFF_ALPHA + 8 * 256;
constexpr int OFF_SEL = OFF_IMP + 16384;
constexpr int OFF_RANK = OFF_SEL + 512;
constexpr int OFF_Q = 65536;
constexpr float NEGBIG = -1e30f;
DI int crow(int r, int h) { return (r & 3) + 8 * (r >> 2) + 4 * h; }
#define MFMA32(a, b, c) __builtin_amdgcn_mfma_f32_32x32x16_bf16((a), (b), (c), 0, 0, 0)

struct KVRegs { u32x4 k, v; };
DI void kv_load(KVRegs& r, const bf16_t* Kg, const bf16_t* Vg, size_t pitch, int tid) {
    const int key = tid >> 3, dc = tid & 7;
    r.k = *(const u32x4*)(Kg + (size_t)key * pitch + dc * 8); r.v = *(const u32x4*)(Vg + (size_t)key * pitch + dc * 8);
}
DI void kv_store(const KVRegs& r, LAS unsigned char* buf, int tid) {
    const int key = tid >> 3, dc = tid & 7;
    *(LAS u32x4*)(buf + key * KPADB + dc * 16) = r.k;
    LAS unsigned short* vt = (LAS unsigned short*)(buf + 64 * KPADB);
    const unsigned w[4] = {r.v.x, r.v.y, r.v.z, r.v.w};
#pragma unroll
    for (int i = 0; i < 4; ++i) { vt[(dc * 8 + 2 * i) * (VPADB / 2) + key] = (unsigned short)(w[i] & 0xffffu); vt[(dc * 8 + 2 * i + 1) * (VPADB / 2) + key] = (unsigned short)(w[i] >> 16); }
}

struct State { f32x16 O[2][2]; float m[2], l[2]; };
DI void state_init(State& s) {
#pragma unroll
    for (int a = 0; a < 2; ++a) { s.m[a] = NEGBIG; s.l[a] = 0.f;
#pragma unroll
        for (int b = 0; b < 2; ++b)
#pragma unroll
            for (int r = 0; r < 16; ++r) s.O[a][b][r] = 0.f; }
}
DI void row_scale(f32x16 (&O)[2], float f, LAS float* area, int c_, int h_) {
    const int c = opq(c_), h = opq(h_);
    area[c] = f;
    asm volatile("s_waitcnt lgkmcnt(0)" ::: "memory");
#pragma unroll
    for (int g4 = 0; g4 < 4; ++g4) { const f32x4 a = *(LAS f32x4*)(area + 8 * g4 + 4 * h);
#pragma unroll
        for (int j = 0; j < 4; ++j) { O[0][4 * g4 + j] *= a[j]; O[1][4 * g4 + j] *= a[j]; } }
    asm volatile("s_waitcnt lgkmcnt(0)" ::: "memory");
}
template <int MODE, bool MASKED>
DI void softmax_block(State& st, f32x16& S, int qb, int kpos0, const int (&tq)[2], int W, bool bit, LAS float* area, int c, int h) {
    if constexpr (MASKED) {
        float mx = NEGBIG;
        const int dd = tq[qb] - kpos0;
#pragma unroll
        for (int r = 0; r < 16; ++r) { const int cr0 = (r & 3) + 8 * (r >> 2); bool valid;
            if (MODE == 0) valid = (cr0 <= dd) && (cr0 > dd - W);
            else if (MODE == 1) valid = (cr0 <= dd);
            else valid = (cr0 <= dd) && bit;
            S[r] = valid ? S[r] : NEGBIG; mx = fmaxf(mx, S[r]); }
        mx = fmaxf(mx, __shfl_xor(mx, 32));
        if (__any(mx > st.m[qb] + 8.0f)) {
            const float mnew = fmaxf(st.m[qb], mx); const float alpha = ex2(st.m[qb] - mnew);
            st.l[qb] *= alpha; st.m[qb] = mnew;
            row_scale(st.O[qb], alpha, area + qb * 32, c, h);
        }
        float ls = 0.f;
#pragma unroll
        for (int r = 0; r < 16; ++r) { S[r] = (S[r] > -1e29f) ? ex2(S[r] - st.m[qb]) : 0.f; ls += S[r]; }
        st.l[qb] += ls;
    } else {
        float mx = fmaxf(fmaxf(fmaxf(S[0], S[1]), fmaxf(S[2], S[3])), fmaxf(fmaxf(S[4], S[5]), fmaxf(S[6], S[7])));
        mx = fmaxf(mx, fmaxf(fmaxf(fmaxf(S[8], S[9]), fmaxf(S[10], S[11])), fmaxf(fmaxf(S[12], S[13]), fmaxf(S[14], S[15]))));
        if (MODE == 2) mx = bit ? mx : NEGBIG;
        mx = fmaxf(mx, __shfl_xor(mx, 32));
        if (__any(mx > st.m[qb] + 8.0f)) {
            const float mnew = fmaxf(st.m[qb], mx); const float alpha = ex2(st.m[qb] - mnew);
            st.l[qb] *= alpha; st.m[qb] = mnew;
            row_scale(st.O[qb], alpha, area + qb * 32, c, h);
        }
        const float mref = (MODE == 2 && !bit) ? 3.0e38f : st.m[qb];
        float ls = 0.f;
#pragma unroll
        for (int r = 0; r < 16; ++r) { S[r] = ex2(S[r] - mref); ls += S[r]; }
        st.l[qb] += ls;
    }
}
DI void pack_p(bf16x8 (&Pf)[2], const f32x16& S) {
#pragma unroll
    for (int ks = 0; ks < 2; ++ks) { u32x4 w; w.x = pk2(S[8 * ks], S[8 * ks + 1]); w.y = pk2(S[8 * ks + 2], S[8 * ks + 3]); w.z = pk2(S[8 * ks + 4], S[8 * ks + 5]); w.w = pk2(S[8 * ks + 6], S[8 * ks + 7]);
        Pf[ks] = __builtin_bit_cast(bf16x8, w); }
}
template <int MODE, bool MASKED>
DI void tile_compute(State& st, const LAS unsigned char* qf, LAS unsigned char* buf, int kbase, const int (&tq)[2], int W, const unsigned long long (&sel)[2], int tile, LAS float* area, int c_, int h_) {
    const int c = opq(c_), h = opq(h_);
    LAS unsigned char* Kl = buf; LAS unsigned char* Vl = buf + 64 * KPADB;
    const bool bit0 = MODE == 2 ? (((sel[0] >> tile) & 1ull) != 0ull) : true, bit1 = MODE == 2 ? (((sel[1] >> tile) & 1ull) != 0ull) : true;
#pragma unroll 1
    for (int kbk = 0; kbk < 2; ++kbk) {
        bf16x8 kf[4];
#pragma unroll
        for (int s = 0; s < 4; ++s) kf[s] = *(LAS bf16x8*)(Kl + (32 * kbk + c) * KPADB + (16 * s + 8 * h) * 2);
        f32x16 S0, S1;
#pragma unroll
        for (int r = 0; r < 16; ++r) { S0[r] = 0.f; S1[r] = 0.f; }
#pragma unroll
        for (int s = 0; s < 4; ++s) { const bf16x8 q = *(const LAS bf16x8*)(qf + s * 1024); S0 = MFMA32(kf[s], q, S0); }
#pragma unroll
        for (int s = 0; s < 4; ++s) { const bf16x8 q = *(const LAS bf16x8*)(qf + (4 + s) * 1024); S1 = MFMA32(kf[s], q, S1); }
        const LAS unsigned char* vbase = Vl + opq(c * VPADB + h * 8) + kbk * 64;
        bf16x8 vf[2][2];
#pragma unroll
        for (int ks = 0; ks < 2; ++ks)
#pragma unroll
            for (int db = 0; db < 2; ++db) {
                const s16x4 lo = *(const LAS s16x4*)(vbase + 32 * db * VPADB + 32 * ks);
                const s16x4 hi = *(const LAS s16x4*)(vbase + 32 * db * VPADB + 32 * ks + 16);
                vf[ks][db] = __builtin_shufflevector(lo, hi, 0, 1, 2, 3, 4, 5, 6, 7);
            }
        __builtin_amdgcn_sched_barrier(0);
        const int kpos0 = kbase + 32 * kbk + 4 * h;
        bf16x8 Pf[2];
        softmax_block<MODE, MASKED>(st, S0, 0, kpos0, tq, W, bit0, area, c, h);
        pack_p(Pf, S0);
        __builtin_amdgcn_sched_barrier(0);
#pragma unroll
        for (int ks = 0; ks < 2; ++ks)
#pragma unroll
            for (int db = 0; db < 2; ++db) st.O[0][db] = MFMA32(Pf[ks], vf[ks][db], st.O[0][db]);
        softmax_block<MODE, MASKED>(st, S1, 1, kpos0, tq, W, bit1, area, c, h);
        pack_p(Pf, S1);
        __builtin_amdgcn_sched_barrier(0);
#pragma unroll
        for (int ks = 0; ks < 2; ++ks)
#pragma unroll
            for (int db = 0; db < 2; ++db) st.O[1][db] = MFMA32(Pf[ks], vf[ks][db], st.O[1][db]);
    }
}
template <int MODE>
DI void run_pass(State& st, LAS unsigned char* lds, const bf16_t* Kg, const bf16_t* Vg, size_t pitch, int tlo, int thi, const int (&tq)[2], int W,
                 const unsigned long long (&sel)[2], int tid, int wave, int c, int h) {
    LAS float* area = (LAS float*)(lds + OFF_ALPHA) + wave * 64;
    const LAS unsigned char* qf = lds + OFF_Q + wave * 8192 + (c + 32 * h) * 16;
    KVRegs kr; kv_load(kr, Kg + (size_t)tlo * 64 * pitch, Vg + (size_t)tlo * 64 * pitch, pitch, tid);
    int bi = 0;
    for (int t = tlo; t <= thi; ++t) {
        LAS unsigned char* buf = lds + bi * BUFB;
        const int tid2 = opq(tid);
        kv_store(kr, buf, tid2);
        if (t < thi) kv_load(kr, Kg + (size_t)(t + 1) * 64 * pitch, Vg + (size_t)(t + 1) * 64 * pitch, pitch, tid2);
        __syncthreads();
        const bool masked = (MODE == 1) || (t == thi) || (MODE == 0 && t == thi - W / 64);
        if (masked) tile_compute<MODE, true>(st, qf, buf, t * 64, tq, W, sel, t, area, c, h);
        else tile_compute<MODE, false>(st, qf, buf, t * 64, tq, W, sel, t, area, c, h);
        bi ^= 1;
    }
    __syncthreads();
}
DI void load_q(LAS unsigned char* lds, int wave, const bf16_t* Pbase  , int colbase, int c_, int h_) {
    const int c = opq(c_), h = opq(h_);
    LAS unsigned char* q = lds + OFF_Q + wave * 8192 + (c + 32 * h) * 16;
#pragma unroll
    for (int qb = 0; qb < 2; ++qb) { const bf16_t* p = Pbase + (size_t)(4 * qb + (c >> 3)) * NP + colbase + (c & 7) * 64 + 8 * h;
#pragma unroll
        for (int s = 0; s < 4; ++s) *(LAS bf16x8*)(q + (qb * 4 + s) * 1024) = *(const bf16x8*)(p + 16 * s); }
}
template <bool ACC>
DI void emit_out(State& st, const float (&f)[2], LAS float* area, LAS unsigned char* lds, int wave, bf16_t* Orow, int c_, int h_, int lane_) {
    const int c = opq(c_), h = opq(h_), lane = opq(lane_);
    LAS unsigned char* slice = lds + wave * 4608;
#pragma unroll
    for (int qb = 0; qb < 2; ++qb) {
        area[qb * 32 + c] = f[qb];
        asm volatile("s_waitcnt lgkmcnt(0)" ::: "memory");
#pragma unroll
        for (int g4 = 0; g4 < 4; ++g4) { const f32x4 a = *(LAS f32x4*)(area + qb * 32 + 8 * g4 + 4 * h);
#pragma unroll
            for (int j = 0; j < 4; ++j)
#pragma unroll
                for (int db = 0; db < 2; ++db)
                    *(LAS unsigned short*)(slice + (8 * g4 + 4 * h + j) * KPADB + (32 * db + c) * 2) = (unsigned short)f2bf(st.O[qb][db][4 * g4 + j] * a[j]); }
        asm volatile("s_waitcnt lgkmcnt(0)" ::: "memory");
        u32x4 v[4], o[4];
#pragma unroll
        for (int i = 0; i < 4; ++i) v[i] = *(LAS u32x4*)(slice + ((lane >> 3) + 8 * i) * KPADB + (lane & 7) * 16);
        if (ACC) {
#pragma unroll
            for (int i = 0; i < 4; ++i) { const int row = (lane >> 3) + 8 * i; o[i] = *(const u32x4*)(Orow + (size_t)(4 * qb + (row >> 3)) * DM + (row & 7) * 64 + (lane & 7) * 8); }
#pragma unroll
            for (int i = 0; i < 4; ++i) { const unsigned a[4] = {v[i].x, v[i].y, v[i].z, v[i].w}, bb[4] = {o[i].x, o[i].y, o[i].z, o[i].w}; unsigned r[4];
#pragma unroll
                for (int k = 0; k < 4; ++k) r[k] = pk2(bflo(a[k]) + bflo(bb[k]), bfhi(a[k]) + bfhi(bb[k]));
                v[i] = (u32x4){r[0], r[1], r[2], r[3]}; }
        }
#pragma unroll
        for (int i = 0; i < 4; ++i) { const int row = (lane >> 3) + 8 * i; *(u32x4*)(Orow + (size_t)(4 * qb + (row >> 3)) * DM + (row & 7) * 64 + (lane & 7) * 8) = v[i]; }
        asm volatile("s_waitcnt lgkmcnt(0)" ::: "memory");
    }
}
}

DI void attn_unit_A(const Frame& F, const bf16_t* P, bf16_t* O, const float* sinks, int b, int kvh, int ch) {
    const int lane = opq(F.lane), tid = F.wave * 64 + lane;
    const int c = lane & 31, h = lane >> 5, w = F.wave;
    const int t0 = ch * 64;
    const bf16_t* Pb = P + (size_t)b * SEQ * NP;
    att::load_q(F.lds, w, Pb + (size_t)(t0 + 8 * w) * NP, C_QA + kvh * 512, c, h);
    int tq[2] = {t0 + 8 * w + (c >> 3), t0 + 8 * w + 4 + (c >> 3)};
    unsigned long long sel[2] = {0ull, 0ull};
    att::State st; att::state_init(st);
    const int tlo = ch >= 2 ? ch - 2 : 0;
    att::run_pass<0>(st, F.lds, Pb + C_KA + kvh * 64, Pb + C_VA + kvh * 64, NP, tlo, ch, tq, 128, sel, tid, w, c, h);
    const float sink2 = sinks[kvh * 8 + (c & 7)] * LOG2E;
    float f[2];
#pragma unroll
    for (int qb = 0; qb < 2; ++qb) { const float lt = st.l[qb] + __shfl_xor(st.l[qb], 32) + ex2(sink2 - st.m[qb]); f[qb] = 1.0f / lt; }
    LAS float* area = (LAS float*)(F.lds + att::OFF_ALPHA) + w * 64;
    att::emit_out<false>(st, f, area, F.lds, w, O + ((size_t)b * SEQ + t0 + 8 * w) * DM + kvh * 512, c, h, lane);
    __syncthreads();
}

DI void attn_unit_B(const Frame& F, const bf16_t* P, const bf16_t* KVC, bf16_t* O, float* OB, int b, int hkv, int ch) {
    const int lane = opq(F.lane), tid = F.wave * 64 + lane;
    const int c = lane & 31, h = lane >> 5, w = F.wave;
    const int t0 = ch * 64;
    const bf16_t* Pb = P + (size_t)b * SEQ * NP;
    LAS float* area = (LAS float*)(F.lds + att::OFF_ALPHA) + w * 64;
    LAS float* imp = (LAS float*)(F.lds + att::OFF_IMP);
    LAS unsigned long long* selbuf = (LAS unsigned long long*)(F.lds + att::OFF_SEL);
    LAS float* rank = (LAS float*)(F.lds + att::OFF_RANK) + w * 64;
    att::load_q(F.lds, w, Pb + (size_t)(t0 + 8 * w) * NP, C_QB + hkv * 512, c, h);
    const LAS unsigned char* qf = F.lds + att::OFF_Q + w * 8192 + (c + 32 * h) * 16;
    int tq[2] = {t0 + 8 * w + (c >> 3), t0 + 8 * w + 4 + (c >> 3)};
    unsigned long long sel[2] = {0ull, 0ull};
#define GATE(qb, j) sigmoidf_(bf2f(Pb[(size_t)tq[qb] * NP + C_GATE + hkv * 24 + (c & 7) * 3 + (j)]))
    for (int i = tid; i < 4096; i += NTHR) imp[i] = 0.f;
    bf16_t* Orow = O + ((size_t)b * SEQ + t0 + 8 * w) * DM + 1024 + hkv * 512;
    const bf16_t* Kc = KVC + (size_t)(0 * 2048 + (b * 2 + hkv) * 256) * 64;
    const bf16_t* Vc = KVC + (size_t)(1 * 2048 + (b * 2 + hkv) * 256) * 64;
    const int ntc = (4 * ch + 2) / 64;
    att::State st; att::state_init(st);
    int tqc[2] = {(tq[0] - 31) >> 4, (tq[1] - 31) >> 4};
    att::run_pass<1>(st, F.lds, Kc, Vc, 64, 0, ntc, tqc, 0, sel, tid, w, c, h);
    float ltot[2], f[2];
#pragma unroll
    for (int qb = 0; qb < 2; ++qb) { ltot[qb] = fmaxf(st.l[qb] + __shfl_xor(st.l[qb], 32), 1e-30f); f[qb] = GATE(qb, 0) / ltot[qb]; }
    att::emit_out<false>(st, f, area, F.lds, w, Orow, c, h, lane);
    __syncthreads();
    {
        att::KVRegs kr; att::kv_load(kr, Kc, Vc, 64, tid);
        int bi = 0;
        for (int t = 0; t <= ntc; ++t) {
            LAS unsigned char* buf = F.lds + bi * att::BUFB;
            att::kv_store(kr, buf, tid);
            if (t < ntc) att::kv_load(kr, Kc + (size_t)(t + 1) * 64 * 64, Vc + (size_t)(t + 1) * 64 * 64, 64, tid);
            __syncthreads();
#pragma unroll
            for (int kbk = 0; kbk < 2; ++kbk) {
#pragma unroll
                for (int qb = 0; qb < 2; ++qb) {
                    f32x16 S;
#pragma unroll
                    for (int r = 0; r < 16; ++r) S[r] = 0.f;
#pragma unroll
                    for (int s = 0; s < 4; ++s) { const bf16x8 kf = *(LAS bf16x8*)(buf + (32 * kbk + c) * att::KPADB + (16 * s + 8 * h) * 2); const bf16x8 q = *(const LAS bf16x8*)(qf + (qb * 4 + s) * 1024); S = MFMA32(kf, q, S); }
                    const float inv = 1.0f / ltot[qb];
                    const int q = 8 * w + 4 * qb + (c >> 3);
                    const int ddq = tqc[qb] - (t * 64 + 32 * kbk + 4 * h);
#pragma unroll
                    for (int g4 = 0; g4 < 4; ++g4) {
                        float s4 = 0.f, p3 = 0.f;
#pragma unroll
                        for (int j = 0; j < 4; ++j) { const float pv = (8 * g4 + j <= ddq) ? ex2(S[4 * g4 + j] - st.m[qb]) * inv : 0.f; s4 += pv; if (j == 3) p3 = pv; }
                        s4 += __shfl_xor(s4, 1); s4 += __shfl_xor(s4, 2); s4 += __shfl_xor(s4, 4);
                        p3 += __shfl_xor(p3, 1); p3 += __shfl_xor(p3, 2); p3 += __shfl_xor(p3, 4);
                        const int n0 = t * 16 + 8 * kbk + 2 * g4 + h;
                        if ((c & 7) == 0) { (void)__hip_atomic_fetch_add(&imp[q * 64 + n0], s4, __ATOMIC_RELAXED, __HIP_MEMORY_SCOPE_WORKGROUP); if (n0 + 1 < 64) (void)__hip_atomic_fetch_add(&imp[q * 64 + n0 + 1], p3, __ATOMIC_RELAXED, __HIP_MEMORY_SCOPE_WORKGROUP); }
                    }
                    __builtin_amdgcn_sched_barrier(0);
                }
            }
            bi ^= 1;
        }
        __syncthreads();
    }
    {
        const int cur = ch;
        for (int qq = 0; qq < 8; ++qq) {
            const int q = 8 * w + qq;
            float v = imp[q * 64 + lane];
            if (lane > cur) v = -1e9f; else if (lane == 0 || lane > cur - 2) v = 1e9f;
            rank[lane] = v;
            asm volatile("s_waitcnt lgkmcnt(0)" ::: "memory");
            int rk = 0;
#pragma unroll 8
            for (int mth = 0; mth < 64; ++mth) { const float o = rank[mth]; rk += (o > v || (o == v && mth < lane)) ? 1 : 0; }
            const unsigned long long msk = __ballot(rk < 16);
            if (lane == 0) selbuf[q] = msk;
            asm volatile("s_waitcnt lgkmcnt(0)" ::: "memory");
        }
        __syncthreads();
        sel[0] = selbuf[8 * w + (c >> 3)]; sel[1] = selbuf[8 * w + 4 + (c >> 3)];
    }
    att::state_init(st);
    att::run_pass<2>(st, F.lds, Pb + C_KSEL + hkv * 64, Pb + C_VSEL + hkv * 64, NP, 0, ch, tq, 0, sel, tid, w, c, h);
#pragma unroll
    for (int qb = 0; qb < 2; ++qb) { const float lt = fmaxf(st.l[qb] + __shfl_xor(st.l[qb], 32), 1e-30f); f[qb] = GATE(qb, 1) / lt; }
    att::emit_out<true>(st, f, area, F.lds, w, Orow, c, h, lane);
    __syncthreads();
    att::state_init(st);
    att::run_pass<0>(st, F.lds, Pb + C_KWIN + hkv * 64, Pb + C_VWIN + hkv * 64, NP, ch >= 8 ? ch - 8 : 0, ch, tq, 512, sel, tid, w, c, h);
#pragma unroll
    for (int qb = 0; qb < 2; ++qb) { const float lt = fmaxf(st.l[qb] + __shfl_xor(st.l[qb], 32), 1e-30f); f[qb] = GATE(qb, 2) / lt; }
    att::emit_out<true>(st, f, area, F.lds, w, Orow, c, h, lane);
#undef GATE
    __syncthreads();
}

namespace scan {
constexpr int TC = 32;
constexpr int STEPB = 5 * 256 + 128;
constexpr int CHB = TC * STEPB;
constexpr int OFF_Y = 2 * CHB;
constexpr int YB = (TC + 1) * 32 * 4;
template <int CTRL> DI float dpp_f(float x) { return __builtin_bit_cast(float, __builtin_amdgcn_update_dpp(0, __builtin_bit_cast(int, x), CTRL, 0xf, 0xf, false)); }
DI void row_sum16x4(float& a, float& b, float& c, float& d) {
    asm volatile("s_nop 1\n\t"
        "v_add_f32_dpp %0, %0, %0 quad_perm:[1,0,3,2] row_mask:0xf bank_mask:0xf\n\tv_add_f32_dpp %1, %1, %1 quad_perm:[1,0,3,2] row_mask:0xf bank_mask:0xf\n\t"
        "v_add_f32_dpp %2, %2, %2 quad_perm:[1,0,3,2] row_mask:0xf bank_mask:0xf\n\tv_add_f32_dpp %3, %3, %3 quad_perm:[1,0,3,2] row_mask:0xf bank_mask:0xf\n\t"
        "v_add_f32_dpp %0, %0, %0 quad_perm:[2,3,0,1] row_mask:0xf bank_mask:0xf\n\tv_add_f32_dpp %1, %1, %1 quad_perm:[2,3,0,1] row_mask:0xf bank_mask:0xf\n\t"
        "v_add_f32_dpp %2, %2, %2 quad_perm:[2,3,0,1] row_mask:0xf bank_mask:0xf\n\tv_add_f32_dpp %3, %3, %3 quad_perm:[2,3,0,1] row_mask:0xf bank_mask:0xf\n\t"
        "v_add_f32_dpp %0, %0, %0 row_half_mirror row_mask:0xf bank_mask:0xf\n\tv_add_f32_dpp %1, %1, %1 row_half_mirror row_mask:0xf bank_mask:0xf\n\t"
        "v_add_f32_dpp %2, %2, %2 row_half_mirror row_mask:0xf bank_mask:0xf\n\tv_add_f32_dpp %3, %3, %3 row_half_mirror row_mask:0xf bank_mask:0xf\n\t"
        "v_add_f32_dpp %0, %0, %0 row_mirror row_mask:0xf bank_mask:0xf\n\tv_add_f32_dpp %1, %1, %1 row_mirror row_mask:0xf bank_mask:0xf\n\t"
        "v_add_f32_dpp %2, %2, %2 row_mirror row_mask:0xf bank_mask:0xf\n\tv_add_f32_dpp %3, %3, %3 row_mirror row_mask:0xf bank_mask:0xf"
        : "+v"(a), "+v"(b), "+v"(c), "+v"(d));
}
DI float wave_sum_dpp(float x) { x += dpp_f<0xB1>(x); x += dpp_f<0x4E>(x); x += dpp_f<0x141>(x); x += dpp_f<0x140>(x);
    const int xi = __builtin_bit_cast(int, x);
    return (__builtin_bit_cast(float, __builtin_amdgcn_readlane(xi, 0)) + __builtin_bit_cast(float, __builtin_amdgcn_readlane(xi, 16))) + (__builtin_bit_cast(float, __builtin_amdgcn_readlane(xi, 32)) + __builtin_bit_cast(float, __builtin_amdgcn_readlane(xi, 48))); }
DI float row_sum16(float x) { x += dpp_f<0xB1>(x); x += dpp_f<0x4E>(x); x += dpp_f<0x141>(x); x += dpp_f<0x140>(x); return x; }
}
struct ScanRegs { unsigned short r[8], k[8], v[8], a[8]; float dec[8]; };
DI void scan_issue(const Frame& F, ScanRegs& R, const bf16_t* RKV, const float* DEC, const bf16_t* AA, int b, int hd, int tch) {
    const int lw = F.wave - 4, lane = F.lane;
#pragma unroll
    for (int i = 0; i < 8; ++i) {
        const size_t tok = (size_t)b * SEQ + (size_t)tch * scan::TC + lw + 4 * i;
        const size_t o = tok * DM + hd * 64 + lane;
        R.r[i] = RKV[o]; R.k[i] = RKV[(size_t)M * DM + o]; R.v[i] = RKV[(size_t)2 * M * DM + o]; R.dec[i] = DEC[o]; R.a[i] = AA[o];
    }
}
DI void scan_fill(const Frame& F, const ScanRegs& R, LAS unsigned char* buf, float kkw, float kaw, int half) {
    const int lw = F.wave - 4, lane = F.lane;
#pragma unroll
    for (int i = 0; i < 8; ++i) {
        const int s = lw + 4 * i;
        const float r = bf2f(R.r[i]), k = bf2f(R.k[i]), v = bf2f(R.v[i]), dec = R.dec[i], a = bf2f(R.a[i]);
        const float kx = k * kkw;
        const float kk = kx * __builtin_amdgcn_rsqf(fmaxf(scan::wave_sum_dpp(kx * kx), 1e-24f));
        const float kp = k * (1.0f + (a - 1.0f) * kaw);
        LAS float* sp = (LAS float*)(buf + s * scan::STEPB);
        sp[lane] = dec; sp[64 + lane] = -kk; sp[128 + lane] = kk * a; sp[192 + lane] = kp; sp[256 + lane] = r;
        if ((lane >> 5) == half) sp[320 + (lane & 31)] = v;
    }
}
DI void scan_flush(const Frame& F, LAS unsigned char* ybuf, bf16_t* YRAW, int b, int hd, int half, int tch) {
    const int lw = F.wave - 4, lane = F.lane;
    for (int s = 2 * lw; s < scan::TC; s += 8) {
        const int ss = s + (lane >> 5);
        const size_t tok = (size_t)b * SEQ + (size_t)tch * scan::TC + ss;
        YRAW[tok * DM + hd * 64 + half * 32 + (lane & 31)] = (bf16_t)f2bf(((LAS float*)ybuf)[(ss + 1) * 32 + (lane & 31)]);
    }
}
struct CvItem { const float* W; unsigned char* WT; int Nsrc, Kd, k0, n0, s0; float mul; bool on; };
constexpr int CV_I13 = (DM / 64) * (2 * DFFE / 32), CV_I2 = (DFFE / 64) * (DM / 32), CV_TOTAL = NEXP * (CV_I13 + CV_I2);
DI CvItem cv_item(int gid, const float* w13, const float* w2, unsigned char* m13, unsigned char* m2) {
    CvItem it; it.on = gid < CV_TOTAL;
    if (gid < NEXP * CV_I13) { const int e = gid / CV_I13, r = gid % CV_I13, kb = r / (2 * DFFE / 32), nb = r % (2 * DFFE / 32);
        it.W = w13 + (size_t)e * DM * 2 * DFFE; it.WT = m13 + (size_t)e * 2 * DFFE * DM; it.Nsrc = 2 * DFFE; it.Kd = DM; it.k0 = 64 * kb; it.n0 = 32 * nb; it.mul = 64.0f;
        const int t = it.n0 >> 8, rr = it.n0 & 255; it.s0 = rr < 128 ? t * 128 + rr : DFFE + t * 128 + (rr - 128);
    } else { const int g2 = gid - NEXP * CV_I13; const int e = g2 / CV_I2, r = g2 % CV_I2, kb = r / (DM / 32), nb = r % (DM / 32);
        it.W = w2 + (size_t)e * DFFE * DM; it.WT = m2 + (size_t)e * DM * DFFE; it.Nsrc = DM; it.Kd = DFFE; it.k0 = 64 * kb; it.n0 = 32 * nb; it.mul = 128.0f; it.s0 = it.n0; }
    return it;
}
DI void cv_load(float (&v)[32], const CvItem& it, int lane) {
    if (!it.on) return;
    const char* rowbase = (const char*)(it.W + (size_t)it.k0 * it.Nsrc + it.s0);
    const unsigned loff = (unsigned)((lane >> 5) * it.Nsrc + (lane & 31)) * 4u;
    const size_t rstep = (size_t)it.Nsrc * 8;
#pragma unroll
    for (int i = 0; i < 32; ++i) v[i] = __builtin_nontemporal_load((const float*)(rowbase + (size_t)i * rstep + loff));
}
DI void cv_store(const float (&v)[32], const CvItem& it, LAS float* scr, int lane) {
    if (!it.on) return;
#pragma unroll
    for (int i = 0; i < 32; ++i) scr[(2 * i + (lane >> 5)) * 33 + (lane & 31)] = v[i];
    asm volatile("s_waitcnt lgkmcnt(0)" ::: "memory");
    const int c = lane & 7;
#pragma unroll
    for (int j = 0; j < 4; ++j) { const int n = (lane >> 3) + 8 * j; const LAS float* s = scr + (8 * c) * 33 + n;
        u32x2 o; o.x = pk4_fp8(s[0 * 33] * it.mul, s[1 * 33] * it.mul, s[2 * 33] * it.mul, s[3 * 33] * it.mul); o.y = pk4_fp8(s[4 * 33] * it.mul, s[5 * 33] * it.mul, s[6 * 33] * it.mul, s[7 * 33] * it.mul);
        *(u32x2*)(it.WT + (size_t)(it.n0 + n) * it.Kd + it.k0 + 8 * c) = o; }
    asm volatile("s_waitcnt lgkmcnt(0)" ::: "memory");
}
DI unsigned long long phase_scan(const Frame& F, const bf16_t* RKV, const float* DEC, const bf16_t* AA, const float* kk_w, const float* ka_w, bf16_t* YRAW,
                                  const float* w13, const float* w2, unsigned char* m13, unsigned char* m2) {
    unsigned long long pacc = 0ull;
    for (int vb = blockIdx.x; vb < 256; vb += F.G) {
        const int bh = vb >> 1, half = vb & 1, b = bh >> 5, hd = bh & 31;
        const int w = F.wave, lane = F.lane;
        const int rp = lane >> 4, cg = lane & 15;
        const int row0 = 8 * w + 2 * rp;
        f32x2 SS[4] = {(f32x2){0.f, 0.f}, (f32x2){0.f, 0.f}, (f32x2){0.f, 0.f}, (f32x2){0.f, 0.f}};
        constexpr int NCH = SEQ / scan::TC;
        volatile LAS unsigned* fl = (volatile LAS unsigned*)(F.lds + 138240);
#define SC_WAIT(idx, target) do { unsigned sp_ = 0; while (fl[idx] < (unsigned)(target) && ++sp_ < (1u << 24)) __builtin_amdgcn_s_sleep(1); asm volatile("" ::: "memory"); } while (0)
#define SC_SIGNAL(idx) do { asm volatile("s_waitcnt lgkmcnt(0)" ::: "memory"); if (lane == 0) (void)__hip_atomic_fetch_add((LAS unsigned*)&fl[idx], 1u, __ATOMIC_RELAXED, __HIP_MEMORY_SCOPE_WORKGROUP); } while (0)
        if (w < 4) {
            __builtin_amdgcn_s_setprio(3);
            for (int ch = 0; ch < NCH; ++ch) {
                LAS unsigned char* buf = F.lds + (ch & 1) * scan::CHB;
                LAS float* yb = (LAS float*)(F.lds + scan::OFF_Y + (ch & 1) * scan::YB);
                SC_WAIT(ch & 1, 4 * (ch / 2 + 1));
                if (ch >= 2) SC_WAIT(4 + (ch & 1), 4 * (ch / 2));
#ifdef PROBE_SCAN
                const unsigned long long pt0 = __builtin_amdgcn_s_memrealtime();
#endif
                f32x2 yp = (f32x2){0.f, 0.f};
                const LAS float* sp0 = (const LAS float*)buf;
                f32x4 w4 = *(const LAS f32x4*)(sp0 + 4 * cg), nk4 = *(const LAS f32x4*)(sp0 + 64 + 4 * cg), b4 = *(const LAS f32x4*)(sp0 + 128 + 4 * cg),
                      k4 = *(const LAS f32x4*)(sp0 + 192 + 4 * cg), r4 = *(const LAS f32x4*)(sp0 + 256 + 4 * cg);
                f32x2 v2 = *(const LAS f32x2*)(sp0 + 320 + row0);
#define SPL(x) ((f32x2){(x), (x)})
#pragma unroll 8
                for (int s = 0; s < scan::TC; ++s) {
                    const LAS float* sp = (const LAS float*)(buf + (s + 1) * scan::STEPB);
                    const f32x4 w4n = *(const LAS f32x4*)(sp + 4 * cg), nk4n = *(const LAS f32x4*)(sp + 64 + 4 * cg), b4n = *(const LAS f32x4*)(sp + 128 + 4 * cg),
                                k4n = *(const LAS f32x4*)(sp + 192 + 4 * cg), r4n = *(const LAS f32x4*)(sp + 256 + 4 * cg);
                    const f32x2 v2n = *(const LAS f32x2*)(sp + 320 + row0);
                    f32x2 sa = SS[0] * SPL(nk4[0]);
#pragma unroll
                    for (int i = 1; i < 4; ++i) sa = __builtin_elementwise_fma(SS[i], SPL(nk4[i]), sa);
                    float sa0 = sa.x, sa1 = sa.y, y0 = yp.x, y1 = yp.y;
                    scan::row_sum16x4(sa0, sa1, y0, y1);
                    if (cg == 0) { yb[s * 32 + row0] = y0; yb[s * 32 + row0 + 1] = y1; }
                    sa = (f32x2){sa0, sa1};
                    yp = (f32x2){0.f, 0.f};
#pragma unroll
                    for (int i = 0; i < 4; ++i) {
                        f32x2 t = v2 * SPL(k4[i]);
                        t = __builtin_elementwise_fma(sa, SPL(b4[i]), t);
                        SS[i] = __builtin_elementwise_fma(SS[i], SPL(w4[i]), t);
                        yp = __builtin_elementwise_fma(SS[i], SPL(r4[i]), yp);
                    }
                    w4 = w4n; nk4 = nk4n; b4 = b4n; k4 = k4n; r4 = r4n; v2 = v2n;
                }
#undef SPL
                float d0 = 0.f, d1 = 0.f, y0 = yp.x, y1 = yp.y;
                scan::row_sum16x4(y0, y1, d0, d1);
                if (cg == 0) { yb[scan::TC * 32 + row0] = y0; yb[scan::TC * 32 + row0 + 1] = y1; }
#ifdef PROBE_SCAN
                if (PROBE_SCAN == 1) pacc += __builtin_amdgcn_s_memrealtime() - pt0;
#endif
                SC_SIGNAL(2 + (ch & 1));
            }
            __builtin_amdgcn_s_setprio(0);
        } else {
            ScanRegs SR;
            const float kkw = kk_w[hd * 64 + lane], kaw = ka_w[hd * 64 + lane];
            scan_issue(F, SR, RKV, DEC, AA, b, hd, 0); scan_fill(F, SR, F.lds, kkw, kaw, half); SC_SIGNAL(0); scan_issue(F, SR, RKV, DEC, AA, b, hd, 1);
            LAS float* cscr = (LAS float*)(F.lds + 98816 + (w - 4) * 8448);
            for (int it = 0; it < NCH; ++it) {
#ifdef PROBE_SCAN
                const unsigned long long pt0 = __builtin_amdgcn_s_memrealtime();
#endif
                const int gid0 = ((it * 256 + vb) * 4 + (w - 4)) * 2;
                const CvItem ia = cv_item(gid0, w13, w2, m13, m2), ib = cv_item(gid0 + 1, w13, w2, m13, m2);
                float ca[32];
                cv_load(ca, ia, lane);
                if (it >= 1) SC_WAIT(2 + ((it - 1) & 1), 4 * ((it - 1) / 2 + 1));
                if (it + 1 < NCH) { scan_fill(F, SR, F.lds + ((it + 1) & 1) * scan::CHB, kkw, kaw, half); SC_SIGNAL((it + 1) & 1); }
                if (it + 2 < NCH) scan_issue(F, SR, RKV, DEC, AA, b, hd, it + 2);
                if (it >= 1) { scan_flush(F, F.lds + scan::OFF_Y + ((it - 1) & 1) * scan::YB, YRAW, b, hd, half, it - 1); SC_SIGNAL(4 + ((it - 1) & 1)); }
                cv_store(ca, ia, cscr, lane);
                cv_load(ca, ib, lane); cv_store(ca, ib, cscr, lane);
#ifdef PROBE_SCAN
                if (PROBE_SCAN == 2) pacc += __builtin_amdgcn_s_memrealtime() - pt0;
#endif
            }
            SC_WAIT(2 + ((NCH - 1) & 1), 4 * ((NCH - 1) / 2 + 1));
            scan_flush(F, F.lds + scan::OFF_Y + ((NCH - 1) & 1) * scan::YB, YRAW, b, hd, half, NCH - 1);
        }
#undef SC_WAIT
#undef SC_SIGNAL
        __syncthreads();
        if (F.tid < 6) fl[F.tid] = 0u;
        __syncthreads();
    }
    return pacc;
}

namespace sc2 {
constexpr int C = 16, NCHK = SEQ / C, NSLOT = 6, NPREP = 4;
constexpr int OFF_XT = 0, OFF_ZS = 4096, OFF_B2T = 8192, OFF_VT = 10240, OFF_GC = 11264, SLOTB = 11520;
constexpr int OFF_SCR = NSLOT * SLOTB, SCRB = 8448;
constexpr int FL = 138240;
constexpr int NITEM = CV_TOTAL / 256;
DI bf16x8 pack8(float a0, float a1, float a2, float a3, float a4, float a5, float a6, float a7) { const u32x4 u = {pk2(a0, a1), pk2(a2, a3), pk2(a4, a5), pk2(a6, a7)}; return __builtin_bit_cast(bf16x8, u); }
struct Raw { unsigned short r[16], k[16], v[16], a[16]; float dec[16]; };
DI void issue(Raw& R, const bf16_t* RKV, const float* DEC, const bf16_t* AA, int b, int hd, int c, int lane) {
#pragma unroll
    for (int t = 0; t < 16; ++t) {
        const size_t o = ((size_t)b * SEQ + (size_t)c * C + t) * DM + hd * 64 + lane;
        R.r[t] = RKV[o]; R.k[t] = RKV[(size_t)M * DM + o]; R.v[t] = RKV[(size_t)2 * M * DM + o]; R.dec[t] = DEC[o]; R.a[t] = AA[o];
    }
}
}
DI unsigned long long phase_scan2(const Frame& F, const bf16_t* RKV, const float* DEC, const bf16_t* AA, const float* kk_w, const float* ka_w, bf16_t* YRAW,
                    const float* w13, const float* w2, unsigned char* m13, unsigned char* m2) {
    using namespace sc2;
    unsigned long long pacc = 0ull;
    for (int vb = blockIdx.x; vb < 256; vb += F.G) {
        const int xq_ = vb & 7, yq_ = vb >> 3; const int half = yq_ & 1, bh = (yq_ >> 1) * 8 + xq_, b = bh >> 5, hd = bh & 31;
        const int w = F.wave, lane = opq(F.lane);
        const int n = lane & 31, h = lane >> 5;
        volatile LAS unsigned* fl = (volatile LAS unsigned*)(F.lds + FL);
#define SC_WAIT(idx, target) do { unsigned sp_ = 0; while (fl[idx] < (unsigned)(target) && ++sp_ < (1u << 24)) __builtin_amdgcn_s_sleep(1); asm volatile("" ::: "memory"); } while (0)
#define SC_GRAB(dst) do { unsigned g_ = 0; if (lane == 0) g_ = __hip_atomic_fetch_add((LAS unsigned*)&fl[7], 1u, __ATOMIC_RELAXED, __HIP_MEMORY_SCOPE_WORKGROUP); dst = __builtin_amdgcn_readfirstlane((int)g_); } while (0)
#define SC_GID(nn) (((nn) >> 3) * 2048 + vb * 8 + ((nn) & 7))
        if (w == 0) {
            __builtin_amdgcn_s_setprio(3);
            f32x16 ST0, ST1;
#pragma unroll
            for (int r = 0; r < 16; ++r) { ST0[r] = 0.f; ST1[r] = 0.f; }
            bf16x8 Sb0 = pack8(0.f, 0.f, 0.f, 0.f, 0.f, 0.f, 0.f, 0.f), Sb1 = Sb0, Sb2 = Sb0, Sb3 = Sb0;
            bf16_t* yout = YRAW + (size_t)b * SEQ * DM + hd * 64 + half * 32 + n;
#ifdef PROBE_SCAN
            const unsigned long long pc0 = __builtin_amdgcn_s_memrealtime();
#endif
#pragma unroll 1
            for (int c = 0; c < NCHK; ++c) {
                const int slot = c % NSLOT;
                const LAS unsigned char* sl = F.lds + slot * SLOTB;
                SC_WAIT(slot, c + 1);
                const int sw8 = n & 7, sw4 = (n >> 1) & 3;
                const bf16x8 A10 = *(const LAS bf16x8*)(sl + OFF_XT + n * 128 + (((0 + h) ^ sw8) << 4)), A11 = *(const LAS bf16x8*)(sl + OFF_XT + n * 128 + (((2 + h) ^ sw8) << 4)),
                             A12 = *(const LAS bf16x8*)(sl + OFF_XT + n * 128 + (((4 + h) ^ sw8) << 4)), A13 = *(const LAS bf16x8*)(sl + OFF_XT + n * 128 + (((6 + h) ^ sw8) << 4));
                const bf16x8 A20 = *(const LAS bf16x8*)(sl + OFF_B2T + n * 64 + (((0 + h) ^ sw4) << 4)), A21 = *(const LAS bf16x8*)(sl + OFF_B2T + n * 64 + (((2 + h) ^ sw4) << 4));
                const bf16x8 Vb = *(const LAS bf16x8*)(sl + OFF_VT + n * 32 + ((h ^ ((n >> 2) & 1)) << 4));
                const bf16x8 A300 = *(const LAS bf16x8*)(sl + OFF_ZS + n * 64 + (((0 + h) ^ sw4) << 4)), A301 = *(const LAS bf16x8*)(sl + OFF_ZS + n * 64 + (((2 + h) ^ sw4) << 4)),
                             A310 = *(const LAS bf16x8*)(sl + OFF_ZS + (32 + n) * 64 + (((0 + h) ^ sw4) << 4)), A311 = *(const LAS bf16x8*)(sl + OFF_ZS + (32 + n) * 64 + (((2 + h) ^ sw4) << 4));
                f32x4 gc0[4], gc1[4];
#pragma unroll
                for (int g = 0; g < 4; ++g) { gc0[g] = *(const LAS f32x4*)(sl + OFF_GC + (8 * g + 4 * h) * 4); gc1[g] = *(const LAS f32x4*)(sl + OFF_GC + (32 + 8 * g + 4 * h) * 4); }
                asm volatile("s_waitcnt lgkmcnt(0)" ::: "memory");
                if (lane == 0) fl[6] = (unsigned)(c + 1);
                f32x16 P;
#pragma unroll
                for (int r = 0; r < 16; ++r) P[r] = 0.f;
                P = MFMA32(A10, Sb0, P); P = MFMA32(A11, Sb1, P); P = MFMA32(A12, Sb2, P); P = MFMA32(A13, Sb3, P);
                const bf16x8 Bp = pack8(P[0], P[1], P[2], P[3], P[4], P[5], P[6], P[7]);
                f32x16 D2 = P;
#pragma unroll
                for (int r = 0; r < 8; ++r) D2[r] = 0.f;
                D2 = MFMA32(A20, Bp, D2); D2 = MFMA32(A21, Vb, D2);
                const bf16x8 Bu = pack8(D2[0], D2[1], D2[2], D2[3], D2[4], D2[5], D2[6], D2[7]);
#pragma unroll
                for (int r = 0; r < 16; ++r) { ST0[r] *= gc0[r >> 2][r & 3]; ST1[r] *= gc1[r >> 2][r & 3]; }
                ST0 = MFMA32(A300, Bu, ST0); ST0 = MFMA32(A301, Vb, ST0);
                ST1 = MFMA32(A310, Bu, ST1); ST1 = MFMA32(A311, Vb, ST1);
#pragma unroll
                for (int q = 0; q < 8; ++q) yout[((size_t)c * C + 8 * (q >> 2) + 4 * h + (q & 3)) * DM] = (bf16_t)f2bf(D2[8 + q]);
                Sb0 = pack8(ST0[0], ST0[1], ST0[2], ST0[3], ST0[4], ST0[5], ST0[6], ST0[7]); Sb1 = pack8(ST0[8], ST0[9], ST0[10], ST0[11], ST0[12], ST0[13], ST0[14], ST0[15]);
                Sb2 = pack8(ST1[0], ST1[1], ST1[2], ST1[3], ST1[4], ST1[5], ST1[6], ST1[7]); Sb3 = pack8(ST1[8], ST1[9], ST1[10], ST1[11], ST1[12], ST1[13], ST1[14], ST1[15]);
            }
#ifdef PROBE_SCAN
            if (PROBE_SCAN == 2) pacc += __builtin_amdgcn_s_memrealtime() - pc0;
#endif
            __builtin_amdgcn_s_setprio(0);
        } else {
            LAS unsigned char* scr = F.lds + OFF_SCR + (w - 1) * SCRB;
            if (w <= NPREP) {
                __builtin_amdgcn_s_setprio(2);
                const float kkw = kk_w[hd * 64 + lane], kaw = ka_w[hd * 64 + lane];
                const int xslot = (lane >> 4) * 2 + ((lane >> 2) & 1), xq = (4 * ((lane >> 3) & 1) + (lane & 3)) * 2;
                LAS unsigned char* ZT = scr; LAS float* GS = (LAS float*)(scr + 4096);
                Raw R; issue(R, RKV, DEC, AA, b, hd, w - 1, lane);
#pragma unroll 1
                for (int c = w - 1; c < NCHK; c += NPREP) {
                    const int slot = c % NSLOT;
                    LAS unsigned char* sl = F.lds + slot * SLOTB;
                    if (c >= NSLOT) SC_WAIT(6, c - NSLOT + 1);
#ifdef PROBE_SCAN
                    const unsigned long long pp0 = __builtin_amdgcn_s_memrealtime();
#endif
                    float gam = 1.0f; float bt[16], kt[16];
#pragma unroll
                    for (int t = 0; t < 16; ++t) {
                        const float r = bf2f(R.r[t]), k = bf2f(R.k[t]), a = bf2f(R.a[t]), dec = R.dec[t];
                        const float kx = k * kkw;
                        const float kk = kx * __builtin_amdgcn_rsqf(fmaxf(scan::wave_sum_dpp(kx * kx), 1e-24f));
                        const float kp = k * (1.0f + (a - 1.0f) * kaw);
                        const float at = -kk * gam;
                        gam *= dec;
                        const float ig = __builtin_amdgcn_rcpf(gam);
                        const float rt = r * gam;
                        bt[t] = kk * a * ig; kt[t] = kp * ig;
                        *(LAS unsigned short*)(sl + OFF_XT + t * 128 + ((xslot ^ (t & 7)) << 4) + xq) = (unsigned short)f2bf(at);
                        *(LAS unsigned short*)(sl + OFF_XT + (16 + t) * 128 + ((xslot ^ (t & 7)) << 4) + xq) = (unsigned short)f2bf(rt);
                        *(LAS unsigned short*)(ZT + t * 128 + ((xslot ^ (t & 7)) << 4) + xq) = (unsigned short)f2bf(bt[t]);
                        *(LAS unsigned short*)(ZT + (16 + t) * 128 + ((xslot ^ (t & 7)) << 4) + xq) = (unsigned short)f2bf(kt[t]);
                    }
                    {
                        const int sw4 = (lane >> 1) & 3;
                        LAS unsigned char* zr = sl + OFF_ZS + lane * 64;
#define ZB(s) (bt[s] * gam)
#define ZK(s) (kt[s] * gam)
                        *(LAS bf16x8*)(zr + ((0 ^ sw4) << 4)) = pack8(ZB(0), ZB(1), ZB(2), ZB(3), ZB(8), ZB(9), ZB(10), ZB(11));
                        *(LAS bf16x8*)(zr + ((1 ^ sw4) << 4)) = pack8(ZB(4), ZB(5), ZB(6), ZB(7), ZB(12), ZB(13), ZB(14), ZB(15));
                        *(LAS bf16x8*)(zr + ((2 ^ sw4) << 4)) = pack8(ZK(0), ZK(1), ZK(2), ZK(3), ZK(4), ZK(5), ZK(6), ZK(7));
                        *(LAS bf16x8*)(zr + ((3 ^ sw4) << 4)) = pack8(ZK(8), ZK(9), ZK(10), ZK(11), ZK(12), ZK(13), ZK(14), ZK(15));
#undef ZB
#undef ZK
                        *(LAS float*)(sl + OFF_GC + lane * 4) = gam;
                        if (h == half) {
                            const u32x4 v0 = {(unsigned)R.v[0] | ((unsigned)R.v[1] << 16), (unsigned)R.v[2] | ((unsigned)R.v[3] << 16), (unsigned)R.v[4] | ((unsigned)R.v[5] << 16), (unsigned)R.v[6] | ((unsigned)R.v[7] << 16)};
                            const u32x4 v1 = {(unsigned)R.v[8] | ((unsigned)R.v[9] << 16), (unsigned)R.v[10] | ((unsigned)R.v[11] << 16), (unsigned)R.v[12] | ((unsigned)R.v[13] << 16), (unsigned)R.v[14] | ((unsigned)R.v[15] << 16)};
                            const int vs = (n >> 2) & 1;
                            *(LAS u32x4*)(sl + OFF_VT + n * 32 + ((0 ^ vs) << 4)) = v0; *(LAS u32x4*)(sl + OFF_VT + n * 32 + ((1 ^ vs) << 4)) = v1;
                        }
                    }
                    if (c + NPREP < NCHK) issue(R, RKV, DEC, AA, b, hd, c + NPREP, lane);
                    asm volatile("s_waitcnt lgkmcnt(0)" ::: "memory");
                    f32x16 Gm;
#pragma unroll
                    for (int r = 0; r < 16; ++r) Gm[r] = 0.f;
#pragma unroll
                    for (int kq = 0; kq < 4; ++kq) {
                        const int so = ((2 * kq + h) ^ (n & 7)) << 4;
                        const bf16x8 za = *(const LAS bf16x8*)(ZT + n * 128 + so), xb = *(const LAS bf16x8*)(sl + OFF_XT + n * 128 + so);
                        Gm = MFMA32(za, xb, Gm);
                    }
#pragma unroll
                    for (int r = 0; r < 16; ++r) GS[(8 * (r >> 2) + 4 * h + (r & 3)) * 32 + n] = Gm[r];
                    asm volatile("s_waitcnt lgkmcnt(0)" ::: "memory");
                    float Xs[16], Wl[16];
                    const int tq = n - 16;
#pragma unroll
                    for (int s = 0; s < 16; ++s) {
                        const float gq = GS[s * 32 + n], gk = GS[(16 + s) * 32 + n];
                        Xs[s] = n < 16 ? (n == s ? 1.0f : 0.0f) : (s <= tq ? gq : 0.0f);
                        Wl[s] = (n >= 16 && s <= tq) ? gk : 0.0f;
                    }
#pragma unroll
                    for (int s = 14; s >= 0; --s) {
#pragma unroll
                        for (int qd = (s + 1) >> 2; qd < 4; ++qd) {
                            const f32x4 l4 = *(const LAS f32x4*)(GS + s * 32 + 4 * qd);
#pragma unroll
                            for (int e = 0; e < 4; ++e) if (4 * qd + e > s) Xs[s] = fmaf(l4[e], Xs[4 * qd + e], Xs[s]);
                        }
                    }
#pragma unroll
                    for (int s = 0; s < 15; ++s) {
#pragma unroll
                        for (int qd = (s + 1) >> 2; qd < 4; ++qd) {
                            const f32x4 l4 = *(const LAS f32x4*)(GS + (16 + s) * 32 + 4 * qd);
#pragma unroll
                            for (int e = 0; e < 4; ++e) if (4 * qd + e > s) Wl[s] = fmaf(l4[e], Xs[4 * qd + e], Wl[s]);
                        }
                    }
                    if (lane < 32) {
                        const int sw4 = (n >> 1) & 3;
                        LAS unsigned char* br = sl + OFF_B2T + n * 64;
                        *(LAS bf16x8*)(br + ((0 ^ sw4) << 4)) = pack8(Xs[0], Xs[1], Xs[2], Xs[3], Xs[8], Xs[9], Xs[10], Xs[11]);
                        *(LAS bf16x8*)(br + ((1 ^ sw4) << 4)) = pack8(Xs[4], Xs[5], Xs[6], Xs[7], Xs[12], Xs[13], Xs[14], Xs[15]);
                        *(LAS bf16x8*)(br + ((2 ^ sw4) << 4)) = pack8(Wl[0], Wl[1], Wl[2], Wl[3], Wl[4], Wl[5], Wl[6], Wl[7]);
                        *(LAS bf16x8*)(br + ((3 ^ sw4) << 4)) = pack8(Wl[8], Wl[9], Wl[10], Wl[11], Wl[12], Wl[13], Wl[14], Wl[15]);
                    }
                    asm volatile("s_waitcnt lgkmcnt(0)" ::: "memory");
                    if (lane == 0) fl[slot] = (unsigned)(c + 1);
#ifdef PROBE_SCAN
                    if (PROBE_SCAN == 1 && w == 1) pacc += __builtin_amdgcn_s_memrealtime() - pp0;
#endif
                }
                __builtin_amdgcn_s_setprio(0);
            }
#ifdef PROBE_SCAN
            const unsigned long long pv0 = __builtin_amdgcn_s_memrealtime();
#endif
#pragma unroll 1
            for (;;) {
                int nn; SC_GRAB(nn);
                if (nn >= NITEM) break;
                const CvItem it = cv_item(SC_GID(nn), w13, w2, m13, m2);
                float ca[32]; cv_load(ca, it, lane); cv_store(ca, it, (LAS float*)scr, lane);
            }
#ifdef PROBE_SCAN
            if (PROBE_SCAN == 3 && w == 4) pacc += __builtin_amdgcn_s_memrealtime() - pv0;
            if (PROBE_SCAN == 4 && w == 1) pacc += __builtin_amdgcn_s_memrealtime() - pv0;
#endif
        }
#undef SC_WAIT
#undef SC_GRAB
#undef SC_GID
        __syncthreads();
        if (F.tid < 8) fl[F.tid] = 0u;
        __syncthreads();
    }
    return pacc;
}

constexpr int NPHASE = 19;
__global__ void __launch_bounds__(NTHR, 2) mk_fwd(Args args) {
    extern __shared__ __attribute__((aligned(16))) unsigned char lds_raw[];
    Frame F;
    F.lds = (LAS unsigned char*)lds_raw;
    F.tid = threadIdx.x; F.lane = F.tid & 63; F.wave = __builtin_amdgcn_readfirstlane(F.tid >> 6);
    F.G = gridDim.x; F.gw = blockIdx.x * NWAVES + F.wave; F.NGW = F.G * NWAVES; F.ws = args.ws;
    unsigned char* ws = args.ws;
    unsigned* ctl = (unsigned*)(ws + WS_CTL);
    volatile LAS unsigned* MISC = (volatile LAS unsigned*)(F.lds + MISC_OFF);
    for (int u = F.tid; u < (LDS_BYTES - LDSCTL_OFF) / 4; u += NTHR) ((LAS unsigned*)(F.lds + LDSCTL_OFF))[u] = 0u;
    __syncthreads();
    XcdBarrier bar; bar.bar = ctl + CW_BAR; bar.x = 0; bar.st = nullptr;
    if (args.use_bar) bar = xcd_barrier_post(ctl + CW_BAR, MISC + 8);
    const int lo = args.ph_lo, hi = args.ph_hi;
#ifndef PH_MASK
#define PH_MASK 0xFFFFFFFFu
#endif
#define IN(k) (((PH_MASK >> (k)) & 1u) && lo <= (k) && (k) < hi)
#define SEAM(k) do { if (IN(k) && IN((k) + 1)) xcd_barrier(bar); if (PROBE_ON(k)) probe_acc += __builtin_amdgcn_s_memrealtime() - probe_t0; if (PROBE_ON((k) + 1)) probe_t0 = __builtin_amdgcn_s_memrealtime(); } while (0)
#ifndef REPEAT_MASK
#define REPEAT_MASK 0u
#endif
#define REPS(k) ((((REPEAT_MASK) >> (k)) & 1u) ? 2 : 1)
#ifndef PROBE_MASK
#define PROBE_MASK 0u
#endif
    unsigned long long probe_acc = 0ull, probe_t0 = 0ull;
#define PROBE_ON(k) (PROBE_MASK != 0u && (((PROBE_MASK) >> (k)) & 1u) && blockIdx.x == 0 && F.tid == 0)
#define PH(k) if (IN(k)) for (int rep_ = 0; rep_ < REPS(k); ++rep_, (rep_ < REPS(k) ? xcd_barrier(bar) : (void)0))

    bf16_t* W_IN = (bf16_t*)(ws + WS_W_IN); bf16_t* W_OUT = (bf16_t*)(ws + WS_W_OUT); bf16_t* CMPW1 = (bf16_t*)(ws + WS_CMPW1);
    bf16_t* FFN13 = (bf16_t*)(ws + WS_FFN13); bf16_t* FFN2 = (bf16_t*)(ws + WS_FFN2); bf16_t* WRKV = (bf16_t*)(ws + WS_WRKV);
    bf16_t* LORA1 = (bf16_t*)(ws + WS_LORA1); bf16_t* LORA2 = (bf16_t*)(ws + WS_LORA2); bf16_t* WO = (bf16_t*)(ws + WS_WO);
    bf16_t* MOE13 = (bf16_t*)(ws + WS_MOE13); bf16_t* MOE2 = (bf16_t*)(ws + WS_MOE2);
    bf16_t* XN = (bf16_t*)(ws + WS_XN); bf16_t* P = (bf16_t*)(ws + WS_P); float* ROPE = (float*)(ws + WS_ROPE); float* CMPB = (float*)(ws + WS_CMPB);
    bf16_t* HID = (bf16_t*)(ws + WS_HID); bf16_t* KVC = (bf16_t*)(ws + WS_KVC); bf16_t* O = (bf16_t*)(ws + WS_O); bf16_t* H = (bf16_t*)(ws + WS_H);
    bf16_t* ACT = (bf16_t*)(ws + WS_ACT); bf16_t* XS = (bf16_t*)(ws + WS_XS); bf16_t* RKV = (bf16_t*)(ws + WS_RKV); bf16_t* L1 = (bf16_t*)(ws + WS_L1);
    float* DEC = (float*)(ws + WS_DEC); bf16_t* AA = (bf16_t*)(ws + WS_AA); bf16_t* GG = (bf16_t*)(ws + WS_GG); bf16_t* YRAW = (bf16_t*)(ws + WS_YRAW); bf16_t* YG = (bf16_t*)(ws + WS_YG);
    int* ROWTOK = (int*)(ws + WS_ROWTOK); int* TOKSLOT = (int*)(ws + WS_TOKSLOT); float* Y2 = (float*)(ws + WS_Y2);
    LAS unsigned char* ring = F.lds;

    if (PROBE_ON(0)) probe_t0 = __builtin_amdgcn_s_memrealtime();
    PH(0) {
        LAS float* scr = (LAS float*)(F.lds + F.wave * 16640);
        transpose_matrix(F, args.in[I_W_IN], IN_COLS, DM, W_IN, DM, NP, ColInProj{}, scr, F.gw, F.NGW);
        for (int kv = 0; kv < 2; ++kv) transpose_matrix(F, args.in[I_CMP_W1] + (size_t)kv * 2048 * 256, 256, 2048, CMPW1 + (size_t)kv * 256 * 2048, 2048, 256, ColIdent{}, scr, F.gw, F.NGW);
        for (int m = F.gw; m < M; m += F.NGW) rms_row_to_bf16(args.in[I_X] + (size_t)m * DM, args.in[I_ATTN_NORM], XN + (size_t)m * DM, F.lane);
        { const int* pos = (const int*)args.in[I_POS];
          for (int i = blockIdx.x * NTHR + F.tid; i < M * 32; i += F.G * NTHR) { const int m = i >> 5, j = i & 31;
              const float inv = powf(150000.0f, -(float)j / 32.0f); const float ang = (float)pos[m] * inv; float sn, cs; sincosf(ang, &sn, &cs);
              ROPE[(size_t)m * 64 + j] = cs; ROPE[(size_t)m * 64 + 32 + j] = sn; } }
        if (F.gw < 512) { const int kv = F.gw >> 8, j = F.gw & 255; const float* pe = args.in[I_CMP_PE] + kv * 2048; const float* w1 = args.in[I_CMP_W1] + (size_t)kv * 2048 * 256;
            float s = 0.f; for (int i = F.lane; i < 2048; i += 64) s += pe[i] * w1[(size_t)i * 256 + j];
            s = wave_sum(s); if (F.lane == 0) CMPB[kv * 256 + j] = s + args.in[I_CMP_B1][kv * 256 + j]; }
    }
    SEAM(0);
    PH(1) {
        OrderSingle S{(const char*)XN, (const char*)W_IN, DM * 2, DM * 2, 64, 12, 64 * 12, F.G, (int)blockIdx.x};
        EpiInProj E{P, ROPE};
        pg8::gemm_phase<EpiInProj, OrderSingle, false>(ring, DM * 2, 128, DM * 2, DM / 64, S, E);
    }
    SEAM(1);
    PH(2) {
        OrderCmp S{(const char*)P, (const char*)CMPW1, (const char*)XN, (const char*)(W_IN + (size_t)C_GATE * DM), F.G, (int)blockIdx.x};
        EpiCmp1 E{HID, CMPB, P};
        pg8::gemm_phase<EpiCmp1, OrderCmp, true>(ring, 0, 0, 2048 * 2, 32, S, E);
        const bool conv = F.G > 80 ? (int)blockIdx.x >= 80 : true;
        if (conv) {
            const int nconv = F.G > 80 ? F.G - 80 : F.G; const int first = ((F.G > 80 ? (int)blockIdx.x - 80 : (int)blockIdx.x)) * NWAVES + F.wave, stride = nconv * NWAVES;
            LAS float* scr = (LAS float*)(F.lds + F.wave * 16640);
            transpose_matrix(F, args.in[I_W_OUT], DM, DM, W_OUT, DM, DM, ColIdent{}, scr, first, stride);
            transpose_matrix(F, args.in[I_FFN_W13], 2 * DFF, DM, FFN13, DM, 2 * DFF, ColSwiglu{DFF}, scr, first, stride);
            transpose_matrix(F, args.in[I_FFN_W2], DM, DFF, FFN2, DFF, DM, ColIdent{}, scr, first, stride);
            for (int i = 0; i < 3; ++i) transpose_matrix(F, args.in[I_W_RKV] + (size_t)i * DM * DM, DM, DM, WRKV + (size_t)i * DM * DM, DM, DM, ColIdent{}, scr, first, stride);
            transpose_matrix(F, args.in[I_DECAY_W1], 96, DM, LORA1, DM, 256, ColIdent{}, scr, first, stride);
            transpose_matrix(F, args.in[I_A1], 96, DM, LORA1 + (size_t)256 * DM, DM, 256, ColIdent{}, scr, first, stride);
            transpose_matrix(F, args.in[I_G1], 256, DM, LORA1 + (size_t)512 * DM, DM, 256, ColIdent{}, scr, first, stride);
            transpose_matrix(F, args.in[I_DECAY_W2], DM, 96, LORA2, 256, DM, ColIdent{}, scr, first, stride);
            transpose_matrix(F, args.in[I_A2], DM, 96, LORA2 + (size_t)DM * 256, 256, DM, ColIdent{}, scr, first, stride);
            transpose_matrix(F, args.in[I_G2], DM, 256, LORA2 + (size_t)2 * DM * 256, 256, DM, ColIdent{}, scr, first, stride);
            transpose_matrix(F, args.in[I_W_O], DM, DM, WO, DM, DM, ColIdent{}, scr, first, stride);
        }
    }
    SEAM(2);
    PH(3) {
        for (int it = blockIdx.x * NTHR + F.tid; it < 2 * 2048 * 16; it += F.G * NTHR) {
            const int dq = it & 15, row = (it >> 4) & 2047, kv = it >> 15;
            const bf16_t* hr = HID + ((size_t)kv * 2048 + row) * 256; const float* w2 = args.in[I_CMP_W2] + (size_t)kv * 256 * 64 + dq * 4;
            f32x4 a = (f32x4){0.f, 0.f, 0.f, 0.f};
            for (int j = 0; j < 256; j += 2) { const unsigned hw = *(const unsigned*)(hr + j); a += bflo(hw) * *(const f32x4*)(w2 + (size_t)j * 64); a += bfhi(hw) * *(const f32x4*)(w2 + (size_t)(j + 1) * 64); }
            u32x2 o; o.x = pk2(a.x, a.y); o.y = pk2(a.z, a.w); *(u32x2*)(KVC + ((size_t)kv * 2048 + row) * 64 + dq * 4) = o;
        }
    }
    SEAM(3);
    PH(4) {
        for (int vb = blockIdx.x; vb < 256; vb += F.G) {
            const int bh = vb >> 5, p = vb & 31;
#pragma unroll 1
            for (int k = 0; k < 2; ++k) attn_unit_B(F, P, KVC, O, nullptr, bh >> 1, bh & 1, k == 0 ? 63 - p : p);
#pragma unroll 1
            for (int k = 0; k < 2; ++k) { const int id = 2 * vb + k; attn_unit_A(F, P, O, args.in[I_SINKS], id >> 7, (id >> 6) & 1, id & 63); }
        }
    }
    SEAM(4);
    PH(5) {
        OrderSingle S{(const char*)O, (const char*)W_OUT, DM * 2, DM * 2, 64, 8, 512, F.G, (int)blockIdx.x};
        EpiResH<true> E{args.in[I_X], H};
        pg8::gemm_phase<EpiResH<true>, OrderSingle, false>(ring, DM * 2, 128, DM * 2, DM / 64, S, E);
    }
    SEAM(5);
    PH(6) { for (int m = F.gw; m < M; m += F.NGW) rms_row_to_bf16_h(H + (size_t)m * DM, args.in[I_FFN_NORM], XN + (size_t)m * DM, F.lane); }
    SEAM(6);
    PH(7) {
        OrderSingle S{(const char*)XN, (const char*)FFN13, DM * 2, DM * 2, 64, 2 * DFF / 256, 64 * (2 * DFF / 256), F.G, (int)blockIdx.x};
        EpiSwiglu E{ACT, DFF};
        pg8::gemm_phase<EpiSwiglu, OrderSingle, false>(ring, DM * 2, 128, DM * 2, DM / 64, S, E);
    }
    SEAM(7);
    PH(8) {
        OrderSingle S{(const char*)ACT, (const char*)FFN2, DFF * 2, DFF * 2, 64, 8, 512, F.G, (int)blockIdx.x};
        EpiResH<false> E{H, H};
        pg8::gemm_phase<EpiResH<false>, OrderSingle, false>(ring, DFF * 2, 128, DFF * 2, DFF / 64, S, E);
    }
    SEAM(8);
    PH(9) {
        const float* g = args.in[I_ATTN_NORM] + DM; const float* mu = args.in[I_MU];
        for (int m0 = F.gw * 8; m0 < M; m0 += F.NGW * 8) {
            f32x4 hp[8], vn[8];
            const bool has_prev0 = (m0 % SEQ) != 0;
            if (has_prev0) { float prs; rms_row_load_h(H + (size_t)(m0 - 1) * DM, F.lane, hp, prs);
#pragma unroll
                for (int j = 0; j < 8; ++j) hp[j] = hp[j] * prs * *(const f32x4*)(g + 4 * F.lane + 256 * j);
            } else {
#pragma unroll
                for (int j = 0; j < 8; ++j) hp[j] = (f32x4){0.f, 0.f, 0.f, 0.f};
            }
#pragma unroll
            for (int j = 0; j < 8; ++j) vn[j] = ld4bf(H + (size_t)m0 * DM + 4 * F.lane + 256 * j);
            for (int q = 0; q < 8; ++q) {
                const int m = m0 + q;
                f32x4 v[8]; float ss = 0.f;
#pragma unroll
                for (int j = 0; j < 8; ++j) { v[j] = vn[j]; ss += (v[j].x * v[j].x + v[j].y * v[j].y) + (v[j].z * v[j].z + v[j].w * v[j].w); }
                if (q < 7) {
#pragma unroll
                    for (int j = 0; j < 8; ++j) vn[j] = ld4bf(H + (size_t)(m + 1) * DM + 4 * F.lane + 256 * j);
                }
                const float rs = __builtin_amdgcn_rsqf(scan::wave_sum_dpp(ss) * (1.0f / DM) + RMS_EPS);
                const float* g_ = opqp(g); const float* mu_ = opqp(mu);
#pragma unroll
                for (int j = 0; j < 8; ++j) {
                    const int col = 4 * F.lane + 256 * j; const f32x4 gg = *(const f32x4*)(g_ + col);
                    const f32x4 hn = v[j] * rs * gg; const f32x4 xx = hp[j] - hn; hp[j] = hn;
#pragma unroll
                    for (int i = 0; i < 6; ++i) { const f32x4 mm = *(const f32x4*)(mu_ + (size_t)i * DM + col); const f32x4 y = hn + xx * mm;
                        u32x2 w; w.x = pk2(y.x, y.y); w.y = pk2(y.z, y.w); *(u32x2*)(XS + ((size_t)i * M + m) * DM + col) = w; }
                }
            }
        }
    }
    SEAM(9);
    PH(10) {
        OrderMulti S{};
        for (int g = 0; g < 6; ++g) { S.A[g] = (const char*)(XS + (size_t)g * M * DM); S.Bt[g] = g < 3 ? (const char*)(WRKV + (size_t)g * DM * DM) : (const char*)(LORA1 + (size_t)(g - 3) * 256 * DM); S.nN[g] = g < 3 ? 8 : 1; }
        S.start[0] = 0; for (int g = 0; g < 6; ++g) S.start[g + 1] = S.start[g] + 64 * S.nN[g];
        S.lda = DM * 2; S.ldb = DM * 2; S.ng = 6; S.nwg = S.start[6]; S.G = F.G; S.c = (int)blockIdx.x;
        EpiRkvLora1 E{RKV, L1};
        pg8::gemm_phase<EpiRkvLora1, OrderMulti, false>(ring, DM * 2, 128, DM * 2, DM / 64, S, E);
    }
    SEAM(10);
    PH(11) {
        OrderMulti S{};
        for (int g = 0; g < 3; ++g) { S.A[g] = (const char*)(L1 + (size_t)g * M * 256); S.Bt[g] = (const char*)(LORA2 + (size_t)g * DM * 256); S.nN[g] = 8; }
        for (int g = 3; g < 6; ++g) { S.A[g] = S.A[0]; S.Bt[g] = S.Bt[0]; S.nN[g] = 0; }
        S.start[0] = 0; for (int g = 0; g < 6; ++g) S.start[g + 1] = S.start[g] + 64 * S.nN[g];
        S.lda = 256 * 2; S.ldb = 256 * 2; S.ng = 3; S.nwg = S.start[3]; S.G = F.G; S.c = (int)blockIdx.x;
        EpiLora2 E{DEC, AA, GG, args.in[I_DECAY_W0], args.in[I_A0]};
        pg8::gemm_phase<EpiLora2, OrderMulti, false>(ring, 256 * 2, 128, 256 * 2, 4, S, E);
    }
    SEAM(11);
    PH(12) {
        const unsigned long long pa = phase_scan2(F, RKV, DEC, AA, args.in[I_K_K], args.in[I_K_A], YRAW, args.in[I_MOE_W13], args.in[I_MOE_W2], (unsigned char*)MOE13, (unsigned char*)MOE2);
#ifdef PROBE_SCAN
        if (blockIdx.x == 0 && F.lane == 0 && pa != 0ull) { const unsigned long long t1 = __builtin_amdgcn_s_memrealtime(); while (__builtin_amdgcn_s_memrealtime() - t1 < 4ull * pa) __builtin_amdgcn_s_sleep(8); }
#else
        (void)pa;
#endif
    }
    SEAM(12);
    PH(13) {
        const float* lnw = args.in[I_LN_W]; const float* lnb = args.in[I_LN_B]; const float* rk = args.in[I_R_K]; const float* kaw = args.in[I_K_A];
        for (int m = F.gw; m < M; m += F.NGW) {
#pragma unroll
            for (int ps = 0; ps < 4; ++ps) {
                const int ch = ps * 512 + F.lane * 8; const size_t o = (size_t)m * DM + ch;
                const u32x4 yy = *(const u32x4*)(YRAW + o);
                const u32x4 aa = *(const u32x4*)(AA + o);
                const u32x4 rr = *(const u32x4*)(RKV + o), kk = *(const u32x4*)(RKV + (size_t)M * DM + o), vv = *(const u32x4*)(RKV + (size_t)2 * M * DM + o), gg = *(const u32x4*)(GG + o);
                float y[8] = {bflo(yy.x), bfhi(yy.x), bflo(yy.y), bfhi(yy.y), bflo(yy.z), bfhi(yy.z), bflo(yy.w), bfhi(yy.w)}, a[8] = {bflo(aa.x), bfhi(aa.x), bflo(aa.y), bfhi(aa.y), bflo(aa.z), bfhi(aa.z), bflo(aa.w), bfhi(aa.w)};
                const unsigned rw[4] = {rr.x, rr.y, rr.z, rr.w}, kw[4] = {kk.x, kk.y, kk.z, kk.w}, vw[4] = {vv.x, vv.y, vv.z, vv.w}, gw4[4] = {gg.x, gg.y, gg.z, gg.w};
                float r[8], k[8], v[8], g[8];
#pragma unroll
                for (int i = 0; i < 4; ++i) { r[2 * i] = bflo(rw[i]); r[2 * i + 1] = bfhi(rw[i]); k[2 * i] = bflo(kw[i]); k[2 * i + 1] = bfhi(kw[i]); v[2 * i] = bflo(vw[i]); v[2 * i + 1] = bfhi(vw[i]); g[2 * i] = bflo(gw4[i]); g[2 * i + 1] = bfhi(gw4[i]); }
                float s = 0.f, bs = 0.f;
#pragma unroll
                for (int i = 0; i < 8; ++i) { s += y[i]; bs += r[i] * (k[i] * (1.0f + (a[i] - 1.0f) * kaw[ch + i])) * rk[ch + i]; }
                s += scan::dpp_f<0xB1>(s); s += scan::dpp_f<0x4E>(s); s += scan::dpp_f<0x141>(s);
                bs += scan::dpp_f<0xB1>(bs); bs += scan::dpp_f<0x4E>(bs); bs += scan::dpp_f<0x141>(bs);
                const float mean = s * (1.0f / 64.0f); float q = 0.f;
#pragma unroll
                for (int i = 0; i < 8; ++i) { y[i] -= mean; q += y[i] * y[i]; }
                q += scan::dpp_f<0xB1>(q); q += scan::dpp_f<0x4E>(q); q += scan::dpp_f<0x141>(q);
                const float rstd = 1.0f / sqrtf(q * (1.0f / 64.0f) + GN_EPS);
                float out[8];
#pragma unroll
                for (int i = 0; i < 8; ++i) out[i] = ((y[i] * rstd) * lnw[ch + i] + lnb[ch + i] + bs * v[i]) * g[i];
                u32x4 w; w.x = pk2(out[0], out[1]); w.y = pk2(out[2], out[3]); w.z = pk2(out[4], out[5]); w.w = pk2(out[6], out[7]);
                *(u32x4*)(YG + o) = w;
            }
        }
    }
    SEAM(13);
    PH(14) {
        OrderSingle S{(const char*)YG, (const char*)WO, DM * 2, DM * 2, 64, 8, 512, F.G, (int)blockIdx.x};
        EpiResH<false> E{H, H};
        pg8::gemm_phase<EpiResH<false>, OrderSingle, false>(ring, DM * 2, 128, DM * 2, DM / 64, S, E);
    }
    SEAM(14);
    PH(15) {
        LAS int* t_e = (LAS int*)(F.lds + 65536);
        LAS float* t_w = (LAS float*)(F.lds + 65536 + 512);
        LAS int* t_p = (LAS int*)(F.lds + 65536 + 1024);
        LAS unsigned char* rwl = F.lds;
        const float* g = args.in[I_FFN_NORM] + DM; const float* rw = args.in[I_ROUTER];
        for (int idx = F.tid; idx < 4096; idx += NTHR) {
            const int chn = idx >> 1, half = idx & 1; const int j = chn >> 8, l = (chn & 255) >> 2, e4 = chn & 3;
            *(LAS f32x4*)(rwl + ((2 * (4 * j + e4) + half) * 64 + l) * 16) = *(const f32x4*)(rw + (size_t)idx * 4);
        }
        __syncthreads();
        for (int base = blockIdx.x * 64; base < M; base += F.G * 64) {
            f32x4 vn[8];
#pragma unroll
            for (int j = 0; j < 8; ++j) vn[j] = ld4bf(H + (size_t)(base + F.wave * 8) * DM + 4 * F.lane + 256 * j);
            for (int qq = 0; qq < 8; ++qq) {
                const int lt = F.wave * 8 + qq, m = base + lt;
                f32x4 v[8]; float ss = 0.f;
#pragma unroll
                for (int j = 0; j < 8; ++j) { v[j] = vn[j]; ss += (v[j].x * v[j].x + v[j].y * v[j].y) + (v[j].z * v[j].z + v[j].w * v[j].w); }
                if (qq < 7) {
#pragma unroll
                    for (int j = 0; j < 8; ++j) vn[j] = ld4bf(H + (size_t)(m + 1) * DM + 4 * F.lane + 256 * j);
                }
                const float rs = __builtin_amdgcn_rsqf(scan::wave_sum_dpp(ss) * (1.0f / DM) + RMS_EPS);
                float lg[8] = {0.f, 0.f, 0.f, 0.f, 0.f, 0.f, 0.f, 0.f};
#pragma unroll
                for (int j = 0; j < 8; ++j) {
                    const int col = 4 * F.lane + 256 * j; const f32x4 gg = *(const f32x4*)(g + col); const f32x4 y = v[j] * rs * gg;
                    *(unsigned*)((unsigned char*)XN + (size_t)m * DM + col) = pk4_fp8(y.x, y.y, y.z, y.w);
#pragma unroll
                    for (int e4 = 0; e4 < 4; ++e4) { const f32x4 r0 = *(const LAS f32x4*)(rwl + ((2 * (4 * j + e4)) * 64 + F.lane) * 16), r1 = *(const LAS f32x4*)(rwl + ((2 * (4 * j + e4) + 1) * 64 + F.lane) * 16); const float yy = y[e4];
                        lg[0] += yy * r0.x; lg[1] += yy * r0.y; lg[2] += yy * r0.z; lg[3] += yy * r0.w; lg[4] += yy * r1.x; lg[5] += yy * r1.y; lg[6] += yy * r1.z; lg[7] += yy * r1.w; }
                }
#pragma unroll
                for (int e = 0; e < 8; ++e) lg[e] = scan::wave_sum_dpp(lg[e]);
                if (F.lane == 0) {
                    int i0 = 0; float v0 = lg[0];
#pragma unroll
                    for (int e = 1; e < 8; ++e) if (lg[e] > v0) { v0 = lg[e]; i0 = e; }
                    int i1 = -1; float v1 = -3.0e38f;
#pragma unroll
                    for (int e = 0; e < 8; ++e) if (e != i0 && (i1 < 0 || lg[e] > v1)) { v1 = lg[e]; i1 = e; }
                    const float w1 = 1.0f / (1.0f + expf(v0 - v1)), w0 = 1.0f - w1;
                    t_e[lt * 2] = i0; t_e[lt * 2 + 1] = i1; t_w[lt * 2] = w0; t_w[lt * 2 + 1] = w1;
                }
            }
            __syncthreads();
            if (F.wave == 0) {
                const int lane = F.lane; const int ea = t_e[lane], eb = t_e[64 + lane];
                const unsigned long long below = (1ull << lane) - 1ull;
                int pa = 0, pb = 0, mycnt = 0, ra = 0, rb = 0, na_sel = 0;
#pragma unroll
                for (int e = 0; e < 8; ++e) {
                    const unsigned long long ma = __ballot(ea == e), mb = __ballot(eb == e);
                    const int na = __popcll(ma), nb = __popcll(mb);
                    if (lane == e) mycnt = na + nb;
                    if (ea == e) ra = __popcll(ma & below);
                    if (eb == e) { rb = __popcll(mb & below); na_sel = na; }
                }
                int basep = 0;
                if (lane < 8 && mycnt) basep = (int)__hip_atomic_fetch_add(ctl + CW_MOECNT + 64 * lane, (unsigned)mycnt, RLX_AGENT);
#pragma unroll
                for (int e = 0; e < 8; ++e) { const int be = __builtin_amdgcn_readlane(basep, e); if (ea == e) pa = be + ra; if (eb == e) pb = be + na_sel + rb; }
                t_p[lane] = pa; t_p[64 + lane] = pb;
            }
            __syncthreads();
            if (F.tid < 128) { const int lt = F.tid >> 1, k = F.tid & 1, m = base + lt; const int e = t_e[F.tid], pos = t_p[F.tid];
                ROWTOK[e * M + pos] = m; TOKSLOT[m * 4 + k * 2] = e; TOKSLOT[m * 4 + k * 2 + 1] = pos; ((float*)TOKSLOT)[(size_t)M * 4 + m * 2 + k] = t_w[F.tid]; }
            __syncthreads();
        }
    }
    SEAM(15);
#define MOE_TABLE() do { if (F.tid == 0) { int ts_ = 0; for (int e = 0; e < 8; ++e) { const int ce = (int)__hip_atomic_load(ctl + CW_MOECNT + 64 * e, RLX_AGENT); moetab[16 + e] = ce; moetab[e] = ts_; ts_ += (ce + 255) >> 8; } moetab[8] = ts_; } __syncthreads(); } while (0)
    LAS int* moetab = (LAS int*)(F.lds + MISC_OFF + 256);
    PH(16) {
        MOE_TABLE();
        OrderMoe SM; SM.tab = moetab;
        SM.A = (const char*)XN; SM.Bt = (const char*)MOE13; SM.rowtok = ROWTOK; SM.lda = DM; SM.ldb = DM; SM.bstride = (size_t)2 * DFFE * DM; SM.nN = 2 * DFFE / 256;
        SM.nwg = moetab[8] * SM.nN; SM.G = F.G; SM.c = (int)blockIdx.x; SM.gather = true;
        EpiSwiglu8 E{(unsigned char*)ACT, DFFE};
        pg8::gemm_phase<EpiSwiglu8, OrderMoe, true, true>(ring, DM, 128, DM, DM / 128, SM, E, 0x7f7f7f7f, 0x79797979);
    }
    SEAM(16);
    PH(17) {
        MOE_TABLE();
        OrderMoe SM; SM.tab = moetab;
        SM.A = (const char*)ACT; SM.Bt = (const char*)MOE2; SM.rowtok = ROWTOK; SM.lda = DFFE; SM.ldb = DFFE; SM.bstride = (size_t)DM * DFFE; SM.nN = 8;
        SM.nwg = moetab[8] * SM.nN; SM.G = F.G; SM.c = (int)blockIdx.x; SM.gather = false;
        EpiBf16Out E{(bf16_t*)Y2};
        pg8::gemm_phase<EpiBf16Out, OrderMoe, false, true>(ring, DFFE, 128, DFFE, DFFE / 128, SM, E, 0x7f7f7f7f, 0x78787878);
    }
    SEAM(17);
    PH(18) {
        MOE_TABLE();
        const float* g = args.in[I_FINAL_NORM];
        for (int m = F.gw; m < M; m += F.NGW) {
            const int e0 = TOKSLOT[m * 4], p0 = TOKSLOT[m * 4 + 1], e1 = TOKSLOT[m * 4 + 2], p1 = TOKSLOT[m * 4 + 3];
            const float w0 = ((const float*)TOKSLOT)[(size_t)M * 4 + m * 2], w1 = ((const float*)TOKSLOT)[(size_t)M * 4 + m * 2 + 1];
            const int ts0 = moetab[e0], ts1 = moetab[e1];
            const bf16_t* y0 = (const bf16_t*)Y2 + ((size_t)ts0 * 256 + p0) * DM; const bf16_t* y1 = (const bf16_t*)Y2 + ((size_t)ts1 * 256 + p1) * DM; const bf16_t* hr = H + (size_t)m * DM;
            f32x4 v[8]; float s = 0.f;
#pragma unroll
            for (int j = 0; j < 8; ++j) { const int col = 4 * F.lane + 256 * j; const u32x2 q0 = *(const u32x2*)(y0 + col), q1 = *(const u32x2*)(y1 + col);
                const f32x4 f0 = (f32x4){bflo(q0.x), bfhi(q0.x), bflo(q0.y), bfhi(q0.y)}, f1 = (f32x4){bflo(q1.x), bfhi(q1.x), bflo(q1.y), bfhi(q1.y)};
                v[j] = ld4bf(hr + col) + (w0 * f0 + w1 * f1);
                s += (v[j].x * v[j].x + v[j].y * v[j].y) + (v[j].z * v[j].z + v[j].w * v[j].w); }
            const float rstd = 1.0f / sqrtf(wave_sum(s) * (1.0f / DM) + RMS_EPS);
#pragma unroll
            for (int j = 0; j < 8; ++j) { const int col = 4 * F.lane + 256 * j; *(f32x4*)(args.out + (size_t)m * DM + col) = v[j] * rstd * *(const f32x4*)(g + col); }
        }
    }
    if (PROBE_MASK != 0u && blockIdx.x == 0 && F.tid == 0) { if (PROBE_ON(18)) probe_acc += __builtin_amdgcn_s_memrealtime() - probe_t0; const unsigned long long t1 = __builtin_amdgcn_s_memrealtime(); while (__builtin_amdgcn_s_memrealtime() - t1 < 4ull * probe_acc) __builtin_amdgcn_s_sleep(8); }
#undef IN
#undef SEAM
}

extern "C" void kernel_launch(void* const* d_in, const int* in_sizes, int n_in, void* d_out, int out_size, void* d_ws, size_t ws_size, hipStream_t stream) {
    static int grid = 0;
    if (grid == 0) {
        if (n_in != 33 || out_size != M * DM || ws_size < WS_END) { fprintf(stderr, "kernel_launch: unexpected shapes (n_in %d, out %d, ws %zu < %zu)\n", n_in, out_size, ws_size, (size_t)WS_END); grid = -1; return; }
        int dev = 0, cus = 0, per_cu = 0;
        if (hipGetDevice(&dev) != hipSuccess || hipDeviceGetAttribute(&cus, hipDeviceAttributeMultiprocessorCount, dev) != hipSuccess) { grid = -1; return; }
        if (hipFuncSetAttribute((const void*)mk_fwd, hipFuncAttributeMaxDynamicSharedMemorySize, LDS_BYTES) != hipSuccess) { fprintf(stderr, "kernel_launch: hipFuncSetAttribute failed\n"); grid = -1; return; }
        if (hipOccupancyMaxActiveBlocksPerMultiprocessor(&per_cu, (const void*)mk_fwd, NTHR, LDS_BYTES) != hipSuccess || per_cu < 1) fprintf(stderr, "kernel_launch: occupancy query reports %d\n", per_cu);
        (void)hipGetLastError();
        grid = cus < 256 ? cus : 256;
    }
    if (grid < 0) return;
    if (hipMemsetAsync((char*)d_ws + WS_CTL, 0, CTL_ZERO_BYTES, stream) != hipSuccess) return;
    Args a{};
    for (int i = 0; i < 33; ++i) a.in[i] = (const float*)d_in[i];
    a.out = (float*)d_out; a.ws = (unsigned char*)d_ws; a.pad = 0;
    if (MK_N_LAUNCHES == 1) {
        a.ph_lo = 0; a.ph_hi = NPHASE; a.use_bar = 1;
        hipLaunchKernelGGL(mk_fwd, dim3(grid), dim3(NTHR), LDS_BYTES, stream, a);
    } else {
        for (int p = 0; p < NPHASE; ++p) { a.ph_lo = p; a.ph_hi = p + 1; a.use_bar = 0; hipLaunchKernelGGL(mk_fwd, dim3(grid), dim3(NTHR), LDS_BYTES, stream, a); }
    }
}
```

```cpp
#include <hip/hip_runtime.h>
#include <cstdio>
#include <cstdint>

#define GAS __attribute__((address_space(1)))
#define LAS __attribute__((address_space(3)))
typedef unsigned short bf16_t;
typedef short bf16x8 __attribute__((ext_vector_type(8)));
typedef short s16x4 __attribute__((ext_vector_type(4)));
typedef float f32x4 __attribute__((ext_vector_type(4)));
typedef float f32x2 __attribute__((ext_vector_type(2)));
typedef float f32x16 __attribute__((ext_vector_type(16)));
typedef unsigned u32x4 __attribute__((ext_vector_type(4)));
typedef unsigned u32x2 __attribute__((ext_vector_type(2)));
typedef __bf16 bf16x2_t __attribute__((ext_vector_type(2)));
typedef int i32x8 __attribute__((ext_vector_type(8)));
typedef int i32x4 __attribute__((ext_vector_type(4)));
#define DI __device__ __forceinline__

#ifndef MK_N_LAUNCHES
#define MK_N_LAUNCHES 1
#endif

constexpr int BATCH = 4, SEQ = 4096, DM = 2048, M = BATCH * SEQ;
constexpr int NP = 3328;
constexpr int IN_COLS = 3120;
constexpr int C_QA = 0, C_KA = 1024, C_VA = 1152, C_QB = 1280, C_KCMP = 2304, C_VCMP = 2432, C_KSEL = 2560, C_VSEL = 2688, C_KWIN = 2816, C_VWIN = 2944, C_GATE = 3072;
constexpr int DFF = 5632, DFFE = 7168, NEXP = 8;
constexpr float RMS_EPS = 1e-5f, GN_EPS = 64e-5f;
constexpr float LOG2E = 1.4426950408889634f;
constexpr float QSCALE = 0.125f * LOG2E;
constexpr int NWAVES = 8, NTHR = 512;
constexpr int MOE_ROWS = 2 * M + NEXP * 256;

constexpr size_t MiB = 1u << 20;
constexpr size_t al(size_t x) { return (x + 0xFFFFF) & ~(size_t)0xFFFFF; }
constexpr size_t WS_CTL = 0, CTL_ZERO_BYTES = 1 * MiB;
constexpr size_t WS_W_IN = 1 * MiB;
constexpr size_t WS_W_OUT = WS_W_IN + al((size_t)NP * DM * 2);
constexpr size_t WS_CMPW1 = WS_W_OUT + al((size_t)DM * DM * 2);
constexpr size_t WS_FFN13 = WS_CMPW1 + al((size_t)2 * 256 * 2048 * 2);
constexpr size_t WS_FFN2 = WS_FFN13 + al((size_t)2 * DFF * DM * 2);
constexpr size_t WS_WRKV = WS_FFN2 + al((size_t)DM * DFF * 2);
constexpr size_t WS_LORA1 = WS_WRKV + al((size_t)3 * DM * DM * 2);
constexpr size_t WS_LORA2 = WS_LORA1 + al((size_t)3 * 256 * DM * 2);
constexpr size_t WS_WO = WS_LORA2 + al((size_t)3 * DM * 256 * 2);
constexpr size_t WS_MOE13 = WS_WO + al((size_t)DM * DM * 2);
constexpr size_t WS_MOE2 = WS_MOE13 + al((size_t)NEXP * 2 * DFFE * DM * 2);
constexpr size_t WS_XN = WS_MOE2 + al((size_t)NEXP * DM * DFFE * 2);
constexpr size_t WS_P = WS_XN + al((size_t)M * DM * 2);
constexpr size_t WS_ROPE = WS_P + al((size_t)(M + 64) * NP * 2);
constexpr size_t WS_CMPB = WS_ROPE + al((size_t)M * 64 * 4);
constexpr size_t WS_HID = WS_CMPB + MiB;
constexpr size_t WS_KVC = WS_HID + al((size_t)2 * 2048 * 256 * 2);
constexpr size_t WS_O = WS_KVC + al((size_t)2 * 2048 * 64 * 2);
constexpr size_t WS_H = WS_O + al((size_t)M * DM * 2);
constexpr size_t WS_ACT = WS_H + al((size_t)M * DM * 4);
constexpr size_t WS_XS = WS_ACT + al((size_t)MOE_ROWS * DFFE * 2);
constexpr size_t WS_RKV = WS_XS + al((size_t)6 * M * DM * 2);
constexpr size_t WS_L1 = WS_RKV + al((size_t)3 * M * DM * 2);
constexpr size_t WS_DEC = WS_L1 + al((size_t)3 * M * 256 * 2);
constexpr size_t WS_AA = WS_DEC + al((size_t)M * DM * 4);
constexpr size_t WS_GG = WS_AA + al((size_t)M * DM * 4);
constexpr size_t WS_YRAW = WS_GG + al((size_t)M * DM * 2);
constexpr size_t WS_YG = WS_YRAW + al((size_t)M * DM * 4);
constexpr size_t WS_ROWTOK = WS_YG + al((size_t)M * DM * 2);
constexpr size_t WS_TOKSLOT = WS_ROWTOK + al((size_t)NEXP * M * 4);
constexpr size_t WS_Y2 = WS_TOKSLOT + al((size_t)M * 16);
constexpr size_t WS_END = WS_Y2 + al((size_t)MOE_ROWS * DM * 4);
constexpr int CW_BAR = 0;
constexpr int CW_MOECNT = 4096;

constexpr int RING_BYTES = 131072, LDSCTL_OFF = 135168, MISC_OFF = LDSCTL_OFF + 320, LDS_BYTES = 147456;

#define RLX_AGENT __ATOMIC_RELAXED, __HIP_MEMORY_SCOPE_AGENT
DI unsigned f2bf(float f) { unsigned u = __builtin_bit_cast(unsigned, f); return (u + 0x7fffu + ((u >> 16) & 1u)) >> 16; }
DI unsigned pk2(float lo, float hi) { f32x2 v = {lo, hi}; bf16x2_t b = __builtin_convertvector(v, bf16x2_t); return __builtin_bit_cast(unsigned, b); }
DI unsigned pk4_fp8(float a, float b, float c, float d) { int p = __builtin_amdgcn_cvt_pk_fp8_f32(a, b, 0, false); p = __builtin_amdgcn_cvt_pk_fp8_f32(c, d, p, true); return (unsigned)p; }
DI float bf2f(unsigned short b) { return __builtin_bit_cast(float, ((unsigned)b) << 16); }
DI float bflo(unsigned w) { return __builtin_bit_cast(float, w << 16); }
DI float bfhi(unsigned w) { return __builtin_bit_cast(float, w & 0xffff0000u); }
DI float wave_sum(float v) {
#pragma unroll
    for (int o = 1; o < 64; o <<= 1) v += __shfl_xor(v, o);
    return v;
}
DI int opq(int x) { asm volatile("" : "+v"(x)); return x; }
DI const float* opqp(const float* p) { asm volatile("" : "+s"(p)); return p; }
DI float ex2(float x) { return __builtin_amdgcn_exp2f(x); }
DI float sigmoidf_(float x) { return __builtin_amdgcn_rcpf(1.0f + __expf(-x)); }
DI float siluf_(float x) { return x * __builtin_amdgcn_rcpf(1.0f + __expf(-x)); }
DI float tanhf_(float x) { return 1.0f - 2.0f * __builtin_amdgcn_rcpf(__expf(2.0f * x) + 1.0f); }

#define XB_TMO      128
#define XB_XCNT(j)  (256  + 64 * (j))
#define XB_XSUB(j)  (1280 + 64 * (j))
#define XB_XGEN(j)  (2304 + 64 * (j))
#define XB_TOP      3328
#define XB_TOPGEN   3392
#define XCD_BAR_WORDS 3456
#define XB_SPIN_CAP (1u << 22)
DI unsigned xb_ld(unsigned* p)              { return __hip_atomic_load(p, __ATOMIC_RELAXED, __HIP_MEMORY_SCOPE_AGENT); }
DI unsigned xb_add(unsigned* p, unsigned v) { return __hip_atomic_fetch_add(p, v, __ATOMIC_RELAXED, __HIP_MEMORY_SCOPE_AGENT); }
DI unsigned xb_xcc_id() { return (unsigned)__builtin_amdgcn_s_getreg((3 << 11) | 20) & 0xFu; }
#define XB_SPIN(cond, bar) do { unsigned _sp = 0; while (cond) { __builtin_amdgcn_s_sleep(1); \
    if ((++_sp & 255u) == 0u) { if (xb_ld(&(bar)[XB_TMO])) break; if (_sp > XB_SPIN_CAP) { atomicAdd(&(bar)[XB_TMO], 1u); break; } } } } while (0)
struct XcdBarrier { unsigned* bar; unsigned x; volatile LAS unsigned* st; };
DI XcdBarrier xcd_barrier_post(unsigned* bar, volatile LAS unsigned* st) {
    XcdBarrier b; b.bar = bar; b.x = xb_xcc_id(); b.st = st;
    if (threadIdx.x == 0) (void)xb_add(&bar[XB_XCNT(b.x)], 1u);
    return b;
}
DI void xcd_barrier_complete(unsigned* bar, unsigned x, unsigned& nloc, unsigned& nx) {
    const unsigned G = gridDim.x * gridDim.y * gridDim.z;
    unsigned sum, cnt, mine, sp = 0u;
    for (;;) {
        sum = 0u; cnt = 0u; mine = 0u;
#pragma unroll
        for (unsigned j = 0; j < 16; ++j) { const unsigned c = xb_ld(&bar[XB_XCNT(j)]); sum += c; cnt += (c > 0u) ? 1u : 0u; mine = (j == x) ? c : mine; }
        if (sum == G) break;
        __builtin_amdgcn_s_sleep(1);
        if ((++sp & 255u) == 0u) { if (xb_ld(&bar[XB_TMO])) break; if (sp > XB_SPIN_CAP) { atomicAdd(&bar[XB_TMO], 1u); break; } }
    }
    nloc = mine > 0u ? mine : 1u; nx = cnt > 0u ? cnt : 1u;
}
DI void xcd_barrier(const XcdBarrier& b) {
    asm volatile("s_waitcnt vmcnt(0)" ::: "memory");
    __syncthreads();
    if (threadIdx.x == 0) {
        unsigned* bar = b.bar;
        __builtin_amdgcn_s_waitcnt(0);
        unsigned nloc = b.st[0], nx = b.st[1];
        if (nloc == 0u) { xcd_barrier_complete(bar, b.x, nloc, nx); b.st[0] = nloc; b.st[1] = nx; }
        const unsigned old = xb_add(&bar[XB_XSUB(b.x)], 1u);
        const unsigned gen = old / nloc;
        if (old + 1u == (gen + 1u) * nloc) {
            __builtin_amdgcn_fence(__ATOMIC_RELEASE, "agent");
            asm volatile("s_waitcnt vmcnt(0)" ::: "memory");
            const unsigned og = xb_add(&bar[XB_TOP], 1u);
            const unsigned tg = og / nx;
            if (og + 1u == (tg + 1u) * nx) xb_add(&bar[XB_TOPGEN], 1u);
            else XB_SPIN(xb_ld(&bar[XB_TOPGEN]) == tg, bar);
            __builtin_amdgcn_fence(__ATOMIC_ACQUIRE, "agent");
            xb_add(&bar[XB_XGEN(b.x)], 1u);
            asm volatile("s_waitcnt vmcnt(0)" ::: "memory");
        } else {
            XB_SPIN(xb_ld(&bar[XB_XGEN(b.x)]) == gen, bar);
            __builtin_amdgcn_fence(__ATOMIC_ACQUIRE, "agent");
            asm volatile("s_waitcnt vmcnt(0)" ::: "memory");
        }
    }
    __syncthreads();
}

namespace pg8 {
constexpr int BM = 256, BK = 64, HALF = 128, HTB = HALF * BK * 2, STAGE_BYTES = 8 * HTB, NXCD = 8, WGM = 4;
__host__ __device__ __forceinline__ int lds_byte(int r, int c) { const int st = (r >> 4) * 2 + (c >> 5), rr = r & 15, cc = c & 31, ob = rr * 64 + cc * 2; return st * 1024 + (ob ^ (((ob >> 9) & 1) << 5)); }
__host__ __device__ __forceinline__ void stage_rc(int b, int& R, int& C) { const int st = b / 1024, sb = b % 1024, swz = sb ^ (((sb >> 9) & 1) << 5); R = (st >> 1) * 16 + swz / 64; C = (st & 1) * 32 + (swz % 64) / 2; }
__host__ __device__ __forceinline__ int perm32(int rho) { const int n = rho >> 4, i = rho & 15; return 8 * (i >> 2) + 4 * n + (i & 3); }

struct Unit { const char* a; const char* b; int pm, pn, g; unsigned ka; };

DI int xcd_remap(int L, int nwg) { const int q = nwg / NXCD, r = nwg % NXCD, xcd = L % NXCD, off = L / NXCD; return (xcd < r ? xcd * (q + 1) : r * (q + 1) + (xcd - r) * q) + off; }
DI void tile_map(int idx, int nM, int nN, int& pm, int& pn) { const int nig = WGM * nN, gid = idx / nig, fm = gid * WGM, gsz = (nM - fm) < WGM ? (nM - fm) : WGM; pm = fm + ((idx % nig) % gsz); pn = (idx % nig) / gsz; }

template <class Epi, class Sched, bool GATHER, bool FP8 = false>
DI void gemm_phase(LAS unsigned char* lds, const unsigned lda, const unsigned ka, const unsigned ldb, const int nt, const Sched& S, const Epi& E, const int scaleA = 0x7f7f7f7f, const int scaleB = 0x7f7f7f7f) {
    const int tid = threadIdx.x, wid = __builtin_amdgcn_readfirstlane(tid >> 6), lane = tid & 63, wr = wid >> 2, wc = wid & 3, fr = lane & 15, fq = lane >> 4;
    int Rr[2], Cc[2];
    unsigned vB[2], vA[2][2], vN[2][2];
#pragma unroll
    for (int i = 0; i < 2; ++i) { stage_rc(tid * 16 + i * 8192, Rr[i], Cc[i]); const int Rb = (Rr[i] & ~31) + perm32(Rr[i] & 31); vB[i] = (unsigned)Rb * ldb + (unsigned)Cc[i] * 2u; }
    const size_t kb = (size_t)(BK * 2);
    const size_t hB = (size_t)HALF * ldb;
    const unsigned ldsw = (unsigned)wid * 1024u;
    const int aoff = lds_byte(wr * 64 + fr, fq * 8), boff = lds_byte(wc * 32 + fr, fq * 8);
#define PG8_SA(b, h) (((b) * 2 + (h)) * HTB)
#define PG8_SB(b, h) ((4 + (b) * 2 + (h)) * HTB)
#define PG8_STAGE(bufoff, gbase, v0, v1) do { \
        __builtin_amdgcn_global_load_lds((const unsigned*)((const char*)(gbase) + (v0)), (LAS unsigned*)(lds + (bufoff) + ldsw), 16, 0, 0); \
        __builtin_amdgcn_global_load_lds((const unsigned*)((const char*)(gbase) + (v1)), (LAS unsigned*)(lds + (bufoff) + ldsw + 8192), 16, 0, 0); } while (0)
#define PG8_LDA(dst, b, h) do { _Pragma("unroll") for (int m = 0; m < 4; ++m) { const i32x4 f0_ = *(const LAS i32x4*)(lds + PG8_SA(b, h) + aoff + m * 2048), f1_ = *(const LAS i32x4*)(lds + PG8_SA(b, h) + aoff + m * 2048 + 1024); \
        dst[m] = __builtin_shufflevector(f0_, f1_, 0, 1, 2, 3, 4, 5, 6, 7); } } while (0)
#define PG8_LDB(dst, b, h) do { _Pragma("unroll") for (int n = 0; n < 2; ++n) { const i32x4 f0_ = *(const LAS i32x4*)(lds + PG8_SB(b, h) + boff + n * 2048), f1_ = *(const LAS i32x4*)(lds + PG8_SB(b, h) + boff + n * 2048 + 1024); \
        dst[n] = __builtin_shufflevector(f0_, f1_, 0, 1, 2, 3, 4, 5, 6, 7); } } while (0)
#define PG8_MMA(ai, bj, At, Bt) do { __builtin_amdgcn_s_setprio(1); \
        if constexpr (FP8) { _Pragma("unroll") for (int m = 0; m < 4; ++m) _Pragma("unroll") for (int n = 0; n < 2; ++n) \
            asm volatile("v_mfma_scale_f32_16x16x128_f8f6f4 %0, %1, %2, %0, %3, %4 op_sel_hi:[0,0,0]" : "+v"(acc[ai][bj][m][n]) : "v"(Bt[n]), "v"(At[m]), "v"(scaleB), "v"(scaleA)); } \
        else { _Pragma("unroll") for (int m = 0; m < 4; ++m) _Pragma("unroll") for (int n = 0; n < 2; ++n) { \
            acc[ai][bj][m][n] = __builtin_amdgcn_mfma_f32_16x16x32_bf16(__builtin_bit_cast(bf16x8, __builtin_shufflevector(Bt[n], Bt[n], 0, 1, 2, 3)), __builtin_bit_cast(bf16x8, __builtin_shufflevector(At[m], At[m], 0, 1, 2, 3)), acc[ai][bj][m][n], 0, 0, 0); \
            acc[ai][bj][m][n] = __builtin_amdgcn_mfma_f32_16x16x32_bf16(__builtin_bit_cast(bf16x8, __builtin_shufflevector(Bt[n], Bt[n], 4, 5, 6, 7)), __builtin_bit_cast(bf16x8, __builtin_shufflevector(At[m], At[m], 4, 5, 6, 7)), acc[ai][bj][m][n], 0, 0, 0); } } __builtin_amdgcn_s_setprio(0); } while (0)
#define PG8_WAIT_V(n) asm volatile("s_waitcnt vmcnt(" #n ")" ::: "memory")
#define PG8_WAIT_L(n) asm volatile("s_waitcnt lgkmcnt(" #n ")" ::: "memory")
#define PG8_BAR __builtin_amdgcn_s_barrier()
#define PG8_SCHED __builtin_amdgcn_sched_barrier(0)
    Unit cur, nxt; int ui = 0;
    if (!S.next(0, cur)) return;
#pragma unroll
    for (int h = 0; h < 2; ++h)
#pragma unroll
        for (int i = 0; i < 2; ++i) {
            if constexpr (GATHER) vA[h][i] = S.rowoff(cur, h * HALF + Rr[i]) + (unsigned)Cc[i] * 2u;
            else vA[h][i] = (unsigned)(h * HALF + Rr[i]) * lda + (unsigned)Cc[i] * 2u;
            vN[h][i] = vA[h][i];
        }
    f32x4 acc[2][2][4][2];
#pragma unroll
    for (int a = 0; a < 2; ++a)
#pragma unroll
        for (int b = 0; b < 2; ++b)
#pragma unroll
            for (int m = 0; m < 4; ++m)
#pragma unroll
                for (int n = 0; n < 2; ++n) acc[a][b][m][n] = (f32x4){0.f, 0.f, 0.f, 0.f};
    i32x8 At[4], B0[2], B1[2];
    const char* cA = cur.a; const char* cB = cur.b;
    PG8_STAGE(PG8_SB(0, 0), cB, vB[0], vB[1]); PG8_STAGE(PG8_SB(0, 1), cB + hB, vB[0], vB[1]); PG8_STAGE(PG8_SA(0, 0), cA, vA[0][0], vA[0][1]); PG8_STAGE(PG8_SA(0, 1), cA, vA[1][0], vA[1][1]);
    if (wr == 1) PG8_BAR;
    PG8_WAIT_V(2); PG8_BAR;
    PG8_STAGE(PG8_SB(1, 0), cB + kb, vB[0], vB[1]); PG8_STAGE(PG8_SA(1, 0), cA + cur.ka, vA[0][0], vA[0][1]); PG8_STAGE(PG8_SB(1, 1), cB + hB + kb, vB[0], vB[1]);
    PG8_WAIT_V(6); PG8_BAR;
    for (;;) {
        const bool has_next = S.next(ui + 1, nxt);
        const char* nA = has_next ? nxt.a : cA; const char* nB = has_next ? nxt.b : cB; const unsigned nka = has_next ? nxt.ka : cur.ka;
        if constexpr (GATHER) {
            if (has_next) {
#pragma unroll
                for (int h = 0; h < 2; ++h)
#pragma unroll
                    for (int i = 0; i < 2; ++i) vN[h][i] = S.rowoff(nxt, h * HALF + Rr[i]) + (unsigned)Cc[i] * 2u;
            }
        }
        for (int t = 0; t < nt; t += 2) {
            const bool last = (t == nt - 2);
            const char* a1 = cA + (size_t)(t + 1) * cur.ka;
            const char* a2 = last ? nA : cA + (size_t)(t + 2) * cur.ka; const char* b2 = last ? nB : cB + (size_t)(t + 2) * kb;
            const char* a3 = a2 + (last ? nka : cur.ka); const char* b3 = b2 + kb;
            unsigned x00 = vA[0][0], x01 = vA[0][1], x10 = vA[1][0], x11 = vA[1][1];
            if constexpr (GATHER) { if (last) { x00 = vN[0][0]; x01 = vN[0][1]; x10 = vN[1][0]; x11 = vN[1][1]; } }
            PG8_LDB(B0, 0, 0); PG8_LDB(B1, 0, 1); PG8_SCHED; PG8_LDA(At, 0, 0); PG8_STAGE(PG8_SA(1, 1), a1, vA[1][0], vA[1][1]);
            PG8_WAIT_V(8); PG8_WAIT_L(0); PG8_BAR; PG8_MMA(0, 0, At, B0); PG8_MMA(0, 1, At, B1); PG8_BAR; PG8_SCHED;
            PG8_LDA(At, 0, 1); PG8_STAGE(PG8_SB(0, 0), b2, vB[0], vB[1]); PG8_STAGE(PG8_SB(0, 1), b2 + hB, vB[0], vB[1]); PG8_STAGE(PG8_SA(0, 0), a2, x00, x01);
            PG8_WAIT_V(8); PG8_WAIT_L(0); PG8_BAR; PG8_MMA(1, 0, At, B0); PG8_MMA(1, 1, At, B1); PG8_BAR; PG8_SCHED;
            PG8_LDB(B0, 1, 0); PG8_LDB(B1, 1, 1); PG8_SCHED; PG8_LDA(At, 1, 0); PG8_STAGE(PG8_SA(0, 1), a2, x10, x11);
            PG8_WAIT_V(8); PG8_WAIT_L(0); PG8_BAR; PG8_MMA(0, 0, At, B0); PG8_MMA(0, 1, At, B1); PG8_BAR; PG8_SCHED;
            PG8_LDA(At, 1, 1); PG8_STAGE(PG8_SB(1, 0), b3, vB[0], vB[1]); PG8_STAGE(PG8_SB(1, 1), b3 + hB, vB[0], vB[1]); PG8_STAGE(PG8_SA(1, 0), a3, x00, x01);
            PG8_WAIT_V(8); PG8_WAIT_L(0); PG8_BAR; PG8_MMA(1, 0, At, B0); PG8_MMA(1, 1, At, B1); PG8_BAR; PG8_SCHED;
        }
        if (wr == 0) PG8_BAR;
        if constexpr (FP8) asm volatile("s_nop 15\n\ts_nop 15" ::: "memory");
        E(acc, cur, wr, wc, fr, fq);
        if (!has_next) break;
#pragma unroll
        for (int a = 0; a < 2; ++a)
#pragma unroll
            for (int b = 0; b < 2; ++b)
#pragma unroll
                for (int m = 0; m < 4; ++m)
#pragma unroll
                    for (int n = 0; n < 2; ++n) acc[a][b][m][n] = (f32x4){0.f, 0.f, 0.f, 0.f};
        cur = nxt; cA = nA; cB = nB; ++ui;
        if constexpr (GATHER) {
#pragma unroll
            for (int h = 0; h < 2; ++h)
#pragma unroll
                for (int i = 0; i < 2; ++i) vA[h][i] = vN[h][i];
        }
        if (wr == 1) PG8_BAR;
    }
    PG8_WAIT_V(0);
    PG8_BAR;
#undef PG8_SA
#undef PG8_SB
#undef PG8_STAGE
#undef PG8_LDA
#undef PG8_LDB
#undef PG8_MMA
#undef PG8_WAIT_V
#undef PG8_WAIT_L
#undef PG8_BAR
#undef PG8_SCHED
}
}

typedef f32x4 AccT[2][2][4][2];
DI void st_bf16x8(bf16_t* p, f32x4 v0, f32x4 v1) { u32x4 w; w.x = pk2(v0[0], v0[1]); w.y = pk2(v0[2], v0[3]); w.z = pk2(v1[0], v1[1]); w.w = pk2(v1[2], v1[3]); *(u32x4*)p = w; }

struct OrderSingle {
    const char* A; const char* Bt; unsigned lda, ldb; int nM, nN, nwg, G, c;
    DI bool next(int i, pg8::Unit& u) const {
        const long L = (long)i * G + c; if (L >= nwg) return false;
        const int w = pg8::xcd_remap((int)L, nwg); int pm, pn; pg8::tile_map(w, nM, nN, pm, pn);
        u.pm = pm; u.pn = pn; u.g = 0; u.ka = 128u; u.a = A + (size_t)pm * 256 * lda; u.b = Bt + (size_t)pn * 256 * ldb; return true;
    }
    DI unsigned rowoff(const pg8::Unit&, int) const { return 0u; }
};
struct OrderMulti {
    const char* A[6]; const char* Bt[6]; int nN[6]; int start[7]; unsigned lda, ldb; int ng, nwg, G, c;
    DI bool next(int i, pg8::Unit& u) const {
        const long L = (long)i * G + c; if (L >= nwg) return false;
        const int w = pg8::xcd_remap((int)L, nwg);
        int g = 0; const char* a = A[0]; const char* b = Bt[0]; int nn = nN[0], st = start[0];
#pragma unroll
        for (int k = 1; k < 6; ++k) if (k < ng && w >= start[k]) { g = k; a = A[k]; b = Bt[k]; nn = nN[k]; st = start[k]; }
        int pm, pn; pg8::tile_map(w - st, 64, nn, pm, pn);
        u.pm = pm; u.pn = pn; u.g = g; u.ka = 128u; u.a = a + (size_t)pm * 256 * lda; u.b = b + (size_t)pn * 256 * ldb; return true;
    }
    DI unsigned rowoff(const pg8::Unit&, int) const { return 0u; }
};
struct OrderCmp {
    const char* P; const char* Bt; const char* XNp; const char* Wg; int G, c;
    DI bool next(int i, pg8::Unit& u) const {
        const int L = i * G + c; if (L >= 80) return false;
        if (L < 16) { const int kv = L >> 3, bh = L & 7, b = bh >> 1, h = bh & 1;
            u.pm = bh; u.pn = 0; u.g = kv; u.ka = (unsigned)(NP * 2);
            u.a = P + ((size_t)b * SEQ * NP + (size_t)(C_KCMP + kv * 128 + h * 64)) * 2;
            u.b = Bt + (size_t)kv * 256 * 2048 * 2; }
        else { const int pm = L - 16; u.pm = pm; u.pn = 12; u.g = 2; u.ka = 128u; u.a = XNp + (size_t)pm * 256 * DM * 2; u.b = Wg; }
        return true;
    }
    DI unsigned rowoff(const pg8::Unit& u, int row) const { return (unsigned)row * (u.g == 2 ? (unsigned)(DM * 2) : (unsigned)(16 * NP * 2)); }
};
struct OrderMoe {
    const char* A; const char* Bt; const int* rowtok; const LAS int* tab; unsigned lda, ldb; size_t bstride; int nN, nwg, G, c; bool gather;
    DI bool next(int i, pg8::Unit& u) const {
        const long L = (long)i * G + c; if (L >= nwg) return false;
        const int w = (int)L;
        const int tau = w / nN, pn = w % nN;
        int e = 0;
#pragma unroll
        for (int k = 1; k < 8; ++k) if (tau >= tab[k]) e = k;
        u.pm = tau; u.pn = pn; u.g = e; u.ka = 128u;
        u.a = gather ? A : A + (size_t)tau * 256 * lda;
        u.b = Bt + (size_t)e * bstride + (size_t)pn * 256 * ldb; return true;
    }
    DI unsigned rowoff(const pg8::Unit& u, int row) const {
        const int e = u.g; const int ce = tab[16 + e], ts = tab[e];
        const int pos = (u.pm - ts) * 256 + row;
        const int tok = pos < ce ? rowtok[e * M + pos] : 0;
        return (unsigned)tok * lda;
    }
};

struct EpiInProj {
    bf16_t* P; const float* rope;
    DI void operator()(const AccT& acc, const pg8::Unit& u, int wr, int wc, int fr, int fq) const {
        const int row0 = u.pm * 256 + wr * 64 + fr;
#pragma unroll
        for (int bj = 0; bj < 2; ++bj) {
            const int cb = u.pn * 256 + bj * 128;
            const int col0 = cb + wc * 32 + 8 * fq;
            const bool do_rope = cb < C_VA;
            const float sc = (cb < C_KA || (cb >= C_QB && cb < C_KCMP)) ? QSCALE : 1.0f;
            const int uidx = 4 * (wc & 1) + fq;
#pragma unroll
            for (int ai = 0; ai < 2; ++ai)
#pragma unroll
                for (int m = 0; m < 4; ++m) {
                    const int row = row0 + ai * 128 + m * 16;
                    f32x4 v0 = acc[ai][bj][m][0], v1 = acc[ai][bj][m][1];
                    if (do_rope) {
                        const f32x4 cs = *(const f32x4*)(rope + (size_t)row * 64 + 4 * uidx), sn = *(const f32x4*)(rope + (size_t)row * 64 + 32 + 4 * uidx);
                        const f32x4 o0 = v0 * cs - v1 * sn, o1 = v1 * cs + v0 * sn; v0 = o0; v1 = o1;
                    }
                    v0 = v0 * sc; v1 = v1 * sc;
                    st_bf16x8(P + (size_t)row * NP + col0, v0, v1);
                }
        }
    }
};
struct EpiCmp1 {
    bf16_t* HID; const float* bias; bf16_t* P;
    DI void operator()(const AccT& acc, const pg8::Unit& u, int wr, int wc, int fr, int fq) const {
        const int row0 = wr * 64 + fr;
        if (u.g == 2) {
#pragma unroll
            for (int bj = 0; bj < 2; ++bj)
#pragma unroll
                for (int ai = 0; ai < 2; ++ai)
#pragma unroll
                    for (int m = 0; m < 4; ++m) st_bf16x8(P + (size_t)(u.pm * 256 + row0 + ai * 128 + m * 16) * NP + C_GATE + bj * 128 + wc * 32 + 8 * fq, acc[ai][bj][m][0], acc[ai][bj][m][1]);
            return;
        }
#pragma unroll
        for (int bj = 0; bj < 2; ++bj) {
            const int col0 = bj * 128 + wc * 32 + 8 * fq;
            const f32x4 b0 = *(const f32x4*)(bias + u.g * 256 + col0), b1 = *(const f32x4*)(bias + u.g * 256 + col0 + 4);
#pragma unroll
            for (int ai = 0; ai < 2; ++ai)
#pragma unroll
                for (int m = 0; m < 4; ++m) {
                    const int row = row0 + ai * 128 + m * 16;
                    f32x4 v0 = acc[ai][bj][m][0] + b0, v1 = acc[ai][bj][m][1] + b1;
#pragma unroll
                    for (int j = 0; j < 4; ++j) { v0[j] = siluf_(v0[j]); v1[j] = siluf_(v1[j]); }
                    st_bf16x8(HID + ((size_t)(u.g * 2048 + u.pm * 256 + row)) * 256 + col0, v0, v1);
                }
        }
    }
};
template <bool RESF32>
struct EpiResH {
    const void* res; bf16_t* out;
    DI void operator()(const AccT& acc, const pg8::Unit& u, int wr, int wc, int fr_, int fq_) const {
        const int fr = opq(fr_), fq = opq(fq_);
        const int row0 = u.pm * 256 + wr * 64 + fr;
#pragma unroll
        for (int ai = 0; ai < 2; ++ai) {
            f32x4 r[4][2][2];
#pragma unroll
            for (int m = 0; m < 4; ++m) { const size_t ro = (size_t)(row0 + ai * 128 + m * 16) * DM;
#pragma unroll
                for (int bj = 0; bj < 2; ++bj) { const int col0 = u.pn * 256 + bj * 128 + wc * 32 + 8 * fq;
                    if (RESF32) { r[m][bj][0] = *(const f32x4*)((const float*)res + ro + col0); r[m][bj][1] = *(const f32x4*)((const float*)res + ro + col0 + 4); }
                    else { const u32x4 q = *(const u32x4*)((const bf16_t*)res + ro + col0); r[m][bj][0] = (f32x4){bflo(q.x), bfhi(q.x), bflo(q.y), bfhi(q.y)}; r[m][bj][1] = (f32x4){bflo(q.z), bfhi(q.z), bflo(q.w), bfhi(q.w)}; } } }
            asm volatile("s_waitcnt vmcnt(0)" ::: "memory");
#pragma unroll
            for (int m = 0; m < 4; ++m) { const size_t ro = (size_t)(row0 + ai * 128 + m * 16) * DM;
#pragma unroll
                for (int bj = 0; bj < 2; ++bj) { const int col0 = u.pn * 256 + bj * 128 + wc * 32 + 8 * fq;
                    st_bf16x8(out + ro + col0, r[m][bj][0] + acc[ai][bj][m][0], r[m][bj][1] + acc[ai][bj][m][1]); } }
        }
    }
};
struct EpiSwiglu {
    bf16_t* ACT; int ldc;
    DI void operator()(const AccT& acc, const pg8::Unit& u, int wr, int wc, int fr, int fq) const {
        const int row0 = u.pm * 256 + wr * 64 + fr; const int col0 = u.pn * 128 + wc * 32 + 8 * fq;
#pragma unroll
        for (int ai = 0; ai < 2; ++ai)
#pragma unroll
            for (int m = 0; m < 4; ++m) {
                f32x4 v0, v1;
#pragma unroll
                for (int j = 0; j < 4; ++j) { v0[j] = siluf_(acc[ai][0][m][0][j]) * acc[ai][1][m][0][j]; v1[j] = siluf_(acc[ai][0][m][1][j]) * acc[ai][1][m][1][j]; }
                st_bf16x8(ACT + (size_t)(row0 + ai * 128 + m * 16) * ldc + col0, v0, v1);
            }
    }
};
struct EpiSwiglu8 {
    unsigned char* ACT; int ldc;
    DI void operator()(const AccT& acc, const pg8::Unit& u, int wr, int wc, int fr, int fq) const {
        const int row0 = u.pm * 256 + wr * 64 + fr; const int col0 = u.pn * 128 + wc * 32 + 8 * fq;
#pragma unroll
        for (int ai = 0; ai < 2; ++ai)
#pragma unroll
            for (int m = 0; m < 4; ++m) {
                f32x4 v0, v1;
#pragma unroll
                for (int j = 0; j < 4; ++j) { v0[j] = siluf_(acc[ai][0][m][0][j]) * acc[ai][1][m][0][j]; v1[j] = siluf_(acc[ai][0][m][1][j]) * acc[ai][1][m][1][j]; }
                u32x2 o; o.x = pk4_fp8(v0[0], v0[1], v0[2], v0[3]); o.y = pk4_fp8(v1[0], v1[1], v1[2], v1[3]);
                *(u32x2*)(ACT + (size_t)(row0 + ai * 128 + m * 16) * ldc + col0) = o;
            }
    }
};
struct EpiRkvLora1 {
    bf16_t* RKV; bf16_t* L1;
    DI void operator()(const AccT& acc, const pg8::Unit& u, int wr, int wc, int fr, int fq) const {
        const int row0 = u.pm * 256 + wr * 64 + fr; const int g = u.g;
        bf16_t* base = g < 3 ? RKV + (size_t)g * M * DM : L1 + (size_t)(g - 3) * M * 256;
        const int ldc = g < 3 ? DM : 256;
#pragma unroll
        for (int ai = 0; ai < 2; ++ai)
#pragma unroll
            for (int m = 0; m < 4; ++m)
#pragma unroll
                for (int bj = 0; bj < 2; ++bj) {
                    const int col0 = u.pn * 256 + bj * 128 + wc * 32 + 8 * fq;
                    f32x4 v0 = acc[ai][bj][m][0], v1 = acc[ai][bj][m][1];
                    if (g == 3) {
#pragma unroll
                        for (int j = 0; j < 4; ++j) { v0[j] = tanhf_(v0[j]); v1[j] = tanhf_(v1[j]); }
                    } else if (g == 5) {
#pragma unroll
                        for (int j = 0; j < 4; ++j) { v0[j] = sigmoidf_(v0[j]); v1[j] = sigmoidf_(v1[j]); }
                    }
                    st_bf16x8(base + (size_t)(row0 + ai * 128 + m * 16) * ldc + col0, v0, v1);
                }
    }
};
struct EpiLora2 {
    float* DEC; bf16_t* AA; bf16_t* GG; const float* w0; const float* a0;
    DI void operator()(const AccT& acc, const pg8::Unit& u, int wr, int wc, int fr_, int fq_) const {
        const int fr = opq(fr_), fq = opq(fq_);
        const int row0 = u.pm * 256 + wr * 64 + fr; const int g = u.g;
        const float* cvec = g == 0 ? w0 : a0;
#pragma unroll
        for (int bj = 0; bj < 2; ++bj) {
            const int col0 = u.pn * 256 + bj * 128 + wc * 32 + 8 * fq;
            f32x4 c0 = (f32x4){0.f, 0.f, 0.f, 0.f}, c1 = c0;
            if (g < 2) { c0 = *(const f32x4*)(cvec + col0); c1 = *(const f32x4*)(cvec + col0 + 4); }
#pragma unroll
            for (int ai = 0; ai < 2; ++ai)
#pragma unroll
                for (int m = 0; m < 4; ++m) {
                    const size_t ro = (size_t)(row0 + ai * 128 + m * 16) * DM + col0;
                    f32x4 v0 = acc[ai][bj][m][0] + c0, v1 = acc[ai][bj][m][1] + c1;
                    if (g < 2) {
#pragma unroll
                        for (int j = 0; j < 4; ++j) { v0[j] = sigmoidf_(v0[j]); v1[j] = sigmoidf_(v1[j]); }
                        if (g == 0) {
#pragma unroll
                            for (int j = 0; j < 4; ++j) { v0[j] = __expf(-0.60653065971f * v0[j]); v1[j] = __expf(-0.60653065971f * v1[j]); }
                            *(f32x4*)(DEC + ro) = v0; *(f32x4*)(DEC + ro + 4) = v1;
                        } else st_bf16x8(AA + ro, v0, v1);
                    } else st_bf16x8(GG + ro, v0, v1);
                    asm volatile("" ::: "memory");
                }
        }
    }
};
struct EpiBf16Out {
    bf16_t* out;
    DI void operator()(const AccT& acc, const pg8::Unit& u, int wr, int wc, int fr, int fq) const {
        const int row0 = u.pm * 256 + wr * 64 + fr;
#pragma unroll
        for (int ai = 0; ai < 2; ++ai)
#pragma unroll
            for (int m = 0; m < 4; ++m) {
                const size_t ro = (size_t)(row0 + ai * 128 + m * 16) * DM;
#pragma unroll
                for (int bj = 0; bj < 2; ++bj) { const int col0 = u.pn * 256 + bj * 128 + wc * 32 + 8 * fq; st_bf16x8(out + ro + col0, acc[ai][bj][m][0], acc[ai][bj][m][1]); }
            }
    }
};

struct Args { const float* in[33]; float* out; unsigned char* ws; int ph_lo, ph_hi, use_bar, pad; };
enum { I_X = 0, I_POS, I_ATTN_NORM, I_FFN_NORM, I_FINAL_NORM, I_W_IN, I_W_OUT, I_SINKS, I_CMP_PE, I_CMP_W1, I_CMP_B1, I_CMP_W2, I_FFN_W13, I_FFN_W2, I_MU, I_W_RKV, I_DECAY_W0, I_DECAY_W1,
       I_DECAY_W2, I_A0, I_A1, I_A2, I_G1, I_G2, I_K_K, I_K_A, I_R_K, I_LN_W, I_LN_B, I_W_O, I_ROUTER, I_MOE_W13, I_MOE_W2 };

struct Frame {
    LAS unsigned char* lds;
    int tid, lane, wave, G, gw, NGW;
    unsigned char* ws;
};

template <class F>
DI void transpose_item(const float* W, int Nsrc, int kvalid, bf16_t* WT, int Kd, const F& map, int k0, int n0, LAS float* scr, int lane) {
    const int s0 = map.src0(n0);
    const int rsub = lane >> 4, col = s0 + 4 * (lane & 15);
    f32x4 v[16];
#pragma unroll
    for (int i = 0; i < 16; ++i) { const int k = k0 + 4 * i + rsub; v[i] = (f32x4){0.f, 0.f, 0.f, 0.f}; if (k < kvalid && col < Nsrc) v[i] = *(const f32x4*)(W + (size_t)k * Nsrc + col); }
#pragma unroll
    for (int i = 0; i < 16; ++i) { LAS float* d = scr + (4 * i + rsub) * 65 + 4 * (lane & 15); d[0] = v[i].x; d[1] = v[i].y; d[2] = v[i].z; d[3] = v[i].w; }
    asm volatile("s_waitcnt lgkmcnt(0)" ::: "memory");
    const int c = lane & 7;
#pragma unroll
    for (int j = 0; j < 8; ++j) { const int nl = (lane >> 3) + 8 * j; const LAS float* s = scr + (8 * c) * 65 + map.perm(n0, nl);
        u32x4 o; o.x = pk2(s[0 * 65], s[1 * 65]); o.y = pk2(s[2 * 65], s[3 * 65]); o.z = pk2(s[4 * 65], s[5 * 65]); o.w = pk2(s[6 * 65], s[7 * 65]);
        *(u32x4*)(WT + (size_t)(n0 + nl) * Kd + k0 + 8 * c) = o; }
    asm volatile("s_waitcnt lgkmcnt(0)" ::: "memory");
}
template <class F>
DI void t8_load(f32x4 (&v)[16], const float* W, int Nsrc, int kvalid, const F& map, int k0, int n0, int lane) {
    const int s0 = map.src0(n0); const int rsub = lane >> 4, col = s0 + 4 * (lane & 15);
#pragma unroll
    for (int i = 0; i < 16; ++i) { const int k = k0 + 4 * i + rsub; v[i] = (f32x4){0.f, 0.f, 0.f, 0.f}; if (k < kvalid && col < Nsrc) v[i] = __builtin_nontemporal_load((const f32x4*)(W + (size_t)k * Nsrc + col)); }
}
template <class F>
DI void t8_store(const f32x4 (&v)[16], unsigned char* WT, int Kd, const F& map, int k0, int n0, LAS float* scr, int lane, float mul) {
    const int rsub = lane >> 4;
#pragma unroll
    for (int i = 0; i < 16; ++i) { LAS float* d = scr + (4 * i + rsub) * 65 + 4 * (lane & 15); d[0] = v[i].x; d[1] = v[i].y; d[2] = v[i].z; d[3] = v[i].w; }
    asm volatile("s_waitcnt lgkmcnt(0)" ::: "memory");
    const int c = lane & 7;
#pragma unroll
    for (int j = 0; j < 8; ++j) { const int nl = (lane >> 3) + 8 * j; const LAS float* s = scr + (8 * c) * 65 + map.perm(n0, nl);
        u32x2 o; o.x = pk4_fp8(s[0 * 65] * mul, s[1 * 65] * mul, s[2 * 65] * mul, s[3 * 65] * mul); o.y = pk4_fp8(s[4 * 65] * mul, s[5 * 65] * mul, s[6 * 65] * mul, s[7 * 65] * mul);
        *(u32x2*)(WT + (size_t)(n0 + nl) * Kd + k0 + 8 * c) = o; }
    asm volatile("s_waitcnt lgkmcnt(0)" ::: "memory");
}
template <class F>
DI void transpose_matrix8(const Frame& F_, const float* W, int Nsrc, int kvalid, unsigned char* WT, int Kd, int Nd, const F& map, LAS float* scr, float mul) {
    const int nkb = Kd / 64, nnb = Nd / 64, nitems = nkb * nnb;
    for (int it = F_.gw; it < nitems; it += 2 * F_.NGW) {
        const int it2 = it + F_.NGW; const bool two = it2 < nitems;
        const int k0a = 64 * (it / nnb), n0a = 64 * (it % nnb), k0b = two ? 64 * (it2 / nnb) : k0a, n0b = two ? 64 * (it2 % nnb) : n0a;
        f32x4 va[16], vb[16];
        t8_load(va, W, Nsrc, kvalid, map, k0a, n0a, F_.lane);
        if (two) t8_load(vb, W, Nsrc, kvalid, map, k0b, n0b, F_.lane);
        t8_store(va, WT, Kd, map, k0a, n0a, scr, F_.lane, mul);
        if (two) t8_store(vb, WT, Kd, map, k0b, n0b, scr, F_.lane, mul);
    }
}
template <class F>
DI void transpose_matrix(const Frame& F_, const float* W, int Nsrc, int kvalid, bf16_t* WT, int Kd, int Nd, const F& map, LAS float* scr, int first, int stride) {
    const int nkb = Kd / 64, nnb = Nd / 64, nitems = nkb * nnb;
    for (int it = first; it < nitems; it += stride) { const int kbi = it / nnb, nb = it % nnb; transpose_item(W, Nsrc, kvalid, WT, Kd, map, 64 * kbi, 64 * nb, scr, F_.lane); }
}
struct ColIdent { DI int src0(int n0) const { return n0; } DI int perm(int, int nl) const { return nl; } };
struct ColInProj { DI int src0(int n0) const { return n0; }
    DI int perm(int n0, int l) const { return n0 < C_VA ? ((l & 7) < 4 ? 4 * (l >> 3) + (l & 3) : 32 + 4 * (l >> 3) + (l & 3)) : l; } };
struct ColSwiglu { int F; DI int src0(int n0) const { const int t = n0 >> 8, r = n0 & 255; return r < 128 ? t * 128 + r : F + t * 128 + (r - 128); } DI int perm(int, int nl) const { return nl; } };

DI f32x4 ld4bf(const bf16_t* p) { const u32x2 q = *(const u32x2*)p; return (f32x4){bflo(q.x), bfhi(q.x), bflo(q.y), bfhi(q.y)}; }
DI void rms_row_load(const float* xrow, int lane, f32x4 (&v)[8], float& rstd) {
    float s = 0.f;
#pragma unroll
    for (int j = 0; j < 8; ++j) { v[j] = *(const f32x4*)(xrow + 4 * lane + 256 * j); s += (v[j].x * v[j].x + v[j].y * v[j].y) + (v[j].z * v[j].z + v[j].w * v[j].w); }
    rstd = 1.0f / sqrtf(wave_sum(s) * (1.0f / DM) + RMS_EPS);
}
DI void rms_row_to_bf16(const float* xrow, const float* g, bf16_t* orow, int lane) {
    f32x4 v[8]; float rstd; rms_row_load(xrow, lane, v, rstd);
#pragma unroll
    for (int j = 0; j < 8; ++j) { const f32x4 gg = *(const f32x4*)(g + 4 * lane + 256 * j); const f32x4 y = v[j] * rstd * gg;
        u32x2 w; w.x = pk2(y.x, y.y); w.y = pk2(y.z, y.w); *(u32x2*)(orow + 4 * lane + 256 * j) = w; }
}

DI void rms_row_load_h(const bf16_t* xrow, int lane, f32x4 (&v)[8], float& rstd) {
    float s = 0.f;
#pragma unroll
    for (int j = 0; j < 8; ++j) { v[j] = ld4bf(xrow + 4 * lane + 256 * j); s += (v[j].x * v[j].x + v[j].y * v[j].y) + (v[j].z * v[j].z + v[j].w * v[j].w); }
    rstd = 1.0f / sqrtf(wave_sum(s) * (1.0f / DM) + RMS_EPS);
}
DI void rms_row_to_bf16_h(const bf16_t* xrow, const float* g, bf16_t* orow, int lane) {
    f32x4 v[8]; float rstd; rms_row_load_h(xrow, lane, v, rstd);
#pragma unroll
    for (int j = 0; j < 8; ++j) { const f32x4 gg = *(const f32x4*)(g + 4 * lane + 256 * j); const f32x4 y = v[j] * rstd * gg;
        u32x2 w; w.x = pk2(y.x, y.y); w.y = pk2(y.z, y.w); *(u32x2*)(orow + 4 * lane + 256 * j) = w; }
}
namespace att {
constexpr int KPADB = 144;
constexpr int VPADB = 144;
constexpr int BUFB = 64 * KPADB + 64 * VPADB;
constexpr int OFF_ALPHA = 2 * BUFB;
constexpr int OFF_IMP = OFF_ALPHA + 8 * 256;
constexpr int OFF_SEL = OFF_IMP + 16384;
constexpr int OFF_RANK = OFF_SEL + 512;
constexpr int OFF_Q = 65536;
constexpr float NEGBIG = -1e30f;
DI int crow(int r, int h) { return (r & 3) + 8 * (r >> 2) + 4 * h; }
#define MFMA32(a, b, c) __builtin_amdgcn_mfma_f32_32x32x16_bf16((a), (b), (c), 0, 0, 0)

struct KVRegs { u32x4 k, v; };
DI void kv_load(KVRegs& r, const bf16_t* Kg, const bf16_t* Vg, size_t pitch, int tid) {
    const int key = tid >> 3, dc = tid & 7;
    r.k = *(const u32x4*)(Kg + (size_t)key * pitch + dc * 8); r.v = *(const u32x4*)(Vg + (size_t)key * pitch + dc * 8);
}
DI void kv_store(const KVRegs& r, LAS unsigned char* buf, int tid) {
    const int key = tid >> 3, dc = tid & 7;
    *(LAS u32x4*)(buf + key * KPADB + dc * 16) = r.k;
    LAS unsigned short* vt = (LAS unsigned short*)(buf + 64 * KPADB);
    const unsigned w[4] = {r.v.x, r.v.y, r.v.z, r.v.w};
#pragma unroll
    for (int i = 0; i < 4; ++i) { vt[(dc * 8 + 2 * i) * (VPADB / 2) + key] = (unsigned short)(w[i] & 0xffffu); vt[(dc * 8 + 2 * i + 1) * (VPADB / 2) + key] = (unsigned short)(w[i] >> 16); }
}

struct State { f32x16 O[2][2]; float m[2], l[2]; };
DI void state_init(State& s) {
#pragma unroll
    for (int a = 0; a < 2; ++a) { s.m[a] = NEGBIG; s.l[a] = 0.f;
#pragma unroll
        for (int b = 0; b < 2; ++b)
#pragma unroll
            for (int r = 0; r < 16; ++r) s.O[a][b][r] = 0.f; }
}
DI void row_scale(f32x16 (&O)[2], float f, LAS float* area, int c_, int h_) {
    const int c = opq(c_), h = opq(h_);
    area[c] = f;
    asm volatile("s_waitcnt lgkmcnt(0)" ::: "memory");
#pragma unroll
    for (int g4 = 0; g4 < 4; ++g4) { const f32x4 a = *(LAS f32x4*)(area + 8 * g4 + 4 * h);
#pragma unroll
        for (int j = 0; j < 4; ++j) { O[0][4 * g4 + j] *= a[j]; O[1][4 * g4 + j] *= a[j]; } }
    asm volatile("s_waitcnt lgkmcnt(0)" ::: "memory");
}
template <int MODE, bool MASKED>
DI void softmax_block(State& st, f32x16& S, int qb, int kpos0, const int (&tq)[2], int W, bool bit, LAS float* area, int c, int h) {
    if constexpr (MASKED) {
        float mx = NEGBIG;
        const int dd = tq[qb] - kpos0;
#pragma unroll
        for (int r = 0; r < 16; ++r) { const int cr0 = (r & 3) + 8 * (r >> 2); bool valid;
            if (MODE == 0) valid = (cr0 <= dd) && (cr0 > dd - W);
            else if (MODE == 1) valid = (cr0 <= dd);
            else valid = (cr0 <= dd) && bit;
            S[r] = valid ? S[r] : NEGBIG; mx = fmaxf(mx, S[r]); }
        mx = fmaxf(mx, __shfl_xor(mx, 32));
        if (__any(mx > st.m[qb] + 8.0f)) {
            const float mnew = fmaxf(st.m[qb], mx); const float alpha = ex2(st.m[qb] - mnew);
            st.l[qb] *= alpha; st.m[qb] = mnew;
            row_scale(st.O[qb], alpha, area + qb * 32, c, h);
        }
        float ls = 0.f;
#pragma unroll
        for (int r = 0; r < 16; ++r) { S[r] = (S[r] > -1e29f) ? ex2(S[r] - st.m[qb]) : 0.f; ls += S[r]; }
        st.l[qb] += ls;
    } else {
        float mx = fmaxf(fmaxf(fmaxf(S[0], S[1]), fmaxf(S[2], S[3])), fmaxf(fmaxf(S[4], S[5]), fmaxf(S[6], S[7])));
        mx = fmaxf(mx, fmaxf(fmaxf(fmaxf(S[8], S[9]), fmaxf(S[10], S[11])), fmaxf(fmaxf(S[12], S[13]), fmaxf(S[14], S[15]))));
        if (MODE == 2) mx = bit ? mx : NEGBIG;
        mx = fmaxf(mx, __shfl_xor(mx, 32));
        if (__any(mx > st.m[qb] + 8.0f)) {
            const float mnew = fmaxf(st.m[qb], mx); const float alpha = ex2(st.m[qb] - mnew);
            st.l[qb] *= alpha; st.m[qb] = mnew;
            row_scale(st.O[qb], alpha, area + qb * 32, c, h);
        }
        const float mref = (MODE == 2 && !bit) ? 3.0e38f : st.m[qb];
        float ls = 0.f;
#pragma unroll
        for (int r = 0; r < 16; ++r) { S[r] = ex2(S[r] - mref); ls += S[r]; }
        st.l[qb] += ls;
    }
}
DI void pack_p(bf16x8 (&Pf)[2], const f32x16& S) {
#pragma unroll
    for (int ks = 0; ks < 2; ++ks) { u32x4 w; w.x = pk2(S[8 * ks], S[8 * ks + 1]); w.y = pk2(S[8 * ks + 2], S[8 * ks + 3]); w.z = pk2(S[8 * ks + 4], S[8 * ks + 5]); w.w = pk2(S[8 * ks + 6], S[8 * ks + 7]);
        Pf[ks] = __builtin_bit_cast(bf16x8, w); }
}
template <int MODE, bool MASKED>
DI void tile_compute(State& st, const LAS unsigned char* qf, LAS unsigned char* buf, int kbase, const int (&tq)[2], int W, const unsigned long long (&sel)[2], int tile, LAS float* area, int c_, int h_) {
    const int c = opq(c_), h = opq(h_);
    LAS unsigned char* Kl = buf; LAS unsigned char* Vl = buf + 64 * KPADB;
    const bool bit0 = MODE == 2 ? (((sel[0] >> tile) & 1ull) != 0ull) : true, bit1 = MODE == 2 ? (((sel[1] >> tile) & 1ull) != 0ull) : true;
#pragma unroll 1
    for (int kbk = 0; kbk < 2; ++kbk) {
        bf16x8 kf[4];
#pragma unroll
        for (int s = 0; s < 4; ++s) kf[s] = *(LAS bf16x8*)(Kl + (32 * kbk + c) * KPADB + (16 * s + 8 * h) * 2);
        f32x16 S0, S1;
#pragma unroll
        for (int r = 0; r < 16; ++r) { S0[r] = 0.f; S1[r] = 0.f; }
#pragma unroll
        for (int s = 0; s < 4; ++s) { const bf16x8 q = *(const LAS bf16x8*)(qf + s * 1024); S0 = MFMA32(kf[s], q, S0); }
#pragma unroll
        for (int s = 0; s < 4; ++s) { const bf16x8 q = *(const LAS bf16x8*)(qf + (4 + s) * 1024); S1 = MFMA32(kf[s], q, S1); }
        const LAS unsigned char* vbase = Vl + opq(c * VPADB + h * 8) + kbk * 64;
        bf16x8 vf[2][2];
#pragma unroll
        for (int ks = 0; ks < 2; ++ks)
#pragma unroll
            for (int db = 0; db < 2; ++db) {
                const s16x4 lo = *(const LAS s16x4*)(vbase + 32 * db * VPADB + 32 * ks);
                const s16x4 hi = *(const LAS s16x4*)(vbase + 32 * db * VPADB + 32 * ks + 16);
                vf[ks][db] = __builtin_shufflevector(lo, hi, 0, 1, 2, 3, 4, 5, 6, 7);
            }
        __builtin_amdgcn_sched_barrier(0);
        const int kpos0 = kbase + 32 * kbk + 4 * h;
        bf16x8 Pf[2];
        softmax_block<MODE, MASKED>(st, S0, 0, kpos0, tq, W, bit0, area, c, h);
        pack_p(Pf, S0);
        __builtin_amdgcn_sched_barrier(0);
#pragma unroll
        for (int ks = 0; ks < 2; ++ks)
#pragma unroll
            for (int db = 0; db < 2; ++db) st.O[0][db] = MFMA32(Pf[ks], vf[ks][db], st.O[0][db]);
        softmax_block<MODE, MASKED>(st, S1, 1, kpos0, tq, W, bit1, area, c, h);
        pack_p(Pf, S1);
        __builtin_amdgcn_sched_barrier(0);
#pragma unroll
        for (int ks = 0; ks < 2; ++ks)
#pragma unroll
            for (int db = 0; db < 2; ++db) st.O[1][db] = MFMA32(Pf[ks], vf[ks][db], st.O[1][db]);
    }
}
template <int MODE>
DI void run_pass(State& st, LAS unsigned char* lds, const bf16_t* Kg, const bf16_t* Vg, size_t pitch, int tlo, int thi, const int (&tq)[2], int W,
                 const unsigned long long (&sel)[2], int tid, int wave, int c, int h) {
    LAS float* area = (LAS float*)(lds + OFF_ALPHA) + wave * 64;
    const LAS unsigned char* qf = lds + OFF_Q + wave * 8192 + (c + 32 * h) * 16;
    KVRegs kr; kv_load(kr, Kg + (size_t)tlo * 64 * pitch, Vg + (size_t)tlo * 64 * pitch, pitch, tid);
    int bi = 0;
    for (int t = tlo; t <= thi; ++t) {
        LAS unsigned char* buf = lds + bi * BUFB;
        const int tid2 = opq(tid);
        kv_store(kr, buf, tid2);
        if (t < thi) kv_load(kr, Kg + (size_t)(t + 1) * 64 * pitch, Vg + (size_t)(t + 1) * 64 * pitch, pitch, tid2);
        __syncthreads();
        const bool masked = (MODE == 1) || (t == thi) || (MODE == 0 && t == thi - W / 64);
        if (masked) tile_compute<MODE, true>(st, qf, buf, t * 64, tq, W, sel, t, area, c, h);
        else tile_compute<MODE, false>(st, qf, buf, t * 64, tq, W, sel, t, area, c, h);
        bi ^= 1;
    }
    __syncthreads();
}
DI void load_q(LAS unsigned char* lds, int wave, const bf16_t* Pbase  , int colbase, int c_, int h_) {
    const int c = opq(c_), h = opq(h_);
    LAS unsigned char* q = lds + OFF_Q + wave * 8192 + (c + 32 * h) * 16;
#pragma unroll
    for (int qb = 0; qb < 2; ++qb) { const bf16_t* p = Pbase + (size_t)(4 * qb + (c >> 3)) * NP + colbase + (c & 7) * 64 + 8 * h;
#pragma unroll
        for (int s = 0; s < 4; ++s) *(LAS bf16x8*)(q + (qb * 4 + s) * 1024) = *(const bf16x8*)(p + 16 * s); }
}
template <bool ACC>
DI void emit_out(State& st, const float (&f)[2], LAS float* area, LAS unsigned char* lds, int wave, bf16_t* Orow, int c_, int h_, int lane_) {
    const int c = opq(c_), h = opq(h_), lane = opq(lane_);
    LAS unsigned char* slice = lds + wave * 4608;
#pragma unroll
    for (int qb = 0; qb < 2; ++qb) {
        area[qb * 32 + c] = f[qb];
        asm volatile("s_waitcnt lgkmcnt(0)" ::: "memory");
#pragma unroll
        for (int g4 = 0; g4 < 4; ++g4) { const f32x4 a = *(LAS f32x4*)(area + qb * 32 + 8 * g4 + 4 * h);
#pragma unroll
            for (int j = 0; j < 4; ++j)
#pragma unroll
                for (int db = 0; db < 2; ++db)
                    *(LAS unsigned short*)(slice + (8 * g4 + 4 * h + j) * KPADB + (32 * db + c) * 2) = (unsigned short)f2bf(st.O[qb][db][4 * g4 + j] * a[j]); }
        asm volatile("s_waitcnt lgkmcnt(0)" ::: "memory");
        u32x4 v[4], o[4];
#pragma unroll
        for (int i = 0; i < 4; ++i) v[i] = *(LAS u32x4*)(slice + ((lane >> 3) + 8 * i) * KPADB + (lane & 7) * 16);
        if (ACC) {
#pragma unroll
            for (int i = 0; i < 4; ++i) { const int row = (lane >> 3) + 8 * i; o[i] = *(const u32x4*)(Orow + (size_t)(4 * qb + (row >> 3)) * DM + (row & 7) * 64 + (lane & 7) * 8); }
#pragma unroll
            for (int i = 0; i < 4; ++i) { const unsigned a[4] = {v[i].x, v[i].y, v[i].z, v[i].w}, bb[4] = {o[i].x, o[i].y, o[i].z, o[i].w}; unsigned r[4];
#pragma unroll
                for (int k = 0; k < 4; ++k) r[k] = pk2(bflo(a[k]) + bflo(bb[k]), bfhi(a[k]) + bfhi(bb[k]));
                v[i] = (u32x4){r[0], r[1], r[2], r[3]}; }
        }
#pragma unroll
        for (int i = 0; i < 4; ++i) { const int row = (lane >> 3) + 8 * i; *(u32x4*)(Orow + (size_t)(4 * qb + (row >> 3)) * DM + (row & 7) * 64 + (lane & 7) * 8) = v[i]; }
        asm volatile("s_waitcnt lgkmcnt(0)" ::: "memory");
    }
}
}

DI void attn_unit_A(const Frame& F, const bf16_t* P, bf16_t* O, const float* sinks, int b, int kvh, int ch) {
    const int lane = opq(F.lane), tid = F.wave * 64 + lane;
    const int c = lane & 31, h = lane >> 5, w = F.wave;
    const int t0 = ch * 64;
    const bf16_t* Pb = P + (size_t)b * SEQ * NP;
    att::load_q(F.lds, w, Pb + (size_t)(t0 + 8 * w) * NP, C_QA + kvh * 512, c, h);
    int tq[2] = {t0 + 8 * w + (c >> 3), t0 + 8 * w + 4 + (c >> 3)};
    unsigned long long sel[2] = {0ull, 0ull};
    att::State st; att::state_init(st);
    const int tlo = ch >= 2 ? ch - 2 : 0;
    att::run_pass<0>(st, F.lds, Pb + C_KA + kvh * 64, Pb + C_VA + kvh * 64, NP, tlo, ch, tq, 128, sel, tid, w, c, h);
    const float sink2 = sinks[kvh * 8 + (c & 7)] * LOG2E;
    float f[2];
#pragma unroll
    for (int qb = 0; qb < 2; ++qb) { const float lt = st.l[qb] + __shfl_xor(st.l[qb], 32) + ex2(sink2 - st.m[qb]); f[qb] = 1.0f / lt; }
    LAS float* area = (LAS float*)(F.lds + att::OFF_ALPHA) + w * 64;
    att::emit_out<false>(st, f, area, F.lds, w, O + ((size_t)b * SEQ + t0 + 8 * w) * DM + kvh * 512, c, h, lane);
    __syncthreads();
}

DI void attn_unit_B(const Frame& F, const bf16_t* P, const bf16_t* KVC, bf16_t* O, float* OB, int b, int hkv, int ch) {
    const int lane = opq(F.lane), tid = F.wave * 64 + lane;
    const int c = lane & 31, h = lane >> 5, w = F.wave;
    const int t0 = ch * 64;
    const bf16_t* Pb = P + (size_t)b * SEQ * NP;
    LAS float* area = (LAS float*)(F.lds + att::OFF_ALPHA) + w * 64;
    LAS float* imp = (LAS float*)(F.lds + att::OFF_IMP);
    LAS unsigned long long* selbuf = (LAS unsigned long long*)(F.lds + att::OFF_SEL);
    LAS float* rank = (LAS float*)(F.lds + att::OFF_RANK) + w * 64;
    att::load_q(F.lds, w, Pb + (size_t)(t0 + 8 * w) * NP, C_QB + hkv * 512, c, h);
    const LAS unsigned char* qf = F.lds + att::OFF_Q + w * 8192 + (c + 32 * h) * 16;
    int tq[2] = {t0 + 8 * w + (c >> 3), t0 + 8 * w + 4 + (c >> 3)};
    unsigned long long sel[2] = {0ull, 0ull};
#define GATE(qb, j) sigmoidf_(bf2f(Pb[(size_t)tq[qb] * NP + C_GATE + hkv * 24 + (c & 7) * 3 + (j)]))
    for (int i = tid; i < 4096; i += NTHR) imp[i] = 0.f;
    bf16_t* Orow = O + ((size_t)b * SEQ + t0 + 8 * w) * DM + 1024 + hkv * 512;
    const bf16_t* Kc = KVC + (size_t)(0 * 2048 + (b * 2 + hkv) * 256) * 64;
    const bf16_t* Vc = KVC + (size_t)(1 * 2048 + (b * 2 + hkv) * 256) * 64;
    const int ntc = (4 * ch + 2) / 64;
    att::State st; att::state_init(st);
    int tqc[2] = {(tq[0] - 31) >> 4, (tq[1] - 31) >> 4};
    att::run_pass<1>(st, F.lds, Kc, Vc, 64, 0, ntc, tqc, 0, sel, tid, w, c, h);
    float ltot[2], f[2];
#pragma unroll
    for (int qb = 0; qb < 2; ++qb) { ltot[qb] = fmaxf(st.l[qb] + __shfl_xor(st.l[qb], 32), 1e-30f); f[qb] = GATE(qb, 0) / ltot[qb]; }
    att::emit_out<false>(st, f, area, F.lds, w, Orow, c, h, lane);
    __syncthreads();
    {
        att::KVRegs kr; att::kv_load(kr, Kc, Vc, 64, tid);
        int bi = 0;
        for (int t = 0; t <= ntc; ++t) {
            LAS unsigned char* buf = F.lds + bi * att::BUFB;
            att::kv_store(kr, buf, tid);
            if (t < ntc) att::kv_load(kr, Kc + (size_t)(t + 1) * 64 * 64, Vc + (size_t)(t + 1) * 64 * 64, 64, tid);
            __syncthreads();
#pragma unroll
            for (int kbk = 0; kbk < 2; ++kbk) {
#pragma unroll
                for (int qb = 0; qb < 2; ++qb) {
                    f32x16 S;
#pragma unroll
                    for (int r = 0; r < 16; ++r) S[r] = 0.f;
#pragma unroll
                    for (int s = 0; s < 4; ++s) { const bf16x8 kf = *(LAS bf16x8*)(buf + (32 * kbk + c) * att::KPADB + (16 * s + 8 * h) * 2); const bf16x8 q = *(const LAS bf16x8*)(qf + (qb * 4 + s) * 1024); S = MFMA32(kf, q, S); }
                    const float inv = 1.0f / ltot[qb];
                    const int q = 8 * w + 4 * qb + (c >> 3);
                    const int ddq = tqc[qb] - (t * 64 + 32 * kbk + 4 * h);
#pragma unroll
                    for (int g4 = 0; g4 < 4; ++g4) {
                        float s4 = 0.f, p3 = 0.f;
#pragma unroll
                        for (int j = 0; j < 4; ++j) { const float pv = (8 * g4 + j <= ddq) ? ex2(S[4 * g4 + j] - st.m[qb]) * inv : 0.f; s4 += pv; if (j == 3) p3 = pv; }
                        s4 += __shfl_xor(s4, 1); s4 += __shfl_xor(s4, 2); s4 += __shfl_xor(s4, 4);
                        p3 += __shfl_xor(p3, 1); p3 += __shfl_xor(p3, 2); p3 += __shfl_xor(p3, 4);
                        const int n0 = t * 16 + 8 * kbk + 2 * g4 + h;
                        if ((c & 7) == 0) { (void)__hip_atomic_fetch_add(&imp[q * 64 + n0], s4, __ATOMIC_RELAXED, __HIP_MEMORY_SCOPE_WORKGROUP); if (n0 + 1 < 64) (void)__hip_atomic_fetch_add(&imp[q * 64 + n0 + 1], p3, __ATOMIC_RELAXED, __HIP_MEMORY_SCOPE_WORKGROUP); }
                    }
                    __builtin_amdgcn_sched_barrier(0);
                }
            }
            bi ^= 1;
        }
        __syncthreads();
    }
    {
        const int cur = ch;
        for (int qq = 0; qq < 8; ++qq) {
            const int q = 8 * w + qq;
            float v = imp[q * 64 + lane];
            if (lane > cur) v = -1e9f; else if (lane == 0 || lane > cur - 2) v = 1e9f;
            rank[lane] = v;
            asm volatile("s_waitcnt lgkmcnt(0)" ::: "memory");
            int rk = 0;
#pragma unroll 8
            for (int mth = 0; mth < 64; ++mth) { const float o = rank[mth]; rk += (o > v || (o == v && mth < lane)) ? 1 : 0; }
            const unsigned long long msk = __ballot(rk < 16);
            if (lane == 0) selbuf[q] = msk;
            asm volatile("s_waitcnt lgkmcnt(0)" ::: "memory");
        }
        __syncthreads();
        sel[0] = selbuf[8 * w + (c >> 3)]; sel[1] = selbuf[8 * w + 4 + (c >> 3)];
    }
    att::state_init(st);
    att::run_pass<2>(st, F.lds, Pb + C_KSEL + hkv * 64, Pb + C_VSEL + hkv * 64, NP, 0, ch, tq, 0, sel, tid, w, c, h);
#pragma unroll
    for (int qb = 0; qb < 2; ++qb) { const float lt = fmaxf(st.l[qb] + __shfl_xor(st.l[qb], 32), 1e-30f); f[qb] = GATE(qb, 1) / lt; }
    att::emit_out<true>(st, f, area, F.lds, w, Orow, c, h, lane);
    __syncthreads();
    att::state_init(st);
    att::run_pass<0>(st, F.lds, Pb + C_KWIN + hkv * 64, Pb + C_VWIN + hkv * 64, NP, ch >= 8 ? ch - 8 : 0, ch, tq, 512, sel, tid, w, c, h);
#pragma unroll
    for (int qb = 0; qb < 2; ++qb) { const float lt = fmaxf(st.l[qb] + __shfl_xor(st.l[qb], 32), 1e-30f); f[qb] = GATE(qb, 2) / lt; }
    att::emit_out<true>(st, f, area, F.lds, w, Orow, c, h, lane);
#undef GATE
    __syncthreads();
}

namespace scan {
constexpr int TC = 32;
constexpr int STEPB = 5 * 256 + 128;
constexpr int CHB = TC * STEPB;
constexpr int OFF_Y = 2 * CHB;
constexpr int YB = (TC + 1) * 32 * 4;
template <int CTRL> DI float dpp_f(float x) { return __builtin_bit_cast(float, __builtin_amdgcn_update_dpp(0, __builtin_bit_cast(int, x), CTRL, 0xf, 0xf, false)); }
DI void row_sum16x4(float& a, float& b, float& c, float& d) {
    asm volatile("s_nop 1\n\t"
        "v_add_f32_dpp %0, %0, %0 quad_perm:[1,0,3,2] row_mask:0xf bank_mask:0xf\n\tv_add_f32_dpp %1, %1, %1 quad_perm:[1,0,3,2] row_mask:0xf bank_mask:0xf\n\t"
        "v_add_f32_dpp %2, %2, %2 quad_perm:[1,0,3,2] row_mask:0xf bank_mask:0xf\n\tv_add_f32_dpp %3, %3, %3 quad_perm:[1,0,3,2] row_mask:0xf bank_mask:0xf\n\t"
        "v_add_f32_dpp %0, %0, %0 quad_perm:[2,3,0,1] row_mask:0xf bank_mask:0xf\n\tv_add_f32_dpp %1, %1, %1 quad_perm:[2,3,0,1] row_mask:0xf bank_mask:0xf\n\t"
        "v_add_f32_dpp %2, %2, %2 quad_perm:[2,3,0,1] row_mask:0xf bank_mask:0xf\n\tv_add_f32_dpp %3, %3, %3 quad_perm:[2,3,0,1] row_mask:0xf bank_mask:0xf\n\t"
        "v_add_f32_dpp %0, %0, %0 row_half_mirror row_mask:0xf bank_mask:0xf\n\tv_add_f32_dpp %1, %1, %1 row_half_mirror row_mask:0xf bank_mask:0xf\n\t"
        "v_add_f32_dpp %2, %2, %2 row_half_mirror row_mask:0xf bank_mask:0xf\n\tv_add_f32_dpp %3, %3, %3 row_half_mirror row_mask:0xf bank_mask:0xf\n\t"
        "v_add_f32_dpp %0, %0, %0 row_mirror row_mask:0xf bank_mask:0xf\n\tv_add_f32_dpp %1, %1, %1 row_mirror row_mask:0xf bank_mask:0xf\n\t"
        "v_add_f32_dpp %2, %2, %2 row_mirror row_mask:0xf bank_mask:0xf\n\tv_add_f32_dpp %3, %3, %3 row_mirror row_mask:0xf bank_mask:0xf"
        : "+v"(a), "+v"(b), "+v"(c), "+v"(d));
}
DI float wave_sum_dpp(float x) { x += dpp_f<0xB1>(x); x += dpp_f<0x4E>(x); x += dpp_f<0x141>(x); x += dpp_f<0x140>(x);
    const int xi = __builtin_bit_cast(int, x);
    return (__builtin_bit_cast(float, __builtin_amdgcn_readlane(xi, 0)) + __builtin_bit_cast(float, __builtin_amdgcn_readlane(xi, 16))) + (__builtin_bit_cast(float, __builtin_amdgcn_readlane(xi, 32)) + __builtin_bit_cast(float, __builtin_amdgcn_readlane(xi, 48))); }
DI float row_sum16(float x) { x += dpp_f<0xB1>(x); x += dpp_f<0x4E>(x); x += dpp_f<0x141>(x); x += dpp_f<0x140>(x); return x; }
}
struct ScanRegs { unsigned short r[8], k[8], v[8], a[8]; float dec[8]; };
DI void scan_issue(const Frame& F, ScanRegs& R, const bf16_t* RKV, const float* DEC, const bf16_t* AA, int b, int hd, int tch) {
    const int lw = F.wave - 4, lane = F.lane;
#pragma unroll
    for (int i = 0; i < 8; ++i) {
        const size_t tok = (size_t)b * SEQ + (size_t)tch * scan::TC + lw + 4 * i;
        const size_t o = tok * DM + hd * 64 + lane;
        R.r[i] = RKV[o]; R.k[i] = RKV[(size_t)M * DM + o]; R.v[i] = RKV[(size_t)2 * M * DM + o]; R.dec[i] = DEC[o]; R.a[i] = AA[o];
    }
}
DI void scan_fill(const Frame& F, const ScanRegs& R, LAS unsigned char* buf, float kkw, float kaw, int half) {
    const int lw = F.wave - 4, lane = F.lane;
#pragma unroll
    for (int i = 0; i < 8; ++i) {
        const int s = lw + 4 * i;
        const float r = bf2f(R.r[i]), k = bf2f(R.k[i]), v = bf2f(R.v[i]), dec = R.dec[i], a = bf2f(R.a[i]);
        const float kx = k * kkw;
        const float kk = kx * __builtin_amdgcn_rsqf(fmaxf(scan::wave_sum_dpp(kx * kx), 1e-24f));
        const float kp = k * (1.0f + (a - 1.0f) * kaw);
        LAS float* sp = (LAS float*)(buf + s * scan::STEPB);
        sp[lane] = dec; sp[64 + lane] = -kk; sp[128 + lane] = kk * a; sp[192 + lane] = kp; sp[256 + lane] = r;
        if ((lane >> 5) == half) sp[320 + (lane & 31)] = v;
    }
}
DI void scan_flush(const Frame& F, LAS unsigned char* ybuf, bf16_t* YRAW, int b, int hd, int half, int tch) {
    const int lw = F.wave - 4, lane = F.lane;
    for (int s = 2 * lw; s < scan::TC; s += 8) {
        const int ss = s + (lane >> 5);
        const size_t tok = (size_t)b * SEQ + (size_t)tch * scan::TC + ss;
        YRAW[tok * DM + hd * 64 + half * 32 + (lane & 31)] = (bf16_t)f2bf(((LAS float*)ybuf)[(ss + 1) * 32 + (lane & 31)]);
    }
}
struct CvItem { const float* W; unsigned char* WT; int Nsrc, Kd, k0, n0, s0; float mul; bool on; };
constexpr int CV_I13 = (DM / 64) * (2 * DFFE / 32), CV_I2 = (DFFE / 64) * (DM / 32), CV_TOTAL = NEXP * (CV_I13 + CV_I2);
DI CvItem cv_item(int gid, const float* w13, const float* w2, unsigned char* m13, unsigned char* m2) {
    CvItem it; it.on = gid < CV_TOTAL;
    if (gid < NEXP * CV_I13) { const int e = gid / CV_I13, r = gid % CV_I13, kb = r / (2 * DFFE / 32), nb = r % (2 * DFFE / 32);
        it.W = w13 + (size_t)e * DM * 2 * DFFE; it.WT = m13 + (size_t)e * 2 * DFFE * DM; it.Nsrc = 2 * DFFE; it.Kd = DM; it.k0 = 64 * kb; it.n0 = 32 * nb; it.mul = 64.0f;
        const int t = it.n0 >> 8, rr = it.n0 & 255; it.s0 = rr < 128 ? t * 128 + rr : DFFE + t * 128 + (rr - 128);
    } else { const int g2 = gid - NEXP * CV_I13; const int e = g2 / CV_I2, r = g2 % CV_I2, kb = r / (DM / 32), nb = r % (DM / 32);
        it.W = w2 + (size_t)e * DFFE * DM; it.WT = m2 + (size_t)e * DM * DFFE; it.Nsrc = DM; it.Kd = DFFE; it.k0 = 64 * kb; it.n0 = 32 * nb; it.mul = 128.0f; it.s0 = it.n0; }
    return it;
}
template <bool CHK = true>
DI void cv_load(float (&v)[32], const CvItem& it, int lane) {
    if (CHK && !it.on) return;
    const char* rowbase = (const char*)(it.W + (size_t)it.k0 * it.Nsrc + it.s0);
    const unsigned loff = (unsigned)((lane >> 5) * it.Nsrc + (lane & 31)) * 4u;
    const size_t rstep = (size_t)it.Nsrc * 8;
#pragma unroll
    for (int i = 0; i < 32; ++i) v[i] = __builtin_nontemporal_load((const float*)(rowbase + (size_t)i * rstep + loff));
}
template <bool CHK = true>
DI void cv_store(const float (&v)[32], const CvItem& it, LAS float* scr, int lane) {
    if (CHK && !it.on) return;
#pragma unroll
    for (int i = 0; i < 32; ++i) scr[(2 * i + (lane >> 5)) * 33 + (lane & 31)] = v[i];
    asm volatile("s_waitcnt lgkmcnt(0)" ::: "memory");
    const int c = lane & 7;
#pragma unroll
    for (int j = 0; j < 4; ++j) { const int n = (lane >> 3) + 8 * j; const LAS float* s = scr + (8 * c) * 33 + n;
        u32x2 o; o.x = pk4_fp8(s[0 * 33] * it.mul, s[1 * 33] * it.mul, s[2 * 33] * it.mul, s[3 * 33] * it.mul); o.y = pk4_fp8(s[4 * 33] * it.mul, s[5 * 33] * it.mul, s[6 * 33] * it.mul, s[7 * 33] * it.mul);
        *(u32x2*)(it.WT + (size_t)(it.n0 + n) * it.Kd + it.k0 + 8 * c) = o; }
    asm volatile("s_waitcnt lgkmcnt(0)" ::: "memory");
}
DI unsigned long long phase_scan(const Frame& F, const bf16_t* RKV, const float* DEC, const bf16_t* AA, const float* kk_w, const float* ka_w, bf16_t* YRAW,
                                  const float* w13, const float* w2, unsigned char* m13, unsigned char* m2) {
    unsigned long long pacc = 0ull;
    for (int vb = blockIdx.x; vb < 256; vb += F.G) {
        const int bh = vb >> 1, half = vb & 1, b = bh >> 5, hd = bh & 31;
        const int w = F.wave, lane = F.lane;
        const int rp = lane >> 4, cg = lane & 15;
        const int row0 = 8 * w + 2 * rp;
        f32x2 SS[4] = {(f32x2){0.f, 0.f}, (f32x2){0.f, 0.f}, (f32x2){0.f, 0.f}, (f32x2){0.f, 0.f}};
        constexpr int NCH = SEQ / scan::TC;
        volatile LAS unsigned* fl = (volatile LAS unsigned*)(F.lds + 138240);
#define SC_WAIT(idx, target) do { unsigned sp_ = 0; while (fl[idx] < (unsigned)(target) && ++sp_ < (1u << 24)) __builtin_amdgcn_s_sleep(1); asm volatile("" ::: "memory"); } while (0)
#define SC_SIGNAL(idx) do { asm volatile("s_waitcnt lgkmcnt(0)" ::: "memory"); if (lane == 0) (void)__hip_atomic_fetch_add((LAS unsigned*)&fl[idx], 1u, __ATOMIC_RELAXED, __HIP_MEMORY_SCOPE_WORKGROUP); } while (0)
        if (w < 4) {
            __builtin_amdgcn_s_setprio(3);
            for (int ch = 0; ch < NCH; ++ch) {
                LAS unsigned char* buf = F.lds + (ch & 1) * scan::CHB;
                LAS float* yb = (LAS float*)(F.lds + scan::OFF_Y + (ch & 1) * scan::YB);
                SC_WAIT(ch & 1, 4 * (ch / 2 + 1));
                if (ch >= 2) SC_WAIT(4 + (ch & 1), 4 * (ch / 2));
#ifdef PROBE_SCAN
                const unsigned long long pt0 = __builtin_amdgcn_s_memrealtime();
#endif
                f32x2 yp = (f32x2){0.f, 0.f};
                const LAS float* sp0 = (const LAS float*)buf;
                f32x4 w4 = *(const LAS f32x4*)(sp0 + 4 * cg), nk4 = *(const LAS f32x4*)(sp0 + 64 + 4 * cg), b4 = *(const LAS f32x4*)(sp0 + 128 + 4 * cg),
                      k4 = *(const LAS f32x4*)(sp0 + 192 + 4 * cg), r4 = *(const LAS f32x4*)(sp0 + 256 + 4 * cg);
                f32x2 v2 = *(const LAS f32x2*)(sp0 + 320 + row0);
#define SPL(x) ((f32x2){(x), (x)})
#pragma unroll 8
                for (int s = 0; s < scan::TC; ++s) {
                    const LAS float* sp = (const LAS float*)(buf + (s + 1) * scan::STEPB);
                    const f32x4 w4n = *(const LAS f32x4*)(sp + 4 * cg), nk4n = *(const LAS f32x4*)(sp + 64 + 4 * cg), b4n = *(const LAS f32x4*)(sp + 128 + 4 * cg),
                                k4n = *(const LAS f32x4*)(sp + 192 + 4 * cg), r4n = *(const LAS f32x4*)(sp + 256 + 4 * cg);
                    const f32x2 v2n = *(const LAS f32x2*)(sp + 320 + row0);
                    f32x2 sa = SS[0] * SPL(nk4[0]);
#pragma unroll
                    for (int i = 1; i < 4; ++i) sa = __builtin_elementwise_fma(SS[i], SPL(nk4[i]), sa);
                    float sa0 = sa.x, sa1 = sa.y, y0 = yp.x, y1 = yp.y;
                    scan::row_sum16x4(sa0, sa1, y0, y1);
                    if (cg == 0) { yb[s * 32 + row0] = y0; yb[s * 32 + row0 + 1] = y1; }
                    sa = (f32x2){sa0, sa1};
                    yp = (f32x2){0.f, 0.f};
#pragma unroll
                    for (int i = 0; i < 4; ++i) {
                        f32x2 t = v2 * SPL(k4[i]);
                        t = __builtin_elementwise_fma(sa, SPL(b4[i]), t);
                        SS[i] = __builtin_elementwise_fma(SS[i], SPL(w4[i]), t);
                        yp = __builtin_elementwise_fma(SS[i], SPL(r4[i]), yp);
                    }
                    w4 = w4n; nk4 = nk4n; b4 = b4n; k4 = k4n; r4 = r4n; v2 = v2n;
                }
#undef SPL
                float d0 = 0.f, d1 = 0.f, y0 = yp.x, y1 = yp.y;
                scan::row_sum16x4(y0, y1, d0, d1);
                if (cg == 0) { yb[scan::TC * 32 + row0] = y0; yb[scan::TC * 32 + row0 + 1] = y1; }
#ifdef PROBE_SCAN
                if (PROBE_SCAN == 1) pacc += __builtin_amdgcn_s_memrealtime() - pt0;
#endif
                SC_SIGNAL(2 + (ch & 1));
            }
            __builtin_amdgcn_s_setprio(0);
        } else {
            ScanRegs SR;
            const float kkw = kk_w[hd * 64 + lane], kaw = ka_w[hd * 64 + lane];
            scan_issue(F, SR, RKV, DEC, AA, b, hd, 0); scan_fill(F, SR, F.lds, kkw, kaw, half); SC_SIGNAL(0); scan_issue(F, SR, RKV, DEC, AA, b, hd, 1);
            LAS float* cscr = (LAS float*)(F.lds + 98816 + (w - 4) * 8448);
            for (int it = 0; it < NCH; ++it) {
#ifdef PROBE_SCAN
                const unsigned long long pt0 = __builtin_amdgcn_s_memrealtime();
#endif
                const int gid0 = ((it * 256 + vb) * 4 + (w - 4)) * 2;
                const CvItem ia = cv_item(gid0, w13, w2, m13, m2), ib = cv_item(gid0 + 1, w13, w2, m13, m2);
                float ca[32];
                cv_load(ca, ia, lane);
                if (it >= 1) SC_WAIT(2 + ((it - 1) & 1), 4 * ((it - 1) / 2 + 1));
                if (it + 1 < NCH) { scan_fill(F, SR, F.lds + ((it + 1) & 1) * scan::CHB, kkw, kaw, half); SC_SIGNAL((it + 1) & 1); }
                if (it + 2 < NCH) scan_issue(F, SR, RKV, DEC, AA, b, hd, it + 2);
                if (it >= 1) { scan_flush(F, F.lds + scan::OFF_Y + ((it - 1) & 1) * scan::YB, YRAW, b, hd, half, it - 1); SC_SIGNAL(4 + ((it - 1) & 1)); }
                cv_store(ca, ia, cscr, lane);
                cv_load(ca, ib, lane); cv_store(ca, ib, cscr, lane);
#ifdef PROBE_SCAN
                if (PROBE_SCAN == 2) pacc += __builtin_amdgcn_s_memrealtime() - pt0;
#endif
            }
            SC_WAIT(2 + ((NCH - 1) & 1), 4 * ((NCH - 1) / 2 + 1));
            scan_flush(F, F.lds + scan::OFF_Y + ((NCH - 1) & 1) * scan::YB, YRAW, b, hd, half, NCH - 1);
        }
#undef SC_WAIT
#undef SC_SIGNAL
        __syncthreads();
        if (F.tid < 6) fl[F.tid] = 0u;
        __syncthreads();
    }
    return pacc;
}

namespace sc2 {
constexpr int C = 16, NCHK = SEQ / C, NSLOT = 6, NPREP = 5;
constexpr int OFF_XT = 0, OFF_ZS = 4096, OFF_B2T = 8192, OFF_VT = 10240, OFF_GC = 11264, SLOTB = 11520;
constexpr int OFF_SCR = NSLOT * SLOTB, SCRB = 8448;
constexpr int FL = 138240;
constexpr int NITEM = CV_TOTAL / 256;
constexpr int NDRAIN = NITEM;
DI bf16x8 pack8(float a0, float a1, float a2, float a3, float a4, float a5, float a6, float a7) { const u32x4 u = {pk2(a0, a1), pk2(a2, a3), pk2(a4, a5), pk2(a6, a7)}; return __builtin_bit_cast(bf16x8, u); }
struct Raw { unsigned short r[16], k[16], a[16], v[8]; float dec[16]; };
DI void issue(Raw& R, const bf16_t* RKV, const float* DEC, const bf16_t* AA, int b, int hd, int half, int c, int lane) {
#pragma unroll
    for (int t = 0; t < 16; ++t) {
        const size_t o = ((size_t)b * SEQ + (size_t)c * C + t) * DM + hd * 64 + lane;
        R.r[t] = RKV[o]; R.k[t] = RKV[(size_t)M * DM + o]; R.dec[t] = DEC[o]; R.a[t] = AA[o];
    }
#pragma unroll
    for (int q = 0; q < 8; ++q) R.v[q] = RKV[(size_t)2 * M * DM + ((size_t)b * SEQ + (size_t)c * C + 8 * (lane >> 5) + q) * DM + hd * 64 + half * 32 + (lane & 31)];
}
}
DI unsigned long long phase_scan2(const Frame& F, const bf16_t* RKV, const float* DEC, const bf16_t* AA, const float* kk_w, const float* ka_w, bf16_t* YRAW,
                    const float* w13, const float* w2, unsigned char* m13, unsigned char* m2) {
    using namespace sc2;
    unsigned long long pacc = 0ull;
    for (int vb = blockIdx.x; vb < 256; vb += F.G) {
        const int xq_ = vb & 7, yq_ = vb >> 3; const int half = yq_ & 1, bh = (yq_ >> 1) * 8 + xq_, b = bh >> 5, hd = bh & 31;
        const int w = F.wave, lane = opq(F.lane);
        const int n = lane & 31, h = lane >> 5;
        volatile LAS unsigned* fl = (volatile LAS unsigned*)(F.lds + FL);
#define SC_WAIT(idx, target) do { unsigned sp_ = 0; while (fl[idx] < (unsigned)(target) && ++sp_ < (1u << 24)) __builtin_amdgcn_s_sleep(1); asm volatile("" ::: "memory"); } while (0)
#define SC_GRAB(dst) do { unsigned g_ = 0; if (lane == 0) g_ = __hip_atomic_fetch_add((LAS unsigned*)&fl[7], 1u, __ATOMIC_RELAXED, __HIP_MEMORY_SCOPE_WORKGROUP); dst = __builtin_amdgcn_readfirstlane((int)g_); } while (0)
#define SC_GID(nn) (((nn) >> 3) * 2048 + vb * 8 + ((nn) & 7))
        if (w == 0) {
            __builtin_amdgcn_s_setprio(3);
            f32x16 ST0, ST1;
#pragma unroll
            for (int r = 0; r < 16; ++r) { ST0[r] = 0.f; ST1[r] = 0.f; }
            bf16x8 Sb0 = pack8(0.f, 0.f, 0.f, 0.f, 0.f, 0.f, 0.f, 0.f), Sb1 = Sb0, Sb2 = Sb0, Sb3 = Sb0;
            bf16_t* yout = YRAW + (size_t)b * SEQ * DM + hd * 64 + half * 32 + n;
#ifdef PROBE_SCAN
            const unsigned long long pc0 = __builtin_amdgcn_s_memrealtime();
#endif
#pragma unroll 1
            for (int c = 0; c < NCHK; ++c) {
                const int slot = c % NSLOT;
                const LAS unsigned char* sl = F.lds + slot * SLOTB;
                SC_WAIT(slot, c + 1);
                const int sw8 = n & 7, sw4 = (n >> 1) & 3;
                const bf16x8 A10 = *(const LAS bf16x8*)(sl + OFF_XT + n * 128 + (((0 + h) ^ sw8) << 4)), A11 = *(const LAS bf16x8*)(sl + OFF_XT + n * 128 + (((2 + h) ^ sw8) << 4)),
                             A12 = *(const LAS bf16x8*)(sl + OFF_XT + n * 128 + (((4 + h) ^ sw8) << 4)), A13 = *(const LAS bf16x8*)(sl + OFF_XT + n * 128 + (((6 + h) ^ sw8) << 4));
                const bf16x8 A20 = *(const LAS bf16x8*)(sl + OFF_B2T + n * 64 + (((0 + h) ^ sw4) << 4)), A21 = *(const LAS bf16x8*)(sl + OFF_B2T + n * 64 + (((2 + h) ^ sw4) << 4));
                const bf16x8 Vb = *(const LAS bf16x8*)(sl + OFF_VT + n * 32 + ((h ^ ((n >> 2) & 1)) << 4));
                const bf16x8 A300 = *(const LAS bf16x8*)(sl + OFF_ZS + n * 64 + (((0 + h) ^ sw4) << 4)), A301 = *(const LAS bf16x8*)(sl + OFF_ZS + n * 64 + (((2 + h) ^ sw4) << 4)),
                             A310 = *(const LAS bf16x8*)(sl + OFF_ZS + (32 + n) * 64 + (((0 + h) ^ sw4) << 4)), A311 = *(const LAS bf16x8*)(sl + OFF_ZS + (32 + n) * 64 + (((2 + h) ^ sw4) << 4));
                f32x4 gc0[4], gc1[4];
#pragma unroll
                for (int g = 0; g < 4; ++g) { gc0[g] = *(const LAS f32x4*)(sl + OFF_GC + (8 * g + 4 * h) * 4); gc1[g] = *(const LAS f32x4*)(sl + OFF_GC + (32 + 8 * g + 4 * h) * 4); }
                asm volatile("s_waitcnt lgkmcnt(0)" ::: "memory");
                if (lane == 0) fl[6] = (unsigned)(c + 1);
                f32x16 P;
#pragma unroll
                for (int r = 0; r < 16; ++r) P[r] = 0.f;
                P = MFMA32(A10, Sb0, P); P = MFMA32(A11, Sb1, P); P = MFMA32(A12, Sb2, P); P = MFMA32(A13, Sb3, P);
                const bf16x8 Bp = pack8(P[0], P[1], P[2], P[3], P[4], P[5], P[6], P[7]);
                f32x16 D2 = P;
#pragma unroll
                for (int r = 0; r < 8; ++r) D2[r] = 0.f;
                D2 = MFMA32(A20, Bp, D2); D2 = MFMA32(A21, Vb, D2);
                const bf16x8 Bu = pack8(D2[0], D2[1], D2[2], D2[3], D2[4], D2[5], D2[6], D2[7]);
#pragma unroll
                for (int r = 0; r < 16; ++r) { ST0[r] *= gc0[r >> 2][r & 3]; ST1[r] *= gc1[r >> 2][r & 3]; }
                ST0 = MFMA32(A300, Bu, ST0); ST0 = MFMA32(A301, Vb, ST0);
                ST1 = MFMA32(A310, Bu, ST1); ST1 = MFMA32(A311, Vb, ST1);
#pragma unroll
                for (int q = 0; q < 8; ++q) yout[((size_t)c * C + 8 * (q >> 2) + 4 * h + (q & 3)) * DM] = (bf16_t)f2bf(D2[8 + q]);
                Sb0 = pack8(ST0[0], ST0[1], ST0[2], ST0[3], ST0[4], ST0[5], ST0[6], ST0[7]); Sb1 = pack8(ST0[8], ST0[9], ST0[10], ST0[11], ST0[12], ST0[13], ST0[14], ST0[15]);
                Sb2 = pack8(ST1[0], ST1[1], ST1[2], ST1[3], ST1[4], ST1[5], ST1[6], ST1[7]); Sb3 = pack8(ST1[8], ST1[9], ST1[10], ST1[11], ST1[12], ST1[13], ST1[14], ST1[15]);
            }
#ifdef PROBE_SCAN
            if (PROBE_SCAN == 2) pacc += __builtin_amdgcn_s_memrealtime() - pc0;
#endif
            __builtin_amdgcn_s_setprio(0);
        } else {
            LAS unsigned char* scr = F.lds + OFF_SCR + (w - 1) * SCRB;
            if (w <= NPREP) {
                __builtin_amdgcn_s_setprio(2);
                const float kkw = kk_w[hd * 64 + lane], kaw = ka_w[hd * 64 + lane];
                const int xslot = (lane >> 4) * 2 + ((lane >> 2) & 1), xq = (4 * ((lane >> 3) & 1) + (lane & 3)) * 2;
                LAS unsigned char* ZT = scr; LAS float* GS = (LAS float*)(scr + 4096);
                Raw R; issue(R, RKV, DEC, AA, b, hd, half, w - 1, lane);
#pragma unroll 1
                for (int c = w - 1; c < NCHK; c += NPREP) {
                    const int slot = c % NSLOT;
                    LAS unsigned char* sl = F.lds + slot * SLOTB;
                    if (c >= NSLOT) SC_WAIT(6, c - NSLOT + 1);
#ifdef PROBE_SCAN
                    const unsigned long long pp0 = __builtin_amdgcn_s_memrealtime();
#endif
                    float gC = R.dec[0];
#pragma unroll
                    for (int t = 1; t < 16; ++t) gC *= R.dec[t];
                    float gam = 1.0f, zbp = 0.f, zkp = 0.f; unsigned zb[8], zk[8];
#pragma unroll
                    for (int t = 0; t < 16; ++t) {
                        const float r = bf2f(R.r[t]), k = bf2f(R.k[t]), a = bf2f(R.a[t]), dec = R.dec[t];
                        const float kx = k * kkw;
                        const float kk = kx * __builtin_amdgcn_rsqf(fmaxf(scan::wave_sum_dpp(kx * kx), 1e-24f));
                        const float kp = k * (1.0f + (a - 1.0f) * kaw);
                        const float at = -kk * gam;
                        gam *= dec;
                        const float ig = __builtin_amdgcn_rcpf(gam);
                        const float rt = r * gam;
                        const float bt = kk * a * ig, kt = kp * ig;
                        *(LAS unsigned short*)(sl + OFF_XT + t * 128 + ((xslot ^ (t & 7)) << 4) + xq) = (unsigned short)f2bf(at);
                        *(LAS unsigned short*)(sl + OFF_XT + (16 + t) * 128 + ((xslot ^ (t & 7)) << 4) + xq) = (unsigned short)f2bf(rt);
                        *(LAS unsigned short*)(ZT + t * 128 + ((xslot ^ (t & 7)) << 4) + xq) = (unsigned short)f2bf(bt);
                        *(LAS unsigned short*)(ZT + (16 + t) * 128 + ((xslot ^ (t & 7)) << 4) + xq) = (unsigned short)f2bf(kt);
                        if (t & 1) { zb[t >> 1] = pk2(zbp, bt * gC); zk[t >> 1] = pk2(zkp, kt * gC); } else { zbp = bt * gC; zkp = kt * gC; }
                    }
                    {
                        const int sw4 = (lane >> 1) & 3;
                        LAS unsigned char* zr = sl + OFF_ZS + lane * 64;
                        *(LAS u32x4*)(zr + ((0 ^ sw4) << 4)) = (u32x4){zb[0], zb[1], zb[4], zb[5]};
                        *(LAS u32x4*)(zr + ((1 ^ sw4) << 4)) = (u32x4){zb[2], zb[3], zb[6], zb[7]};
                        *(LAS u32x4*)(zr + ((2 ^ sw4) << 4)) = (u32x4){zk[0], zk[1], zk[2], zk[3]};
                        *(LAS u32x4*)(zr + ((3 ^ sw4) << 4)) = (u32x4){zk[4], zk[5], zk[6], zk[7]};
                        *(LAS float*)(sl + OFF_GC + lane * 4) = gC;
                        const u32x4 vv = {(unsigned)R.v[0] | ((unsigned)R.v[1] << 16), (unsigned)R.v[2] | ((unsigned)R.v[3] << 16), (unsigned)R.v[4] | ((unsigned)R.v[5] << 16), (unsigned)R.v[6] | ((unsigned)R.v[7] << 16)};
                        *(LAS u32x4*)(sl + OFF_VT + n * 32 + ((h ^ ((n >> 2) & 1)) << 4)) = vv;
                    }
                    if (c + NPREP < NCHK) issue(R, RKV, DEC, AA, b, hd, half, c + NPREP, lane);
                    asm volatile("s_waitcnt lgkmcnt(0)" ::: "memory");
                    f32x16 Gm;
#pragma unroll
                    for (int r = 0; r < 16; ++r) Gm[r] = 0.f;
#pragma unroll
                    for (int kq = 0; kq < 4; ++kq) {
                        const int so = ((2 * kq + h) ^ (n & 7)) << 4;
                        const bf16x8 za = *(const LAS bf16x8*)(ZT + n * 128 + so), xb = *(const LAS bf16x8*)(sl + OFF_XT + n * 128 + so);
                        Gm = MFMA32(za, xb, Gm);
                    }
#pragma unroll
                    for (int r = 0; r < 16; ++r) GS[(8 * (r >> 2) + 4 * h + (r & 3)) * 32 + n] = Gm[r];
                    asm volatile("s_waitcnt lgkmcnt(0)" ::: "memory");
                    float Xs[16], Wl[16];
                    const int tq = n - 16;
#pragma unroll
                    for (int s = 0; s < 16; ++s) {
                        const float gq = GS[s * 32 + n], gk = GS[(16 + s) * 32 + n];
                        Xs[s] = n < 16 ? (n == s ? 1.0f : 0.0f) : (s <= tq ? gq : 0.0f);
                        Wl[s] = (n >= 16 && s <= tq) ? gk : 0.0f;
                    }
#pragma unroll
                    for (int s = 14; s >= 0; --s) {
#pragma unroll
                        for (int qd = (s + 1) >> 2; qd < 4; ++qd) {
                            const f32x4 l4 = *(const LAS f32x4*)(GS + s * 32 + 4 * qd);
#pragma unroll
                            for (int e = 0; e < 4; ++e) if (4 * qd + e > s) Xs[s] = fmaf(l4[e], Xs[4 * qd + e], Xs[s]);
                        }
                    }
#pragma unroll
                    for (int s = 0; s < 15; ++s) {
#pragma unroll
                        for (int qd = (s + 1) >> 2; qd < 4; ++qd) {
                            const f32x4 l4 = *(const LAS f32x4*)(GS + (16 + s) * 32 + 4 * qd);
#pragma unroll
                            for (int e = 0; e < 4; ++e) if (4 * qd + e > s) Wl[s] = fmaf(l4[e], Xs[4 * qd + e], Wl[s]);
                        }
                    }
                    if (lane < 32) {
                        const int sw4 = (n >> 1) & 3;
                        LAS unsigned char* br = sl + OFF_B2T + n * 64;
                        *(LAS bf16x8*)(br + ((0 ^ sw4) << 4)) = pack8(Xs[0], Xs[1], Xs[2], Xs[3], Xs[8], Xs[9], Xs[10], Xs[11]);
                        *(LAS bf16x8*)(br + ((1 ^ sw4) << 4)) = pack8(Xs[4], Xs[5], Xs[6], Xs[7], Xs[12], Xs[13], Xs[14], Xs[15]);
                        *(LAS bf16x8*)(br + ((2 ^ sw4) << 4)) = pack8(Wl[0], Wl[1], Wl[2], Wl[3], Wl[4], Wl[5], Wl[6], Wl[7]);
                        *(LAS bf16x8*)(br + ((3 ^ sw4) << 4)) = pack8(Wl[8], Wl[9], Wl[10], Wl[11], Wl[12], Wl[13], Wl[14], Wl[15]);
                    }
                    asm volatile("s_waitcnt lgkmcnt(0)" ::: "memory");
                    if (lane == 0) fl[slot] = (unsigned)(c + 1);
#ifdef PROBE_SCAN
                    if (PROBE_SCAN == 1 && w == 1) pacc += __builtin_amdgcn_s_memrealtime() - pp0;
#endif
                }
                __builtin_amdgcn_s_setprio(0);
            }
#ifdef PROBE_SCAN
            const unsigned long long pv0 = __builtin_amdgcn_s_memrealtime();
#endif
#pragma unroll 1
            for (;;) {
                int nn; SC_GRAB(nn); nn *= 4;
                if (nn >= NDRAIN) break;
                const CvItem i0 = cv_item(SC_GID(nn), w13, w2, m13, m2), i1 = cv_item(SC_GID(nn + 1), w13, w2, m13, m2), i2 = cv_item(SC_GID(nn + 2), w13, w2, m13, m2), i3 = cv_item(SC_GID(nn + 3), w13, w2, m13, m2);
                float c0[32], c1[32], c2[32], c3[32];
                cv_load<false>(c0, i0, lane); cv_load<false>(c1, i1, lane); cv_load<false>(c2, i2, lane); cv_load<false>(c3, i3, lane);
                cv_store<false>(c0, i0, (LAS float*)scr, lane); cv_store<false>(c1, i1, (LAS float*)scr, lane); cv_store<false>(c2, i2, (LAS float*)scr, lane); cv_store<false>(c3, i3, (LAS float*)scr, lane);
            }
#ifdef PROBE_SCAN
            if (PROBE_SCAN == 3 && w == 4) pacc += __builtin_amdgcn_s_memrealtime() - pv0;
            if (PROBE_SCAN == 4 && w == 1) pacc += __builtin_amdgcn_s_memrealtime() - pv0;
#endif
        }
#undef SC_WAIT
#undef SC_GRAB
#undef SC_GID
        __syncthreads();
        if (F.tid < 8) fl[F.tid] = 0u;
        __syncthreads();
    }
    return pacc;
}

constexpr int NPHASE = 19;
__global__ void __launch_bounds__(NTHR, 2) mk_fwd(Args args) {
    extern __shared__ __attribute__((aligned(16))) unsigned char lds_raw[];
    Frame F;
    F.lds = (LAS unsigned char*)lds_raw;
    F.tid = threadIdx.x; F.lane = F.tid & 63; F.wave = __builtin_amdgcn_readfirstlane(F.tid >> 6);
    F.G = gridDim.x; F.gw = blockIdx.x * NWAVES + F.wave; F.NGW = F.G * NWAVES; F.ws = args.ws;
    unsigned char* ws = args.ws;
    unsigned* ctl = (unsigned*)(ws + WS_CTL);
    volatile LAS unsigned* MISC = (volatile LAS unsigned*)(F.lds + MISC_OFF);
    for (int u = F.tid; u < (LDS_BYTES - LDSCTL_OFF) / 4; u += NTHR) ((LAS unsigned*)(F.lds + LDSCTL_OFF))[u] = 0u;
    __syncthreads();
    XcdBarrier bar; bar.bar = ctl + CW_BAR; bar.x = 0; bar.st = nullptr;
    if (args.use_bar) bar = xcd_barrier_post(ctl + CW_BAR, MISC + 8);
    const int lo = args.ph_lo, hi = args.ph_hi;
#ifndef PH_MASK
#define PH_MASK 0xFFFFFFFFu
#endif
#define IN(k) (((PH_MASK >> (k)) & 1u) && lo <= (k) && (k) < hi)
#define SEAM(k) do { if (IN(k) && IN((k) + 1)) xcd_barrier(bar); if (PROBE_ON(k)) probe_acc += __builtin_amdgcn_s_memrealtime() - probe_t0; if (PROBE_ON((k) + 1)) probe_t0 = __builtin_amdgcn_s_memrealtime(); } while (0)
#ifndef REPEAT_MASK
#define REPEAT_MASK 0u
#endif
#define REPS(k) ((((REPEAT_MASK) >> (k)) & 1u) ? 2 : 1)
#ifndef PROBE_MASK
#define PROBE_MASK 0u
#endif
    unsigned long long probe_acc = 0ull, probe_t0 = 0ull;
#define PROBE_ON(k) (PROBE_MASK != 0u && (((PROBE_MASK) >> (k)) & 1u) && blockIdx.x == 0 && F.tid == 0)
#define PH(k) if (IN(k)) for (int rep_ = 0; rep_ < REPS(k); ++rep_, (rep_ < REPS(k) ? xcd_barrier(bar) : (void)0))

    bf16_t* W_IN = (bf16_t*)(ws + WS_W_IN); bf16_t* W_OUT = (bf16_t*)(ws + WS_W_OUT); bf16_t* CMPW1 = (bf16_t*)(ws + WS_CMPW1);
    bf16_t* FFN13 = (bf16_t*)(ws + WS_FFN13); bf16_t* FFN2 = (bf16_t*)(ws + WS_FFN2); bf16_t* WRKV = (bf16_t*)(ws + WS_WRKV);
    bf16_t* LORA1 = (bf16_t*)(ws + WS_LORA1); bf16_t* LORA2 = (bf16_t*)(ws + WS_LORA2); bf16_t* WO = (bf16_t*)(ws + WS_WO);
    bf16_t* MOE13 = (bf16_t*)(ws + WS_MOE13); bf16_t* MOE2 = (bf16_t*)(ws + WS_MOE2);
    bf16_t* XN = (bf16_t*)(ws + WS_XN); bf16_t* P = (bf16_t*)(ws + WS_P); float* ROPE = (float*)(ws + WS_ROPE); float* CMPB = (float*)(ws + WS_CMPB);
    bf16_t* HID = (bf16_t*)(ws + WS_HID); bf16_t* KVC = (bf16_t*)(ws + WS_KVC); bf16_t* O = (bf16_t*)(ws + WS_O); bf16_t* H = (bf16_t*)(ws + WS_H);
    bf16_t* ACT = (bf16_t*)(ws + WS_ACT); bf16_t* XS = (bf16_t*)(ws + WS_XS); bf16_t* RKV = (bf16_t*)(ws + WS_RKV); bf16_t* L1 = (bf16_t*)(ws + WS_L1);
    float* DEC = (float*)(ws + WS_DEC); bf16_t* AA = (bf16_t*)(ws + WS_AA); bf16_t* GG = (bf16_t*)(ws + WS_GG); bf16_t* YRAW = (bf16_t*)(ws + WS_YRAW); bf16_t* YG = (bf16_t*)(ws + WS_YG);
    int* ROWTOK = (int*)(ws + WS_ROWTOK); int* TOKSLOT = (int*)(ws + WS_TOKSLOT); float* Y2 = (float*)(ws + WS_Y2);
    LAS unsigned char* ring = F.lds;

    if (PROBE_ON(0)) probe_t0 = __builtin_amdgcn_s_memrealtime();
    PH(0) {
        LAS float* scr = (LAS float*)(F.lds + F.wave * 16640);
        transpose_matrix(F, args.in[I_W_IN], IN_COLS, DM, W_IN, DM, NP, ColInProj{}, scr, F.gw, F.NGW);
        for (int kv = 0; kv < 2; ++kv) transpose_matrix(F, args.in[I_CMP_W1] + (size_t)kv * 2048 * 256, 256, 2048, CMPW1 + (size_t)kv * 256 * 2048, 2048, 256, ColIdent{}, scr, F.gw, F.NGW);
        for (int m = F.gw; m < M; m += F.NGW) rms_row_to_bf16(args.in[I_X] + (size_t)m * DM, args.in[I_ATTN_NORM], XN + (size_t)m * DM, F.lane);
        { const int* pos = (const int*)args.in[I_POS];
          for (int i = blockIdx.x * NTHR + F.tid; i < M * 32; i += F.G * NTHR) { const int m = i >> 5, j = i & 31;
              const float inv = powf(150000.0f, -(float)j / 32.0f); const float ang = (float)pos[m] * inv; float sn, cs; sincosf(ang, &sn, &cs);
              ROPE[(size_t)m * 64 + j] = cs; ROPE[(size_t)m * 64 + 32 + j] = sn; } }
        if (F.gw < 512) { const int kv = F.gw >> 8, j = F.gw & 255; const float* pe = args.in[I_CMP_PE] + kv * 2048; const float* w1 = args.in[I_CMP_W1] + (size_t)kv * 2048 * 256;
            float s = 0.f; for (int i = F.lane; i < 2048; i += 64) s += pe[i] * w1[(size_t)i * 256 + j];
            s = wave_sum(s); if (F.lane == 0) CMPB[kv * 256 + j] = s + args.in[I_CMP_B1][kv * 256 + j]; }
    }
    SEAM(0);
    PH(1) {
        OrderSingle S{(const char*)XN, (const char*)W_IN, DM * 2, DM * 2, 64, 12, 64 * 12, F.G, (int)blockIdx.x};
        EpiInProj E{P, ROPE};
        pg8::gemm_phase<EpiInProj, OrderSingle, false>(ring, DM * 2, 128, DM * 2, DM / 64, S, E);
    }
    SEAM(1);
    PH(2) {
        OrderCmp S{(const char*)P, (const char*)CMPW1, (const char*)XN, (const char*)(W_IN + (size_t)C_GATE * DM), F.G, (int)blockIdx.x};
        EpiCmp1 E{HID, CMPB, P};
        pg8::gemm_phase<EpiCmp1, OrderCmp, true>(ring, 0, 0, 2048 * 2, 32, S, E);
        const bool conv = F.G > 80 ? (int)blockIdx.x >= 80 : true;
        if (conv) {
            const int nconv = F.G > 80 ? F.G - 80 : F.G; const int first = ((F.G > 80 ? (int)blockIdx.x - 80 : (int)blockIdx.x)) * NWAVES + F.wave, stride = nconv * NWAVES;
            LAS float* scr = (LAS float*)(F.lds + F.wave * 16640);
            transpose_matrix(F, args.in[I_W_OUT], DM, DM, W_OUT, DM, DM, ColIdent{}, scr, first, stride);
            transpose_matrix(F, args.in[I_FFN_W13], 2 * DFF, DM, FFN13, DM, 2 * DFF, ColSwiglu{DFF}, scr, first, stride);
            transpose_matrix(F, args.in[I_FFN_W2], DM, DFF, FFN2, DFF, DM, ColIdent{}, scr, first, stride);
            for (int i = 0; i < 3; ++i) transpose_matrix(F, args.in[I_W_RKV] + (size_t)i * DM * DM, DM, DM, WRKV + (size_t)i * DM * DM, DM, DM, ColIdent{}, scr, first, stride);
            transpose_matrix(F, args.in[I_DECAY_W1], 96, DM, LORA1, DM, 256, ColIdent{}, scr, first, stride);
            transpose_matrix(F, args.in[I_A1], 96, DM, LORA1 + (size_t)256 * DM, DM, 256, ColIdent{}, scr, first, stride);
            transpose_matrix(F, args.in[I_G1], 256, DM, LORA1 + (size_t)512 * DM, DM, 256, ColIdent{}, scr, first, stride);
            transpose_matrix(F, args.in[I_DECAY_W2], DM, 96, LORA2, 256, DM, ColIdent{}, scr, first, stride);
            transpose_matrix(F, args.in[I_A2], DM, 96, LORA2 + (size_t)DM * 256, 256, DM, ColIdent{}, scr, first, stride);
            transpose_matrix(F, args.in[I_G2], DM, 256, LORA2 + (size_t)2 * DM * 256, 256, DM, ColIdent{}, scr, first, stride);
            transpose_matrix(F, args.in[I_W_O], DM, DM, WO, DM, DM, ColIdent{}, scr, first, stride);
        }
    }
    SEAM(2);
    PH(3) {
        for (int it = blockIdx.x * NTHR + F.tid; it < 2 * 2048 * 16; it += F.G * NTHR) {
            const int dq = it & 15, row = (it >> 4) & 2047, kv = it >> 15;
            const bf16_t* hr = HID + ((size_t)kv * 2048 + row) * 256; const float* w2 = args.in[I_CMP_W2] + (size_t)kv * 256 * 64 + dq * 4;
            f32x4 a = (f32x4){0.f, 0.f, 0.f, 0.f};
            for (int j = 0; j < 256; j += 2) { const unsigned hw = *(const unsigned*)(hr + j); a += bflo(hw) * *(const f32x4*)(w2 + (size_t)j * 64); a += bfhi(hw) * *(const f32x4*)(w2 + (size_t)(j + 1) * 64); }
            u32x2 o; o.x = pk2(a.x, a.y); o.y = pk2(a.z, a.w); *(u32x2*)(KVC + ((size_t)kv * 2048 + row) * 64 + dq * 4) = o;
        }
    }
    SEAM(3);
    PH(4) {
        for (int vb = blockIdx.x; vb < 256; vb += F.G) {
            const int bh = vb >> 5, p = vb & 31;
#pragma unroll 1
            for (int k = 0; k < 2; ++k) attn_unit_B(F, P, KVC, O, nullptr, bh >> 1, bh & 1, k == 0 ? 63 - p : p);
#pragma unroll 1
            for (int k = 0; k < 2; ++k) { const int id = 2 * vb + k; attn_unit_A(F, P, O, args.in[I_SINKS], id >> 7, (id >> 6) & 1, id & 63); }
        }
    }
    SEAM(4);
    PH(5) {
        OrderSingle S{(const char*)O, (const char*)W_OUT, DM * 2, DM * 2, 64, 8, 512, F.G, (int)blockIdx.x};
        EpiResH<true> E{args.in[I_X], H};
        pg8::gemm_phase<EpiResH<true>, OrderSingle, false>(ring, DM * 2, 128, DM * 2, DM / 64, S, E);
    }
    SEAM(5);
    PH(6) { for (int m = F.gw; m < M; m += F.NGW) rms_row_to_bf16_h(H + (size_t)m * DM, args.in[I_FFN_NORM], XN + (size_t)m * DM, F.lane); }
    SEAM(6);
    PH(7) {
        OrderSingle S{(const char*)XN, (const char*)FFN13, DM * 2, DM * 2, 64, 2 * DFF / 256, 64 * (2 * DFF / 256), F.G, (int)blockIdx.x};
        EpiSwiglu E{ACT, DFF};
        pg8::gemm_phase<EpiSwiglu, OrderSingle, false>(ring, DM * 2, 128, DM * 2, DM / 64, S, E);
    }
    SEAM(7);
    PH(8) {
        OrderSingle S{(const char*)ACT, (const char*)FFN2, DFF * 2, DFF * 2, 64, 8, 512, F.G, (int)blockIdx.x};
        EpiResH<false> E{H, H};
        pg8::gemm_phase<EpiResH<false>, OrderSingle, false>(ring, DFF * 2, 128, DFF * 2, DFF / 64, S, E);
    }
    SEAM(8);
    PH(9) {
        const float* g = args.in[I_ATTN_NORM] + DM; const float* mu = args.in[I_MU];
        for (int m0 = F.gw * 8; m0 < M; m0 += F.NGW * 8) {
            f32x4 hp[8], vn[8];
            const bool has_prev0 = (m0 % SEQ) != 0;
            if (has_prev0) { float prs; rms_row_load_h(H + (size_t)(m0 - 1) * DM, F.lane, hp, prs);
#pragma unroll
                for (int j = 0; j < 8; ++j) hp[j] = hp[j] * prs * *(const f32x4*)(g + 4 * F.lane + 256 * j);
            } else {
#pragma unroll
                for (int j = 0; j < 8; ++j) hp[j] = (f32x4){0.f, 0.f, 0.f, 0.f};
            }
#pragma unroll
            for (int j = 0; j < 8; ++j) vn[j] = ld4bf(H + (size_t)m0 * DM + 4 * F.lane + 256 * j);
            for (int q = 0; q < 8; ++q) {
                const int m = m0 + q;
                f32x4 v[8]; float ss = 0.f;
#pragma unroll
                for (int j = 0; j < 8; ++j) { v[j] = vn[j]; ss += (v[j].x * v[j].x + v[j].y * v[j].y) + (v[j].z * v[j].z + v[j].w * v[j].w); }
                if (q < 7) {
#pragma unroll
                    for (int j = 0; j < 8; ++j) vn[j] = ld4bf(H + (size_t)(m + 1) * DM + 4 * F.lane + 256 * j);
                }
                const float rs = __builtin_amdgcn_rsqf(scan::wave_sum_dpp(ss) * (1.0f / DM) + RMS_EPS);
                const float* g_ = opqp(g); const float* mu_ = opqp(mu);
#pragma unroll
                for (int j = 0; j < 8; ++j) {
                    const int col = 4 * F.lane + 256 * j; const f32x4 gg = *(const f32x4*)(g_ + col);
                    const f32x4 hn = v[j] * rs * gg; const f32x4 xx = hp[j] - hn; hp[j] = hn;
#pragma unroll
                    for (int i = 0; i < 6; ++i) { const f32x4 mm = *(const f32x4*)(mu_ + (size_t)i * DM + col); const f32x4 y = hn + xx * mm;
                        u32x2 w; w.x = pk2(y.x, y.y); w.y = pk2(y.z, y.w); *(u32x2*)(XS + ((size_t)i * M + m) * DM + col) = w; }
                }
            }
        }
    }
    SEAM(9);
    PH(10) {
        OrderMulti S{};
        for (int g = 0; g < 6; ++g) { S.A[g] = (const char*)(XS + (size_t)g * M * DM); S.Bt[g] = g < 3 ? (const char*)(WRKV + (size_t)g * DM * DM) : (const char*)(LORA1 + (size_t)(g - 3) * 256 * DM); S.nN[g] = g < 3 ? 8 : 1; }
        S.start[0] = 0; for (int g = 0; g < 6; ++g) S.start[g + 1] = S.start[g] + 64 * S.nN[g];
        S.lda = DM * 2; S.ldb = DM * 2; S.ng = 6; S.nwg = S.start[6]; S.G = F.G; S.c = (int)blockIdx.x;
        EpiRkvLora1 E{RKV, L1};
        pg8::gemm_phase<EpiRkvLora1, OrderMulti, false>(ring, DM * 2, 128, DM * 2, DM / 64, S, E);
    }
    SEAM(10);
    PH(11) {
        OrderMulti S{};
        for (int g = 0; g < 3; ++g) { S.A[g] = (const char*)(L1 + (size_t)g * M * 256); S.Bt[g] = (const char*)(LORA2 + (size_t)g * DM * 256); S.nN[g] = 8; }
        for (int g = 3; g < 6; ++g) { S.A[g] = S.A[0]; S.Bt[g] = S.Bt[0]; S.nN[g] = 0; }
        S.start[0] = 0; for (int g = 0; g < 6; ++g) S.start[g + 1] = S.start[g] + 64 * S.nN[g];
        S.lda = 256 * 2; S.ldb = 256 * 2; S.ng = 3; S.nwg = S.start[3]; S.G = F.G; S.c = (int)blockIdx.x;
        EpiLora2 E{DEC, AA, GG, args.in[I_DECAY_W0], args.in[I_A0]};
        pg8::gemm_phase<EpiLora2, OrderMulti, false>(ring, 256 * 2, 128, 256 * 2, 4, S, E);
    }
    SEAM(11);
    PH(12) {
        const unsigned long long pa = phase_scan2(F, RKV, DEC, AA, args.in[I_K_K], args.in[I_K_A], YRAW, args.in[I_MOE_W13], args.in[I_MOE_W2], (unsigned char*)MOE13, (unsigned char*)MOE2);
#ifdef PROBE_SCAN
        if (blockIdx.x == 0 && F.lane == 0 && pa != 0ull) { const unsigned long long t1 = __builtin_amdgcn_s_memrealtime(); while (__builtin_amdgcn_s_memrealtime() - t1 < 4ull * pa) __builtin_amdgcn_s_sleep(8); }
#else
        (void)pa;
#endif
    }
    SEAM(12);
    PH(13) {
        const float* lnw = args.in[I_LN_W]; const float* lnb = args.in[I_LN_B]; const float* rk = args.in[I_R_K]; const float* kaw = args.in[I_K_A];
        for (int m = F.gw; m < M; m += F.NGW) {
#pragma unroll
            for (int ps = 0; ps < 4; ++ps) {
                const int ch = ps * 512 + F.lane * 8; const size_t o = (size_t)m * DM + ch;
                const u32x4 yy = *(const u32x4*)(YRAW + o);
                const u32x4 aa = *(const u32x4*)(AA + o);
                const u32x4 rr = *(const u32x4*)(RKV + o), kk = *(const u32x4*)(RKV + (size_t)M * DM + o), vv = *(const u32x4*)(RKV + (size_t)2 * M * DM + o), gg = *(const u32x4*)(GG + o);
                float y[8] = {bflo(yy.x), bfhi(yy.x), bflo(yy.y), bfhi(yy.y), bflo(yy.z), bfhi(yy.z), bflo(yy.w), bfhi(yy.w)}, a[8] = {bflo(aa.x), bfhi(aa.x), bflo(aa.y), bfhi(aa.y), bflo(aa.z), bfhi(aa.z), bflo(aa.w), bfhi(aa.w)};
                const unsigned rw[4] = {rr.x, rr.y, rr.z, rr.w}, kw[4] = {kk.x, kk.y, kk.z, kk.w}, vw[4] = {vv.x, vv.y, vv.z, vv.w}, gw4[4] = {gg.x, gg.y, gg.z, gg.w};
                float r[8], k[8], v[8], g[8];
#pragma unroll
                for (int i = 0; i < 4; ++i) { r[2 * i] = bflo(rw[i]); r[2 * i + 1] = bfhi(rw[i]); k[2 * i] = bflo(kw[i]); k[2 * i + 1] = bfhi(kw[i]); v[2 * i] = bflo(vw[i]); v[2 * i + 1] = bfhi(vw[i]); g[2 * i] = bflo(gw4[i]); g[2 * i + 1] = bfhi(gw4[i]); }
                float s = 0.f, bs = 0.f;
#pragma unroll
                for (int i = 0; i < 8; ++i) { s += y[i]; bs += r[i] * (k[i] * (1.0f + (a[i] - 1.0f) * kaw[ch + i])) * rk[ch + i]; }
                s += scan::dpp_f<0xB1>(s); s += scan::dpp_f<0x4E>(s); s += scan::dpp_f<0x141>(s);
                bs += scan::dpp_f<0xB1>(bs); bs += scan::dpp_f<0x4E>(bs); bs += scan::dpp_f<0x141>(bs);
                const float mean = s * (1.0f / 64.0f); float q = 0.f;
#pragma unroll
                for (int i = 0; i < 8; ++i) { y[i] -= mean; q += y[i] * y[i]; }
                q += scan::dpp_f<0xB1>(q); q += scan::dpp_f<0x4E>(q); q += scan::dpp_f<0x141>(q);
                const float rstd = 1.0f / sqrtf(q * (1.0f / 64.0f) + GN_EPS);
                float out[8];
#pragma unroll
                for (int i = 0; i < 8; ++i) out[i] = ((y[i] * rstd) * lnw[ch + i] + lnb[ch + i] + bs * v[i]) * g[i];
                u32x4 w; w.x = pk2(out[0], out[1]); w.y = pk2(out[2], out[3]); w.z = pk2(out[4], out[5]); w.w = pk2(out[6], out[7]);
                *(u32x4*)(YG + o) = w;
            }
        }
    }
    SEAM(13);
    PH(14) {
        OrderSingle S{(const char*)YG, (const char*)WO, DM * 2, DM * 2, 64, 8, 512, F.G, (int)blockIdx.x};
        EpiResH<false> E{H, H};
        pg8::gemm_phase<EpiResH<false>, OrderSingle, false>(ring, DM * 2, 128, DM * 2, DM / 64, S, E);
    }
    SEAM(14);
    PH(15) {
        LAS int* t_e = (LAS int*)(F.lds + 65536);
        LAS float* t_w = (LAS float*)(F.lds + 65536 + 512);
        LAS int* t_p = (LAS int*)(F.lds + 65536 + 1024);
        LAS unsigned char* rwl = F.lds;
        const float* g = args.in[I_FFN_NORM] + DM; const float* rw = args.in[I_ROUTER];
        for (int idx = F.tid; idx < 4096; idx += NTHR) {
            const int chn = idx >> 1, half = idx & 1; const int j = chn >> 8, l = (chn & 255) >> 2, e4 = chn & 3;
            *(LAS f32x4*)(rwl + ((2 * (4 * j + e4) + half) * 64 + l) * 16) = *(const f32x4*)(rw + (size_t)idx * 4);
        }
        __syncthreads();
        for (int base = blockIdx.x * 64; base < M; base += F.G * 64) {
            f32x4 vn[8];
#pragma unroll
            for (int j = 0; j < 8; ++j) vn[j] = ld4bf(H + (size_t)(base + F.wave * 8) * DM + 4 * F.lane + 256 * j);
            for (int qq = 0; qq < 8; ++qq) {
                const int lt = F.wave * 8 + qq, m = base + lt;
                f32x4 v[8]; float ss = 0.f;
#pragma unroll
                for (int j = 0; j < 8; ++j) { v[j] = vn[j]; ss += (v[j].x * v[j].x + v[j].y * v[j].y) + (v[j].z * v[j].z + v[j].w * v[j].w); }
                if (qq < 7) {
#pragma unroll
                    for (int j = 0; j < 8; ++j) vn[j] = ld4bf(H + (size_t)(m + 1) * DM + 4 * F.lane + 256 * j);
                }
                const float rs = __builtin_amdgcn_rsqf(scan::wave_sum_dpp(ss) * (1.0f / DM) + RMS_EPS);
                float lg[8] = {0.f, 0.f, 0.f, 0.f, 0.f, 0.f, 0.f, 0.f};
#pragma unroll
                for (int j = 0; j < 8; ++j) {
                    const int col = 4 * F.lane + 256 * j; const f32x4 gg = *(const f32x4*)(g + col); const f32x4 y = v[j] * rs * gg;
                    *(unsigned*)((unsigned char*)XN + (size_t)m * DM + col) = pk4_fp8(y.x, y.y, y.z, y.w);
#pragma unroll
                    for (int e4 = 0; e4 < 4; ++e4) { const f32x4 r0 = *(const LAS f32x4*)(rwl + ((2 * (4 * j + e4)) * 64 + F.lane) * 16), r1 = *(const LAS f32x4*)(rwl + ((2 * (4 * j + e4) + 1) * 64 + F.lane) * 16); const float yy = y[e4];
                        lg[0] += yy * r0.x; lg[1] += yy * r0.y; lg[2] += yy * r0.z; lg[3] += yy * r0.w; lg[4] += yy * r1.x; lg[5] += yy * r1.y; lg[6] += yy * r1.z; lg[7] += yy * r1.w; }
                }
#pragma unroll
                for (int e = 0; e < 8; ++e) lg[e] = scan::wave_sum_dpp(lg[e]);
                if (F.lane == 0) {
                    int i0 = 0; float v0 = lg[0];
#pragma unroll
                    for (int e = 1; e < 8; ++e) if (lg[e] > v0) { v0 = lg[e]; i0 = e; }
                    int i1 = -1; float v1 = -3.0e38f;
#pragma unroll
                    for (int e = 0; e < 8; ++e) if (e != i0 && (i1 < 0 || lg[e] > v1)) { v1 = lg[e]; i1 = e; }
                    const float w1 = 1.0f / (1.0f + expf(v0 - v1)), w0 = 1.0f - w1;
                    t_e[lt * 2] = i0; t_e[lt * 2 + 1] = i1; t_w[lt * 2] = w0; t_w[lt * 2 + 1] = w1;
                }
            }
            __syncthreads();
            if (F.wave == 0) {
                const int lane = F.lane; const int ea = t_e[lane], eb = t_e[64 + lane];
                const unsigned long long below = (1ull << lane) - 1ull;
                int pa = 0, pb = 0, mycnt = 0, ra = 0, rb = 0, na_sel = 0;
#pragma unroll
                for (int e = 0; e < 8; ++e) {
                    const unsigned long long ma = __ballot(ea == e), mb = __ballot(eb == e);
                    const int na = __popcll(ma), nb = __popcll(mb);
                    if (lane == e) mycnt = na + nb;
                    if (ea == e) ra = __popcll(ma & below);
                    if (eb == e) { rb = __popcll(mb & below); na_sel = na; }
                }
                int basep = 0;
                if (lane < 8 && mycnt) basep = (int)__hip_atomic_fetch_add(ctl + CW_MOECNT + 64 * lane, (unsigned)mycnt, RLX_AGENT);
#pragma unroll
                for (int e = 0; e < 8; ++e) { const int be = __builtin_amdgcn_readlane(basep, e); if (ea == e) pa = be + ra; if (eb == e) pb = be + na_sel + rb; }
                t_p[lane] = pa; t_p[64 + lane] = pb;
            }
            __syncthreads();
            if (F.tid < 128) { const int lt = F.tid >> 1, k = F.tid & 1, m = base + lt; const int e = t_e[F.tid], pos = t_p[F.tid];
                ROWTOK[e * M + pos] = m; TOKSLOT[m * 4 + k * 2] = e; TOKSLOT[m * 4 + k * 2 + 1] = pos; ((float*)TOKSLOT)[(size_t)M * 4 + m * 2 + k] = t_w[F.tid]; }
            __syncthreads();
        }
    }
    SEAM(15);
#define MOE_TABLE() do { if (F.tid == 0) { int ts_ = 0; for (int e = 0; e < 8; ++e) { const int ce = (int)__hip_atomic_load(ctl + CW_MOECNT + 64 * e, RLX_AGENT); moetab[16 + e] = ce; moetab[e] = ts_; ts_ += (ce + 255) >> 8; } moetab[8] = ts_; } __syncthreads(); } while (0)
    LAS int* moetab = (LAS int*)(F.lds + MISC_OFF + 256);
    PH(16) {
        MOE_TABLE();
        OrderMoe SM; SM.tab = moetab;
        SM.A = (const char*)XN; SM.Bt = (const char*)MOE13; SM.rowtok = ROWTOK; SM.lda = DM; SM.ldb = DM; SM.bstride = (size_t)2 * DFFE * DM; SM.nN = 2 * DFFE / 256;
        SM.nwg = moetab[8] * SM.nN; SM.G = F.G; SM.c = (int)blockIdx.x; SM.gather = true;
        EpiSwiglu8 E{(unsigned char*)ACT, DFFE};
        pg8::gemm_phase<EpiSwiglu8, OrderMoe, true, true>(ring, DM, 128, DM, DM / 128, SM, E, 0x7f7f7f7f, 0x79797979);
    }
    SEAM(16);
    PH(17) {
        MOE_TABLE();
        OrderMoe SM; SM.tab = moetab;
        SM.A = (const char*)ACT; SM.Bt = (const char*)MOE2; SM.rowtok = ROWTOK; SM.lda = DFFE; SM.ldb = DFFE; SM.bstride = (size_t)DM * DFFE; SM.nN = 8;
        SM.nwg = moetab[8] * SM.nN; SM.G = F.G; SM.c = (int)blockIdx.x; SM.gather = false;
        EpiBf16Out E{(bf16_t*)Y2};
        pg8::gemm_phase<EpiBf16Out, OrderMoe, false, true>(ring, DFFE, 128, DFFE, DFFE / 128, SM, E, 0x7f7f7f7f, 0x78787878);
    }
    SEAM(17);
    PH(18) {
        MOE_TABLE();
        const float* g = args.in[I_FINAL_NORM];
        for (int m = F.gw; m < M; m += F.NGW) {
            const int e0 = TOKSLOT[m * 4], p0 = TOKSLOT[m * 4 + 1], e1 = TOKSLOT[m * 4 + 2], p1 = TOKSLOT[m * 4 + 3];
            const float w0 = ((const float*)TOKSLOT)[(size_t)M * 4 + m * 2], w1 = ((const float*)TOKSLOT)[(size_t)M * 4 + m * 2 + 1];
            const int ts0 = moetab[e0], ts1 = moetab[e1];
            const bf16_t* y0 = (const bf16_t*)Y2 + ((size_t)ts0 * 256 + p0) * DM; const bf16_t* y1 = (const bf16_t*)Y2 + ((size_t)ts1 * 256 + p1) * DM; const bf16_t* hr = H + (size_t)m * DM;
            f32x4 v[8]; float s = 0.f;
#pragma unroll
            for (int j = 0; j < 8; ++j) { const int col = 4 * F.lane + 256 * j; const u32x2 q0 = *(const u32x2*)(y0 + col), q1 = *(const u32x2*)(y1 + col);
                const f32x4 f0 = (f32x4){bflo(q0.x), bfhi(q0.x), bflo(q0.y), bfhi(q0.y)}, f1 = (f32x4){bflo(q1.x), bfhi(q1.x), bflo(q1.y), bfhi(q1.y)};
                v[j] = ld4bf(hr + col) + (w0 * f0 + w1 * f1);
                s += (v[j].x * v[j].x + v[j].y * v[j].y) + (v[j].z * v[j].z + v[j].w * v[j].w); }
            const float rstd = 1.0f / sqrtf(wave_sum(s) * (1.0f / DM) + RMS_EPS);
#pragma unroll
            for (int j = 0; j < 8; ++j) { const int col = 4 * F.lane + 256 * j; *(f32x4*)(args.out + (size_t)m * DM + col) = v[j] * rstd * *(const f32x4*)(g + col); }
        }
    }
    if (PROBE_MASK != 0u && blockIdx.x == 0 && F.tid == 0) { if (PROBE_ON(18)) probe_acc += __builtin_amdgcn_s_memrealtime() - probe_t0; const unsigned long long t1 = __builtin_amdgcn_s_memrealtime(); while (__builtin_amdgcn_s_memrealtime() - t1 < 4ull * probe_acc) __builtin_amdgcn_s_sleep(8); }
#undef IN
#undef SEAM
}

extern "C" void kernel_launch(void* const* d_in, const int* in_sizes, int n_in, void* d_out, int out_size, void* d_ws, size_t ws_size, hipStream_t stream) {
    static int grid = 0;
    if (grid == 0) {
        if (n_in != 33 || out_size != M * DM || ws_size < WS_END) { fprintf(stderr, "kernel_launch: unexpected shapes (n_in %d, out %d, ws %zu < %zu)\n", n_in, out_size, ws_size, (size_t)WS_END); grid = -1; return; }
        int dev = 0, cus = 0, per_cu = 0;
        if (hipGetDevice(&dev) != hipSuccess || hipDeviceGetAttribute(&cus, hipDeviceAttributeMultiprocessorCount, dev) != hipSuccess) { grid = -1; return; }
        if (hipFuncSetAttribute((const void*)mk_fwd, hipFuncAttributeMaxDynamicSharedMemorySize, LDS_BYTES) != hipSuccess) { fprintf(stderr, "kernel_launch: hipFuncSetAttribute failed\n"); grid = -1; return; }
        if (hipOccupancyMaxActiveBlocksPerMultiprocessor(&per_cu, (const void*)mk_fwd, NTHR, LDS_BYTES) != hipSuccess || per_cu < 1) fprintf(stderr, "kernel_launch: occupancy query reports %d\n", per_cu);
        (void)hipGetLastError();
        grid = cus < 256 ? cus : 256;
    }
    if (grid < 0) return;
    if (hipMemsetAsync((char*)d_ws + WS_CTL, 0, CTL_ZERO_BYTES, stream) != hipSuccess) return;
    Args a{};
    for (int i = 0; i < 33; ++i) a.in[i] = (const float*)d_in[i];
    a.out = (float*)d_out; a.ws = (unsigned char*)d_ws; a.pad = 0;
    if (MK_N_LAUNCHES == 1) {
        a.ph_lo = 0; a.ph_hi = NPHASE; a.use_bar = 1;
        hipLaunchKernelGGL(mk_fwd, dim3(grid), dim3(NTHR), LDS_BYTES, stream, a);
    } else {
        for (int p = 0; p < NPHASE; ++p) { a.ph_lo = p; a.ph_hi = p + 1; a.use_bar = 0; hipLaunchKernelGGL(mk_fwd, dim3(grid), dim3(NTHR), LDS_BYTES, stream, a); }
    }
}
```
